# Optimizing an MI355X kernel written in HIP

```python
import jax
import jax.numpy as jnp
from jax import lax
import numpy as np

D_MODEL = 1024
BATCH = 4
SEQ = 4096
DEPTH = 2

CONV_DIM = 512
CONV_KERNEL = 3
GMLP_DIM = 512
GMLP_GROUPS = 8
GMLP_GROUP_DIM = GMLP_DIM // GMLP_GROUPS
GMLP_CHUNK = 128
MIX_IN_EVEN = 3 * CONV_DIM + 2 * GMLP_DIM
MIX_OUT_EVEN = CONV_DIM + GMLP_DIM
N_HEADS = 8
HEAD_DIM = 128
ROT_DIM = HEAD_DIM // 4
ROPE_THETA = 500000.0
MOBA_BLOCK = 256
MOBA_TOPK = 3
MOBA_Q_CHUNK = 64
D_FF_DENSE = 2816
N_EXPERTS = 8
TOP_K_EXPERTS = 2
D_FF_EXPERT = 3584
EPS = 1e-6
N_EVEN = (DEPTH + 1) // 2
N_ODD = DEPTH // 2

kernel_name = 'hybrid_conv_gmlp_moba_moe_block'


def rms_norm(x, g):
    xf = x.astype(jnp.float32)
    y = xf * lax.rsqrt(jnp.mean(jnp.square(xf), axis=-1, keepdims=True) + EPS)
    return (y * g.astype(jnp.float32)).astype(x.dtype)


def layer_norm(x, g, b):
    xf = x.astype(jnp.float32)
    mu = jnp.mean(xf, axis=-1, keepdims=True)
    var = jnp.mean(jnp.square(xf - mu), axis=-1, keepdims=True)
    y = (xf - mu) * lax.rsqrt(var + EPS) * g.astype(jnp.float32) + b.astype(jnp.float32)
    return y.astype(x.dtype)


def rope_partial(x):
    seq = x.shape[1]
    half = ROT_DIM // 2
    inv_freq = ROPE_THETA ** (-jnp.arange(half, dtype=jnp.float32) / half)
    ang = jnp.arange(seq, dtype=jnp.float32)[:, None] * inv_freq[None, :]
    cos = jnp.cos(ang)[:, None, :]
    sin = jnp.sin(ang)[:, None, :]
    xf = x.astype(jnp.float32)
    x1 = xf[..., :half]
    x2 = xf[..., half:ROT_DIM]
    out = jnp.concatenate([x1 * cos - x2 * sin, x2 * cos + x1 * sin, xf[..., ROT_DIM:]], axis=-1)
    return out.astype(x.dtype)


def conv_gmlp_mixer(h, w_in, conv_w, ln_g, ln_b, w_s, b_s, w_out):
    bsz, seq, _ = h.shape
    proj = h @ w_in
    a_h, a_c, a_b, g_u, g_v = jnp.split(
        proj, [CONV_DIM, 2 * CONV_DIM, 3 * CONV_DIM, 3 * CONV_DIM + GMLP_DIM], axis=-1)
    z = a_c * a_h
    z = lax.conv_general_dilated(
        z, conv_w[:, None, :], window_strides=(1,), padding=[(CONV_KERNEL - 1, 0)],
        dimension_numbers=('NWC', 'WIO', 'NWC'), feature_group_count=CONV_DIM)
    y_a = a_b * z
    v = layer_norm(g_v, ln_g, ln_b)
    n_chunks = seq // GMLP_CHUNK
    v = v.reshape(bsz, n_chunks, GMLP_CHUNK, GMLP_GROUPS, GMLP_GROUP_DIM)
    causal = jnp.tril(jnp.ones((GMLP_CHUNK, GMLP_CHUNK), dtype=bool))
    w_causal = jnp.where(causal, w_s, jnp.zeros((), w_s.dtype))
    mixed = jnp.einsum('gts,bcsgd->bctgd', w_causal, v) + jnp.transpose(b_s)[:, :, None]
    y_b = g_u * mixed.reshape(bsz, seq, GMLP_DIM)
    return jnp.concatenate([y_a, y_b], axis=-1) @ w_out


def moba_attention(q, k, v):
    bsz, n_heads, seq, hd = q.shape
    n_blocks = -(-seq // MOBA_BLOCK)
    pad = n_blocks * MOBA_BLOCK - seq
    widths = ((0, 0), (0, 0), (0, pad), (0, 0))
    kb = jnp.pad(k, widths).reshape(bsz, n_heads, n_blocks, MOBA_BLOCK, hd)
    vb = jnp.pad(v, widths).reshape(bsz, n_heads, n_blocks, MOBA_BLOCK, hd)
    k_mean = jnp.mean(kb.astype(jnp.float32), axis=3)
    gate = jnp.einsum('bhsd,bhnd->bhsn', q.astype(jnp.float32), k_mean)
    q_block = jnp.arange(seq) // MOBA_BLOCK
    past = jnp.arange(n_blocks)[None, :] < q_block[:, None]
    gate = jnp.where(past, gate, -jnp.inf)
    n_sel = min(MOBA_TOPK, n_blocks)
    _, sel_idx = lax.top_k(gate, n_sel)
    sel_valid = sel_idx < q_block[:, None]
    n_chunks = seq // MOBA_Q_CHUNK

    def to_chunks(a):
        a = a.reshape(bsz, n_heads, n_chunks, MOBA_Q_CHUNK, *a.shape[3:])
        return jnp.moveaxis(a, 2, 0)

    starts = jnp.arange(n_chunks) * MOBA_Q_CHUNK
    b_ix = jnp.arange(bsz)[:, None, None, None]
    h_ix = jnp.arange(n_heads)[None, :, None, None]
    scale = hd ** -0.5

    def attend_chunk(args):
        q_c, idx_c, valid_c, start = args
        blk = start // MOBA_BLOCK
        k_own = lax.dynamic_index_in_dim(kb, blk, axis=2, keepdims=False)
        v_own = lax.dynamic_index_in_dim(vb, blk, axis=2, keepdims=False)
        k_sel = kb[b_ix, h_ix, idx_c]
        v_sel = vb[b_ix, h_ix, idx_c]
        s_sel = jnp.einsum('bhqd,bhqnld->bhqnl', q_c, k_sel).reshape(
            bsz, n_heads, MOBA_Q_CHUNK, n_sel * MOBA_BLOCK)
        s_own = jnp.einsum('bhqd,bhld->bhql', q_c, k_own)
        q_pos = start + jnp.arange(MOBA_Q_CHUNK)
        k_pos = blk * MOBA_BLOCK + jnp.arange(MOBA_BLOCK)
        sel_mask = jnp.repeat(valid_c, MOBA_BLOCK, axis=-1)
        own_mask = k_pos[None, :] <= q_pos[:, None]
        s = jnp.concatenate([
            jnp.where(sel_mask, s_sel.astype(jnp.float32) * scale, -jnp.inf),
            jnp.where(own_mask, s_own.astype(jnp.float32) * scale, -jnp.inf)], axis=-1)
        p = jax.nn.softmax(s, axis=-1).astype(v.dtype)
        p_sel = p[..., :n_sel * MOBA_BLOCK].reshape(bsz, n_heads, MOBA_Q_CHUNK, n_sel, MOBA_BLOCK)
        p_own = p[..., n_sel * MOBA_BLOCK:]
        return (jnp.einsum('bhqnl,bhqnld->bhqd', p_sel, v_sel)
                + jnp.einsum('bhql,bhld->bhqd', p_own, v_own))

    out = lax.map(attend_chunk, (to_chunks(q), to_chunks(sel_idx), to_chunks(sel_valid), starts))
    return jnp.moveaxis(out, 0, 2).reshape(bsz, n_heads, seq, hd)


def moba_mixer(h, w_qkv, q_g, k_g, w_o):
    bsz, seq, _ = h.shape
    qkv = (h @ w_qkv).reshape(bsz, seq, 3, N_HEADS, HEAD_DIM)
    q = rope_partial(rms_norm(qkv[:, :, 0], q_g))
    k = rope_partial(rms_norm(qkv[:, :, 1], k_g))
    v = qkv[:, :, 2]
    o = moba_attention(q.transpose(0, 2, 1, 3), k.transpose(0, 2, 1, 3), v.transpose(0, 2, 1, 3))
    o = o.transpose(0, 2, 1, 3).reshape(bsz, seq, N_HEADS * HEAD_DIM)
    return o @ w_o


def swiglu(h, w_gate, w_up, w_down):
    return (jax.nn.silu(h @ w_gate) * (h @ w_up)) @ w_down


def moe_swiglu(h, w_router, w_gate, w_up, w_down):
    logits = (h @ w_router).astype(jnp.float32)
    top_v, top_i = lax.top_k(logits, TOP_K_EXPERTS)
    probs = jax.nn.softmax(top_v, axis=-1)
    gates = jnp.sum(jax.nn.one_hot(top_i, N_EXPERTS, dtype=jnp.float32) * probs[..., None], axis=-2)
    gates = gates.astype(h.dtype)
    y = jnp.zeros_like(h)
    for e in range(N_EXPERTS):
        y = y + gates[..., e:e + 1] * swiglu(h, w_gate[e], w_up[e], w_down[e])
    return y


def setup_inputs(seed: int = 0) -> dict:
    key = jax.random.key(seed)
    ks = jax.random.split(key, 24)

    def nrm(k, shape, scale):
        return jax.random.normal(k, shape, jnp.float32) * scale

    def gain(k, shape):
        return 1.0 + 0.02 * jax.random.normal(k, shape, jnp.float32)

    return {
        'x': nrm(ks[0], (BATCH, SEQ, D_MODEL), 1.0),
        'e_mix_norm': gain(ks[1], (N_EVEN, D_MODEL)),
        'e_w_in': nrm(ks[2], (N_EVEN, D_MODEL, MIX_IN_EVEN), D_MODEL ** -0.5),
        'e_conv_w': nrm(ks[3], (N_EVEN, CONV_KERNEL, CONV_DIM), CONV_KERNEL ** -0.5),
        'e_gmlp_ln_g': gain(ks[4], (N_EVEN, GMLP_DIM)),
        'e_gmlp_ln_b': nrm(ks[5], (N_EVEN, GMLP_DIM), 0.02),
        'e_w_spatial': nrm(ks[6], (N_EVEN, GMLP_GROUPS, GMLP_CHUNK, GMLP_CHUNK), GMLP_CHUNK ** -0.5),
        'e_b_spatial': gain(ks[7], (N_EVEN, GMLP_GROUPS, GMLP_CHUNK)),
        'e_w_out': nrm(ks[8], (N_EVEN, MIX_OUT_EVEN, D_MODEL), MIX_OUT_EVEN ** -0.5),
        'e_ffn_norm': gain(ks[9], (N_EVEN, D_MODEL)),
        'e_w_gate': nrm(ks[10], (N_EVEN, D_MODEL, D_FF_DENSE), D_MODEL ** -0.5),
        'e_w_up': nrm(ks[11], (N_EVEN, D_MODEL, D_FF_DENSE), D_MODEL ** -0.5),
        'e_w_down': nrm(ks[12], (N_EVEN, D_FF_DENSE, D_MODEL), D_FF_DENSE ** -0.5),
        'o_mix_norm': gain(ks[13], (N_ODD, D_MODEL)),
        'o_w_qkv': nrm(ks[14], (N_ODD, D_MODEL, 3 * N_HEADS * HEAD_DIM), D_MODEL ** -0.5),
        'o_q_norm': gain(ks[15], (N_ODD, HEAD_DIM)),
        'o_k_norm': gain(ks[16], (N_ODD, HEAD_DIM)),
        'o_w_o': nrm(ks[17], (N_ODD, N_HEADS * HEAD_DIM, D_MODEL), (N_HEADS * HEAD_DIM) ** -0.5),
        'o_ffn_norm': gain(ks[18], (N_ODD, D_MODEL)),
        'o_w_router': nrm(ks[19], (N_ODD, D_MODEL, N_EXPERTS), D_MODEL ** -0.5),
        'o_w_gate': nrm(ks[20], (N_ODD, N_EXPERTS, D_MODEL, D_FF_EXPERT), D_MODEL ** -0.5),
        'o_w_up': nrm(ks[21], (N_ODD, N_EXPERTS, D_MODEL, D_FF_EXPERT), D_MODEL ** -0.5),
        'o_w_down': nrm(ks[22], (N_ODD, N_EXPERTS, D_FF_EXPERT, D_MODEL), D_FF_EXPERT ** -0.5),
    }


def reference(x, e_mix_norm, e_w_in, e_conv_w, e_gmlp_ln_g, e_gmlp_ln_b, e_w_spatial,
              e_b_spatial, e_w_out, e_ffn_norm, e_w_gate, e_w_up, e_w_down,
              o_mix_norm, o_w_qkv, o_q_norm, o_k_norm, o_w_o, o_ffn_norm, o_w_router,
              o_w_gate, o_w_up, o_w_down):
    h = x
    for layer in range(DEPTH):
        i = layer // 2
        if layer % 2 == 0:
            h = h + conv_gmlp_mixer(rms_norm(h, e_mix_norm[i]), e_w_in[i], e_conv_w[i],
                                    e_gmlp_ln_g[i], e_gmlp_ln_b[i], e_w_spatial[i],
                                    e_b_spatial[i], e_w_out[i])
            h = h + swiglu(rms_norm(h, e_ffn_norm[i]), e_w_gate[i], e_w_up[i], e_w_down[i])
        else:
            h = h + moba_mixer(rms_norm(h, o_mix_norm[i]), o_w_qkv[i], o_q_norm[i],
                               o_k_norm[i], o_w_o[i])
            h = h + moe_swiglu(rms_norm(h, o_ffn_norm[i]), o_w_router[i], o_w_gate[i],
                               o_w_up[i], o_w_down[i])
    return h
```

```cpp
#include <hip/hip_runtime.h>
#include <hip/hip_cooperative_groups.h>
#include <cstdio>
#include <cstdint>

#define LAS __attribute__((address_space(3)))
typedef unsigned short bf16_t;
typedef short bf16x8 __attribute__((ext_vector_type(8)));
typedef float f32x4 __attribute__((ext_vector_type(4)));
typedef float f32x2 __attribute__((ext_vector_type(2)));
typedef unsigned u32x4 __attribute__((ext_vector_type(4)));
typedef unsigned u32x2 __attribute__((ext_vector_type(2)));

constexpr int T = 16384, D = 1024, SEQ = 4096, NBATCH = 4;
constexpr int CONV = 512, GM = 512, NPROJ = 2560;
constexpr int FF = 2816, NGU = 2 * FF;
constexpr int NH = 8, HD = 128, NQKV = 3072;
constexpr int NE = 8, FE = 3584, NGUE = 2 * FE;
constexpr int MB = 256, NBLK = SEQ / MB;
constexpr float EPS = 1e-6f;

constexpr size_t al256(size_t x) { return (x + 255) & ~(size_t)255; }
constexpr size_t WS_CTL = 0;
constexpr int NSS = 16;
constexpr size_t WS_SS0 = 4096;
constexpr size_t WS_SS1 = WS_SS0 + (size_t)T * NSS * 4;
constexpr size_t WS_SS2 = WS_SS1 + (size_t)T * NSS * 4;
constexpr size_t WS_SS3 = WS_SS2 + (size_t)T * NSS * 4;
constexpr size_t WS_ROPE = WS_SS3 + (size_t)T * NSS * 4;
constexpr size_t WS_KMEAN = WS_ROPE + (size_t)SEQ * 16 * 2 * 4;
constexpr size_t WS_TOKOF = WS_KMEAN + (size_t)NBATCH * NH * NBLK * HD * 4;
constexpr size_t WS_GATEOF = WS_TOKOF + (size_t)NE * T * 4;
constexpr size_t WS_W = al256(WS_GATEOF + (size_t)NE * T * 4);
constexpr size_t WS_WIN = WS_W;
constexpr size_t WS_WOUT = WS_WIN + (size_t)NPROJ * D * 2;
constexpr size_t WS_WGU = WS_WOUT + (size_t)D * D * 2;
constexpr size_t WS_WDN = WS_WGU + (size_t)NGU * D * 2;
constexpr size_t WS_WQKV = WS_WDN + (size_t)D * FF * 2;
constexpr size_t WS_WO = WS_WQKV + (size_t)NQKV * D * 2;
constexpr size_t WS_MGU = WS_WO + (size_t)D * D * 2;
constexpr size_t WS_MDN = WS_MGU + (size_t)NE * NGUE * D * 2;
constexpr size_t WS_ARENA = WS_MDN + (size_t)NE * D * FE * 2;
constexpr size_t SZ_TD2 = (size_t)T * D * 2;
constexpr size_t AR_XB = 0, AR_PROJ = SZ_TD2, AR_Y = 0, AR_H1B = SZ_TD2, AR_ACT = 2 * SZ_TD2, AR_H2B = 0, AR_QKV = SZ_TD2,
                 AR_O = SZ_TD2 + (size_t)T * NQKV * 2, AR_H3B = 0, AR_MACT = SZ_TD2;
constexpr size_t WS_END = WS_ARENA + SZ_TD2 + (size_t)(2 * T + 256) * FE * 2;
static_assert(AR_ACT + (size_t)T * FF * 2 <= SZ_TD2 + (size_t)2 * T * FE * 2, "arena");
static_assert(WS_END <= 486079488ull, "workspace budget");

__device__ __forceinline__ unsigned f2bf(float f) { unsigned u = __builtin_bit_cast(unsigned, f); return (u + 0x7fffu + ((u >> 16) & 1u)) >> 16; }
__device__ __forceinline__ float bf2f(unsigned b) { return __builtin_bit_cast(float, b << 16); }
__device__ __forceinline__ unsigned pk2(float lo, float hi) { return f2bf(lo) | (f2bf(hi) << 16); }
__device__ __forceinline__ unsigned cvt_pk_bf16(float lo, float hi) { unsigned r; asm volatile("v_cvt_pk_bf16_f32 %0, %1, %2" : "=v"(r) : "v"(lo), "v"(hi)); return r; }
__device__ __forceinline__ float wave_sum(float v) {
#pragma unroll
    for (int o = 1; o < 64; o <<= 1) v += __shfl_xor(v, o);
    return v;
}
__device__ __forceinline__ float row_rscale(const float* ssp, int row) {
    const f32x4* p = (const f32x4*)(ssp + (size_t)row * NSS); const f32x4 a = p[0], b = p[1], c = p[2], d = p[3];
    const float s = (((a[0] + a[1]) + (a[2] + a[3])) + ((b[0] + b[1]) + (b[2] + b[3]))) + (((c[0] + c[1]) + (c[2] + c[3])) + ((d[0] + d[1]) + (d[2] + d[3])));
    return rsqrtf(s * (1.0f / D) + EPS);
}
__device__ __forceinline__ float silu_f(float g) { return g * __frcp_rn(1.0f + __expf(-g)); }

namespace pg8 {
constexpr int BM = 256, BK = 64, HALF = 128, HTB = HALF * BK * 2, STAGE_BYTES = 8 * HTB, NXCD = 8, WGM = 8;
__host__ __device__ __forceinline__ int lds_byte(int r, int c) { const int st = (r >> 4) * 2 + (c >> 5), rr = r & 15, cc = c & 31, ob = rr * 64 + cc * 2; return st * 1024 + (ob ^ (((ob >> 9) & 1) << 5)); }
__host__ __device__ __forceinline__ void stage_rc(int b, int& R, int& C) { const int st = b / 1024, sb = b % 1024, swz = sb ^ (((sb >> 9) & 1) << 5); R = (st >> 1) * 16 + swz / 64; C = (st & 1) * 32 + (swz % 64) / 2; }
__host__ __device__ __forceinline__ int perm32(int rho) { const int n = rho >> 4, i = rho & 15; return 8 * (i >> 2) + 4 * n + (i & 3); }

struct Unit { int row0, pn, e, nvalid; };

struct DenseOrder {
    int nM, nN, nwg, G, c;
    __device__ void init(int M, int N, int G_, int c_) { nM = M / BM; nN = N / BM; nwg = nM * nN; G = G_; c = c_; }
    __device__ __forceinline__ bool next(int i, Unit& u) const {
        const long L = (long)i * G + c; if (L >= nwg) return false;
        int wgid = (int)L; { const int q = nwg / NXCD, r = nwg % NXCD, xcd = wgid % NXCD, off = wgid / NXCD; wgid = (xcd < r ? xcd * (q + 1) : r * (q + 1) + (xcd - r) * q) + off; }
        const int nig = WGM * nN, gid = wgid / nig, fm = gid * WGM, gsz = (nM - fm) < WGM ? (nM - fm) : WGM;
        u.row0 = (fm + ((wgid % nig) % gsz)) * BM; u.pn = (wgid % nig) / gsz; u.e = 0; u.nvalid = BM; return true;
    }
    __device__ __forceinline__ int src_row(const Unit& u, int r) const { return u.row0 + r; }
    __device__ __forceinline__ size_t b_off(const Unit&) const { return 0; }
};
struct MoeOrder {
    const LAS int* tb; const int* tokof; int nN, G, c; bool gather; size_t bstride;
    __device__ __forceinline__ bool next(int i, Unit& u) const {
        const long L = (long)i * G + c; const int nwg = tb[8]; if (L >= nwg) return false;
        int wgid = (int)L; { const int q = nwg / NXCD, r = nwg % NXCD, xcd = wgid % NXCD, off = wgid / NXCD; wgid = (xcd < r ? xcd * (q + 1) : r * (q + 1) + (xcd - r) * q) + off; }
        int e = 0;
#pragma unroll
        for (int j = 1; j < 8; ++j) e += (wgid >= tb[j]) ? 1 : 0;
        const int w = wgid - tb[e], cnt = tb[32 + e], nM = (cnt + BM - 1) / BM;
        const int nig = WGM * nN, gid = w / nig, fm = gid * WGM, gsz = (nM - fm) < WGM ? (nM - fm) : WGM;
        const int pm = fm + ((w % nig) % gsz); u.pn = (w % nig) / gsz; u.e = e; u.row0 = pm * BM; u.nvalid = (cnt - pm * BM) < BM ? (cnt - pm * BM) : BM; return true;
    }
    __device__ __forceinline__ int src_row(const Unit& u, int r) const {
        if (gather) return (r < u.nvalid) ? tokof[u.e * T + u.row0 + r] : 0;
        return tb[16 + u.e] + u.row0 + r;
    }
    __device__ __forceinline__ size_t b_off(const Unit& u) const { return (size_t)u.e * bstride; }
};

struct EpiScaleBf16 {
    static constexpr bool PERM = true;
    bf16_t* O; int ldc; const float* ss;
    __device__ __forceinline__ void operator()(const f32x4 (&acc)[2][2][4][2], const Unit& u, int wr, int wc, int fr, int fq) const {
        const int col0 = u.pn * BM + wc * 32 + 8 * fq;
#pragma unroll
        for (int ai = 0; ai < 2; ++ai)
#pragma unroll
            for (int m = 0; m < 4; ++m) { const int row = u.row0 + ai * HALF + wr * 64 + m * 16 + fr; const float r = row_rscale(ss, row);
                bf16_t* rowp = O + (size_t)row * ldc + col0;
#pragma unroll
                for (int bj = 0; bj < 2; ++bj) { const f32x4 v0 = acc[ai][bj][m][0] * r, v1 = acc[ai][bj][m][1] * r;
                    u32x4 w; w.x = cvt_pk_bf16(v0[0], v0[1]); w.y = cvt_pk_bf16(v0[2], v0[3]); w.z = cvt_pk_bf16(v1[0], v1[1]); w.w = cvt_pk_bf16(v1[2], v1[3]);
                    *(u32x4*)(rowp + bj * HALF) = w; } }
    }
};
struct EpiSwiglu {
    static constexpr bool PERM = true;
    bf16_t* O; int ldc; const float* ss; const int* tokof; const LAS int* tb; bool moe;
    __device__ __forceinline__ void operator()(const f32x4 (&acc)[2][2][4][2], const Unit& u, int wr, int wc, int fr, int fq) const {
        const int col0 = u.pn * HALF + wc * 32 + 8 * fq;
#pragma unroll
        for (int ai = 0; ai < 2; ++ai)
#pragma unroll
            for (int m = 0; m < 4; ++m) { const int tr = ai * HALF + wr * 64 + m * 16 + fr; int srow, orow; bool ok = true;
                if (moe) { ok = tr < u.nvalid; srow = ok ? tokof[u.e * T + u.row0 + tr] : 0; orow = tb[16 + u.e] + u.row0 + tr; } else { srow = u.row0 + tr; orow = srow; }
                const float r = row_rscale(ss, srow);
                f32x4 a[2];
#pragma unroll
                for (int n = 0; n < 2; ++n) { const f32x4 g = acc[ai][0][m][n] * r, up = acc[ai][1][m][n] * r;
#pragma unroll
                    for (int j = 0; j < 4; ++j) a[n][j] = silu_f(g[j]) * up[j]; }
                u32x4 w; w.x = cvt_pk_bf16(a[0][0], a[0][1]); w.y = cvt_pk_bf16(a[0][2], a[0][3]); w.z = cvt_pk_bf16(a[1][0], a[1][1]); w.w = cvt_pk_bf16(a[1][2], a[1][3]);
                if (ok) *(u32x4*)(O + (size_t)orow * ldc + col0) = w; }
    }
};
struct EpiResid {
    static constexpr bool PERM = false;
    const float* base; float* out; bf16_t* hb; float* ssout;
    __device__ __forceinline__ void operator()(const f32x4 (&acc)[2][2][4][2], const Unit& u, int wr, int wc, int fr, int fq) const {
        const int col0 = u.pn * BM + wc * 32 + 4 * fq;
#pragma unroll
        for (int ai = 0; ai < 2; ++ai)
#pragma unroll
            for (int m = 0; m < 4; ++m) { const int row = u.row0 + ai * HALF + wr * 64 + m * 16 + fr; const size_t off = (size_t)row * D + col0; float q = 0.f;
#pragma unroll
                for (int bj = 0; bj < 2; ++bj)
#pragma unroll
                    for (int n = 0; n < 2; ++n) { const f32x4 b = *(const f32x4*)(base + off + bj * HALF + n * 16); const f32x4 h = b + acc[ai][bj][m][n];
                        *(f32x4*)(out + off + bj * HALF + n * 16) = h; q += (h[0] * h[0] + h[1] * h[1]) + (h[2] * h[2] + h[3] * h[3]);
                        u32x2 w; w.x = cvt_pk_bf16(h[0], h[1]); w.y = cvt_pk_bf16(h[2], h[3]); *(u32x2*)(hb + off + bj * HALF + n * 16) = w; }
                q += __shfl_xor(q, 16); q += __shfl_xor(q, 32);
                if (fq == 0) ssout[(size_t)row * NSS + u.pn * 4 + wc] = q;
                asm volatile("" ::: "memory"); }
    }
};
struct EpiMoeDown {
    static constexpr bool PERM = false;
    float* out; const int* tokof; const float* gateof;
    __device__ __forceinline__ void operator()(const f32x4 (&acc)[2][2][4][2], const Unit& u, int wr, int wc, int fr, int fq) const {
        const int col0 = u.pn * BM + wc * 32 + 4 * fq;
#pragma unroll
        for (int ai = 0; ai < 2; ++ai)
#pragma unroll
            for (int m = 0; m < 4; ++m) { const int tr = ai * HALF + wr * 64 + m * 16 + fr; const bool ok = tr < u.nvalid;
                const int tok = ok ? tokof[u.e * T + u.row0 + tr] : 0; const float gt = ok ? gateof[u.e * T + u.row0 + tr] : 0.f;
                float* rowp = out + (size_t)tok * D + col0;
                if (ok) {
#pragma unroll
                    for (int bj = 0; bj < 2; ++bj)
#pragma unroll
                        for (int n = 0; n < 2; ++n)
#pragma unroll
                            for (int j = 0; j < 4; ++j) __hip_atomic_fetch_add(rowp + bj * HALF + n * 16 + j, gt * acc[ai][bj][m][n][j], __ATOMIC_RELAXED, __HIP_MEMORY_SCOPE_AGENT); } }
    }
};

template <class Epi, class Sched>
__device__ __forceinline__ void gemm_naive(const bf16_t* A, const bf16_t* Bt, int K, const Sched& S, const Epi& E) {
    const int tid = threadIdx.x, wid = __builtin_amdgcn_readfirstlane(tid >> 6), lane = tid & 63, wr = wid >> 2, wc = wid & 3, fr = lane & 15, fq = lane >> 4;
    Unit u;
    for (int ui = 0; S.next(ui, u); ++ui) {
        f32x4 acc[2][2][4][2];
#pragma unroll
        for (int a = 0; a < 2; ++a)
#pragma unroll
            for (int b = 0; b < 2; ++b)
#pragma unroll
                for (int m = 0; m < 4; ++m)
#pragma unroll
                    for (int n = 0; n < 2; ++n) acc[a][b][m][n] = (f32x4){0.f, 0.f, 0.f, 0.f};
        const bf16_t* ap[2][4]; const bf16_t* bp[2][2];
#pragma unroll
        for (int ai = 0; ai < 2; ++ai)
#pragma unroll
            for (int m = 0; m < 4; ++m) ap[ai][m] = A + (size_t)S.src_row(u, ai * HALF + wr * 64 + m * 16 + fr) * K + fq * 8;
#pragma unroll
        for (int bj = 0; bj < 2; ++bj)
#pragma unroll
            for (int n = 0; n < 2; ++n) { const int rho = 16 * n + fr; bp[bj][n] = Bt + S.b_off(u) + (size_t)(u.pn * BM + bj * HALF + wc * 32 + (Epi::PERM ? perm32(rho) : rho)) * K + fq * 8; }
        for (int k0 = 0; k0 < K; k0 += 32) {
            bf16x8 bf[2][2];
#pragma unroll
            for (int bj = 0; bj < 2; ++bj)
#pragma unroll
                for (int n = 0; n < 2; ++n) bf[bj][n] = *(const bf16x8*)(bp[bj][n] + k0);
#pragma unroll
            for (int ai = 0; ai < 2; ++ai)
#pragma unroll
                for (int m = 0; m < 4; ++m) { const bf16x8 af = *(const bf16x8*)(ap[ai][m] + k0);
#pragma unroll
                    for (int bj = 0; bj < 2; ++bj)
#pragma unroll
                        for (int n = 0; n < 2; ++n) acc[ai][bj][m][n] = __builtin_amdgcn_mfma_f32_16x16x32_bf16(bf[bj][n], af, acc[ai][bj][m][n], 0, 0, 0); }
        }
        E(acc, u, wr, wc, fr, fq);
    }
}
}

__global__ void __launch_bounds__(256) k_prep_w(const float* W, int K, int N, bf16_t* Wt, const float* fold, int inter, int which, size_t src_bstride, size_t dst_bstride) {
    __shared__ float tile[32][33];
    W += (size_t)blockIdx.z * src_bstride; Wt += (size_t)blockIdx.z * dst_bstride;
    const int n0 = blockIdx.x * 32, k0 = blockIdx.y * 32, tx = threadIdx.x & 31, ty = threadIdx.x >> 5;
    for (int i = ty; i < 32; i += 8) tile[i][tx] = W[(size_t)(k0 + i) * N + n0 + tx] * (fold ? fold[k0 + i] : 1.0f);
    __syncthreads();
    for (int i = ty; i < 32; i += 8) { const int n = n0 + i; const int dr = inter ? (n / 128) * 256 + which * 128 + (n % 128) : n;
        Wt[(size_t)dr * K + k0 + tx] = (bf16_t)f2bf(tile[tx][i]); }
}
__global__ void __launch_bounds__(256) k_rowprep(const float* x, bf16_t* xb, float* ss0, float* ss1, float* ss2, float* ss3, int* cnt) {
    const int lane = threadIdx.x & 63, gw = (blockIdx.x * blockDim.x + threadIdx.x) >> 6, ngw = (gridDim.x * blockDim.x) >> 6;
    if (blockIdx.x == 0 && threadIdx.x < 64) cnt[threadIdx.x] = 0;
    for (int row = gw; row < T; row += ngw) {
        const f32x4* xr = (const f32x4*)(x + (size_t)row * D) + lane; float s = 0.f; u32x2* o = (u32x2*)(xb + (size_t)row * D) + lane;
#pragma unroll
        for (int j = 0; j < 4; ++j) { const f32x4 v = xr[64 * j]; s += (v[0] * v[0] + v[1] * v[1]) + (v[2] * v[2] + v[3] * v[3]); u32x2 w; w.x = pk2(v[0], v[1]); w.y = pk2(v[2], v[3]); o[64 * j] = w; }
        s = wave_sum(s);
        if (lane < NSS) ss0[(size_t)row * NSS + lane] = (lane == 0) ? s : 0.f;
    }
}
__global__ void k_rope_table(float* tab) {
    const int i = blockIdx.x * blockDim.x + threadIdx.x; if (i >= SEQ * 16) return;
    const int s = i / 16, f = i % 16; const double inv = pow(500000.0, -(double)f / 16.0); const double ang = (double)s * inv;
    tab[2 * i] = (float)cos(ang); tab[2 * i + 1] = (float)sin(ang);
}
__global__ void __launch_bounds__(256) k_mixer_naive(const bf16_t* proj, const float* conv_w, const float* ln_g, const float* ln_b, const float* w_s, const float* b_s, bf16_t* y) {
    __shared__ float vn[128][65]; __shared__ float mu[128], rstd[128];
    const int c = blockIdx.x, p = blockIdx.y, tid = threadIdx.x, t0 = c * 128;
    for (int i = tid; i < 128 * 64; i += 256) { const int tt = i / 64, ch = 64 * p + (i % 64), t = t0 + tt, s = t % SEQ; float z = 0.f;
        for (int k = 0; k < 3; ++k) { const int sp = s - 2 + k; if (sp >= 0) { const bf16_t* pr = proj + (size_t)(t - 2 + k) * NPROJ; z += conv_w[k * CONV + ch] * (bf2f(pr[CONV + ch]) * bf2f(pr[ch])); } }
        y[(size_t)t * D + ch] = (bf16_t)f2bf(bf2f(proj[(size_t)t * NPROJ + 2 * CONV + ch]) * z); }
    { const int tt = tid >> 1, hf = tid & 1; const bf16_t* pr = proj + (size_t)(t0 + tt) * NPROJ + 3 * CONV + GM + hf * 256; float s = 0.f, q = 0.f;
      for (int j = 0; j < 256; ++j) { const float v = bf2f(pr[j]); s += v; }
      s += __shfl_xor(s, 1); const float m = s * (1.0f / GM);
      for (int j = 0; j < 256; ++j) { const float v = bf2f(pr[j]) - m; q += v * v; }
      q += __shfl_xor(q, 1); if (hf == 0) { mu[tt] = m; rstd[tt] = rsqrtf(q * (1.0f / GM) + EPS); } }
    __syncthreads();
    for (int i = tid; i < 128 * 64; i += 256) { const int tt = i / 64, d = i % 64, ch = 64 * p + d; const float v = bf2f(proj[(size_t)(t0 + tt) * NPROJ + 3 * CONV + GM + ch]);
        vn[tt][d] = (v - mu[tt]) * rstd[tt] * ln_g[ch] + ln_b[ch]; }
    __syncthreads();
    { const int d = tid & 63;
      for (int tt = tid >> 6; tt < 128; tt += 4) { float a = b_s[p * 128 + tt]; const float* wr = w_s + ((size_t)p * 128 + tt) * 128;
          for (int s = 0; s <= tt; ++s) a += wr[s] * vn[s][d];
          const int t = t0 + tt; y[(size_t)t * D + CONV + 64 * p + d] = (bf16_t)f2bf(bf2f(proj[(size_t)t * NPROJ + 3 * CONV + 64 * p + d]) * a); } }
}
__global__ void __launch_bounds__(256) k_qkprep_naive(bf16_t* qkv, const float* qg, const float* kg, const float* rope) {
    const int lane = threadIdx.x & 63, i = (blockIdx.x * blockDim.x + threadIdx.x) >> 6; if (i >= T * NH * 2) return;
    const int which = i & 1, h = (i >> 1) & 7, t = i >> 4, s = t % SEQ; bf16_t* p = qkv + (size_t)t * NQKV + which * D + h * HD; const float* g = which ? kg : qg;
    float v0 = bf2f(p[lane]), v1 = bf2f(p[lane + 64]);
    const float q = wave_sum(v0 * v0 + v1 * v1), r = rsqrtf(q * (1.0f / HD) + EPS);
    v0 = v0 * r * g[lane]; v1 = v1 * r * g[lane + 64];
    const float partner = __shfl_xor(v0, 16); const int f = lane & 15; const float cs = rope[(s * 16 + f) * 2], sn = rope[(s * 16 + f) * 2 + 1];
    if (lane < 16) v0 = v0 * cs - partner * sn; else if (lane < 32) v0 = v0 * cs + partner * sn;
    p[lane] = (bf16_t)f2bf(v0); p[lane + 64] = (bf16_t)f2bf(v1);
}
__global__ void __launch_bounds__(128) k_kmean_naive(const bf16_t* qkv, float* kmean) {
    const int bhn = blockIdx.x, n = bhn % NBLK, h = (bhn / NBLK) % NH, b = bhn / (NBLK * NH), d = threadIdx.x; float s = 0.f;
    for (int j = 0; j < MB; ++j) s += bf2f(qkv[(size_t)(b * SEQ + n * MB + j) * NQKV + D + h * HD + d]);
    kmean[(size_t)bhn * HD + d] = s * (1.0f / MB);
}
__global__ void __launch_bounds__(256) k_attn_naive(const bf16_t* qkv, const float* kmean, bf16_t* o) {
    __shared__ float qs[4][HD]; __shared__ float ps[4][4 * MB];
    const int w = threadIdx.x >> 6, lane = threadIdx.x & 63, gq = blockIdx.x * 4 + w;
    const int h = gq % NH, t = gq / NH, b = t / SEQ, s = t % SEQ, qb = s / MB;
    const bf16_t* qp = qkv + (size_t)t * NQKV + h * HD; qs[w][lane] = bf2f(qp[lane]); qs[w][lane + 64] = bf2f(qp[lane + 64]);
    __syncthreads();
    float mygate = -INFINITY;
    for (int n = 0; n < qb; ++n) { const float* km = kmean + ((size_t)(b * NH + h) * NBLK + n) * HD; float a = qs[w][lane] * km[lane] + qs[w][lane + 64] * km[lane + 64]; a = wave_sum(a); if (lane == n) mygate = a; }
    int sel0 = -1, sel1 = -1, sel2 = -1; const int nsel = qb < 3 ? qb : 3;
#pragma unroll
    for (int j = 0; j < 3; ++j) { float bv = mygate; int bi = lane;
#pragma unroll
        for (int o2 = 1; o2 < 64; o2 <<= 1) { const float ov = __shfl_xor(bv, o2); const int oi = __shfl_xor(bi, o2); if (ov > bv || (ov == bv && oi < bi)) { bv = ov; bi = oi; } }
        if (j == 0) sel0 = bi; if (j == 1) sel1 = bi; if (j == 2) sel2 = bi;
        if (lane == bi) mygate = -INFINITY; }
    const float scale = 0.08838834764831845f;
    float mx = -INFINITY;
    for (int j = 0; j < 4; ++j) { const bool val = (j < 3) ? (j < nsel) : true; const int blk = (j == 0) ? sel0 : (j == 1) ? sel1 : (j == 2) ? sel2 : qb;
        for (int i = 0; i < 4; ++i) { const int kk = lane + 64 * i; float sc = -INFINITY;
            if (val && (j < 3 || blk * MB + kk <= s)) { const bf16_t* kp = qkv + (size_t)(b * SEQ + blk * MB + kk) * NQKV + D + h * HD; float a = 0.f; for (int d = 0; d < HD; ++d) a += qs[w][d] * bf2f(kp[d]); sc = a * scale; }
            ps[w][j * MB + kk] = sc; mx = fmaxf(mx, sc); } }
#pragma unroll
    for (int o2 = 1; o2 < 64; o2 <<= 1) mx = fmaxf(mx, __shfl_xor(mx, o2));
    float sum = 0.f;
    for (int i = lane; i < 4 * MB; i += 64) { const float e = (ps[w][i] == -INFINITY) ? 0.f : __expf(ps[w][i] - mx); ps[w][i] = e; sum += e; }
    sum = wave_sum(sum); const float inv = 1.0f / sum;
    __syncthreads();
    float a0 = 0.f, a1 = 0.f;
    for (int j = 0; j < 4; ++j) { const bool val = (j < 3) ? (j < nsel) : true; if (!val) continue; const int blk = (j == 0) ? sel0 : (j == 1) ? sel1 : (j == 2) ? sel2 : qb; const int nk = (j < 3) ? MB : (s - qb * MB + 1);
        for (int kk = 0; kk < nk; ++kk) { const float p = ps[w][j * MB + kk]; const bf16_t* vp = qkv + (size_t)(b * SEQ + blk * MB + kk) * NQKV + 2 * D + h * HD; a0 += p * bf2f(vp[lane]); a1 += p * bf2f(vp[lane + 64]); } }
    o[(size_t)t * D + h * HD + lane] = (bf16_t)f2bf(a0 * inv); o[(size_t)t * D + h * HD + lane + 64] = (bf16_t)f2bf(a1 * inv);
}
__global__ void __launch_bounds__(256) k_router_naive(const float* h3, const float* ss3, const float* g, const float* wr, int* cnt, int* tokof, float* gateof) {
    const int lane = threadIdx.x & 63, t = (blockIdx.x * blockDim.x + threadIdx.x) >> 6; if (t >= T) return;
    const float r = row_rscale(ss3, t); float lg[NE];
#pragma unroll
    for (int e = 0; e < NE; ++e) lg[e] = 0.f;
    for (int j = 0; j < 16; ++j) { const int c = lane + 64 * j; const float xn = h3[(size_t)t * D + c] * r * g[c];
#pragma unroll
        for (int e = 0; e < NE; ++e) lg[e] += xn * wr[c * NE + e]; }
#pragma unroll
    for (int e = 0; e < NE; ++e) lg[e] = wave_sum(lg[e]);
    if (lane == 0) { int e1 = 0; float v1 = lg[0];
#pragma unroll
        for (int e = 1; e < NE; ++e) if (lg[e] > v1) { v1 = lg[e]; e1 = e; }
        int e2 = -1; float v2 = -INFINITY;
#pragma unroll
        for (int e = 0; e < NE; ++e) if (e != e1 && lg[e] > v2) { v2 = lg[e]; e2 = e; }
        const float p1 = 1.0f / (1.0f + __expf(v2 - v1)), p2 = 1.0f - p1;
        const int q1 = atomicAdd(cnt + e1, 1), q2 = atomicAdd(cnt + e2, 1);
        tokof[e1 * T + q1] = t; gateof[e1 * T + q1] = p1; tokof[e2 * T + q2] = t; gateof[e2 * T + q2] = p2; }
}

__device__ __forceinline__ void moe_tables(LAS int* tb, const int* cnt, int nN) {
    if (threadIdx.x == 0) { int cu = 0, off = 0; for (int e = 0; e < NE; ++e) { const int c = cnt[e]; tb[e] = cu; tb[16 + e] = off; tb[32 + e] = c; cu += ((c + 255) / 256) * nN; off += c; } tb[8] = cu; tb[24] = off; }
    __syncthreads();
}
template <int WHICH>
__global__ void __launch_bounds__(512) k_gemm(const bf16_t* A, const bf16_t* Bt, int N, int K, void* o1, void* o2, const float* ss, float* ssout, const float* base, const int* cnt, const int* tokof, const float* gateof) {
    __shared__ int tbs[48]; LAS int* tb = (LAS int*)tbs;
    if constexpr (WHICH == 0) { pg8::DenseOrder S; S.init(T, N, gridDim.x, blockIdx.x); pg8::EpiScaleBf16 E{(bf16_t*)o1, N, ss}; pg8::gemm_naive(A, Bt, K, S, E); }
    if constexpr (WHICH == 1) { pg8::DenseOrder S; S.init(T, N, gridDim.x, blockIdx.x); pg8::EpiResid E{base, (float*)o1, (bf16_t*)o2, ssout}; pg8::gemm_naive(A, Bt, K, S, E); }
    if constexpr (WHICH == 2) { pg8::DenseOrder S; S.init(T, N, gridDim.x, blockIdx.x); pg8::EpiSwiglu E{(bf16_t*)o1, N / 2, ss, nullptr, tb, false}; pg8::gemm_naive(A, Bt, K, S, E); }
    if constexpr (WHICH == 3) { moe_tables(tb, cnt, N / 256); pg8::MoeOrder S{tb, tokof, N / 256, (int)gridDim.x, (int)blockIdx.x, true, (size_t)N * K}; pg8::EpiSwiglu E{(bf16_t*)o1, N / 2, ss, tokof, tb, true}; pg8::gemm_naive(A, Bt, K, S, E); }
    if constexpr (WHICH == 4) { moe_tables(tb, cnt, N / 256); pg8::MoeOrder S{tb, tokof, N / 256, (int)gridDim.x, (int)blockIdx.x, false, (size_t)N * K}; pg8::EpiMoeDown E{(float*)o1, tokof, gateof}; pg8::gemm_naive(A, Bt, K, S, E); }
}

extern "C" void kernel_launch(void* const* d_in, const int* in_sizes, int n_in, void* d_out, int out_size, void* d_ws, size_t ws_size, hipStream_t stream) {
    if (n_in != 23 || out_size != T * D || ws_size < WS_END) { fprintf(stderr, "kernel_launch: bad shapes n_in %d out %d ws %zu (need %zu)\n", n_in, out_size, ws_size, (size_t)WS_END); return; }
    const float* x = (const float*)d_in[0]; const float* e_mix_norm = (const float*)d_in[1]; const float* e_w_in = (const float*)d_in[2]; const float* e_conv_w = (const float*)d_in[3];
    const float* e_ln_g = (const float*)d_in[4]; const float* e_ln_b = (const float*)d_in[5]; const float* e_w_sp = (const float*)d_in[6]; const float* e_b_sp = (const float*)d_in[7];
    const float* e_w_out = (const float*)d_in[8]; const float* e_ffn_norm = (const float*)d_in[9]; const float* e_w_gate = (const float*)d_in[10]; const float* e_w_up = (const float*)d_in[11];
    const float* e_w_down = (const float*)d_in[12]; const float* o_mix_norm = (const float*)d_in[13]; const float* o_w_qkv = (const float*)d_in[14]; const float* o_q_norm = (const float*)d_in[15];
    const float* o_k_norm = (const float*)d_in[16]; const float* o_w_o = (const float*)d_in[17]; const float* o_ffn_norm = (const float*)d_in[18]; const float* o_w_router = (const float*)d_in[19];
    const float* o_w_gate = (const float*)d_in[20]; const float* o_w_up = (const float*)d_in[21]; const float* o_w_down = (const float*)d_in[22];
    unsigned char* ws = (unsigned char*)d_ws; float* out = (float*)d_out;
    int* cnt = (int*)(ws + WS_CTL); float* ss0 = (float*)(ws + WS_SS0); float* ss1 = (float*)(ws + WS_SS1); float* ss2 = (float*)(ws + WS_SS2); float* ss3 = (float*)(ws + WS_SS3);
    float* rope = (float*)(ws + WS_ROPE); float* kmean = (float*)(ws + WS_KMEAN); int* tokof = (int*)(ws + WS_TOKOF); float* gateof = (float*)(ws + WS_GATEOF);
    bf16_t* win = (bf16_t*)(ws + WS_WIN); bf16_t* wout = (bf16_t*)(ws + WS_WOUT); bf16_t* wgu = (bf16_t*)(ws + WS_WGU); bf16_t* wdn = (bf16_t*)(ws + WS_WDN);
    bf16_t* wqkv = (bf16_t*)(ws + WS_WQKV); bf16_t* wo = (bf16_t*)(ws + WS_WO); bf16_t* mgu = (bf16_t*)(ws + WS_MGU); bf16_t* mdn = (bf16_t*)(ws + WS_MDN);
    unsigned char* ar = ws + WS_ARENA;
    bf16_t* xb = (bf16_t*)(ar + AR_XB); bf16_t* proj = (bf16_t*)(ar + AR_PROJ); bf16_t* y = (bf16_t*)(ar + AR_Y); bf16_t* h1b = (bf16_t*)(ar + AR_H1B); bf16_t* act = (bf16_t*)(ar + AR_ACT);
    bf16_t* h2b = (bf16_t*)(ar + AR_H2B); bf16_t* qkv = (bf16_t*)(ar + AR_QKV); bf16_t* ob = (bf16_t*)(ar + AR_O); bf16_t* h3b = (bf16_t*)(ar + AR_H3B); bf16_t* mact = (bf16_t*)(ar + AR_MACT);
    k_prep_w<<<dim3(NPROJ / 32, D / 32, 1), 256, 0, stream>>>(e_w_in, D, NPROJ, win, e_mix_norm, 0, 0, 0, 0);
    k_prep_w<<<dim3(D / 32, D / 32, 1), 256, 0, stream>>>(e_w_out, D, D, wout, nullptr, 0, 0, 0, 0);
    k_prep_w<<<dim3(FF / 32, D / 32, 1), 256, 0, stream>>>(e_w_gate, D, FF, wgu, e_ffn_norm, 1, 0, 0, 0);
    k_prep_w<<<dim3(FF / 32, D / 32, 1), 256, 0, stream>>>(e_w_up, D, FF, wgu, e_ffn_norm, 1, 1, 0, 0);
    k_prep_w<<<dim3(D / 32, FF / 32, 1), 256, 0, stream>>>(e_w_down, FF, D, wdn, nullptr, 0, 0, 0, 0);
    k_prep_w<<<dim3(NQKV / 32, D / 32, 1), 256, 0, stream>>>(o_w_qkv, D, NQKV, wqkv, o_mix_norm, 0, 0, 0, 0);
    k_prep_w<<<dim3(D / 32, D / 32, 1), 256, 0, stream>>>(o_w_o, D, D, wo, nullptr, 0, 0, 0, 0);
    k_prep_w<<<dim3(FE / 32, D / 32, NE), 256, 0, stream>>>(o_w_gate, D, FE, mgu, o_ffn_norm, 1, 0, (size_t)D * FE, (size_t)NGUE * D);
    k_prep_w<<<dim3(FE / 32, D / 32, NE), 256, 0, stream>>>(o_w_up, D, FE, mgu, o_ffn_norm, 1, 1, (size_t)D * FE, (size_t)NGUE * D);
    k_prep_w<<<dim3(D / 32, FE / 32, NE), 256, 0, stream>>>(o_w_down, FE, D, mdn, nullptr, 0, 0, (size_t)FE * D, (size_t)D * FE);
    k_rope_table<<<SEQ * 16 / 256, 256, 0, stream>>>(rope);
    k_rowprep<<<1024, 256, 0, stream>>>(x, xb, ss0, ss1, ss2, ss3, cnt);
    const int G = 256;
    k_gemm<0><<<G, 512, 0, stream>>>(xb, win, NPROJ, D, proj, nullptr, ss0, nullptr, nullptr, nullptr, nullptr, nullptr);
    k_mixer_naive<<<dim3(T / 128, 8), 256, 0, stream>>>(proj, e_conv_w, e_ln_g, e_ln_b, e_w_sp, e_b_sp, y);
    k_gemm<1><<<G, 512, 0, stream>>>(y, wout, D, D, out, h1b, nullptr, ss1, x, nullptr, nullptr, nullptr);
    k_gemm<2><<<G, 512, 0, stream>>>(h1b, wgu, NGU, D, act, nullptr, ss1, nullptr, nullptr, nullptr, nullptr, nullptr);
    k_gemm<1><<<G, 512, 0, stream>>>(act, wdn, D, FF, out, h2b, nullptr, ss2, out, nullptr, nullptr, nullptr);
    k_gemm<0><<<G, 512, 0, stream>>>(h2b, wqkv, NQKV, D, qkv, nullptr, ss2, nullptr, nullptr, nullptr, nullptr, nullptr);
    k_qkprep_naive<<<T * NH * 2 / 4, 256, 0, stream>>>(qkv, o_q_norm, o_k_norm, rope);
    k_kmean_naive<<<NBATCH * NH * NBLK, 128, 0, stream>>>(qkv, kmean);
    k_attn_naive<<<T * NH / 4, 256, 0, stream>>>(qkv, kmean, ob);
    k_gemm<1><<<G, 512, 0, stream>>>(ob, wo, D, D, out, h3b, nullptr, ss3, out, nullptr, nullptr, nullptr);
    k_router_naive<<<T / 4, 256, 0, stream>>>(out, ss3, o_ffn_norm, o_w_router, cnt, tokof, gateof);
    k_gemm<3><<<G, 512, 0, stream>>>(h3b, mgu, NGUE, D, mact, nullptr, ss3, nullptr, nullptr, cnt, tokof, nullptr);
    k_gemm<4><<<G, 512, 0, stream>>>(mact, mdn, D, FE, out, nullptr, nullptr, nullptr, nullptr, cnt, tokof, gateof);
}
```

```cpp
#include <hip/hip_runtime.h>
#include <hip/hip_cooperative_groups.h>
#include <cstdio>
#include <cstdint>

#define LAS __attribute__((address_space(3)))
typedef unsigned short bf16_t;
typedef short bf16x8 __attribute__((ext_vector_type(8)));
typedef float f32x4 __attribute__((ext_vector_type(4)));
typedef float f32x2 __attribute__((ext_vector_type(2)));
typedef unsigned u32x4 __attribute__((ext_vector_type(4)));
typedef unsigned u32x2 __attribute__((ext_vector_type(2)));

constexpr int T = 16384, D = 1024, SEQ = 4096, NBATCH = 4;
constexpr int CONV = 512, GM = 512, NPROJ = 2560;
constexpr int FF = 2816, NGU = 2 * FF;
constexpr int NH = 8, HD = 128, NQKV = 3072;
constexpr int NE = 8, FE = 3584, NGUE = 2 * FE;
constexpr int MB = 256, NBLK = SEQ / MB;
constexpr float EPS = 1e-6f;

constexpr size_t al256(size_t x) { return (x + 255) & ~(size_t)255; }
constexpr size_t WS_CTL = 0;
constexpr int NSS = 16;
constexpr size_t WS_SS0 = 4096;
constexpr size_t WS_SS1 = WS_SS0 + (size_t)T * NSS * 4;
constexpr size_t WS_SS2 = WS_SS1 + (size_t)T * NSS * 4;
constexpr size_t WS_SS3 = WS_SS2 + (size_t)T * NSS * 4;
constexpr size_t WS_ROPE = WS_SS3 + (size_t)T * NSS * 4;
constexpr size_t WS_KMEAN = WS_ROPE + (size_t)SEQ * 16 * 2 * 4;
constexpr size_t WS_TOKOF = WS_KMEAN + (size_t)NBATCH * NH * NBLK * HD * 4;
constexpr size_t WS_GATEOF = WS_TOKOF + (size_t)NE * T * 4;
constexpr size_t WS_W = al256(WS_GATEOF + (size_t)NE * T * 4);
constexpr size_t WS_WIN = WS_W;
constexpr size_t WS_WOUT = WS_WIN + (size_t)NPROJ * D * 2;
constexpr size_t WS_WGU = WS_WOUT + (size_t)D * D * 2;
constexpr size_t WS_WDN = WS_WGU + (size_t)NGU * D * 2;
constexpr size_t WS_WQKV = WS_WDN + (size_t)D * FF * 2;
constexpr size_t WS_WO = WS_WQKV + (size_t)NQKV * D * 2;
constexpr size_t WS_MGU = WS_WO + (size_t)D * D * 2;
constexpr size_t WS_MDN = WS_MGU + (size_t)NE * NGUE * D * 2;
constexpr size_t WS_ARENA = WS_MDN + (size_t)NE * D * FE * 2;
constexpr size_t SZ_TD2 = (size_t)T * D * 2;
constexpr size_t AR_XB = 0, AR_PROJ = SZ_TD2, AR_Y = 0, AR_H1B = SZ_TD2, AR_ACT = 2 * SZ_TD2, AR_H2B = 0, AR_QKV = SZ_TD2,
                 AR_O = SZ_TD2 + (size_t)T * NQKV * 2, AR_H3B = 0, AR_MACT = SZ_TD2;
constexpr size_t WS_END = WS_ARENA + SZ_TD2 + (size_t)(2 * T + 256) * FE * 2;
static_assert(AR_ACT + (size_t)T * FF * 2 <= SZ_TD2 + (size_t)2 * T * FE * 2, "arena");
static_assert(WS_END <= 486079488ull, "workspace budget");

__device__ __forceinline__ unsigned f2bf(float f) { unsigned u = __builtin_bit_cast(unsigned, f); return (u + 0x7fffu + ((u >> 16) & 1u)) >> 16; }
__device__ __forceinline__ float bf2f(unsigned b) { return __builtin_bit_cast(float, b << 16); }
__device__ __forceinline__ unsigned pk2(float lo, float hi) { return f2bf(lo) | (f2bf(hi) << 16); }
__device__ __forceinline__ unsigned cvt_pk_bf16(float lo, float hi) { unsigned r; asm volatile("v_cvt_pk_bf16_f32 %0, %1, %2" : "=v"(r) : "v"(lo), "v"(hi)); return r; }
__device__ __forceinline__ float wave_sum(float v) {
#pragma unroll
    for (int o = 1; o < 64; o <<= 1) v += __shfl_xor(v, o);
    return v;
}
__device__ __forceinline__ float row_rscale(const float* ssp, int row) {
    const f32x4* p = (const f32x4*)(ssp + (size_t)row * NSS); const f32x4 a = p[0], b = p[1], c = p[2], d = p[3];
    const float s = (((a[0] + a[1]) + (a[2] + a[3])) + ((b[0] + b[1]) + (b[2] + b[3]))) + (((c[0] + c[1]) + (c[2] + c[3])) + ((d[0] + d[1]) + (d[2] + d[3])));
    return rsqrtf(s * (1.0f / D) + EPS);
}
__device__ __forceinline__ float row_ss_part(const float* ssp, int row, int fq) { const f32x4 a = *(const f32x4*)(ssp + (size_t)row * NSS + 4 * fq); return (a[0] + a[1]) + (a[2] + a[3]); }
__device__ __forceinline__ float row_rscale4(float s) { s += __shfl_xor(s, 16); s += __shfl_xor(s, 32); return rsqrtf(s * (1.0f / D) + EPS); }
__device__ __forceinline__ float silu_f(float g) { return g * __frcp_rn(1.0f + __expf(-g)); }

namespace pg8 {
constexpr int BM = 256, BK = 64, HALF = 128, HTB = HALF * BK * 2, STAGE_BYTES = 8 * HTB, NXCD = 8, WGM = 8;
__host__ __device__ __forceinline__ int lds_byte(int r, int c) { const int st = (r >> 4) * 2 + (c >> 5), rr = r & 15, cc = c & 31, ob = rr * 64 + cc * 2; return st * 1024 + (ob ^ (((ob >> 9) & 1) << 5)); }
__host__ __device__ __forceinline__ void stage_rc(int b, int& R, int& C) { const int st = b / 1024, sb = b % 1024, swz = sb ^ (((sb >> 9) & 1) << 5); R = (st >> 1) * 16 + swz / 64; C = (st & 1) * 32 + (swz % 64) / 2; }
__host__ __device__ __forceinline__ int perm32(int rho) { const int n = rho >> 4, i = rho & 15; return 8 * (i >> 2) + 4 * n + (i & 3); }

struct Unit { int row0, pn, e, nvalid; };

struct DenseOrder {
    int nM, nN, nwg, G, c;
    __device__ void init(int M, int N, int G_, int c_) { nM = M / BM; nN = N / BM; nwg = nM * nN; G = G_; c = c_; }
    __device__ __forceinline__ bool next(int i, Unit& u) const {
        const long L = (long)i * G + c; if (L >= nwg) return false;
        int wgid = (int)L; { const int q = nwg / NXCD, r = nwg % NXCD, xcd = wgid % NXCD, off = wgid / NXCD; wgid = (xcd < r ? xcd * (q + 1) : r * (q + 1) + (xcd - r) * q) + off; }
        const int nig = WGM * nN, gid = wgid / nig, fm = gid * WGM, gsz = (nM - fm) < WGM ? (nM - fm) : WGM;
        u.row0 = (fm + ((wgid % nig) % gsz)) * BM; u.pn = (wgid % nig) / gsz; u.e = 0; u.nvalid = BM; return true;
    }
    __device__ __forceinline__ int src_row(const Unit& u, int r) const { return u.row0 + r; }
    __device__ __forceinline__ size_t b_off(const Unit&) const { return 0; }
};
struct MoeOrder {
    const LAS int* tb; const int* tokof; int nN, G, c; bool gather; size_t bstride;
    __device__ __forceinline__ bool next(int i, Unit& u) const {
        const long L = (long)i * G + c; const int nwg = tb[8]; if (L >= nwg) return false;
        int wgid = (int)L; { const int q = nwg / NXCD, r = nwg % NXCD, xcd = wgid % NXCD, off = wgid / NXCD; wgid = (xcd < r ? xcd * (q + 1) : r * (q + 1) + (xcd - r) * q) + off; }
        int e = 0;
#pragma unroll
        for (int j = 1; j < 8; ++j) e += (wgid >= tb[j]) ? 1 : 0;
        const int w = wgid - tb[e], cnt = tb[32 + e], nM = (cnt + BM - 1) / BM;
        const int nig = WGM * nN, gid = w / nig, fm = gid * WGM, gsz = (nM - fm) < WGM ? (nM - fm) : WGM;
        const int pm = fm + ((w % nig) % gsz); u.pn = (w % nig) / gsz; u.e = e; u.row0 = pm * BM; u.nvalid = (cnt - pm * BM) < BM ? (cnt - pm * BM) : BM; return true;
    }
    __device__ __forceinline__ int src_row(const Unit& u, int r) const {
        if (gather) return (r < u.nvalid) ? tokof[u.e * T + u.row0 + r] : 0;
        return tb[16 + u.e] + u.row0 + r;
    }
    __device__ __forceinline__ size_t b_off(const Unit& u) const { return (size_t)u.e * bstride; }
};

struct EpiScaleBf16 {
    static constexpr bool PERM = true;
    bf16_t* O; int ldc; const float* ss;
    __device__ __forceinline__ void operator()(const f32x4 (&acc)[2][2][4][2], const Unit& u, int wr, int wc, int fr, int fq) const {
        const int col0 = u.pn * BM + wc * 32 + 8 * fq; float rs[2][4];
#pragma unroll
        for (int ai = 0; ai < 2; ++ai)
#pragma unroll
            for (int m = 0; m < 4; ++m) rs[ai][m] = row_ss_part(ss, u.row0 + ai * HALF + wr * 64 + m * 16 + fr, fq);
#pragma unroll
        for (int ai = 0; ai < 2; ++ai)
#pragma unroll
            for (int m = 0; m < 4; ++m) { const int row = u.row0 + ai * HALF + wr * 64 + m * 16 + fr; const float r = row_rscale4(rs[ai][m]);
                bf16_t* rowp = O + (size_t)row * ldc + col0;
#pragma unroll
                for (int bj = 0; bj < 2; ++bj) { const f32x4 v0 = acc[ai][bj][m][0] * r, v1 = acc[ai][bj][m][1] * r;
                    u32x4 w; w.x = cvt_pk_bf16(v0[0], v0[1]); w.y = cvt_pk_bf16(v0[2], v0[3]); w.z = cvt_pk_bf16(v1[0], v1[1]); w.w = cvt_pk_bf16(v1[2], v1[3]);
                    *(u32x4*)(rowp + bj * HALF) = w; } }
    }
};
struct EpiSwiglu {
    static constexpr bool PERM = true;
    bf16_t* O; int ldc; const float* ss; const int* tokof; const LAS int* tb; bool moe;
    __device__ __forceinline__ void operator()(const f32x4 (&acc)[2][2][4][2], const Unit& u, int wr, int wc, int fr, int fq) const {
        const int col0 = u.pn * HALF + wc * 32 + 8 * fq; float rs[2][4]; int orow[2][4];
#pragma unroll
        for (int ai = 0; ai < 2; ++ai)
#pragma unroll
            for (int m = 0; m < 4; ++m) { const int tr = ai * HALF + wr * 64 + m * 16 + fr; int srow;
                if (moe) { const bool ok = tr < u.nvalid; srow = ok ? tokof[u.e * T + u.row0 + tr] : 0; orow[ai][m] = ok ? tb[16 + u.e] + u.row0 + tr : -1; } else { srow = u.row0 + tr; orow[ai][m] = srow; }
                rs[ai][m] = row_ss_part(ss, srow, fq); }
#pragma unroll
        for (int ai = 0; ai < 2; ++ai)
#pragma unroll
            for (int m = 0; m < 4; ++m) { const float r = row_rscale4(rs[ai][m]);
                f32x4 a[2];
#pragma unroll
                for (int n = 0; n < 2; ++n) { const f32x4 g = acc[ai][0][m][n] * r, up = acc[ai][1][m][n] * r;
#pragma unroll
                    for (int j = 0; j < 4; ++j) a[n][j] = silu_f(g[j]) * up[j]; }
                u32x4 w; w.x = cvt_pk_bf16(a[0][0], a[0][1]); w.y = cvt_pk_bf16(a[0][2], a[0][3]); w.z = cvt_pk_bf16(a[1][0], a[1][1]); w.w = cvt_pk_bf16(a[1][2], a[1][3]);
                if (orow[ai][m] >= 0) *(u32x4*)(O + (size_t)orow[ai][m] * ldc + col0) = w; }
    }
};
struct EpiResid {
    static constexpr bool PERM = false;
    const float* base; float* out; bf16_t* hb; float* ssout;
    __device__ __forceinline__ void operator()(const f32x4 (&acc)[2][2][4][2], const Unit& u, int wr, int wc, int fr, int fq) const {
        const int col0 = u.pn * BM + wc * 32 + 4 * fq;
#pragma unroll
        for (int ai = 0; ai < 2; ++ai)
#pragma unroll
            for (int m = 0; m < 4; ++m) { const int row = u.row0 + ai * HALF + wr * 64 + m * 16 + fr; const size_t off = (size_t)row * D + col0; float q = 0.f;
#pragma unroll
                for (int bj = 0; bj < 2; ++bj)
#pragma unroll
                    for (int n = 0; n < 2; ++n) { const f32x4 b = *(const f32x4*)(base + off + bj * HALF + n * 16); const f32x4 h = b + acc[ai][bj][m][n];
                        *(f32x4*)(out + off + bj * HALF + n * 16) = h; q += (h[0] * h[0] + h[1] * h[1]) + (h[2] * h[2] + h[3] * h[3]);
                        u32x2 w; w.x = cvt_pk_bf16(h[0], h[1]); w.y = cvt_pk_bf16(h[2], h[3]); *(u32x2*)(hb + off + bj * HALF + n * 16) = w; }
                q += __shfl_xor(q, 16); q += __shfl_xor(q, 32);
                if (fq == 0) ssout[(size_t)row * NSS + u.pn * 4 + wc] = q;
                asm volatile("" ::: "memory"); }
    }
};
struct EpiMoeDown {
    static constexpr bool PERM = false;
    float* out; const int* tokof; const float* gateof;
    __device__ __forceinline__ void operator()(const f32x4 (&acc)[2][2][4][2], const Unit& u, int wr, int wc, int fr, int fq) const {
        const int col0 = u.pn * BM + wc * 32 + 4 * fq;
#pragma unroll
        for (int ai = 0; ai < 2; ++ai)
#pragma unroll
            for (int m = 0; m < 4; ++m) { const int tr = ai * HALF + wr * 64 + m * 16 + fr; const bool ok = tr < u.nvalid;
                const int tok = ok ? tokof[u.e * T + u.row0 + tr] : 0; const float gt = ok ? gateof[u.e * T + u.row0 + tr] : 0.f;
                float* rowp = out + (size_t)tok * D + col0;
                if (ok) {
#pragma unroll
                    for (int bj = 0; bj < 2; ++bj)
#pragma unroll
                        for (int n = 0; n < 2; ++n)
#pragma unroll
                            for (int j = 0; j < 4; ++j) __hip_atomic_fetch_add(rowp + bj * HALF + n * 16 + j, gt * acc[ai][bj][m][n][j], __ATOMIC_RELAXED, __HIP_MEMORY_SCOPE_AGENT); } }
    }
};

template <class Epi, class Sched>
__device__ __forceinline__ void gemm_naive(const bf16_t* A, const bf16_t* Bt, int K, const Sched& S, const Epi& E) {
    const int tid = threadIdx.x, wid = __builtin_amdgcn_readfirstlane(tid >> 6), lane = tid & 63, wr = wid >> 2, wc = wid & 3, fr = lane & 15, fq = lane >> 4;
    Unit u;
    for (int ui = 0; S.next(ui, u); ++ui) {
        f32x4 acc[2][2][4][2];
#pragma unroll
        for (int a = 0; a < 2; ++a)
#pragma unroll
            for (int b = 0; b < 2; ++b)
#pragma unroll
                for (int m = 0; m < 4; ++m)
#pragma unroll
                    for (int n = 0; n < 2; ++n) acc[a][b][m][n] = (f32x4){0.f, 0.f, 0.f, 0.f};
        const bf16_t* ap[2][4]; const bf16_t* bp[2][2];
#pragma unroll
        for (int ai = 0; ai < 2; ++ai)
#pragma unroll
            for (int m = 0; m < 4; ++m) ap[ai][m] = A + (size_t)S.src_row(u, ai * HALF + wr * 64 + m * 16 + fr) * K + fq * 8;
#pragma unroll
        for (int bj = 0; bj < 2; ++bj)
#pragma unroll
            for (int n = 0; n < 2; ++n) { const int rho = 16 * n + fr; bp[bj][n] = Bt + S.b_off(u) + (size_t)(u.pn * BM + bj * HALF + wc * 32 + (Epi::PERM ? perm32(rho) : rho)) * K + fq * 8; }
        for (int k0 = 0; k0 < K; k0 += 32) {
            bf16x8 bf[2][2];
#pragma unroll
            for (int bj = 0; bj < 2; ++bj)
#pragma unroll
                for (int n = 0; n < 2; ++n) bf[bj][n] = *(const bf16x8*)(bp[bj][n] + k0);
#pragma unroll
            for (int ai = 0; ai < 2; ++ai)
#pragma unroll
                for (int m = 0; m < 4; ++m) { const bf16x8 af = *(const bf16x8*)(ap[ai][m] + k0);
#pragma unroll
                    for (int bj = 0; bj < 2; ++bj)
#pragma unroll
                        for (int n = 0; n < 2; ++n) acc[ai][bj][m][n] = __builtin_amdgcn_mfma_f32_16x16x32_bf16(bf[bj][n], af, acc[ai][bj][m][n], 0, 0, 0); }
        }
        E(acc, u, wr, wc, fr, fq);
    }
}

template <class Epi, class Sched, bool ALIGN_EPI, bool SP2>
__device__ __forceinline__ void gemm_fast(LAS unsigned char* lds, const bf16_t* A, const bf16_t* Bt, int K, const Sched& S, const Epi& E) {
    const int tid = threadIdx.x, wid = __builtin_amdgcn_readfirstlane(tid >> 6), lane = tid & 63, wr = wid >> 2, wc = wid & 3, fr = lane & 15, fq = lane >> 4;
    const int nt = K / BK;
    int Rs[2], Cs[2]; unsigned voffB[2];
#pragma unroll
    for (int i = 0; i < 2; ++i) { int R, C; stage_rc(tid * 16 + i * 8192, R, C); Rs[i] = R; Cs[i] = C; const int Rb = Epi::PERM ? ((R & ~31) + perm32(R & 31)) : R; voffB[i] = (unsigned)(Rb * K + C) * 2u; }
    const size_t kstep = (size_t)(BK * 2), hstep = (size_t)HALF * K * 2, tstep = 2 * hstep;
    const unsigned ldsw = (unsigned)wid * 1024u;
    const int aoff = lds_byte(wr * 64 + fr, fq * 8), boff = lds_byte(wc * 32 + fr, fq * 8);
#define PG8_SA(b, h) (((b) * 2 + (h)) * HTB)
#define PG8_SB(b, h) ((4 + (b) * 2 + (h)) * HTB)
#define PG8_STAGE(bufoff, gbase, voff) do { _Pragma("unroll") for (int _i = 0; _i < 2; ++_i) \
        __builtin_amdgcn_global_load_lds((const unsigned*)((const char*)(gbase) + (voff)[_i]), (LAS unsigned*)(lds + (bufoff) + ldsw + _i * 8192), 16, 0, 0); } while (0)
#define PG8_LDA(dst, b, h) do { _Pragma("unroll") for (int m = 0; m < 4; ++m) _Pragma("unroll") for (int k = 0; k < 2; ++k) dst[m][k] = *(const LAS bf16x8*)(lds + PG8_SA(b, h) + aoff + m * 2048 + k * 1024); } while (0)
#define PG8_LDB(dst, b, h) do { _Pragma("unroll") for (int n = 0; n < 2; ++n) _Pragma("unroll") for (int k = 0; k < 2; ++k) dst[n][k] = *(const LAS bf16x8*)(lds + PG8_SB(b, h) + boff + n * 2048 + k * 1024); } while (0)
#define PG8_MMA(ai, bj, At, Bt_) do { __builtin_amdgcn_s_setprio(1); _Pragma("unroll") for (int m = 0; m < 4; ++m) _Pragma("unroll") for (int n = 0; n < 2; ++n) _Pragma("unroll") for (int k = 0; k < 2; ++k) \
        acc[ai][bj][m][n] = __builtin_amdgcn_mfma_f32_16x16x32_bf16(Bt_[n][k], At[m][k], acc[ai][bj][m][n], 0, 0, 0); __builtin_amdgcn_s_setprio(0); } while (0)
#define PG8_WAIT_V(n) asm volatile("s_waitcnt vmcnt(" #n ")" ::: "memory")
#define PG8_WAIT_L(n) asm volatile("s_waitcnt lgkmcnt(" #n ")" ::: "memory")
#define PG8_BAR __builtin_amdgcn_s_barrier()
#define PG8_SCHED __builtin_amdgcn_sched_barrier(0)
#define PG8_AOFFS(u, ao) do { _Pragma("unroll") for (int _h = 0; _h < 2; ++_h) _Pragma("unroll") for (int _i = 0; _i < 2; ++_i) \
        ao[_h][_i] = ((unsigned)S.src_row(u, _h * HALF + Rs[_i]) * (unsigned)K + (unsigned)Cs[_i]) * 2u; } while (0)
    Unit cur, nxt; int ui = 0;
    if (!S.next(0, cur)) return;
    f32x4 acc[2][2][4][2];
#pragma unroll
    for (int a = 0; a < 2; ++a)
#pragma unroll
        for (int b = 0; b < 2; ++b)
#pragma unroll
            for (int m = 0; m < 4; ++m)
#pragma unroll
                for (int n = 0; n < 2; ++n) acc[a][b][m][n] = (f32x4){0.f, 0.f, 0.f, 0.f};
    bf16x8 At[4][2], B0[2][2], B1[2][2];
    unsigned aoc[2][2], aon[2][2];
    PG8_AOFFS(cur, aoc);
    const char* Ab = (const char*)A;
    const char* cB = (const char*)Bt + S.b_off(cur) * 2 + (size_t)cur.pn * tstep;
    if constexpr (SP2) {
        PG8_STAGE(PG8_SB(0, 0), cB, voffB); PG8_STAGE(PG8_SB(0, 1), cB + hstep, voffB); PG8_STAGE(PG8_SA(0, 0), Ab, aoc[0]); PG8_STAGE(PG8_SA(0, 1), Ab, aoc[1]);
        if (wr == 1) PG8_BAR;
        PG8_WAIT_V(2); PG8_BAR;
        PG8_STAGE(PG8_SB(1, 0), cB + kstep, voffB); PG8_STAGE(PG8_SA(1, 0), Ab + kstep, aoc[0]); PG8_STAGE(PG8_SB(1, 1), cB + hstep + kstep, voffB);
        PG8_WAIT_V(6); PG8_BAR;
    } else {
        PG8_STAGE(PG8_SB(0, 0), cB, voffB); PG8_STAGE(PG8_SA(0, 0), Ab, aoc[0]); PG8_STAGE(PG8_SB(0, 1), cB + hstep, voffB); PG8_STAGE(PG8_SA(0, 1), Ab, aoc[1]);
        if (wr == 1) PG8_BAR;
        PG8_WAIT_V(4); PG8_BAR;
        PG8_STAGE(PG8_SB(1, 0), cB + kstep, voffB); PG8_STAGE(PG8_SA(1, 0), Ab + kstep, aoc[0]); PG8_STAGE(PG8_SB(1, 1), cB + hstep + kstep, voffB);
        PG8_WAIT_V(6); PG8_BAR;
    }
    for (;;) {
        const bool has_next = S.next(ui + 1, nxt);
        if (has_next) { PG8_AOFFS(nxt, aon); } else {
#pragma unroll
            for (int h = 0; h < 2; ++h)
#pragma unroll
                for (int i = 0; i < 2; ++i) aon[h][i] = aoc[h][i]; }
        const char* nB = has_next ? (const char*)Bt + S.b_off(nxt) * 2 + (size_t)nxt.pn * tstep : cB;
        for (int t = 0; t < nt; t += 2) {
            const bool last = (t == nt - 2);
            const char* a1 = Ab + (size_t)(t + 1) * kstep;
            const char* a2 = last ? Ab : Ab + (size_t)(t + 2) * kstep; const char* b2 = last ? nB : cB + (size_t)(t + 2) * kstep;
            const char* a3 = a2 + kstep; const char* b3 = b2 + kstep;
            unsigned a2o[2][2];
#pragma unroll
            for (int h = 0; h < 2; ++h)
#pragma unroll
                for (int i = 0; i < 2; ++i) a2o[h][i] = last ? aon[h][i] : aoc[h][i];
            if constexpr (SP2) {
            PG8_LDB(B0, 0, 0); PG8_LDB(B1, 0, 1); PG8_SCHED; PG8_LDA(At, 0, 0); PG8_STAGE(PG8_SA(1, 1), a1, aoc[1]);
            PG8_WAIT_V(8); PG8_WAIT_L(0); PG8_BAR; PG8_MMA(0, 0, At, B0); PG8_MMA(0, 1, At, B1); PG8_BAR; PG8_SCHED;
            PG8_LDA(At, 0, 1); PG8_STAGE(PG8_SB(0, 0), b2, voffB); PG8_STAGE(PG8_SB(0, 1), b2 + hstep, voffB); PG8_STAGE(PG8_SA(0, 0), a2, a2o[0]);
            PG8_WAIT_V(8); PG8_WAIT_L(0); PG8_BAR; PG8_MMA(1, 0, At, B0); PG8_MMA(1, 1, At, B1); PG8_BAR; PG8_SCHED;
            PG8_LDB(B0, 1, 0); PG8_LDB(B1, 1, 1); PG8_SCHED; PG8_LDA(At, 1, 0); PG8_STAGE(PG8_SA(0, 1), a2, a2o[1]);
            PG8_WAIT_V(8); PG8_WAIT_L(0); PG8_BAR; PG8_MMA(0, 0, At, B0); PG8_MMA(0, 1, At, B1); PG8_BAR; PG8_SCHED;
            PG8_LDA(At, 1, 1); PG8_STAGE(PG8_SB(1, 0), b3, voffB); PG8_STAGE(PG8_SB(1, 1), b3 + hstep, voffB); PG8_STAGE(PG8_SA(1, 0), a3, a2o[0]);
            PG8_WAIT_V(8); PG8_WAIT_L(0); PG8_BAR; PG8_MMA(1, 0, At, B0); PG8_MMA(1, 1, At, B1); PG8_BAR; PG8_SCHED;
            } else {
            PG8_LDB(B0, 0, 0); PG8_SCHED; PG8_LDA(At, 0, 0); PG8_STAGE(PG8_SA(1, 1), a1, aoc[1]);
            PG8_WAIT_L(8); PG8_BAR; PG8_WAIT_L(0); PG8_MMA(0, 0, At, B0); PG8_BAR; PG8_SCHED;
            PG8_LDB(B1, 0, 1); PG8_STAGE(PG8_SB(0, 0), b2, voffB);
            PG8_BAR; PG8_WAIT_L(0); PG8_MMA(0, 1, At, B1); PG8_BAR;
            PG8_LDA(At, 0, 1); PG8_STAGE(PG8_SA(0, 0), a2, a2o[0]);
            PG8_BAR; PG8_WAIT_L(0); PG8_MMA(1, 0, At, B0); PG8_BAR; PG8_SCHED;
            PG8_STAGE(PG8_SB(0, 1), b2 + hstep, voffB);
            PG8_WAIT_V(6); PG8_BAR; PG8_MMA(1, 1, At, B1); PG8_BAR;
            PG8_LDB(B0, 1, 0); PG8_SCHED; PG8_LDA(At, 1, 0); PG8_STAGE(PG8_SA(0, 1), a2, a2o[1]);
            PG8_WAIT_L(8); PG8_BAR; PG8_WAIT_L(0); PG8_MMA(0, 0, At, B0); PG8_BAR; PG8_SCHED;
            PG8_LDB(B1, 1, 1); PG8_STAGE(PG8_SB(1, 0), b3, voffB);
            PG8_BAR; PG8_WAIT_L(0); PG8_MMA(0, 1, At, B1); PG8_BAR;
            PG8_LDA(At, 1, 1); PG8_STAGE(PG8_SA(1, 0), a3, a2o[0]);
            PG8_BAR; PG8_WAIT_L(0); PG8_MMA(1, 0, At, B0); PG8_BAR; PG8_SCHED;
            PG8_STAGE(PG8_SB(1, 1), b3 + hstep, voffB);
            PG8_WAIT_V(6); PG8_BAR; PG8_MMA(1, 1, At, B1); PG8_BAR;
            }
        }
        if constexpr (ALIGN_EPI) { if (wr == 0) PG8_BAR; }
        E(acc, cur, wr, wc, fr, fq);
        if (!has_next) break;
#pragma unroll
        for (int a = 0; a < 2; ++a)
#pragma unroll
            for (int b = 0; b < 2; ++b)
#pragma unroll
                for (int m = 0; m < 4; ++m)
#pragma unroll
                    for (int n = 0; n < 2; ++n) acc[a][b][m][n] = (f32x4){0.f, 0.f, 0.f, 0.f};
        cur = nxt; cB = nB; ++ui;
#pragma unroll
        for (int h = 0; h < 2; ++h)
#pragma unroll
            for (int i = 0; i < 2; ++i) aoc[h][i] = aon[h][i];
        if constexpr (ALIGN_EPI) { if (wr == 1) PG8_BAR; }
    }
    PG8_WAIT_V(0);
    if constexpr (!ALIGN_EPI) { if (wr == 0) PG8_BAR; }
    PG8_BAR;
#undef PG8_SA
#undef PG8_SB
#undef PG8_STAGE
#undef PG8_LDA
#undef PG8_LDB
#undef PG8_MMA
#undef PG8_WAIT_V
#undef PG8_WAIT_L
#undef PG8_BAR
#undef PG8_SCHED
#undef PG8_AOFFS
}
}

__global__ void __launch_bounds__(256) k_prep_w(const float* W, int K, int N, bf16_t* Wt, const float* fold, int inter, int which, size_t src_bstride, size_t dst_bstride) {
    __shared__ float tile[32][33];
    W += (size_t)blockIdx.z * src_bstride; Wt += (size_t)blockIdx.z * dst_bstride;
    const int n0 = blockIdx.x * 32, k0 = blockIdx.y * 32, tx = threadIdx.x & 31, ty = threadIdx.x >> 5;
    for (int i = ty; i < 32; i += 8) tile[i][tx] = W[(size_t)(k0 + i) * N + n0 + tx] * (fold ? fold[k0 + i] : 1.0f);
    __syncthreads();
    for (int i = ty; i < 32; i += 8) { const int n = n0 + i; const int dr = inter ? (n / 128) * 256 + which * 128 + (n % 128) : n;
        Wt[(size_t)dr * K + k0 + tx] = (bf16_t)f2bf(tile[tx][i]); }
}
__global__ void __launch_bounds__(256) k_rowprep(const float* x, bf16_t* xb, float* ss0, float* ss1, float* ss2, float* ss3, int* cnt) {
    const int lane = threadIdx.x & 63, gw = (blockIdx.x * blockDim.x + threadIdx.x) >> 6, ngw = (gridDim.x * blockDim.x) >> 6;
    if (blockIdx.x == 0 && threadIdx.x < 64) cnt[threadIdx.x] = 0;
    for (int row = gw; row < T; row += ngw) {
        const f32x4* xr = (const f32x4*)(x + (size_t)row * D) + lane; float s = 0.f; u32x2* o = (u32x2*)(xb + (size_t)row * D) + lane;
#pragma unroll
        for (int j = 0; j < 4; ++j) { const f32x4 v = xr[64 * j]; s += (v[0] * v[0] + v[1] * v[1]) + (v[2] * v[2] + v[3] * v[3]); u32x2 w; w.x = pk2(v[0], v[1]); w.y = pk2(v[2], v[3]); o[64 * j] = w; }
        s = wave_sum(s);
        if (lane < NSS) ss0[(size_t)row * NSS + lane] = (lane == 0) ? s : 0.f;
    }
}
__global__ void k_rope_table(float* tab) {
    const int i = blockIdx.x * blockDim.x + threadIdx.x; if (i >= SEQ * 16) return;
    const int s = i / 16, f = i % 16; const double inv = pow(500000.0, -(double)f / 16.0); const double ang = (double)s * inv;
    tab[2 * i] = (float)cos(ang); tab[2 * i + 1] = (float)sin(ang);
}
__global__ void __launch_bounds__(256) k_mixer_naive(const bf16_t* proj, const float* conv_w, const float* ln_g, const float* ln_b, const float* w_s, const float* b_s, bf16_t* y) {
    __shared__ float vn[128][65]; __shared__ float mu[128], rstd[128];
    const int c = blockIdx.x, p = blockIdx.y, tid = threadIdx.x, t0 = c * 128;
    for (int i = tid; i < 128 * 64; i += 256) { const int tt = i / 64, ch = 64 * p + (i % 64), t = t0 + tt, s = t % SEQ; float z = 0.f;
        for (int k = 0; k < 3; ++k) { const int sp = s - 2 + k; if (sp >= 0) { const bf16_t* pr = proj + (size_t)(t - 2 + k) * NPROJ; z += conv_w[k * CONV + ch] * (bf2f(pr[CONV + ch]) * bf2f(pr[ch])); } }
        y[(size_t)t * D + ch] = (bf16_t)f2bf(bf2f(proj[(size_t)t * NPROJ + 2 * CONV + ch]) * z); }
    { const int tt = tid >> 1, hf = tid & 1; const bf16_t* pr = proj + (size_t)(t0 + tt) * NPROJ + 3 * CONV + GM + hf * 256; float s = 0.f, q = 0.f;
      for (int j = 0; j < 256; ++j) { const float v = bf2f(pr[j]); s += v; }
      s += __shfl_xor(s, 1); const float m = s * (1.0f / GM);
      for (int j = 0; j < 256; ++j) { const float v = bf2f(pr[j]) - m; q += v * v; }
      q += __shfl_xor(q, 1); if (hf == 0) { mu[tt] = m; rstd[tt] = rsqrtf(q * (1.0f / GM) + EPS); } }
    __syncthreads();
    for (int i = tid; i < 128 * 64; i += 256) { const int tt = i / 64, d = i % 64, ch = 64 * p + d; const float v = bf2f(proj[(size_t)(t0 + tt) * NPROJ + 3 * CONV + GM + ch]);
        vn[tt][d] = (v - mu[tt]) * rstd[tt] * ln_g[ch] + ln_b[ch]; }
    __syncthreads();
    { const int d = tid & 63;
      for (int tt = tid >> 6; tt < 128; tt += 4) { float a = b_s[p * 128 + tt]; const float* wr = w_s + ((size_t)p * 128 + tt) * 128;
          for (int s = 0; s <= tt; ++s) a += wr[s] * vn[s][d];
          const int t = t0 + tt; y[(size_t)t * D + CONV + 64 * p + d] = (bf16_t)f2bf(bf2f(proj[(size_t)t * NPROJ + 3 * CONV + 64 * p + d]) * a); } }
}
__global__ void __launch_bounds__(256) k_qkprep_naive(bf16_t* qkv, const float* qg, const float* kg, const float* rope) {
    const int lane = threadIdx.x & 63, i = (blockIdx.x * blockDim.x + threadIdx.x) >> 6; if (i >= T * NH * 2) return;
    const int which = i & 1, h = (i >> 1) & 7, t = i >> 4, s = t % SEQ; bf16_t* p = qkv + (size_t)t * NQKV + which * D + h * HD; const float* g = which ? kg : qg;
    float v0 = bf2f(p[lane]), v1 = bf2f(p[lane + 64]);
    const float q = wave_sum(v0 * v0 + v1 * v1), r = rsqrtf(q * (1.0f / HD) + EPS);
    v0 = v0 * r * g[lane]; v1 = v1 * r * g[lane + 64];
    const float partner = __shfl_xor(v0, 16); const int f = lane & 15; const float cs = rope[(s * 16 + f) * 2], sn = rope[(s * 16 + f) * 2 + 1];
    if (lane < 16) v0 = v0 * cs - partner * sn; else if (lane < 32) v0 = v0 * cs + partner * sn;
    p[lane] = (bf16_t)f2bf(v0); p[lane + 64] = (bf16_t)f2bf(v1);
}
__global__ void __launch_bounds__(128) k_kmean_naive(const bf16_t* qkv, float* kmean) {
    const int bhn = blockIdx.x, n = bhn % NBLK, h = (bhn / NBLK) % NH, b = bhn / (NBLK * NH), d = threadIdx.x; float s = 0.f;
    for (int j = 0; j < MB; ++j) s += bf2f(qkv[(size_t)(b * SEQ + n * MB + j) * NQKV + D + h * HD + d]);
    kmean[(size_t)bhn * HD + d] = s * (1.0f / MB);
}
__global__ void __launch_bounds__(256) k_attn_naive(const bf16_t* qkv, const float* kmean, bf16_t* o) {
    __shared__ float qs[4][HD]; __shared__ float ps[4][4 * MB];
    const int w = threadIdx.x >> 6, lane = threadIdx.x & 63, gq = blockIdx.x * 4 + w;
    const int h = gq % NH, t = gq / NH, b = t / SEQ, s = t % SEQ, qb = s / MB;
    const bf16_t* qp = qkv + (size_t)t * NQKV + h * HD; qs[w][lane] = bf2f(qp[lane]); qs[w][lane + 64] = bf2f(qp[lane + 64]);
    __syncthreads();
    float mygate = -INFINITY;
    for (int n = 0; n < qb; ++n) { const float* km = kmean + ((size_t)(b * NH + h) * NBLK + n) * HD; float a = qs[w][lane] * km[lane] + qs[w][lane + 64] * km[lane + 64]; a = wave_sum(a); if (lane == n) mygate = a; }
    int sel0 = -1, sel1 = -1, sel2 = -1; const int nsel = qb < 3 ? qb : 3;
#pragma unroll
    for (int j = 0; j < 3; ++j) { float bv = mygate; int bi = lane;
#pragma unroll
        for (int o2 = 1; o2 < 64; o2 <<= 1) { const float ov = __shfl_xor(bv, o2); const int oi = __shfl_xor(bi, o2); if (ov > bv || (ov == bv && oi < bi)) { bv = ov; bi = oi; } }
        if (j == 0) sel0 = bi; if (j == 1) sel1 = bi; if (j == 2) sel2 = bi;
        if (lane == bi) mygate = -INFINITY; }
    const float scale = 0.08838834764831845f;
    float mx = -INFINITY;
    for (int j = 0; j < 4; ++j) { const bool val = (j < 3) ? (j < nsel) : true; const int blk = (j == 0) ? sel0 : (j == 1) ? sel1 : (j == 2) ? sel2 : qb;
        for (int i = 0; i < 4; ++i) { const int kk = lane + 64 * i; float sc = -INFINITY;
            if (val && (j < 3 || blk * MB + kk <= s)) { const bf16_t* kp = qkv + (size_t)(b * SEQ + blk * MB + kk) * NQKV + D + h * HD; float a = 0.f; for (int d = 0; d < HD; ++d) a += qs[w][d] * bf2f(kp[d]); sc = a * scale; }
            ps[w][j * MB + kk] = sc; mx = fmaxf(mx, sc); } }
#pragma unroll
    for (int o2 = 1; o2 < 64; o2 <<= 1) mx = fmaxf(mx, __shfl_xor(mx, o2));
    float sum = 0.f;
    for (int i = lane; i < 4 * MB; i += 64) { const float e = (ps[w][i] == -INFINITY) ? 0.f : __expf(ps[w][i] - mx); ps[w][i] = e; sum += e; }
    sum = wave_sum(sum); const float inv = 1.0f / sum;
    __syncthreads();
    float a0 = 0.f, a1 = 0.f;
    for (int j = 0; j < 4; ++j) { const bool val = (j < 3) ? (j < nsel) : true; if (!val) continue; const int blk = (j == 0) ? sel0 : (j == 1) ? sel1 : (j == 2) ? sel2 : qb; const int nk = (j < 3) ? MB : (s - qb * MB + 1);
        for (int kk = 0; kk < nk; ++kk) { const float p = ps[w][j * MB + kk]; const bf16_t* vp = qkv + (size_t)(b * SEQ + blk * MB + kk) * NQKV + 2 * D + h * HD; a0 += p * bf2f(vp[lane]); a1 += p * bf2f(vp[lane + 64]); } }
    o[(size_t)t * D + h * HD + lane] = (bf16_t)f2bf(a0 * inv); o[(size_t)t * D + h * HD + lane + 64] = (bf16_t)f2bf(a1 * inv);
}
__global__ void __launch_bounds__(256) k_router_naive(const float* h3, const float* ss3, const float* g, const float* wr, int* cnt, int* tokof, float* gateof) {
    const int lane = threadIdx.x & 63, t = (blockIdx.x * blockDim.x + threadIdx.x) >> 6; if (t >= T) return;
    const float r = row_rscale(ss3, t); float lg[NE];
#pragma unroll
    for (int e = 0; e < NE; ++e) lg[e] = 0.f;
    for (int j = 0; j < 16; ++j) { const int c = lane + 64 * j; const float xn = h3[(size_t)t * D + c] * r * g[c];
#pragma unroll
        for (int e = 0; e < NE; ++e) lg[e] += xn * wr[c * NE + e]; }
#pragma unroll
    for (int e = 0; e < NE; ++e) lg[e] = wave_sum(lg[e]);
    if (lane == 0) { int e1 = 0; float v1 = lg[0];
#pragma unroll
        for (int e = 1; e < NE; ++e) if (lg[e] > v1) { v1 = lg[e]; e1 = e; }
        int e2 = -1; float v2 = -INFINITY;
#pragma unroll
        for (int e = 0; e < NE; ++e) if (e != e1 && lg[e] > v2) { v2 = lg[e]; e2 = e; }
        const float p1 = 1.0f / (1.0f + __expf(v2 - v1)), p2 = 1.0f - p1;
        const int q1 = atomicAdd(cnt + e1, 1), q2 = atomicAdd(cnt + e2, 1);
        tokof[e1 * T + q1] = t; gateof[e1 * T + q1] = p1; tokof[e2 * T + q2] = t; gateof[e2 * T + q2] = p2; }
}

__device__ __forceinline__ void moe_tables(LAS int* tb, const int* cnt, int nN) {
    if (threadIdx.x == 0) { int cu = 0, off = 0; for (int e = 0; e < NE; ++e) { const int c = cnt[e]; tb[e] = cu; tb[16 + e] = off; tb[32 + e] = c; cu += ((c + 255) / 256) * nN; off += c; } tb[8] = cu; tb[24] = off; }
    __syncthreads();
}
#ifndef GEMM_FAST
#define GEMM_FAST 1
#endif
constexpr int LDS_TB = pg8::STAGE_BYTES;
constexpr int LDS_BYTES = pg8::STAGE_BYTES + 1024;
template <class Epi, class Sched>
__device__ __forceinline__ void gemm_run(LAS unsigned char* lds, const bf16_t* A, const bf16_t* Bt, int K, const Sched& S, const Epi& E) {
#if GEMM_FAST
    pg8::gemm_fast<Epi, Sched, true, true>(lds, A, Bt, K, S, E);
#else
    pg8::gemm_naive(A, Bt, K, S, E);
#endif
}
template <int WHICH>
__global__ void __launch_bounds__(512) k_gemm(const bf16_t* A, const bf16_t* Bt, int N, int K, void* o1, void* o2, const float* ss, float* ssout, const float* base, const int* cnt, const int* tokof, const float* gateof) {
    extern __shared__ __attribute__((aligned(16))) unsigned char lds_raw[];
    LAS unsigned char* lds = (LAS unsigned char*)lds_raw; LAS int* tb = (LAS int*)(lds + LDS_TB);
    if constexpr (WHICH == 0) { pg8::DenseOrder S; S.init(T, N, gridDim.x, blockIdx.x); pg8::EpiScaleBf16 E{(bf16_t*)o1, N, ss}; gemm_run(lds, A, Bt, K, S, E); }
    if constexpr (WHICH == 1) { pg8::DenseOrder S; S.init(T, N, gridDim.x, blockIdx.x); pg8::EpiResid E{base, (float*)o1, (bf16_t*)o2, ssout}; gemm_run(lds, A, Bt, K, S, E); }
    if constexpr (WHICH == 2) { pg8::DenseOrder S; S.init(T, N, gridDim.x, blockIdx.x); pg8::EpiSwiglu E{(bf16_t*)o1, N / 2, ss, nullptr, tb, false}; gemm_run(lds, A, Bt, K, S, E); }
    if constexpr (WHICH == 3) { moe_tables(tb, cnt, N / 256); pg8::MoeOrder S{tb, tokof, N / 256, (int)gridDim.x, (int)blockIdx.x, true, (size_t)N * K}; pg8::EpiSwiglu E{(bf16_t*)o1, N / 2, ss, tokof, tb, true}; gemm_run(lds, A, Bt, K, S, E); }
    if constexpr (WHICH == 4) { moe_tables(tb, cnt, N / 256); pg8::MoeOrder S{tb, tokof, N / 256, (int)gridDim.x, (int)blockIdx.x, false, (size_t)N * K}; pg8::EpiMoeDown E{(float*)o1, tokof, gateof}; gemm_run(lds, A, Bt, K, S, E); }
}

extern "C" void kernel_launch(void* const* d_in, const int* in_sizes, int n_in, void* d_out, int out_size, void* d_ws, size_t ws_size, hipStream_t stream) {
    if (n_in != 23 || out_size != T * D || ws_size < WS_END) { fprintf(stderr, "kernel_launch: bad shapes n_in %d out %d ws %zu (need %zu)\n", n_in, out_size, ws_size, (size_t)WS_END); return; }
    const float* x = (const float*)d_in[0]; const float* e_mix_norm = (const float*)d_in[1]; const float* e_w_in = (const float*)d_in[2]; const float* e_conv_w = (const float*)d_in[3];
    const float* e_ln_g = (const float*)d_in[4]; const float* e_ln_b = (const float*)d_in[5]; const float* e_w_sp = (const float*)d_in[6]; const float* e_b_sp = (const float*)d_in[7];
    const float* e_w_out = (const float*)d_in[8]; const float* e_ffn_norm = (const float*)d_in[9]; const float* e_w_gate = (const float*)d_in[10]; const float* e_w_up = (const float*)d_in[11];
    const float* e_w_down = (const float*)d_in[12]; const float* o_mix_norm = (const float*)d_in[13]; const float* o_w_qkv = (const float*)d_in[14]; const float* o_q_norm = (const float*)d_in[15];
    const float* o_k_norm = (const float*)d_in[16]; const float* o_w_o = (const float*)d_in[17]; const float* o_ffn_norm = (const float*)d_in[18]; const float* o_w_router = (const float*)d_in[19];
    const float* o_w_gate = (const float*)d_in[20]; const float* o_w_up = (const float*)d_in[21]; const float* o_w_down = (const float*)d_in[22];
    unsigned char* ws = (unsigned char*)d_ws; float* out = (float*)d_out;
    int* cnt = (int*)(ws + WS_CTL); float* ss0 = (float*)(ws + WS_SS0); float* ss1 = (float*)(ws + WS_SS1); float* ss2 = (float*)(ws + WS_SS2); float* ss3 = (float*)(ws + WS_SS3);
    float* rope = (float*)(ws + WS_ROPE); float* kmean = (float*)(ws + WS_KMEAN); int* tokof = (int*)(ws + WS_TOKOF); float* gateof = (float*)(ws + WS_GATEOF);
    bf16_t* win = (bf16_t*)(ws + WS_WIN); bf16_t* wout = (bf16_t*)(ws + WS_WOUT); bf16_t* wgu = (bf16_t*)(ws + WS_WGU); bf16_t* wdn = (bf16_t*)(ws + WS_WDN);
    bf16_t* wqkv = (bf16_t*)(ws + WS_WQKV); bf16_t* wo = (bf16_t*)(ws + WS_WO); bf16_t* mgu = (bf16_t*)(ws + WS_MGU); bf16_t* mdn = (bf16_t*)(ws + WS_MDN);
    unsigned char* ar = ws + WS_ARENA;
    bf16_t* xb = (bf16_t*)(ar + AR_XB); bf16_t* proj = (bf16_t*)(ar + AR_PROJ); bf16_t* y = (bf16_t*)(ar + AR_Y); bf16_t* h1b = (bf16_t*)(ar + AR_H1B); bf16_t* act = (bf16_t*)(ar + AR_ACT);
    bf16_t* h2b = (bf16_t*)(ar + AR_H2B); bf16_t* qkv = (bf16_t*)(ar + AR_QKV); bf16_t* ob = (bf16_t*)(ar + AR_O); bf16_t* h3b = (bf16_t*)(ar + AR_H3B); bf16_t* mact = (bf16_t*)(ar + AR_MACT);
    k_prep_w<<<dim3(NPROJ / 32, D / 32, 1), 256, 0, stream>>>(e_w_in, D, NPROJ, win, e_mix_norm, 0, 0, 0, 0);
    k_prep_w<<<dim3(D / 32, D / 32, 1), 256, 0, stream>>>(e_w_out, D, D, wout, nullptr, 0, 0, 0, 0);
    k_prep_w<<<dim3(FF / 32, D / 32, 1), 256, 0, stream>>>(e_w_gate, D, FF, wgu, e_ffn_norm, 1, 0, 0, 0);
    k_prep_w<<<dim3(FF / 32, D / 32, 1), 256, 0, stream>>>(e_w_up, D, FF, wgu, e_ffn_norm, 1, 1, 0, 0);
    k_prep_w<<<dim3(D / 32, FF / 32, 1), 256, 0, stream>>>(e_w_down, FF, D, wdn, nullptr, 0, 0, 0, 0);
    k_prep_w<<<dim3(NQKV / 32, D / 32, 1), 256, 0, stream>>>(o_w_qkv, D, NQKV, wqkv, o_mix_norm, 0, 0, 0, 0);
    k_prep_w<<<dim3(D / 32, D / 32, 1), 256, 0, stream>>>(o_w_o, D, D, wo, nullptr, 0, 0, 0, 0);
    k_prep_w<<<dim3(FE / 32, D / 32, NE), 256, 0, stream>>>(o_w_gate, D, FE, mgu, o_ffn_norm, 1, 0, (size_t)D * FE, (size_t)NGUE * D);
    k_prep_w<<<dim3(FE / 32, D / 32, NE), 256, 0, stream>>>(o_w_up, D, FE, mgu, o_ffn_norm, 1, 1, (size_t)D * FE, (size_t)NGUE * D);
    k_prep_w<<<dim3(D / 32, FE / 32, NE), 256, 0, stream>>>(o_w_down, FE, D, mdn, nullptr, 0, 0, (size_t)FE * D, (size_t)D * FE);
    k_rope_table<<<SEQ * 16 / 256, 256, 0, stream>>>(rope);
    k_rowprep<<<1024, 256, 0, stream>>>(x, xb, ss0, ss1, ss2, ss3, cnt);
    const int G = 256;
    static bool attr_done = false;
    if (!attr_done) { attr_done = true;
        hipFuncSetAttribute((const void*)k_gemm<0>, hipFuncAttributeMaxDynamicSharedMemorySize, LDS_BYTES); hipFuncSetAttribute((const void*)k_gemm<1>, hipFuncAttributeMaxDynamicSharedMemorySize, LDS_BYTES);
        hipFuncSetAttribute((const void*)k_gemm<2>, hipFuncAttributeMaxDynamicSharedMemorySize, LDS_BYTES); hipFuncSetAttribute((const void*)k_gemm<3>, hipFuncAttributeMaxDynamicSharedMemorySize, LDS_BYTES);
        hipFuncSetAttribute((const void*)k_gemm<4>, hipFuncAttributeMaxDynamicSharedMemorySize, LDS_BYTES); }
    k_gemm<0><<<G, 512, LDS_BYTES, stream>>>(xb, win, NPROJ, D, proj, nullptr, ss0, nullptr, nullptr, nullptr, nullptr, nullptr);
    k_mixer_naive<<<dim3(T / 128, 8), 256, 0, stream>>>(proj, e_conv_w, e_ln_g, e_ln_b, e_w_sp, e_b_sp, y);
    k_gemm<1><<<G, 512, LDS_BYTES, stream>>>(y, wout, D, D, out, h1b, nullptr, ss1, x, nullptr, nullptr, nullptr);
    k_gemm<2><<<G, 512, LDS_BYTES, stream>>>(h1b, wgu, NGU, D, act, nullptr, ss1, nullptr, nullptr, nullptr, nullptr, nullptr);
    k_gemm<1><<<G, 512, LDS_BYTES, stream>>>(act, wdn, D, FF, out, h2b, nullptr, ss2, out, nullptr, nullptr, nullptr);
    k_gemm<0><<<G, 512, LDS_BYTES, stream>>>(h2b, wqkv, NQKV, D, qkv, nullptr, ss2, nullptr, nullptr, nullptr, nullptr, nullptr);
    k_qkprep_naive<<<T * NH * 2 / 4, 256, 0, stream>>>(qkv, o_q_norm, o_k_norm, rope);
    k_kmean_naive<<<NBATCH * NH * NBLK, 128, 0, stream>>>(qkv, kmean);
    k_attn_naive<<<T * NH / 4, 256, 0, stream>>>(qkv, kmean, ob);
    k_gemm<1><<<G, 512, LDS_BYTES, stream>>>(ob, wo, D, D, out, h3b, nullptr, ss3, out, nullptr, nullptr, nullptr);
    k_router_naive<<<T / 4, 256, 0, stream>>>(out, ss3, o_ffn_norm, o_w_router, cnt, tokof, gateof);
    k_gemm<3><<<G, 512, LDS_BYTES, stream>>>(h3b, mgu, NGUE, D, mact, nullptr, ss3, nullptr, nullptr, cnt, tokof, nullptr);
    k_gemm<4><<<G, 512, LDS_BYTES, stream>>>(mact, mdn, D, FE, out, nullptr, nullptr, nullptr, nullptr, cnt, tokof, gateof);
}
```

```cpp
#include <hip/hip_runtime.h>
#include <hip/hip_cooperative_groups.h>
#include <cstdio>
#include <cstdint>

#define LAS __attribute__((address_space(3)))
typedef unsigned short bf16_t;
typedef short bf16x8 __attribute__((ext_vector_type(8)));
typedef float f32x4 __attribute__((ext_vector_type(4)));
typedef float f32x2 __attribute__((ext_vector_type(2)));
typedef float f32x16 __attribute__((ext_vector_type(16)));
typedef unsigned u32x4 __attribute__((ext_vector_type(4)));
typedef unsigned u32x2 __attribute__((ext_vector_type(2)));
typedef int v8i __attribute__((ext_vector_type(8)));

constexpr int T = 16384, D = 1024, SEQ = 4096, NBATCH = 4;
constexpr int CONV = 512, GM = 512, NPROJ = 2560;
constexpr int FF = 2816, NGU = 2 * FF;
constexpr int NH = 8, HD = 128, NQKV = 3072;
constexpr int NE = 8, FE = 3584, NGUE = 2 * FE;
constexpr int MB = 256, NBLK = SEQ / MB;
constexpr float EPS = 1e-6f;

constexpr size_t al256(size_t x) { return (x + 255) & ~(size_t)255; }
constexpr size_t WS_CTL = 0;
constexpr int NSS = 4;
constexpr size_t WS_CTLBYTES = 32768;
constexpr int CW_BKT = 64;
constexpr int CW_BAR = 1024;
constexpr size_t WS_SS0 = WS_CTLBYTES;
constexpr size_t WS_SS1 = WS_SS0 + (size_t)T * NSS * 4;
constexpr size_t WS_SS2 = WS_SS1 + (size_t)T * NSS * 4;
constexpr size_t WS_SS3 = WS_SS2 + (size_t)T * NSS * 4;
constexpr size_t WS_ROPE = WS_SS3 + (size_t)T * NSS * 4;
constexpr size_t WS_KMEAN = WS_ROPE + (size_t)SEQ * 16 * 2 * 4;
constexpr size_t WS_TOKOF = WS_KMEAN + (size_t)NBATCH * NH * NBLK * HD * 4;
constexpr size_t WS_GATEOF = WS_TOKOF + (size_t)NE * T * 4;
constexpr size_t WS_TSLOT = al256(WS_GATEOF + (size_t)NE * T * 4);
constexpr size_t WS_MINFO = al256(WS_TSLOT + (size_t)T * 2 * 4);
constexpr size_t WS_W = al256(WS_MINFO + (size_t)NE * T * 16);
constexpr size_t WS_WIN = WS_W;
constexpr size_t WS_WOUT = WS_WIN + (size_t)NPROJ * D * 2;
constexpr size_t WS_WGU = WS_WOUT + (size_t)D * D * 2;
constexpr size_t WS_WDN = WS_WGU + (size_t)NGU * D * 2;
constexpr size_t WS_WQKV = WS_WDN + (size_t)D * FF * 2;
constexpr size_t WS_WO = WS_WQKV + (size_t)NQKV * D * 2;
constexpr size_t WS_MGU = WS_WO + (size_t)D * D * 2;
constexpr size_t WS_MDN = WS_MGU + (size_t)NE * NGUE * D;
constexpr size_t WS_ARENA = WS_MDN + (size_t)NE * D * FE;
constexpr size_t SZ_TD2 = (size_t)T * D * 2;
constexpr size_t AR_XB = 0, AR_PROJ = SZ_TD2, AR_Y = 0, AR_H1B = SZ_TD2, AR_ACT = 2 * SZ_TD2, AR_H2B = 0, AR_QKV = SZ_TD2,
                 AR_O = SZ_TD2 + (size_t)T * NQKV * 2, AR_H3B = 0, AR_MACT = (size_t)68 << 20;
constexpr int BKT_CAP = 3840;
constexpr size_t WS_BLIST = WS_WIN;
constexpr size_t WS_LPART = WS_BLIST + (size_t)512 * BKT_CAP * 4;
constexpr size_t WS_H38 = WS_WIN;
constexpr size_t AR_OPART = AR_O;
static_assert(WS_LPART + (size_t)T * NH * 4 * 4 <= WS_WQKV && WS_H38 + (size_t)T * D <= WS_WQKV, "attention lists / h3 fp8 fit the layer-0 weight copies");
static_assert(AR_OPART + (size_t)T * NH * 4 * HD * 2 <= SZ_TD2 + (size_t)(2 * T + 256) * FE * 2, "attention partials fit the arena");
constexpr size_t AR_YPART = SZ_TD2;
constexpr size_t AR_Y2 = (size_t)186 << 20;
static_assert(AR_YPART + (size_t)256 * 256 * 256 * 2 <= AR_MACT && AR_MACT + (size_t)(2 * T + 256) * FE <= AR_Y2 && AR_Y2 + (size_t)2 * T * D * 2 <= SZ_TD2 + (size_t)(2 * T + 256) * FE * 2, "MoE down arena");
constexpr size_t WS_END = WS_ARENA + SZ_TD2 + (size_t)(2 * T + 256) * FE * 2;
static_assert(AR_ACT + (size_t)T * FF * 2 <= SZ_TD2 + (size_t)2 * T * FE * 2, "arena");
static_assert(WS_END <= 486079488ull, "workspace budget");

__device__ __forceinline__ unsigned f2bf(float f) { unsigned u = __builtin_bit_cast(unsigned, f); return (u + 0x7fffu + ((u >> 16) & 1u)) >> 16; }
__device__ __forceinline__ float bf2f(unsigned b) { return __builtin_bit_cast(float, b << 16); }
__device__ __forceinline__ unsigned pk2(float lo, float hi) { return f2bf(lo) | (f2bf(hi) << 16); }
__device__ __forceinline__ unsigned cvt_pk_bf16(float lo, float hi) { unsigned r; asm volatile("v_cvt_pk_bf16_f32 %0, %1, %2" : "=v"(r) : "v"(lo), "v"(hi)); return r; }
__device__ __forceinline__ int opaque_tid(int wid) { int l; asm volatile("v_mbcnt_lo_u32_b32 %0, -1, 0\n\tv_mbcnt_hi_u32_b32 %0, -1, %0" : "=v"(l)); return wid * 64 + l; }
__device__ __forceinline__ float wave_sum(float v) {
#pragma unroll
    for (int o = 1; o < 64; o <<= 1) v += __shfl_xor(v, o);
    return v;
}
__device__ __forceinline__ float rscale_of(const f32x4 p) { return rsqrtf(((p[0] + p[1]) + (p[2] + p[3])) * (1.0f / D) + EPS); }
__device__ __forceinline__ float row_rscale(const float* ssp, int row) { return rscale_of(*(const f32x4*)(ssp + (size_t)row * NSS)); }
__device__ __forceinline__ unsigned pk_fp8x4(float a, float b, float c, float d) {
    a = fminf(fmaxf(a, -448.f), 448.f); b = fminf(fmaxf(b, -448.f), 448.f); c = fminf(fmaxf(c, -448.f), 448.f); d = fminf(fmaxf(d, -448.f), 448.f);
    int p = __builtin_amdgcn_cvt_pk_fp8_f32(a, b, 0, false); p = __builtin_amdgcn_cvt_pk_fp8_f32(c, d, p, true); return (unsigned)p; }
__device__ __forceinline__ float silu_f(float g) { return g * __builtin_amdgcn_rcpf(1.0f + __builtin_amdgcn_exp2f(g * -1.4426950408889634f)); }

namespace pg8 {
constexpr int BM = 256, BK = 64, HALF = 128, HTB = HALF * BK * 2, STAGE_BYTES = 8 * HTB, NXCD = 8, WGM = 8;
constexpr int RI_OFF = STAGE_BYTES, RI_BYTES = 4 * 4096;
constexpr int EPI_OFF = RI_OFF + RI_BYTES, EPI_TILE = 8 * 144;
__host__ __device__ __forceinline__ int lds_byte(int r, int c) { const int st = (r >> 4) * 2 + (c >> 5), rr = r & 15, cc = c & 31, ob = rr * 64 + cc * 2; return st * 1024 + (ob ^ (((ob >> 9) & 1) << 5)); }
__host__ __device__ __forceinline__ void stage_rc(int b, int& R, int& C) { const int st = b / 1024, sb = b % 1024, swz = sb ^ (((sb >> 9) & 1) << 5); R = (st >> 1) * 16 + swz / 64; C = (st & 1) * 32 + (swz % 64) / 2; }
__host__ __device__ __forceinline__ int perm32(int rho) { const int n = rho >> 4, i = rho & 15; return 8 * (i >> 2) + 4 * n + (i & 3); }

struct Unit { int row0, pn, e, nvalid, kt0, nkt, piece; };

struct DenseOrder {
    int nM, nN, nwg, G, c, nkt;
    __device__ void init(int M, int N, int K, int G_, int c_) { nM = M / BM; nN = N / BM; nwg = nM * nN; G = G_; c = c_; nkt = K / BK; }
    __device__ __forceinline__ bool next(int i, Unit& u) const {
        const long L = (long)i * G + c; if (L >= nwg) return false;
        int wgid = (int)L; { const int q = nwg / NXCD, r = nwg % NXCD, xcd = wgid % NXCD, off = wgid / NXCD; wgid = (xcd < r ? xcd * (q + 1) : r * (q + 1) + (xcd - r) * q) + off; }
        const int nig = WGM * nN, gid = wgid / nig, fm = gid * WGM, gsz = (nM - fm) < WGM ? (nM - fm) : WGM;
        u.row0 = (fm + ((wgid % nig) % gsz)) * BM; u.pn = (wgid % nig) / gsz; u.e = 0; u.nvalid = BM; u.kt0 = 0; u.nkt = nkt; u.piece = -1; return true;
    }
    __device__ __forceinline__ int src_row(const Unit& u, int r) const { return u.row0 + r; }
    __device__ __forceinline__ unsigned tbl_off(const Unit& u) const { return (unsigned)u.row0 * 16u; }
    __device__ __forceinline__ size_t b_off(const Unit&) const { return 0; }
};
struct MoeOrder {
    __device__ __forceinline__ int tbv(int i) const { return __builtin_amdgcn_readfirstlane(tb[i]); }
    const LAS int* tb; const int* tokof; int nN, G, c; bool gather; size_t bstride; int nkt; bool splitk;
    __device__ __forceinline__ void tile(int L, Unit& u) const {
        const int nwg = tbv(8);
        int wgid = L; { const int q = nwg / NXCD, r = nwg % NXCD, xcd = wgid % NXCD, off = wgid / NXCD; wgid = (xcd < r ? xcd * (q + 1) : r * (q + 1) + (xcd - r) * q) + off; }
        int e = 0;
#pragma unroll
        for (int j = 1; j < 8; ++j) e += (wgid >= tbv(j)) ? 1 : 0;
        const int w = wgid - tbv(e), cnt = tbv(32 + e), nM = (cnt + BM - 1) / BM;
        const int nig = WGM * nN, gid = w / nig, fm = gid * WGM, gsz = (nM - fm) < WGM ? (nM - fm) : WGM;
        const int pm = fm + ((w % nig) % gsz); u.pn = (w % nig) / gsz; u.e = e; u.row0 = pm * BM; u.nvalid = (cnt - pm * BM) < BM ? (cnt - pm * BM) : BM;
    }
    __device__ __forceinline__ void tile_nat(int wg, Unit& u) const {
        int e = 0;
#pragma unroll
        for (int j = 1; j < 8; ++j) e += (wg >= tbv(j)) ? 1 : 0;
        const int w = wg - tbv(e), cnt = tbv(32 + e), pm = w / nN; u.pn = w % nN; u.e = e; u.row0 = pm * BM; u.nvalid = (cnt - pm * BM) < BM ? (cnt - pm * BM) : BM;
    }
    __device__ __forceinline__ int pieces(int nwg) const { const int base = (nwg / G) * G, R = nwg - base, ntrip = nkt / 2; int p = 1; if (R * 2 <= G && ntrip % 2 == 0) p = 2; if (R * 7 <= G && ntrip % 7 == 0) p = 7; return p; }
    __device__ __forceinline__ bool next(int i, Unit& u) const {
        const long L = (long)i * G + c; const int nwg = tbv(8);
        if (!splitk) { if (L >= nwg) return false; tile((int)L, u); u.kt0 = 0; u.nkt = nkt; u.piece = -1; return true; }
        const int base = (nwg / G) * G, R = nwg - base;
        if (L < base) { const int wg = ((int)L % NXCD) * (base / NXCD) + (int)L / NXCD; tile_nat(wg, u); u.kt0 = 0; u.nkt = nkt; u.piece = -1; return true; }
        if (R == 0) return false;
        const int p = pieces(nwg), j = (int)(L - base); if (j >= R * p) return false;
        tile_nat(base + j / p, u); const int per = nkt / p; u.kt0 = (j % p) * per; u.nkt = per; u.piece = j; return true;
    }
    __device__ __forceinline__ int src_row(const Unit& u, int r) const {
        if (gather) return (r < u.nvalid) ? tokof[u.e * T + u.row0 + r] : 0;
        return tbv(16 + u.e) + u.row0 + r;
    }
    __device__ __forceinline__ unsigned tbl_off(const Unit& u) const { return (unsigned)(u.e * T + u.row0) * 16u; }
    __device__ __forceinline__ size_t b_off(const Unit& u) const { return (size_t)u.e * bstride; }
};

struct EpiScaleBf16 {
    static constexpr bool PERM = true;
    bf16_t* O; int ldc; const float* ss;
    __device__ __forceinline__ void operator()(const f32x4 (&acc)[2][2][4][2], const Unit& u, int wr, int wc, int fr, int fq, const LAS f32x4* tbl) const {
        const int col0 = u.pn * BM + wc * 32 + 8 * fq; float rs[2][4]; const LAS f32x4* tb0 = tbl + (wr * 64 + fr); asm volatile("" : "+v"(tb0));
#pragma unroll
        for (int ai = 0; ai < 2; ++ai)
#pragma unroll
            for (int m = 0; m < 4; ++m) rs[ai][m] = rscale_of(tb0[ai * HALF + m * 16]);
#pragma unroll
        for (int ai = 0; ai < 2; ++ai)
#pragma unroll
            for (int m = 0; m < 4; ++m) { const int row = u.row0 + ai * HALF + wr * 64 + m * 16 + fr; const float r = rs[ai][m];
                bf16_t* rowp = O + (size_t)row * ldc + col0;
#pragma unroll
                for (int bj = 0; bj < 2; ++bj) { const f32x4 v0 = acc[ai][bj][m][0] * r, v1 = acc[ai][bj][m][1] * r;
                    u32x4 w; w.x = cvt_pk_bf16(v0[0], v0[1]); w.y = cvt_pk_bf16(v0[2], v0[3]); w.z = cvt_pk_bf16(v1[0], v1[1]); w.w = cvt_pk_bf16(v1[2], v1[3]);
                    *(u32x4*)(rowp + bj * HALF) = w; } }
    }
};
struct EpiQKV {
    static constexpr bool PERM = true;
    bf16_t* O; const float* qg; const float* kg; const float* rope; float* kmean; LAS unsigned char* lds; int wid;
    __device__ __forceinline__ void operator()(const f32x4 (&acc)[2][2][4][2], const Unit& u, int wr, int wc, int, int, const LAS f32x4* tbl) const {
        const int lane = opaque_tid(wid) & 63, fr = lane & 15, fq = lane >> 4;
        const int col0 = u.pn * BM + wc * 32 + 8 * fq; const LAS f32x4* tb0 = tbl + (wr * 64 + fr);
        float rr[2][4];
#pragma unroll
        for (int ai = 0; ai < 2; ++ai)
#pragma unroll
            for (int m = 0; m < 4; ++m) rr[ai][m] = rscale_of(tb0[ai * HALF + m * 16]);
        if (u.pn >= 8) {
#pragma unroll
            for (int ai = 0; ai < 2; ++ai)
#pragma unroll
                for (int m = 0; m < 4; ++m) { const int row = u.row0 + ai * HALF + wr * 64 + m * 16 + fr; bf16_t* rowp = O + (size_t)row * NQKV + col0; const float r = rr[ai][m];
#pragma unroll
                    for (int bj = 0; bj < 2; ++bj) { const f32x4 v0 = acc[ai][bj][m][0] * r, v1 = acc[ai][bj][m][1] * r;
                        u32x4 w; w.x = cvt_pk_bf16(v0[0], v0[1]); w.y = cvt_pk_bf16(v0[2], v0[3]); w.z = cvt_pk_bf16(v1[0], v1[1]); w.w = cvt_pk_bf16(v1[2], v1[3]);
                        *(u32x4*)(rowp + bj * HALF) = w; } }
            return; }
        LAS float* sc = (LAS float*)(lds + EPI_OFF);
#pragma unroll
        for (int ai = 0; ai < 2; ++ai)
#pragma unroll
            for (int m = 0; m < 4; ++m) { const int tr = ai * HALF + wr * 64 + m * 16 + fr; const float r = rr[ai][m];
#pragma unroll
                for (int bj = 0; bj < 2; ++bj) { const f32x4 v0 = acc[ai][bj][m][0] * r, v1 = acc[ai][bj][m][1] * r;
                    float q = ((v0[0] * v0[0] + v0[1] * v0[1]) + (v0[2] * v0[2] + v0[3] * v0[3])) + ((v1[0] * v1[0] + v1[1] * v1[1]) + (v1[2] * v1[2] + v1[3] * v1[3]));
                    q += __shfl_xor(q, 16); q += __shfl_xor(q, 32);
                    if (fq == 0) sc[(tr * 2 + bj) * 4 + wc] = q; } }
        asm volatile("s_waitcnt lgkmcnt(0)" ::: "memory"); __builtin_amdgcn_s_barrier(); asm volatile("" ::: "memory");
        const bool isk = u.pn >= 4; const float* gp = (isk ? kg : qg) + wc * 32 + 8 * fq; const f32x4 g0 = *(const f32x4*)gp, g1 = *(const f32x4*)(gp + 4);
        const int b = u.row0 / SEQ, nblk = (u.row0 % SEQ) / MB, h0 = (u.pn & 3) * 2;
        float cs[2][2][4];
#pragma unroll
        for (int bj = 0; bj < 2; ++bj)
#pragma unroll
            for (int n = 0; n < 2; ++n)
#pragma unroll
                for (int j = 0; j < 4; ++j) cs[bj][n][j] = 0.f;
#pragma unroll
        for (int ai = 0; ai < 2; ++ai)
#pragma unroll
            for (int m = 0; m < 4; ++m) { const int tr = ai * HALF + wr * 64 + m * 16 + fr, row = u.row0 + tr; const float r = rr[ai][m]; bf16_t* rowp = O + (size_t)row * NQKV + col0;
                f32x4 rc0 = (f32x4){1.f, 0.f, 1.f, 0.f}, rc1 = rc0, rc2 = rc0, rc3 = rc0;
                if (wc == 0) { const f32x4* rp = (const f32x4*)(rope + ((size_t)(row % SEQ) * 16 + 8 * (fq & 1)) * 2); rc0 = rp[0]; rc1 = rp[1]; rc2 = rp[2]; rc3 = rp[3]; }
#pragma unroll
                for (int bj = 0; bj < 2; ++bj) { const f32x4 p4 = *(const LAS f32x4*)(sc + (tr * 2 + bj) * 4); const float rn = rsqrtf(((p4[0] + p4[1]) + (p4[2] + p4[3])) * (1.0f / HD) + EPS) * r;
                    f32x4 v0 = acc[ai][bj][m][0] * rn * g0, v1 = acc[ai][bj][m][1] * rn * g1;
                    if (wc == 0) {
                        const float c[8] = {rc0[0], rc0[2], rc1[0], rc1[2], rc2[0], rc2[2], rc3[0], rc3[2]}, sn[8] = {rc0[1], rc0[3], rc1[1], rc1[3], rc2[1], rc2[3], rc3[1], rc3[3]};
#pragma unroll
                        for (int j = 0; j < 4; ++j) { const float p0 = __shfl_xor(v0[j], 32), p1 = __shfl_xor(v1[j], 32);
                            v0[j] = (fq < 2) ? v0[j] * c[j] - p0 * sn[j] : v0[j] * c[j] + p0 * sn[j]; v1[j] = (fq < 2) ? v1[j] * c[4 + j] - p1 * sn[4 + j] : v1[j] * c[4 + j] + p1 * sn[4 + j]; } }
                    u32x4 w; w.x = cvt_pk_bf16(v0[0], v0[1]); w.y = cvt_pk_bf16(v0[2], v0[3]); w.z = cvt_pk_bf16(v1[0], v1[1]); w.w = cvt_pk_bf16(v1[2], v1[3]);
                    *(u32x4*)(rowp + bj * HALF) = w;
                    if (isk) { cs[bj][0][0] += bf2f(w.x & 0xffffu); cs[bj][0][1] += __builtin_bit_cast(float, w.x & 0xffff0000u); cs[bj][0][2] += bf2f(w.y & 0xffffu); cs[bj][0][3] += __builtin_bit_cast(float, w.y & 0xffff0000u);
                               cs[bj][1][0] += bf2f(w.z & 0xffffu); cs[bj][1][1] += __builtin_bit_cast(float, w.z & 0xffff0000u); cs[bj][1][2] += bf2f(w.w & 0xffffu); cs[bj][1][3] += __builtin_bit_cast(float, w.w & 0xffff0000u); } } }
        if (isk) {
#pragma unroll
            for (int bj = 0; bj < 2; ++bj)
#pragma unroll
                for (int n = 0; n < 2; ++n)
#pragma unroll
                    for (int j = 0; j < 4; ++j) { float v = cs[bj][n][j]; v += __shfl_xor(v, 1); v += __shfl_xor(v, 2); v += __shfl_xor(v, 4); v += __shfl_xor(v, 8);
                        if (fr == 0) atomicAdd(kmean + ((size_t)(b * NH + h0 + bj) * NBLK + nblk) * HD + wc * 32 + 8 * fq + 4 * n + j, v * (1.0f / MB)); } }
    }
};
struct EpiSwiglu {
    static constexpr bool PERM = true;
    bf16_t* O; int ldc; const float* ss; const int* tokof; const LAS int* tb; bool moe;
    __device__ __forceinline__ void operator()(const f32x4 (&acc)[2][2][4][2], const Unit& u, int wr, int wc, int fr, int fq, const LAS f32x4* tbl) const {
        const int col0 = u.pn * HALF + wc * 32 + 8 * fq; float rs[2][4]; int orow[2][4]; int trb = wr * 64 + fr; asm volatile("" : "+v"(trb));
#pragma unroll
        for (int ai = 0; ai < 2; ++ai)
#pragma unroll
            for (int m = 0; m < 4; ++m) { const int tr = ai * HALF + m * 16 + trb; int srow;
                if (moe) { const bool ok = tr < u.nvalid; srow = ok ? tokof[u.e * T + u.row0 + tr] : 0; orow[ai][m] = ok ? tb[16 + u.e] + u.row0 + tr : -1; } else { srow = u.row0 + tr; orow[ai][m] = srow; }
                rs[ai][m] = moe ? tbl[tr][0] : rscale_of(tbl[tr]); }
#pragma unroll
        for (int ai = 0; ai < 2; ++ai)
#pragma unroll
            for (int m = 0; m < 4; ++m) { const float r = rs[ai][m];
                f32x4 a[2];
#pragma unroll
                for (int n = 0; n < 2; ++n) { const f32x4 g = acc[ai][0][m][n] * r, up = acc[ai][1][m][n] * r;
#pragma unroll
                    for (int j = 0; j < 4; ++j) a[n][j] = silu_f(g[j]) * up[j]; }
                if (moe) { u32x2 w8; w8.x = pk_fp8x4(a[0][0] * 4.f, a[0][1] * 4.f, a[0][2] * 4.f, a[0][3] * 4.f); w8.y = pk_fp8x4(a[1][0] * 4.f, a[1][1] * 4.f, a[1][2] * 4.f, a[1][3] * 4.f);
                    if (orow[ai][m] >= 0) *(u32x2*)((unsigned char*)O + (size_t)orow[ai][m] * ldc + col0) = w8; }
                else { u32x4 w; w.x = cvt_pk_bf16(a[0][0], a[0][1]); w.y = cvt_pk_bf16(a[0][2], a[0][3]); w.z = cvt_pk_bf16(a[1][0], a[1][1]); w.w = cvt_pk_bf16(a[1][2], a[1][3]);
                    if (orow[ai][m] >= 0) *(u32x4*)(O + (size_t)orow[ai][m] * ldc + col0) = w; } }
    }
};
template <bool BASE16, bool F8COPY> struct EpiResid {
    static constexpr bool PERM = false;
    const void* base; bf16_t* hb; unsigned char* h8; float* ssout; LAS unsigned char* lds; int wid;
    __device__ __forceinline__ void operator()(const f32x4 (&acc)[2][2][4][2], const Unit& u, int wr, int wc, int fr, int fq, const LAS f32x4*) const {
        const int col0 = u.pn * BM + wc * 32 + 4 * fq; LAS float* sc = (LAS float*)(lds + EPI_OFF);
#pragma unroll
        for (int ai = 0; ai < 2; ++ai)
#pragma unroll
            for (int m = 0; m < 4; ++m) { const int tr = ai * HALF + wr * 64 + m * 16 + fr, row = u.row0 + tr; const size_t off = (size_t)row * D + col0; float q = 0.f;
#pragma unroll
                for (int bj = 0; bj < 2; ++bj)
#pragma unroll
                    for (int n = 0; n < 2; ++n) { f32x4 bv;
                        if (BASE16) { const u32x2 r = *(const u32x2*)((const bf16_t*)base + off + bj * HALF + n * 16); bv[0] = bf2f(r.x & 0xffffu); bv[1] = __builtin_bit_cast(float, r.x & 0xffff0000u); bv[2] = bf2f(r.y & 0xffffu); bv[3] = __builtin_bit_cast(float, r.y & 0xffff0000u); }
                        else bv = *(const f32x4*)((const float*)base + off + bj * HALF + n * 16);
                        const f32x4 h = bv + acc[ai][bj][m][n]; q += (h[0] * h[0] + h[1] * h[1]) + (h[2] * h[2] + h[3] * h[3]);
                        u32x2 w; w.x = cvt_pk_bf16(h[0], h[1]); w.y = cvt_pk_bf16(h[2], h[3]); *(u32x2*)(hb + off + bj * HALF + n * 16) = w;
                        if (F8COPY) *(unsigned*)(h8 + off + bj * HALF + n * 16) = pk_fp8x4(h[0], h[1], h[2], h[3]); }
                q += __shfl_xor(q, 16); q += __shfl_xor(q, 32);
                if (fq == 0) sc[tr * 4 + wc] = q;
                asm volatile("" ::: "memory"); }
        asm volatile("s_waitcnt lgkmcnt(0)" ::: "memory"); __builtin_amdgcn_s_barrier(); asm volatile("" ::: "memory");
        { const int t2 = opaque_tid(wid); if (t2 < 256) { const f32x4 p = *(const LAS f32x4*)(sc + t2 * 4); ssout[(size_t)(u.row0 + t2) * NSS + u.pn] = (p[0] + p[1]) + (p[2] + p[3]); } }
        asm volatile("s_waitcnt lgkmcnt(0)" ::: "memory"); __builtin_amdgcn_s_barrier(); asm volatile("" ::: "memory");
    }
};
struct EpiMoeDown {
    static constexpr bool PERM = true;
    bf16_t* y2; bf16_t* ypart; const float* gateof; const LAS int* tb; int wid;
    __device__ __forceinline__ void operator()(const f32x4 (&acc)[2][2][4][2], const Unit& u, int wr, int wc, int, int, const LAS f32x4*) const {
        const int lane = opaque_tid(wid) & 63, fr = lane & 15, fq = lane >> 4;
        const int cloc = wc * 32 + 8 * fq, trb = wr * 64 + fr;
        bf16_t* ob = (u.piece >= 0) ? ypart + (size_t)u.piece * (BM * BM) + cloc : y2 + (size_t)(tb[16 + u.e] + u.row0) * D + u.pn * BM + cloc; const int ld = (u.piece >= 0) ? BM : D;
#pragma unroll
        for (int ai = 0; ai < 2; ++ai)
#pragma unroll
            for (int m = 0; m < 4; ++m) { const int tr = ai * HALF + m * 16 + trb; const bool ok = tr < u.nvalid; const float gt = ok ? gateof[u.e * T + u.row0 + tr] : 0.f;
#pragma unroll
                for (int bj = 0; bj < 2; ++bj) { const f32x4 v0 = acc[ai][bj][m][0] * gt, v1 = acc[ai][bj][m][1] * gt;
                    u32x4 w; w.x = cvt_pk_bf16(v0[0], v0[1]); w.y = cvt_pk_bf16(v0[2], v0[3]); w.z = cvt_pk_bf16(v1[0], v1[1]); w.w = cvt_pk_bf16(v1[2], v1[3]);
                    if (ok) *(u32x4*)(ob + (size_t)tr * ld + bj * HALF) = w; } }
    }
};

template <class Epi, class Sched, bool ALIGN_EPI, bool F8>
__device__ __forceinline__ void gemm_fast(LAS unsigned char* lds, const void* A, int ldab, const void* Bt, int Kb, const void* tblbase, const Sched& S, const Epi& E, int wid, bool noepi, int sclA, int sclB) {
    const int lane = opaque_tid(wid) & 63, wr = wid >> 2, wc = wid & 3, fr = lane & 15, fq = lane >> 4;
    unsigned voffB[2];
#pragma unroll
    for (int i = 0; i < 2; ++i) { int R, C; stage_rc(opaque_tid(wid) * 16 + i * 8192, R, C); const int Rb = Epi::PERM ? ((R & ~31) + perm32(R & 31)) : R; voffB[i] = (unsigned)Rb * (unsigned)Kb + (unsigned)C * 2u; }
    const unsigned kstep = (unsigned)(BK * 2), hstep = (unsigned)HALF * (unsigned)Kb, tstep = 2u * hstep;
    const unsigned ldsw = (unsigned)wid * 1024u;
    const int fcol = fq * 8; constexpr int KOFF = 1024;
    const int aoff = lds_byte(wr * 64 + fr, fcol), boff = lds_byte(wc * 32 + fr, fcol);
    const __amdgpu_buffer_rsrc_t rA = __builtin_amdgcn_make_buffer_rsrc((void*)A, 0, 0x7fffffff, 0x00020000), rB = __builtin_amdgcn_make_buffer_rsrc((void*)Bt, 0, 0x7fffffff, 0x00020000), rT = __builtin_amdgcn_make_buffer_rsrc((void*)tblbase, 0, 0x7fffffff, 0x00020000);
#define PG8_SA(b, h) (((b) * 2 + (h)) * HTB)
#define PG8_SB(b, h) ((4 + (b) * 2 + (h)) * HTB)
#define PG8_STAGE(bufoff, rsrc, soff, voff) do { _Pragma("unroll") for (int _i = 0; _i < 2; ++_i) \
        __builtin_amdgcn_raw_ptr_buffer_load_lds(rsrc, (LAS void*)(lds + (bufoff) + ldsw + _i * 8192), 16, (voff)[_i], (soff), 0, 0); } while (0)
#define PG8_LDA(dst, b, h) do { _Pragma("unroll") for (int m = 0; m < 4; ++m) _Pragma("unroll") for (int k = 0; k < 2; ++k) dst[m][k] = *(const LAS bf16x8*)(lds + PG8_SA(b, h) + aoff + m * 2048 + k * KOFF); } while (0)
#define PG8_LDB(dst, b, h) do { _Pragma("unroll") for (int n = 0; n < 2; ++n) _Pragma("unroll") for (int k = 0; k < 2; ++k) dst[n][k] = *(const LAS bf16x8*)(lds + PG8_SB(b, h) + boff + n * 2048 + k * KOFF); } while (0)
#define PG8_V8(f) __builtin_shufflevector(__builtin_bit_cast(u32x4, (f)[0]), __builtin_bit_cast(u32x4, (f)[1]), 0, 1, 2, 3, 4, 5, 6, 7)
#define PG8_MMA(ai, bj, At, Bt_) do { __builtin_amdgcn_s_setprio(1); _Pragma("unroll") for (int m = 0; m < 4; ++m) _Pragma("unroll") for (int n = 0; n < 2; ++n) { \
        if constexpr (F8) acc[ai][bj][m][n] = __builtin_amdgcn_mfma_scale_f32_16x16x128_f8f6f4(__builtin_bit_cast(v8i, PG8_V8(Bt_[n])), __builtin_bit_cast(v8i, PG8_V8(At[m])), acc[ai][bj][m][n], 0, 0, 0, sclB, 0, sclA); \
        else { _Pragma("unroll") for (int k = 0; k < 2; ++k) acc[ai][bj][m][n] = __builtin_amdgcn_mfma_f32_16x16x32_bf16(Bt_[n][k], At[m][k], acc[ai][bj][m][n], 0, 0, 0); } } __builtin_amdgcn_s_setprio(0); } while (0)
#define PG8_WAIT_V(n) asm volatile("s_waitcnt vmcnt(" #n ")" ::: "memory")
#define PG8_WAIT_L(n) asm volatile("s_waitcnt lgkmcnt(" #n ")" ::: "memory")
#define PG8_BAR __builtin_amdgcn_s_barrier()
#define PG8_SCHED __builtin_amdgcn_sched_barrier(0)
#define PG8_TBL(u, bf) __builtin_amdgcn_raw_ptr_buffer_load_lds(rT, (LAS void*)(lds + RI_OFF + ((bf) * 2 + wr) * 4096 + wc * 1024), 16, (unsigned)lane * 16u, S.tbl_off(u) + (unsigned)wc * 1024u, 0, 0)
#define PG8_AOFFS(u, ao) do { _Pragma("unroll") for (int _i = 0; _i < 2; ++_i) { int _R, _C; stage_rc(opaque_tid(wid) * 16 + _i * 8192, _R, _C); _Pragma("unroll") for (int _h = 0; _h < 2; ++_h) \
        ao[_h][_i] = (unsigned)S.src_row(u, _h * HALF + _R) * (unsigned)ldab + (unsigned)_C * 2u; } } while (0)
    Unit cur, nxt; int ui = 0;
    if (!S.next(0, cur)) return;
    f32x4 acc[2][2][4][2];
#pragma unroll
    for (int a = 0; a < 2; ++a)
#pragma unroll
        for (int b = 0; b < 2; ++b)
#pragma unroll
            for (int m = 0; m < 4; ++m)
#pragma unroll
                for (int n = 0; n < 2; ++n) acc[a][b][m][n] = (f32x4){0.f, 0.f, 0.f, 0.f};
    bf16x8 At[4][2], B0[2][2], B1[2][2];
    unsigned aoc[2][2], aon[2][2];
    PG8_AOFFS(cur, aoc);
    unsigned sA = (unsigned)cur.kt0 * kstep;
    unsigned sB = (unsigned)(S.b_off(cur) * 2) + (unsigned)cur.pn * tstep + (unsigned)cur.kt0 * kstep;
    PG8_TBL(cur, 0);
    PG8_STAGE(PG8_SB(0, 0), rB, sB, voffB); PG8_STAGE(PG8_SB(0, 1), rB, sB + hstep, voffB); PG8_STAGE(PG8_SA(0, 0), rA, sA, aoc[0]); PG8_STAGE(PG8_SA(0, 1), rA, sA, aoc[1]);
    if (wr == 1) PG8_BAR;
    PG8_WAIT_V(2); PG8_BAR;
    PG8_STAGE(PG8_SB(1, 0), rB, sB + kstep, voffB); PG8_STAGE(PG8_SA(1, 0), rA, sA + kstep, aoc[0]); PG8_STAGE(PG8_SB(1, 1), rB, sB + hstep + kstep, voffB);
    PG8_WAIT_V(6); PG8_BAR;
    for (;;) {
        const bool has_next = S.next(ui + 1, nxt);
        if (has_next) { PG8_AOFFS(nxt, aon); } else {
#pragma unroll
            for (int h = 0; h < 2; ++h)
#pragma unroll
                for (int i = 0; i < 2; ++i) aon[h][i] = aoc[h][i]; }
        const unsigned nsB = has_next ? (unsigned)(S.b_off(nxt) * 2) + (unsigned)nxt.pn * tstep + (unsigned)nxt.kt0 * kstep : sB;
        const unsigned nsA = has_next ? (unsigned)nxt.kt0 * kstep : sA;
        const int nt = cur.nkt; int tsel = has_next ? 0 : -2; asm volatile("" : "+s"(tsel));
        for (int t = 0; t < nt; t += 2) {
            const bool last = (t == nt - 2);
            const unsigned a1 = sA + (unsigned)(t + 1) * kstep;
            const unsigned a2 = last ? nsA : sA + (unsigned)(t + 2) * kstep, b2 = last ? nsB : sB + (unsigned)(t + 2) * kstep;
            const unsigned a3 = a2 + kstep, b3 = b2 + kstep;
            PG8_LDB(B0, 0, 0); PG8_LDB(B1, 0, 1); PG8_SCHED; PG8_LDA(At, 0, 0); PG8_STAGE(PG8_SA(1, 1), rA, a1, aoc[1]);
            if (last) {
#pragma unroll
                for (int h = 0; h < 2; ++h)
#pragma unroll
                    for (int i = 0; i < 2; ++i) aoc[h][i] = aon[h][i]; }
            PG8_WAIT_V(8); PG8_WAIT_L(0); PG8_BAR; PG8_MMA(0, 0, At, B0); PG8_MMA(0, 1, At, B1); PG8_BAR; PG8_SCHED;
            PG8_LDA(At, 0, 1); if (t == tsel) PG8_TBL(nxt, (ui + 1) & 1);
            PG8_STAGE(PG8_SB(0, 0), rB, b2, voffB); PG8_STAGE(PG8_SB(0, 1), rB, b2 + hstep, voffB); PG8_STAGE(PG8_SA(0, 0), rA, a2, aoc[0]);
            PG8_WAIT_V(8); PG8_WAIT_L(0); PG8_BAR; PG8_MMA(1, 0, At, B0); PG8_MMA(1, 1, At, B1); PG8_BAR; PG8_SCHED;
            PG8_LDB(B0, 1, 0); PG8_LDB(B1, 1, 1); PG8_SCHED; PG8_LDA(At, 1, 0); PG8_STAGE(PG8_SA(0, 1), rA, a2, aoc[1]);
            PG8_WAIT_V(8); PG8_WAIT_L(0); PG8_BAR; PG8_MMA(0, 0, At, B0); PG8_MMA(0, 1, At, B1); PG8_BAR; PG8_SCHED;
            PG8_LDA(At, 1, 1); PG8_STAGE(PG8_SB(1, 0), rB, b3, voffB); PG8_STAGE(PG8_SB(1, 1), rB, b3 + hstep, voffB); PG8_STAGE(PG8_SA(1, 0), rA, a3, aoc[0]);
            PG8_WAIT_V(8); PG8_WAIT_L(0); PG8_BAR; PG8_MMA(1, 0, At, B0); PG8_MMA(1, 1, At, B1); PG8_BAR; PG8_SCHED;
        }
        if constexpr (ALIGN_EPI) { if (wr == 0) PG8_BAR; }
        if (!noepi) E(acc, cur, wr, wc, fr, fq, (const LAS f32x4*)(lds + RI_OFF + ((ui & 1) * 2 + wr) * 4096));
        if (!has_next) break;
#pragma unroll
        for (int a = 0; a < 2; ++a)
#pragma unroll
            for (int b = 0; b < 2; ++b)
#pragma unroll
                for (int m = 0; m < 4; ++m)
#pragma unroll
                    for (int n = 0; n < 2; ++n) acc[a][b][m][n] = (f32x4){0.f, 0.f, 0.f, 0.f};
        cur = nxt; sB = nsB; sA = nsA; ++ui;
        if constexpr (ALIGN_EPI) { if (wr == 1) PG8_BAR; }
    }
    PG8_WAIT_V(0);
    if constexpr (!ALIGN_EPI) { if (wr == 0) PG8_BAR; }
    PG8_BAR;
#undef PG8_SA
#undef PG8_SB
#undef PG8_STAGE
#undef PG8_LDA
#undef PG8_LDB
#undef PG8_MMA
#undef PG8_V8
#undef PG8_WAIT_V
#undef PG8_WAIT_L
#undef PG8_BAR
#undef PG8_SCHED
#undef PG8_AOFFS
#undef PG8_TBL
}
}

namespace cg = cooperative_groups;
constexpr int NTHREADS = 512, NWAVES = 8;
constexpr int LDS_BYTES = 163840;
constexpr int LDS_TB = LDS_BYTES - 1024;
constexpr int LDS_PTR = LDS_TB + 256;
constexpr int LDS_BST = LDS_PTR + 256;

struct Params {
    const float* in[23];
    float* out; unsigned char* ws;
    unsigned mask; int probe;
};
enum { I_X = 0, I_EMIXN, I_EWIN, I_ECONVW, I_ELNG, I_ELNB, I_EWSP, I_EBSP, I_EWOUT, I_EFFNN, I_EWGATE, I_EWUP, I_EWDOWN, I_OMIXN, I_OWQKV, I_OQN, I_OKN, I_OWO, I_OFFNN, I_OWR, I_OWGATE, I_OWUP, I_OWDOWN, I_OUT, I_WS };
struct Ctx { LAS unsigned char* lds; int wid, bid, G; bool noepi;
    template <class Tp> __device__ __forceinline__ Tp* ptr(int i) const { const unsigned long long v = ((const volatile LAS unsigned long long*)(lds + LDS_PTR))[i];
        const unsigned lo = __builtin_amdgcn_readfirstlane((unsigned)v), hi = __builtin_amdgcn_readfirstlane((unsigned)(v >> 32)); return (Tp*)(((unsigned long long)hi << 32) | lo); }
    __device__ __forceinline__ const float* in(int i) const { return ptr<const float>(i); }
    __device__ __forceinline__ unsigned char* ws() const { return ptr<unsigned char>(I_WS); }
    __device__ __forceinline__ float* out() const { return ptr<float>(I_OUT); }
};

#define XB_TMO      128
#define XB_XCNT(j)  (256  + 64 * (j))
#define XB_XSUB(j)  (1280 + 64 * (j))
#define XB_XGEN(j)  (2304 + 64 * (j))
#define XB_TOP      3328
#define XB_TOPGEN   3392
#define XCD_BAR_WORDS 3456
#define XB_SPIN_CAP (1u << 20)
__device__ __forceinline__ unsigned xb_ld(unsigned* p)              { return __hip_atomic_load(p, __ATOMIC_RELAXED, __HIP_MEMORY_SCOPE_AGENT); }
__device__ __forceinline__ unsigned xb_add(unsigned* p, unsigned v) { return __hip_atomic_fetch_add(p, v, __ATOMIC_RELAXED, __HIP_MEMORY_SCOPE_AGENT); }
__device__ __forceinline__ unsigned xb_xcc_id() { return (unsigned)__builtin_amdgcn_s_getreg((3 << 11) | 20) & 0xFu; }
#define XB_SPIN(cond, bar) do { unsigned _sp = 0; while (cond) { __builtin_amdgcn_s_sleep(1); \
    if ((++_sp & 255u) == 0u) { if (xb_ld(&(bar)[XB_TMO])) break; if (_sp > XB_SPIN_CAP) { atomicAdd(&(bar)[XB_TMO], 1u); break; } } } } while (0)
__device__ __forceinline__ void xcd_barrier_complete(unsigned* bar, unsigned x, unsigned G, unsigned& nloc, unsigned& nx) {
    unsigned sum, cnt, mine, sp = 0u;
    for (;;) {
        sum = 0u; cnt = 0u; mine = 0u;
#pragma unroll
        for (unsigned j = 0; j < 16; ++j) { const unsigned c = xb_ld(&bar[XB_XCNT(j)]); sum += c; cnt += (c > 0u) ? 1u : 0u; mine = (j == x) ? c : mine; }
        if (sum == G) break;
        __builtin_amdgcn_s_sleep(1);
        if ((++sp & 255u) == 0u) { if (xb_ld(&bar[XB_TMO])) break; if (sp > XB_SPIN_CAP) { atomicAdd(&bar[XB_TMO], 1u); break; } }
    }
    nloc = mine > 0u ? mine : 1u; nx = cnt > 0u ? cnt : 1u;
}
__device__ __forceinline__ void grid_barrier(const Ctx& C) {
    asm volatile("s_waitcnt vmcnt(0)" ::: "memory");
    __syncthreads();
    if (opaque_tid(C.wid) == 0) {
        unsigned* bar = (unsigned*)C.ws() + CW_BAR; volatile LAS unsigned* st = (volatile LAS unsigned*)(C.lds + LDS_BST); const unsigned x = xb_xcc_id();
        __builtin_amdgcn_s_waitcnt(0);
        unsigned nloc = st[0], nx = st[1];
        if (nloc == 0u) { xcd_barrier_complete(bar, x, (unsigned)C.G, nloc, nx); st[0] = nloc; st[1] = nx; }
        const unsigned old = xb_add(&bar[XB_XSUB(x)], 1u);
        const unsigned gen = old / nloc;
        if (old + 1u == (gen + 1u) * nloc) {
            __builtin_amdgcn_fence(__ATOMIC_RELEASE, "agent");
            asm volatile("s_waitcnt vmcnt(0)" ::: "memory");
            const unsigned og = xb_add(&bar[XB_TOP], 1u);
            const unsigned tg = og / nx;
            if (og + 1u == (tg + 1u) * nx) xb_add(&bar[XB_TOPGEN], 1u);
            else XB_SPIN(xb_ld(&bar[XB_TOPGEN]) == tg, bar);
            __builtin_amdgcn_fence(__ATOMIC_ACQUIRE, "agent");
            xb_add(&bar[XB_XGEN(x)], 1u);
            asm volatile("s_waitcnt vmcnt(0)" ::: "memory");
        } else {
            XB_SPIN(xb_ld(&bar[XB_XGEN(x)]) == gen, bar);
            __builtin_amdgcn_fence(__ATOMIC_ACQUIRE, "agent");
            asm volatile("s_waitcnt vmcnt(0)" ::: "memory");
        }
    }
    __syncthreads();
}

__device__ __forceinline__ void p0_transpose_item(const float* W, int K, int N, bf16_t* WT, const float* fold, int inter, int which, LAS float* scr, int item, int lane) {
    const int nblk = N / 32, kb = item / nblk, nb = item % nblk, k0 = 64 * kb, n0 = 32 * nb;
    const int kr = lane >> 3, c4 = lane & 7; f32x4 v[8]; float f[8];
#pragma unroll
    for (int i = 0; i < 8; ++i) v[i] = *(const f32x4*)(W + (size_t)(k0 + 8 * i + kr) * N + n0 + 4 * c4);
#pragma unroll
    for (int i = 0; i < 8; ++i) f[i] = fold ? fold[k0 + 8 * i + kr] : 1.0f;
#pragma unroll
    for (int i = 0; i < 8; ++i) { LAS float* d = scr + (8 * i + kr) * 33 + 4 * c4; d[0] = v[i][0] * f[i]; d[1] = v[i][1] * f[i]; d[2] = v[i][2] * f[i]; d[3] = v[i][3] * f[i]; }
    asm volatile("s_waitcnt lgkmcnt(0)" ::: "memory");
    const int c = lane & 7;
#pragma unroll
    for (int j = 0; j < 4; ++j) { const int nl = (lane >> 3) + 8 * j, n = n0 + nl; const LAS float* sp = scr + (8 * c) * 33 + nl;
        u32x4 o; o.x = pk2(sp[0 * 33], sp[1 * 33]); o.y = pk2(sp[2 * 33], sp[3 * 33]); o.z = pk2(sp[4 * 33], sp[5 * 33]); o.w = pk2(sp[6 * 33], sp[7 * 33]);
        const int dr = inter ? (n / 128) * 256 + which * 128 + (n % 128) : n;
        *(u32x4*)(WT + (size_t)dr * K + k0 + 8 * c) = o; }
    asm volatile("s_waitcnt lgkmcnt(0)" ::: "memory");
}
__device__ __forceinline__ void p0_transpose_item8(const float* W, int K, int N, unsigned char* WT, const float* fold, int inter, int which, LAS float* scr, int item, int lane) {
    const int nblk = N / 32, kb = item / nblk, nb = item % nblk, k0 = 64 * kb, n0 = 32 * nb;
    const int kr = lane >> 3, c4 = lane & 7; f32x4 v[8]; float f[8];
#pragma unroll
    for (int i = 0; i < 8; ++i) v[i] = *(const f32x4*)(W + (size_t)(k0 + 8 * i + kr) * N + n0 + 4 * c4);
#pragma unroll
    for (int i = 0; i < 8; ++i) f[i] = (fold ? fold[k0 + 8 * i + kr] : 1.0f) * 64.0f;
#pragma unroll
    for (int i = 0; i < 8; ++i) { LAS float* d = scr + (8 * i + kr) * 33 + 4 * c4; d[0] = v[i][0] * f[i]; d[1] = v[i][1] * f[i]; d[2] = v[i][2] * f[i]; d[3] = v[i][3] * f[i]; }
    asm volatile("s_waitcnt lgkmcnt(0)" ::: "memory");
    const int c = lane & 7;
#pragma unroll
    for (int j = 0; j < 4; ++j) { const int nl = (lane >> 3) + 8 * j, n = n0 + nl; const LAS float* sp = scr + (8 * c) * 33 + nl;
        u32x2 o; o.x = pk_fp8x4(sp[0 * 33], sp[1 * 33], sp[2 * 33], sp[3 * 33]); o.y = pk_fp8x4(sp[4 * 33], sp[5 * 33], sp[6 * 33], sp[7 * 33]);
        const int dr = inter ? (n / 128) * 256 + which * 128 + (n % 128) : n;
        *(u32x2*)(WT + (size_t)dr * K + k0 + 8 * c) = o; }
    asm volatile("s_waitcnt lgkmcnt(0)" ::: "memory");
}
__device__ __forceinline__ void phase_prep(const Ctx& C) {
    LAS unsigned char* lds = C.lds; const int bid = C.bid, G = C.G; unsigned char* ws = C.ws(); const int tid = opaque_tid(C.wid), lane = tid & 63, wave = C.wid;
    const int gw = bid * NWAVES + wave, NGW = G * NWAVES;
    LAS float* scr = (LAS float*)(lds + wave * 16384);
    constexpr int I_IN = (D / 64) * (NPROJ / 32), I_OUT = (D / 64) * (D / 32), I_G = (D / 64) * (FF / 32), I_DN = (FF / 64) * (D / 32), I_QKV = (D / 64) * (NQKV / 32),
                  I_MG = (D / 64) * (FE / 32), I_MD = (FE / 64) * (D / 32);
    constexpr int NITEMS = I_IN + I_OUT + 2 * I_G + I_DN + I_QKV + I_OUT + NE * (2 * I_MG + I_MD);
    for (int it = gw; it < NITEMS; it += NGW) {
        int r = it;
        if (r < I_IN) { p0_transpose_item(C.in(I_EWIN), D, NPROJ, (bf16_t*)(ws + WS_WIN), C.in(I_EMIXN), 0, 0, scr, r, lane); continue; } r -= I_IN;
        if (r < I_OUT) { p0_transpose_item(C.in(I_EWOUT), D, D, (bf16_t*)(ws + WS_WOUT), nullptr, 0, 0, scr, r, lane); continue; } r -= I_OUT;
        if (r < I_G) { p0_transpose_item(C.in(I_EWGATE), D, FF, (bf16_t*)(ws + WS_WGU), C.in(I_EFFNN), 1, 0, scr, r, lane); continue; } r -= I_G;
        if (r < I_G) { p0_transpose_item(C.in(I_EWUP), D, FF, (bf16_t*)(ws + WS_WGU), C.in(I_EFFNN), 1, 1, scr, r, lane); continue; } r -= I_G;
        if (r < I_DN) { p0_transpose_item(C.in(I_EWDOWN), FF, D, (bf16_t*)(ws + WS_WDN), nullptr, 0, 0, scr, r, lane); continue; } r -= I_DN;
        if (r < I_QKV) { p0_transpose_item(C.in(I_OWQKV), D, NQKV, (bf16_t*)(ws + WS_WQKV), C.in(I_OMIXN), 0, 0, scr, r, lane); continue; } r -= I_QKV;
        if (r < I_OUT) { p0_transpose_item(C.in(I_OWO), D, D, (bf16_t*)(ws + WS_WO), nullptr, 0, 0, scr, r, lane); continue; } r -= I_OUT;
        if (r < NE * I_MG) { const int e = r / I_MG; p0_transpose_item8(C.in(I_OWGATE) + (size_t)e * D * FE, D, FE, ws + WS_MGU + (size_t)e * NGUE * D, C.in(I_OFFNN), 1, 0, scr, r % I_MG, lane); continue; } r -= NE * I_MG;
        if (r < NE * I_MG) { const int e = r / I_MG; p0_transpose_item8(C.in(I_OWUP) + (size_t)e * D * FE, D, FE, ws + WS_MGU + (size_t)e * NGUE * D, C.in(I_OFFNN), 1, 1, scr, r % I_MG, lane); continue; } r -= NE * I_MG;
        { const int e = r / I_MD; p0_transpose_item8(C.in(I_OWDOWN) + (size_t)e * FE * D, FE, D, ws + WS_MDN + (size_t)e * D * FE, nullptr, 0, 0, scr, r % I_MD, lane); }
    }
    bf16_t* xb = (bf16_t*)(ws + WS_ARENA + AR_XB); float* ss0 = (float*)(ws + WS_SS0); const float* xin = C.in(I_X);
    for (int row = gw; row < T; row += NGW) {
        const f32x4* xr = (const f32x4*)(xin + (size_t)row * D) + lane; float sq = 0.f; u32x2* o = (u32x2*)(xb + (size_t)row * D) + lane;
#pragma unroll
        for (int j = 0; j < 4; ++j) { const f32x4 v = xr[64 * j]; sq += (v[0] * v[0] + v[1] * v[1]) + (v[2] * v[2] + v[3] * v[3]); u32x2 w; w.x = pk2(v[0], v[1]); w.y = pk2(v[2], v[3]); o[64 * j] = w; }
        sq = wave_sum(sq);
        if (lane < NSS) ss0[(size_t)row * NSS + lane] = (lane == 0) ? sq : 0.f;
    }
    { float* km = (float*)(ws + WS_KMEAN); for (int i = bid * NTHREADS + tid; i < NBATCH * NH * NBLK * HD; i += G * NTHREADS) km[i] = 0.f; }
    float* tab = (float*)(ws + WS_ROPE);
    for (int i = bid * NTHREADS + tid; i < SEQ * 16; i += G * NTHREADS) { const int sp = i / 16, f = i % 16; const double inv = pow(500000.0, -(double)f / 16.0); const double ang = (double)sp * inv;
        tab[2 * i] = (float)cos(ang); tab[2 * i + 1] = (float)sin(ang); }
}

constexpr int MX_VROW = 520, MX_MU = 256 * MX_VROW;
__device__ __forceinline__ void phase_mixer(const Ctx& C) {
    LAS unsigned char* lds = C.lds; const int bid = C.bid, G = C.G; unsigned char* ws = C.ws();
    const float* conv_w = C.in(I_ECONVW); const float* ln_g = C.in(I_ELNG); const float* ln_b = C.in(I_ELNB); const float* w_sp = C.in(I_EWSP); const float* b_sp = C.in(I_EBSP);
    const bf16_t* proj = (const bf16_t*)(ws + WS_ARENA + AR_PROJ); bf16_t* y = (bf16_t*)(ws + WS_ARENA + AR_Y);
    LAS float* mu = (LAS float*)(lds + MX_MU); LAS float* rstd = mu + 128;
    const int tid = opaque_tid(C.wid), lane = tid & 63, wave = C.wid, r31 = lane & 31, hh = lane >> 5;
    for (int unit = bid; unit < (T / 128) * 2; unit += G) {
        const int c = unit >> 1, hf = unit & 1, t0 = c * 128;
        { u32x4 vv[16];
#pragma unroll
          for (int i = 0; i < 16; ++i) vv[i] = *(const u32x4*)(proj + (size_t)(t0 + wave * 16 + i) * NPROJ + 3 * CONV + GM + lane * 8);
#pragma unroll
          for (int i = 0; i < 16; ++i) { const int sl = wave * 16 + i; const u32x4 v = vv[i];
            const float x0 = bf2f(v.x & 0xffffu), x1 = __builtin_bit_cast(float, v.x & 0xffff0000u), x2 = bf2f(v.y & 0xffffu), x3 = __builtin_bit_cast(float, v.y & 0xffff0000u),
                        x4 = bf2f(v.z & 0xffffu), x5 = __builtin_bit_cast(float, v.z & 0xffff0000u), x6 = bf2f(v.w & 0xffffu), x7 = __builtin_bit_cast(float, v.w & 0xffff0000u);
            float sm = ((x0 + x1) + (x2 + x3)) + ((x4 + x5) + (x6 + x7)), sq = ((x0 * x0 + x1 * x1) + (x2 * x2 + x3 * x3)) + ((x4 * x4 + x5 * x5) + (x6 * x6 + x7 * x7));
            sm = wave_sum(sm); sq = wave_sum(sq); const float m = sm * (1.0f / GM), var = sq * (1.0f / GM) - m * m;
            if (lane == 0) { mu[sl] = m; rstd[sl] = rsqrtf(fmaxf(var, 0.f) + EPS); } } }
        { const int co = tid & 31, sg = tid >> 5, ch = 256 * hf + 8 * co; float w0[8], w1[8], w2[8];
#pragma unroll
          for (int j = 0; j < 8; ++j) { w0[j] = conv_w[ch + j]; w1[j] = conv_w[CONV + ch + j]; w2[j] = conv_w[2 * CONV + ch + j]; }
          float zm2[8], zm1[8];
#pragma unroll
          for (int j = 0; j < 8; ++j) { zm2[j] = 0.f; zm1[j] = 0.f; }
#pragma unroll
          for (int i = -2; i < 8; ++i) { const int t = t0 + 8 * sg + i; const bool inseq = (i >= 0) || ((t0 + 8 * sg) % SEQ != 0);
              const bf16_t* pr = proj + (size_t)(inseq ? t : t0) * NPROJ + ch; const u32x4 ah = *(const u32x4*)pr, ac = *(const u32x4*)(pr + CONV);
              float z[8];
              z[0] = bf2f(ah.x & 0xffffu) * bf2f(ac.x & 0xffffu); z[1] = __builtin_bit_cast(float, ah.x & 0xffff0000u) * __builtin_bit_cast(float, ac.x & 0xffff0000u);
              z[2] = bf2f(ah.y & 0xffffu) * bf2f(ac.y & 0xffffu); z[3] = __builtin_bit_cast(float, ah.y & 0xffff0000u) * __builtin_bit_cast(float, ac.y & 0xffff0000u);
              z[4] = bf2f(ah.z & 0xffffu) * bf2f(ac.z & 0xffffu); z[5] = __builtin_bit_cast(float, ah.z & 0xffff0000u) * __builtin_bit_cast(float, ac.z & 0xffff0000u);
              z[6] = bf2f(ah.w & 0xffffu) * bf2f(ac.w & 0xffffu); z[7] = __builtin_bit_cast(float, ah.w & 0xffff0000u) * __builtin_bit_cast(float, ac.w & 0xffff0000u);
              if (!inseq) {
#pragma unroll
                  for (int j = 0; j < 8; ++j) z[j] = 0.f; }
              if (i >= 0) { const u32x4 ab = *(const u32x4*)(pr + 2 * CONV); float o[8];
#pragma unroll
                  for (int j = 0; j < 8; ++j) o[j] = w0[j] * zm2[j] + w1[j] * zm1[j] + w2[j] * z[j];
                  u32x4 w; w.x = pk2(bf2f(ab.x & 0xffffu) * o[0], __builtin_bit_cast(float, ab.x & 0xffff0000u) * o[1]); w.y = pk2(bf2f(ab.y & 0xffffu) * o[2], __builtin_bit_cast(float, ab.y & 0xffff0000u) * o[3]);
                  w.z = pk2(bf2f(ab.z & 0xffffu) * o[4], __builtin_bit_cast(float, ab.z & 0xffff0000u) * o[5]); w.w = pk2(bf2f(ab.w & 0xffffu) * o[6], __builtin_bit_cast(float, ab.w & 0xffff0000u) * o[7]);
                  *(u32x4*)(y + (size_t)t * D + ch) = w; }
#pragma unroll
              for (int j = 0; j < 8; ++j) { zm2[j] = zm1[j]; zm1[j] = z[j]; } } }
        __syncthreads();
#pragma unroll
        for (int i = 0; i < 4; ++i) { const int v = tid + 512 * i, sq4 = v >> 6, cq = v & 63, chl = 4 * cq, chg = 256 * hf + chl; const bf16_t* src = proj + (size_t)(t0 + 4 * sq4) * NPROJ + 3 * CONV + GM + chg;
            const f32x4 gg = *(const f32x4*)(ln_g + chg), bb = *(const f32x4*)(ln_b + chg);
            unsigned e[4][4];
#pragma unroll
            for (int r = 0; r < 4; ++r) { const u32x2 rv = *(const u32x2*)(src + (size_t)r * NPROJ); const float m = mu[4 * sq4 + r], rs = rstd[4 * sq4 + r];
                e[r][0] = f2bf((bf2f(rv.x & 0xffffu) - m) * rs * gg[0] + bb[0]); e[r][1] = f2bf((__builtin_bit_cast(float, rv.x & 0xffff0000u) - m) * rs * gg[1] + bb[1]);
                e[r][2] = f2bf((bf2f(rv.y & 0xffffu) - m) * rs * gg[2] + bb[2]); e[r][3] = f2bf((__builtin_bit_cast(float, rv.y & 0xffff0000u) - m) * rs * gg[3] + bb[3]); }
            LAS unsigned char* dst = lds + chl * MX_VROW + sq4 * 8;
#pragma unroll
            for (int d = 0; d < 4; ++d) { u32x2 w; w.x = e[0][d] | (e[1][d] << 16); w.y = e[2][d] | (e[3][d] << 16); *(LAS u32x2*)(dst + d * MX_VROW) = w; } }
        __syncthreads();
        { const int gl = wave >> 1, dt = wave & 1, g = 4 * hf + gl, chl = 64 * gl + 32 * dt + r31;
          bf16x8 bfr[8];
#pragma unroll
          for (int ks = 0; ks < 8; ++ks) { const LAS unsigned char* vp = lds + chl * MX_VROW + (16 * ks + 8 * hh) * 2; const u32x2 v0 = *(const LAS u32x2*)vp, v1 = *(const LAS u32x2*)(vp + 8);
              u32x4 w; w.x = v0.x; w.y = v0.y; w.z = v1.x; w.w = v1.y; bfr[ks] = __builtin_bit_cast(bf16x8, w); }
#pragma unroll
          for (int tt = 0; tt < 4; ++tt) { f32x16 acc;
#pragma unroll
              for (int i = 0; i < 16; ++i) acc[i] = 0.f;
              const int trow = 32 * tt + r31; const float* wrow = w_sp + ((size_t)g * 128 + trow) * 128 + 8 * hh;
#pragma unroll
              for (int ks = 0; ks < 8; ++ks) if (ks < 2 * tt + 2) { const f32x4 a0 = *(const f32x4*)(wrow + 16 * ks), a1 = *(const f32x4*)(wrow + 16 * ks + 4); float av[8] = {a0[0], a0[1], a0[2], a0[3], a1[0], a1[1], a1[2], a1[3]};
                  if (ks >= 2 * tt) {
#pragma unroll
                      for (int j = 0; j < 8; ++j) if (16 * ks + 8 * hh + j > trow) av[j] = 0.f; }
                  u32x4 w; w.x = pk2(av[0], av[1]); w.y = pk2(av[2], av[3]); w.z = pk2(av[4], av[5]); w.w = pk2(av[6], av[7]);
                  acc = __builtin_amdgcn_mfma_f32_32x32x16_bf16(__builtin_bit_cast(bf16x8, w), bfr[ks], acc, 0, 0, 0); }
              const int chg = 256 * hf + chl;
#pragma unroll
              for (int i = 0; i < 16; ++i) { const int tl = 32 * tt + (i & 3) + 8 * (i >> 2) + 4 * hh, t = t0 + tl; const float val = acc[i] + b_sp[g * 128 + tl];
                  const float gu = bf2f(proj[(size_t)t * NPROJ + 3 * CONV + chg]); y[(size_t)t * D + CONV + chg] = (bf16_t)f2bf(gu * val); } } }
        __syncthreads();
    }
}

__device__ __forceinline__ void phase_qkprep(const Ctx& C) {
    LAS unsigned char* lds = C.lds; const int bid = C.bid, G = C.G; unsigned char* ws = C.ws(); const float* qn = C.in(I_OQN); const float* kn = C.in(I_OKN);
    bf16_t* qkv = (bf16_t*)(ws + WS_ARENA + AR_QKV); const float* rope = (const float*)(ws + WS_ROPE); float* kmean = (float*)(ws + WS_KMEAN);
    LAS float* red = (LAS float*)lds;
    const int tid = opaque_tid(C.wid), lane = tid & 63, wave = C.wid, c16 = lane & 15, sub = lane >> 4;
    float gq[8], gk[8];
#pragma unroll
    for (int j = 0; j < 8; ++j) { gq[j] = qn[8 * c16 + j]; gk[j] = kn[8 * c16 + j]; }
    for (int item = bid; item < NBATCH * NBLK * NH; item += G) {
        const int h = item % NH, n = (item / NH) % NBLK, b = item / (NH * NBLK); float ks[8];
#pragma unroll
        for (int j = 0; j < 8; ++j) ks[j] = 0.f;
#pragma unroll 4
        for (int it = 0; it < 8; ++it) { const int sq = n * MB + wave * 32 + it * 4 + sub, t = b * SEQ + sq;
            float cs[8], sn[8];
            { const f32x4* rp = (const f32x4*)(rope + (sq * 16 + 8 * (c16 & 1)) * 2); f32x4 r0 = (f32x4){1.f, 0.f, 1.f, 0.f}, r1 = r0, r2 = r0, r3 = r0; if (c16 < 4) { r0 = rp[0]; r1 = rp[1]; r2 = rp[2]; r3 = rp[3]; }
              cs[0] = r0[0]; sn[0] = r0[1]; cs[1] = r0[2]; sn[1] = r0[3]; cs[2] = r1[0]; sn[2] = r1[1]; cs[3] = r1[2]; sn[3] = r1[3];
              cs[4] = r2[0]; sn[4] = r2[1]; cs[5] = r2[2]; sn[5] = r2[3]; cs[6] = r3[0]; sn[6] = r3[1]; cs[7] = r3[2]; sn[7] = r3[3]; }
#pragma unroll
            for (int which = 0; which < 2; ++which) { bf16_t* p = qkv + (size_t)t * NQKV + which * D + h * HD + 8 * c16; const u32x4 raw = *(const u32x4*)p;
                float v[8] = {bf2f(raw.x & 0xffffu), __builtin_bit_cast(float, raw.x & 0xffff0000u), bf2f(raw.y & 0xffffu), __builtin_bit_cast(float, raw.y & 0xffff0000u),
                              bf2f(raw.z & 0xffffu), __builtin_bit_cast(float, raw.z & 0xffff0000u), bf2f(raw.w & 0xffffu), __builtin_bit_cast(float, raw.w & 0xffff0000u)};
                float q = ((v[0] * v[0] + v[1] * v[1]) + (v[2] * v[2] + v[3] * v[3])) + ((v[4] * v[4] + v[5] * v[5]) + (v[6] * v[6] + v[7] * v[7]));
                q += __shfl_xor(q, 1); q += __shfl_xor(q, 2); q += __shfl_xor(q, 4); q += __shfl_xor(q, 8);
                const float r = rsqrtf(q * (1.0f / HD) + EPS);
#pragma unroll
                for (int j = 0; j < 8; ++j) v[j] = v[j] * r * (which ? gk[j] : gq[j]);
#pragma unroll
                for (int j = 0; j < 8; ++j) { const float pt = __shfl_xor(v[j], 2); if (c16 < 2) v[j] = v[j] * cs[j] - pt * sn[j]; else if (c16 < 4) v[j] = v[j] * cs[j] + pt * sn[j]; }
                u32x4 w; w.x = pk2(v[0], v[1]); w.y = pk2(v[2], v[3]); w.z = pk2(v[4], v[5]); w.w = pk2(v[6], v[7]);
                *(u32x4*)p = w;
                if (which) { ks[0] += bf2f(w.x & 0xffffu); ks[1] += __builtin_bit_cast(float, w.x & 0xffff0000u); ks[2] += bf2f(w.y & 0xffffu); ks[3] += __builtin_bit_cast(float, w.y & 0xffff0000u);
                             ks[4] += bf2f(w.z & 0xffffu); ks[5] += __builtin_bit_cast(float, w.z & 0xffff0000u); ks[6] += bf2f(w.w & 0xffffu); ks[7] += __builtin_bit_cast(float, w.w & 0xffff0000u); } } }
#pragma unroll
        for (int j = 0; j < 8; ++j) { ks[j] += __shfl_xor(ks[j], 16); ks[j] += __shfl_xor(ks[j], 32); }
        if (sub == 0) {
#pragma unroll
            for (int j = 0; j < 8; ++j) red[wave * 128 + 8 * c16 + j] = ks[j]; }
        __syncthreads();
        if (tid < 128) { float a = 0.f;
#pragma unroll
            for (int w = 0; w < NWAVES; ++w) a += red[w * 128 + tid];
            kmean[((size_t)(b * NH + h) * NBLK + n) * HD + tid] = a * (1.0f / MB); }
        __syncthreads();
    }
}

__device__ __forceinline__ void phase_select(const Ctx& C, bool probe) {
    const int bid = C.bid, G = C.G; unsigned char* ws = C.ws();
    const bf16_t* qkv = (const bf16_t*)(ws + WS_ARENA + AR_QKV); const float* kmean = (const float*)(ws + WS_KMEAN);
    unsigned* bcnt = (unsigned*)ws + (probe ? 5120 : CW_BKT); int* blist = (int*)(ws + (probe ? WS_ARENA + ((size_t)100 << 20) : WS_BLIST));
    const int tid = opaque_tid(C.wid), lane = tid & 63;
    for (int wt = bid * NWAVES + C.wid; wt < (T / 64) * NH; wt += G * NWAVES) {
        const int h = wt & 7, tg = wt >> 3, t = tg * 64 + lane, b = (tg * 64) / SEQ, sq = t % SEQ, qb = ((tg * 64) % SEQ) / MB;
        if (qb == 0) continue;
        const bf16_t* qp = qkv + (size_t)t * NQKV + h * HD; const float* km = kmean + (size_t)(b * NH + h) * NBLK * HD;
        float acc[NBLK];
#pragma unroll
        for (int n = 0; n < NBLK; ++n) acc[n] = 0.f;
#pragma unroll 4
        for (int ch = 0; ch < 16; ++ch) { const u32x4 raw = *(const u32x4*)(qp + 8 * ch);
            const float q0 = bf2f(raw.x & 0xffffu), q1 = __builtin_bit_cast(float, raw.x & 0xffff0000u), q2 = bf2f(raw.y & 0xffffu), q3 = __builtin_bit_cast(float, raw.y & 0xffff0000u),
                        q4 = bf2f(raw.z & 0xffffu), q5 = __builtin_bit_cast(float, raw.z & 0xffff0000u), q6 = bf2f(raw.w & 0xffffu), q7 = __builtin_bit_cast(float, raw.w & 0xffff0000u);
#pragma unroll
            for (int n = 0; n < NBLK; ++n) { const float* kp = km + n * HD + 8 * ch;
                acc[n] += ((q0 * kp[0] + q1 * kp[1]) + (q2 * kp[2] + q3 * kp[3])) + ((q4 * kp[4] + q5 * kp[5]) + (q6 * kp[6] + q7 * kp[7])); } }
        const int nsel = qb < 3 ? qb : 3; int sel0 = -1, sel1 = -1, sel2 = -1;
#pragma unroll
        for (int j = 0; j < 3; ++j) { float bv = -INFINITY; int bi = 0;
#pragma unroll
            for (int n = 0; n < NBLK - 1; ++n) { const float v = (n < qb) ? acc[n] : -INFINITY; if (v > bv) { bv = v; bi = n; } }
#pragma unroll
            for (int n = 0; n < NBLK - 1; ++n) if (n == bi) acc[n] = -INFINITY;
            if (j < nsel) { if (j == 0) sel0 = bi; if (j == 1) sel1 = bi; if (j == 2) sel2 = bi; } }
        const unsigned long long lt = (1ull << lane) - 1ull; int mytot = 0;
        for (int n = 0; n < qb; ++n) { const int tot = __popcll(__ballot(sel0 == n)) + __popcll(__ballot(sel1 == n)) + __popcll(__ballot(sel2 == n)); if (lane == n) mytot = tot; }
        unsigned mybase = 0; if (lane < qb && mytot > 0) mybase = atomicAdd(bcnt + (b * NH + h) * NBLK + lane, (unsigned)mytot);
        for (int n = 0; n < qb; ++n) { const unsigned long long m0 = __ballot(sel0 == n), m1 = __ballot(sel1 == n), m2 = __ballot(sel2 == n); const int c0 = __popcll(m0), c1 = __popcll(m1);
            const unsigned base = (unsigned)__shfl((int)mybase, n); int j = -1, rank = 0;
            if (sel0 == n) { j = 0; rank = __popcll(m0 & lt); } else if (sel1 == n) { j = 1; rank = c0 + __popcll(m1 & lt); } else if (sel2 == n) { j = 2; rank = c0 + c1 + __popcll(m2 & lt); }
            if (j >= 0) blist[(size_t)((b * NH + h) * NBLK + n) * BKT_CAP + base + rank] = (sq << 2) | j; }
    }
}

constexpr int AT_KS = 0, AT_KROW = 272, AT_VT = 256 * AT_KROW, AT_VROW = 520, AT_CUM = AT_VT + 128 * AT_VROW;
constexpr int AT_OT = AT_CUM + 3072, AT_OTW = 32 * 80;
static_assert(AT_CUM + 540 * 4 <= AT_OT && AT_OT + 8 * AT_OTW <= LDS_TB, "attention LDS map");
constexpr int CW_AQ = 600;
__device__ __forceinline__ void phase_attn(const Ctx& C, bool probe, unsigned pflags) {
    LAS unsigned char* lds = C.lds; unsigned char* ws = C.ws();
    const bf16_t* qkv = (const bf16_t*)(ws + WS_ARENA + AR_QKV); const unsigned* bcnt = (const unsigned*)ws + (probe ? 5120 : CW_BKT); const int* blist = (const int*)(ws + (probe ? WS_ARENA + ((size_t)100 << 20) : WS_BLIST));
    bf16_t* opart = (bf16_t*)(ws + WS_ARENA + AR_OPART); float* lpart = (float*)(ws + WS_LPART);
    const int tid = opaque_tid(C.wid), lane = tid & 63, wave = C.wid, r31 = lane & 31, hh = lane >> 5;
    LAS int* cum = (LAS int*)(lds + AT_CUM); LAS int* misc = cum + 520;
    { const int n = tid >> 5, bh = tid & 31; const int c = (int)bcnt[bh * NBLK + n]; int v = (c + 511) >> 9; v = v < 1 ? 1 : v;
#pragma unroll
      for (int o = 1; o < 64; o <<= 1) { const int u = __shfl_up(v, o); if (lane >= o) v += u; }
      if (lane == 63) misc[wave] = v;
      __syncthreads();
      int base = 0;
#pragma unroll
      for (int w = 0; w < NWAVES; ++w) base += (w < wave) ? misc[w] : 0;
      cum[tid + 1] = v + base; if (tid == 0) cum[0] = 0;
      __syncthreads(); }
    const int nitems = cum[512];
    const float cexp = 0.12751743f;
    LAS unsigned char* otile = lds + AT_OT + wave * AT_OTW;
    if (tid == 0) misc[8] = (int)atomicAdd((unsigned*)C.ws() + CW_AQ + (probe ? 1 : 0), 1u);
    __syncthreads();
    int item = misc[8];
    int n = 0, h = 0, b = 0, bk = 0, chunk = 0, cnt = 0, nown = 0, nrg = 0; int ent[3]; bool val[3];
#define AT_DECODE(it_) do { int lo = 0, hi = 512; while (hi - lo > 1) { const int mid = (lo + hi) >> 1; if (cum[mid] <= (it_)) lo = mid; else hi = mid; } \
        chunk = (it_) - cum[lo]; n = lo >> 5; { const int bh = lo & 31; h = bh & 7; b = bh >> 3; bk = bh * NBLK + n; } cnt = (int)bcnt[bk]; \
        { const int rem = cnt - chunk * 512; const int nsrg = ((rem < 512 ? rem : 512) + 31) >> 5; nown = (chunk == 0) ? 8 : 0; nrg = nown + (nsrg > 0 ? nsrg : 0); } } while (0)
#define AT_ENTS() do { _Pragma("unroll") for (int it = 0; it < 3; ++it) { const int rg = wave + 8 * it; val[it] = false; ent[it] = 0; \
        if (rg < nrg) { if (rg < nown) { ent[it] = ((n * MB + (7 - rg) * 32 + r31) << 2) | 3; val[it] = true; } \
                        else { const int ei = chunk * 512 + (rg - nown) * 32 + r31; val[it] = ei < cnt; ent[it] = val[it] ? blist[(size_t)bk * BKT_CAP + ei] : 0; } } } } while (0)
    if (item < nitems) { AT_DECODE(item); AT_ENTS(); }
    while (item < nitems) {
        __syncthreads();
        const int tid = opaque_tid(C.wid), lane = tid & 63, r31 = lane & 31, hh = lane >> 5;
        if (tid == 0) misc[8] = (int)atomicAdd((unsigned*)C.ws() + CW_AQ + (probe ? 1 : 0), 1u);
        const int cn = n, ch = h, cb = b, cnown = nown, cnrg = nrg; int cent[3]; bool cval[3];
#pragma unroll
        for (int it = 0; it < 3; ++it) { cent[it] = ent[it]; cval[it] = val[it]; }
        bf16x8 qn[8];
        { const bf16_t* qp = qkv + (size_t)(cb * SEQ + (cent[0] >> 2)) * NQKV + ch * HD + 8 * hh;
#pragma unroll
          for (int s8 = 0; s8 < 8; ++s8) qn[s8] = *(const bf16x8*)(qp + 16 * s8); }
        {
          const int tl = tid;
          const bf16_t* kb = qkv + (size_t)(cb * SEQ + cn * MB) * NQKV + D + ch * HD;
#pragma unroll
          for (int i = 0; i < 8; ++i) { const int c = tl + 512 * i, row = c >> 4, c16 = c & 15; const u32x4 v = *(const u32x4*)(kb + (size_t)row * NQKV + c16 * 8); *(LAS u32x4*)(lds + AT_KS + row * AT_KROW + c16 * 16) = v; }
          const bf16_t* vb = kb + D;
#pragma unroll
          for (int i = 0; i < 4; ++i) { const int v = tl + 512 * i, kq = v >> 5, dq = v & 31; const bf16_t* src = vb + (size_t)(4 * kq) * NQKV + 4 * dq;
              const u32x2 r0 = *(const u32x2*)src, r1 = *(const u32x2*)(src + NQKV), r2 = *(const u32x2*)(src + 2 * NQKV), r3 = *(const u32x2*)(src + 3 * NQKV);
              LAS unsigned char* dst = lds + AT_VT + (4 * dq) * AT_VROW + kq * 8;
              u32x2 w;
              w.x = (r0.x & 0xffffu) | (r1.x << 16); w.y = (r2.x & 0xffffu) | (r3.x << 16); *(LAS u32x2*)(dst) = w;
              w.x = (r0.x >> 16) | (r1.x & 0xffff0000u); w.y = (r2.x >> 16) | (r3.x & 0xffff0000u); *(LAS u32x2*)(dst + AT_VROW) = w;
              w.x = (r0.y & 0xffffu) | (r1.y << 16); w.y = (r2.y & 0xffffu) | (r3.y << 16); *(LAS u32x2*)(dst + 2 * AT_VROW) = w;
              w.x = (r0.y >> 16) | (r1.y & 0xffff0000u); w.y = (r2.y >> 16) | (r3.y & 0xffff0000u); *(LAS u32x2*)(dst + 3 * AT_VROW) = w; } }
        __syncthreads();
        const int nextitem = misc[8];
        if (nextitem < nitems) { AT_DECODE(nextitem); AT_ENTS(); }
#pragma unroll
        for (int it = 0; it < 3; ++it) { const int rg = wave + 8 * it;
            if (rg < cnrg) {
            const bool own = rg < cnown; const int og = 7 - rg;
            const int sq = cent[it] >> 2, slot = cent[it] & 3, tq = cb * SEQ + sq;
            bf16x8 qf[8];
#pragma unroll
            for (int s8 = 0; s8 < 8; ++s8) qf[s8] = qn[s8];
            if (it < 2 && rg + 8 < cnrg) { const bf16_t* qp = qkv + (size_t)(cb * SEQ + (cent[it < 2 ? it + 1 : 2] >> 2)) * NQKV + ch * HD + 8 * hh;
#pragma unroll
                for (int s8 = 0; s8 < 8; ++s8) qn[s8] = *(const bf16x8*)(qp + 16 * s8); }
            f32x16 oacc[4];
#pragma unroll
            for (int dt = 0; dt < 4; ++dt)
#pragma unroll
                for (int i = 0; i < 16; ++i) oacc[dt][i] = 0.f;
            float lsum = 0.f;
            const int nkt = own ? (og + 1) : 8;
            const LAS unsigned char* kbase = lds + AT_KS + r31 * AT_KROW + 16 * hh;
            const LAS unsigned char* vbase = lds + AT_VT + r31 * AT_VROW + 8 * hh;
            for (int kt = 0; kt < nkt; ++kt) {
                f32x16 sacc;
#pragma unroll
                for (int i = 0; i < 16; ++i) sacc[i] = 0.f;
#pragma unroll
                for (int s8 = 0; s8 < 8; ++s8) { const bf16x8 kf = *(const LAS bf16x8*)(kbase + kt * 32 * AT_KROW + 32 * s8); sacc = __builtin_amdgcn_mfma_f32_32x32x16_bf16(kf, qf[s8], sacc, 0, 0, 0); }
                const bool diag = own && (kt == og);
                float p[16];
#pragma unroll
                for (int i = 0; i < 16; ++i) { const int krow = (i & 3) + 8 * (i >> 2) + 4 * hh; float e = __builtin_amdgcn_exp2f(sacc[i] * cexp); if (diag && krow > r31) e = 0.f; p[i] = e; lsum += e; }
                bf16x8 pb[2];
#pragma unroll
                for (int s2 = 0; s2 < 2; ++s2) { u32x4 w; w.x = cvt_pk_bf16(p[8 * s2 + 0], p[8 * s2 + 1]); w.y = cvt_pk_bf16(p[8 * s2 + 2], p[8 * s2 + 3]); w.z = cvt_pk_bf16(p[8 * s2 + 4], p[8 * s2 + 5]); w.w = cvt_pk_bf16(p[8 * s2 + 6], p[8 * s2 + 7]);
                    pb[s2] = __builtin_bit_cast(bf16x8, w); }
#pragma unroll
                for (int dt = 0; dt < 4; ++dt)
#pragma unroll
                    for (int s2 = 0; s2 < 2; ++s2) { const LAS unsigned char* vp = vbase + dt * 32 * AT_VROW + (kt * 32 + 16 * s2) * 2;
                        const u32x2 v0 = *(const LAS u32x2*)vp, v1 = *(const LAS u32x2*)(vp + 16); u32x4 w; w.x = v0.x; w.y = v0.y; w.z = v1.x; w.w = v1.y;
                        oacc[dt] = __builtin_amdgcn_mfma_f32_32x32x16_bf16(__builtin_bit_cast(bf16x8, w), pb[s2], oacc[dt], 0, 0, 0); }
            }
            { const auto sw = __builtin_amdgcn_permlane32_swap(__builtin_bit_cast(unsigned, lsum), __builtin_bit_cast(unsigned, lsum), false, false);
              lsum = __builtin_bit_cast(float, sw[0]) + __builtin_bit_cast(float, sw[1]); }
            const int pidx = cval[it] ? (int)(((unsigned)tq * NH + ch) * 4 + slot) : -1;
            if (hh == 0 && pidx >= 0) lpart[pidx] = lsum;
            const int l2 = lane, r2 = r31, h2 = hh;
#pragma unroll
            for (int dt = 0; dt < 4; ++dt) {
#pragma unroll
                for (int g4 = 0; g4 < 4; ++g4) { u32x2 w; w.x = cvt_pk_bf16(oacc[dt][4 * g4 + 0], oacc[dt][4 * g4 + 1]); w.y = cvt_pk_bf16(oacc[dt][4 * g4 + 2], oacc[dt][4 * g4 + 3]); *(LAS u32x2*)(otile + r2 * 80 + (8 * g4 + 4 * h2) * 2) = w; }
                asm volatile("s_waitcnt lgkmcnt(0)" ::: "memory");
#pragma unroll
                for (int hf = 0; hf < 2; ++hf) { const int row = (l2 >> 2) + 16 * hf, c4 = l2 & 3; const u32x4 v = *(const LAS u32x4*)(otile + row * 80 + c4 * 16); const int pr = __shfl(pidx, row);
                    if (pr >= 0 && !(pflags & 4u)) *(u32x4*)(opart + (size_t)pr * HD + 32 * dt + 8 * c4) = v; }
                asm volatile("s_waitcnt lgkmcnt(0)" ::: "memory"); }
            } }
        item = nextitem;
    }
#undef AT_DECODE
#undef AT_ENTS
}

__device__ __forceinline__ void phase_combine(const Ctx& C) {
    const int bid = C.bid, G = C.G; unsigned char* ws = C.ws();
    bf16_t* qkv = (bf16_t*)(ws + WS_ARENA + AR_QKV); const bf16_t* opart = (const bf16_t*)(ws + WS_ARENA + AR_OPART); const float* lpart = (const float*)(ws + WS_LPART);
    const int tid = opaque_tid(C.wid), lane = tid & 63, sub = lane >> 4, c16 = lane & 15;
#pragma unroll 4
    for (int p0 = (bid * NWAVES + C.wid) * 4; p0 < T * NH; p0 += G * NWAVES * 4) {
        const int pr = p0 + sub, h = pr & 7, t = pr >> 3, qb = (t % SEQ) / MB, nsel = qb < 3 ? qb : 3;
        float acc[8]; float l = 0.f;
#pragma unroll
        for (int i = 0; i < 8; ++i) acc[i] = 0.f;
#pragma unroll
        for (int j = 0; j < 4; ++j) { if (j < nsel || j == 3) { const size_t pidx = (size_t)pr * 4 + j; const u32x4 v = *(const u32x4*)(opart + pidx * HD + c16 * 8); l += lpart[pidx];
            acc[0] += bf2f(v.x & 0xffffu); acc[1] += __builtin_bit_cast(float, v.x & 0xffff0000u); acc[2] += bf2f(v.y & 0xffffu); acc[3] += __builtin_bit_cast(float, v.y & 0xffff0000u);
            acc[4] += bf2f(v.z & 0xffffu); acc[5] += __builtin_bit_cast(float, v.z & 0xffff0000u); acc[6] += bf2f(v.w & 0xffffu); acc[7] += __builtin_bit_cast(float, v.w & 0xffff0000u); } }
        const float inv = 1.0f / l;
        u32x4 w; w.x = pk2(acc[0] * inv, acc[1] * inv); w.y = pk2(acc[2] * inv, acc[3] * inv); w.z = pk2(acc[4] * inv, acc[5] * inv); w.w = pk2(acc[6] * inv, acc[7] * inv);
        *(u32x4*)(qkv + (size_t)t * NQKV + h * HD + c16 * 8) = w;
    }
}

__device__ __forceinline__ void phase_router(const Ctx& C, bool probe) {
    const int bid = C.bid, G = C.G; unsigned char* ws = C.ws(); const float* ffn_g = C.in(I_OFFNN); const float* w_r = C.in(I_OWR);
    const bf16_t* h3 = (const bf16_t*)(ws + WS_ARENA + AR_H3B); const float* ss3 = (const float*)(ws + WS_SS3); int* cnt = (int*)(ws + WS_CTL) + (probe ? 6144 : 0); int* tslot = (int*)(ws + (probe ? WS_ARENA + ((size_t)103 << 20) : WS_TSLOT)); int* tokof = (int*)(ws + (probe ? WS_ARENA + ((size_t)100 << 20) : WS_TOKOF)); float* gateof = (float*)(ws + (probe ? WS_ARENA + ((size_t)101 << 20) : WS_GATEOF)); f32x4* minfo = (f32x4*)(ws + (probe ? WS_ARENA + ((size_t)102 << 20) : WS_MINFO));
    const int tid = opaque_tid(C.wid), lane = tid & 63, w = C.wid;
    LAS int* lcnt = (LAS int*)C.lds; LAS int* lbase = lcnt + 8; LAS int* te = lcnt + 16; LAS int* trank = te + 128; LAS float* tp = (LAS float*)(trank + 128); LAS float* trs = tp + 128;
    float wg[16][NE];
#pragma unroll
    for (int i = 0; i < 16; ++i) { const int c = lane * 16 + i; const float g = ffn_g[c]; const f32x4 a = *(const f32x4*)(w_r + c * NE), b2 = *(const f32x4*)(w_r + c * NE + 4);
        wg[i][0] = a[0] * g; wg[i][1] = a[1] * g; wg[i][2] = a[2] * g; wg[i][3] = a[3] * g; wg[i][4] = b2[0] * g; wg[i][5] = b2[1] * g; wg[i][6] = b2[2] * g; wg[i][7] = b2[3] * g; }
    for (int grp = bid; grp < T / 64; grp += G) {
        if (tid < 8) lcnt[tid] = 0;
        __syncthreads();
        for (int i8 = 0; i8 < 8; ++i8) { const int tl = w * 8 + i8, t = grp * 64 + tl; const u32x4* hp = (const u32x4*)(h3 + (size_t)t * D + lane * 16); const u32x4 r0 = hp[0], r1 = hp[1];
            const float xv[16] = {bf2f(r0.x & 0xffffu), __builtin_bit_cast(float, r0.x & 0xffff0000u), bf2f(r0.y & 0xffffu), __builtin_bit_cast(float, r0.y & 0xffff0000u), bf2f(r0.z & 0xffffu), __builtin_bit_cast(float, r0.z & 0xffff0000u), bf2f(r0.w & 0xffffu), __builtin_bit_cast(float, r0.w & 0xffff0000u),
                                  bf2f(r1.x & 0xffffu), __builtin_bit_cast(float, r1.x & 0xffff0000u), bf2f(r1.y & 0xffffu), __builtin_bit_cast(float, r1.y & 0xffff0000u), bf2f(r1.z & 0xffffu), __builtin_bit_cast(float, r1.z & 0xffff0000u), bf2f(r1.w & 0xffffu), __builtin_bit_cast(float, r1.w & 0xffff0000u)};
            float lg[NE];
#pragma unroll
            for (int e = 0; e < NE; ++e) lg[e] = 0.f;
#pragma unroll
            for (int i = 0; i < 16; ++i)
#pragma unroll
                for (int e = 0; e < NE; ++e) lg[e] += xv[i] * wg[i][e];
            const float r = row_rscale(ss3, t);
#pragma unroll
            for (int e = 0; e < NE; ++e) lg[e] = wave_sum(lg[e]) * r;
            if (lane == 0) { int e1 = 0; float v1 = lg[0];
#pragma unroll
                for (int e = 1; e < NE; ++e) if (lg[e] > v1) { v1 = lg[e]; e1 = e; }
                int e2 = -1; float v2 = -INFINITY;
#pragma unroll
                for (int e = 0; e < NE; ++e) if (e != e1 && lg[e] > v2) { v2 = lg[e]; e2 = e; }
                if (e2 < 0) { e2 = (e1 == 0) ? 1 : 0; v2 = v1; }
                const float p1 = 1.0f / (1.0f + __expf(v2 - v1)), p2 = 1.0f - p1;
                te[2 * tl] = e1; te[2 * tl + 1] = e2; tp[2 * tl] = p1; tp[2 * tl + 1] = p2; trs[tl] = r;
                trank[2 * tl] = __hip_atomic_fetch_add(lcnt + e1, 1, __ATOMIC_RELAXED, __HIP_MEMORY_SCOPE_WORKGROUP); trank[2 * tl + 1] = __hip_atomic_fetch_add(lcnt + e2, 1, __ATOMIC_RELAXED, __HIP_MEMORY_SCOPE_WORKGROUP); } }
        __syncthreads();
        if (tid < 8) lbase[tid] = atomicAdd(cnt + tid, lcnt[tid]);
        __syncthreads();
        if (tid < 128) { const int e = te[tid], pos = lbase[e] + trank[tid]; tokof[e * T + pos] = grp * 64 + (tid >> 1); gateof[e * T + pos] = tp[tid]; tslot[grp * 128 + tid] = e * T + pos;
            f32x4 rec; rec[0] = trs[tid >> 1]; rec[1] = __builtin_bit_cast(float, grp * 64 + (tid >> 1)); rec[2] = tp[tid]; rec[3] = 0.f; minfo[(size_t)e * T + pos] = rec; }
        __syncthreads();
    }
}

__device__ __forceinline__ void phase_moecombine(const Ctx& C, const LAS int* tb, int p) {
    const int bid = C.bid, G = C.G; unsigned char* ws = C.ws(); float* out = C.out();
    const int* tslot = (const int*)(ws + WS_TSLOT); const bf16_t* y2 = (const bf16_t*)(ws + WS_ARENA + AR_Y2); const bf16_t* ypart = (const bf16_t*)(ws + WS_ARENA + AR_YPART);
    const int lane = opaque_tid(C.wid) & 63, pn = lane >> 4, cl = (lane & 15) * 16; const int nwg = tb[8], base = (nwg / G) * G;
    for (int t = bid * NWAVES + C.wid; t < T; t += G * NWAVES) {
        f32x4 a[4]; { const u32x4* hp = (const u32x4*)((const bf16_t*)(ws + WS_ARENA + AR_H3B) + (size_t)t * D + lane * 16); const u32x4 r0 = hp[0], r1 = hp[1];
            a[0][0] = bf2f(r0.x & 0xffffu); a[0][1] = __builtin_bit_cast(float, r0.x & 0xffff0000u); a[0][2] = bf2f(r0.y & 0xffffu); a[0][3] = __builtin_bit_cast(float, r0.y & 0xffff0000u);
            a[1][0] = bf2f(r0.z & 0xffffu); a[1][1] = __builtin_bit_cast(float, r0.z & 0xffff0000u); a[1][2] = bf2f(r0.w & 0xffffu); a[1][3] = __builtin_bit_cast(float, r0.w & 0xffff0000u);
            a[2][0] = bf2f(r1.x & 0xffffu); a[2][1] = __builtin_bit_cast(float, r1.x & 0xffff0000u); a[2][2] = bf2f(r1.y & 0xffffu); a[2][3] = __builtin_bit_cast(float, r1.y & 0xffff0000u);
            a[3][0] = bf2f(r1.z & 0xffffu); a[3][1] = __builtin_bit_cast(float, r1.z & 0xffff0000u); a[3][2] = bf2f(r1.w & 0xffffu); a[3][3] = __builtin_bit_cast(float, r1.w & 0xffff0000u); }
#pragma unroll
        for (int sl = 0; sl < 2; ++sl) { const int code = tslot[t * 2 + sl], e = code / T, pos = code % T; const int wg = tb[e] + (pos >> 8) * 4 + pn;
            const bf16_t* src; int nsum, stride;
            if (wg < base) { src = y2 + (size_t)(tb[16 + e] + pos) * D + pn * 256 + cl; nsum = 1; stride = 0; }
            else { src = ypart + ((size_t)(wg - base) * p * 256 + (pos & 255)) * 256 + cl; nsum = p; stride = 256 * 256; }
            for (int q = 0; q < nsum; ++q) { const u32x4 v0 = *(const u32x4*)(src + (size_t)q * stride), v1 = *(const u32x4*)(src + (size_t)q * stride + 8);
                a[0][0] += bf2f(v0.x & 0xffffu); a[0][1] += __builtin_bit_cast(float, v0.x & 0xffff0000u); a[0][2] += bf2f(v0.y & 0xffffu); a[0][3] += __builtin_bit_cast(float, v0.y & 0xffff0000u);
                a[1][0] += bf2f(v0.z & 0xffffu); a[1][1] += __builtin_bit_cast(float, v0.z & 0xffff0000u); a[1][2] += bf2f(v0.w & 0xffffu); a[1][3] += __builtin_bit_cast(float, v0.w & 0xffff0000u);
                a[2][0] += bf2f(v1.x & 0xffffu); a[2][1] += __builtin_bit_cast(float, v1.x & 0xffff0000u); a[2][2] += bf2f(v1.y & 0xffffu); a[2][3] += __builtin_bit_cast(float, v1.y & 0xffff0000u);
                a[3][0] += bf2f(v1.z & 0xffffu); a[3][1] += __builtin_bit_cast(float, v1.z & 0xffff0000u); a[3][2] += bf2f(v1.w & 0xffffu); a[3][3] += __builtin_bit_cast(float, v1.w & 0xffff0000u); } }
        { f32x4* hp = (f32x4*)(out + (size_t)t * D + lane * 16); hp[0] = a[0]; hp[1] = a[1]; hp[2] = a[2]; hp[3] = a[3]; }
    }
}

__device__ __forceinline__ void moe_tables(LAS int* tb, const int* cnt, int nN, int wid) {
    if (opaque_tid(wid) == 0) { int cu = 0, off = 0; for (int e = 0; e < NE; ++e) { const int c = cnt[e]; tb[e] = cu; tb[16 + e] = off; tb[32 + e] = c; cu += ((c + 255) / 256) * nN; off += c; } tb[8] = cu; tb[24] = off; }
    __syncthreads();
}
template <class Epi, class Sched>
__device__ __forceinline__ void gemm_run(const Ctx& C, const bf16_t* A, int lda, const bf16_t* Bt, int K, const void* tblbase, const Sched& S, const Epi& E) { pg8::gemm_fast<Epi, Sched, true, false>(C.lds, A, lda * 2, Bt, K * 2, tblbase, S, E, C.wid, C.noepi, 0, 0); }
template <class Epi, class Sched>
__device__ __forceinline__ void gemm_run8(const Ctx& C, const void* A, int lda, const void* Bt, int K, const void* tblbase, const Sched& S, const Epi& E, int ea, int eb) { pg8::gemm_fast<Epi, Sched, true, true>(C.lds, A, lda, Bt, K, tblbase, S, E, C.wid, C.noepi, ea * 0x01010101, eb * 0x01010101); }

__global__ void __launch_bounds__(NTHREADS) fwd_megakernel(Params P) {
    extern __shared__ __attribute__((aligned(16))) unsigned char lds_raw[];
    Ctx C; C.lds = (LAS unsigned char*)lds_raw; C.wid = __builtin_amdgcn_readfirstlane(threadIdx.x >> 6); C.bid = blockIdx.x; C.G = gridDim.x;
    if (threadIdx.x < 25) { const unsigned long long v = (threadIdx.x < 23) ? (unsigned long long)P.in[threadIdx.x] : (threadIdx.x == 23 ? (unsigned long long)P.out : (unsigned long long)P.ws);
        ((LAS unsigned long long*)(C.lds + LDS_PTR))[threadIdx.x] = v; }
    if (threadIdx.x < 2) ((LAS unsigned*)(C.lds + LDS_BST))[threadIdx.x] = 0u;
    if (threadIdx.x == 2) { ((LAS unsigned*)(C.lds + LDS_BST))[4] = P.mask; ((LAS unsigned*)(C.lds + LDS_BST))[5] = (unsigned)P.probe; }
    if (threadIdx.x == 0) (void)xb_add((unsigned*)P.ws + CW_BAR + XB_XCNT(xb_xcc_id()), 1u);
    __syncthreads();
    if (P.ws == nullptr) cg::this_grid().sync();
    LAS int* tb = (LAS int*)(C.lds + LDS_TB);
#define WSP(T_, off) ((T_*)(C.ws() + (off)))
#define ARP(off) ((bf16_t*)(C.ws() + WS_ARENA + (off)))

    const unsigned mask = __builtin_amdgcn_readfirstlane(((const volatile LAS unsigned*)(C.lds + LDS_BST))[4]); const unsigned probev = __builtin_amdgcn_readfirstlane(((const volatile LAS unsigned*)(C.lds + LDS_BST))[5]); const bool probe = probev != 0u; C.noepi = (probev & 2u) != 0u;
#define PH(k) (mask & (1u << (k)))
    float* d_f32 = (float*)(C.ws() + WS_ARENA); bf16_t* d_b16 = ARP((size_t)64 << 20); float* d_ss = (float*)(C.ws() + WS_ARENA + ((size_t)96 << 20));

    if (PH(0)) { phase_prep(C); grid_barrier(C); }
    if (PH(1)) { pg8::DenseOrder S; S.init(T, NPROJ, D, C.G, C.bid); pg8::EpiScaleBf16 E{ARP(AR_PROJ), NPROJ, WSP(float, WS_SS0)}; gemm_run(C, ARP(AR_XB), D, WSP(bf16_t, WS_WIN), D, WSP(float, WS_SS0), S, E); grid_barrier(C); }
    if (PH(2)) { phase_mixer(C); grid_barrier(C); }
    if (PH(3)) { pg8::DenseOrder S; S.init(T, D, D, C.G, C.bid); pg8::EpiResid<false, false> E{C.in(I_X), probe ? d_b16 : ARP(AR_H1B), nullptr, probe ? d_ss : WSP(float, WS_SS1), C.lds, C.wid}; gemm_run(C, ARP(AR_Y), D, WSP(bf16_t, WS_WOUT), D, WSP(float, WS_SS0), S, E); grid_barrier(C); }
    if (PH(4)) { pg8::DenseOrder S; S.init(T, NGU, D, C.G, C.bid); pg8::EpiSwiglu E{ARP(AR_ACT), FF, WSP(float, WS_SS1), nullptr, tb, false}; gemm_run(C, ARP(AR_H1B), D, WSP(bf16_t, WS_WGU), D, WSP(float, WS_SS1), S, E); grid_barrier(C); }
    if (PH(5)) { pg8::DenseOrder S; S.init(T, D, FF, C.G, C.bid); pg8::EpiResid<true, false> E{ARP(AR_H1B), probe ? d_b16 : ARP(AR_H2B), nullptr, probe ? d_ss : WSP(float, WS_SS2), C.lds, C.wid}; gemm_run(C, ARP(AR_ACT), FF, WSP(bf16_t, WS_WDN), FF, WSP(float, WS_SS0), S, E); grid_barrier(C); }
    if (PH(6)) { pg8::DenseOrder S; S.init(T, NQKV, D, C.G, C.bid); pg8::EpiQKV E{ARP(AR_QKV), C.in(I_OQN), C.in(I_OKN), WSP(float, WS_ROPE), WSP(float, WS_KMEAN), C.lds, C.wid}; gemm_run(C, ARP(AR_H2B), D, WSP(bf16_t, WS_WQKV), D, WSP(float, WS_SS2), S, E); grid_barrier(C); }
    if (PH(7)) { phase_qkprep(C); grid_barrier(C); }
    if (PH(8)) { phase_select(C, probe); grid_barrier(C); }
    if (PH(9)) { phase_attn(C, probe, probev); grid_barrier(C); }
    if (PH(10)) { phase_combine(C); grid_barrier(C); }
    if (PH(11)) { pg8::DenseOrder S; S.init(T, D, D, C.G, C.bid); pg8::EpiResid<true, true> E{ARP(AR_H2B), probe ? d_b16 : ARP(AR_H3B), probe ? (unsigned char*)d_f32 : WSP(unsigned char, WS_H38), probe ? d_ss : WSP(float, WS_SS3), C.lds, C.wid}; gemm_run(C, ARP(AR_QKV), NQKV, WSP(bf16_t, WS_WO), D, WSP(float, WS_SS0), S, E); grid_barrier(C); }
    if (PH(12)) { phase_router(C, probe); grid_barrier(C); }
    if (PH(13)) { moe_tables(tb, WSP(int, WS_CTL), NGUE / 256, C.wid); pg8::MoeOrder S{tb, WSP(int, WS_TOKOF), NGUE / 256, C.G, C.bid, true, (size_t)NGUE * D / 2, D / 128, false};
        pg8::EpiSwiglu E{ARP(AR_MACT), FE, WSP(float, WS_SS3), WSP(int, WS_TOKOF), tb, true}; gemm_run8(C, WSP(unsigned char, WS_H38), D, WSP(unsigned char, WS_MGU), D, WSP(float, WS_MINFO), S, E, 127, 121); grid_barrier(C); }
    if (PH(14)) { moe_tables(tb, WSP(int, WS_CTL), D / 256, C.wid); pg8::MoeOrder S{tb, WSP(int, WS_TOKOF), D / 256, C.G, C.bid, false, (size_t)D * FE / 2, FE / 128, true};
        pg8::EpiMoeDown E{ARP(AR_Y2), ARP(AR_YPART), WSP(float, WS_GATEOF), tb, C.wid}; gemm_run8(C, ARP(AR_MACT), FE, WSP(unsigned char, WS_MDN), FE, WSP(float, WS_MINFO), S, E, 125, 121); grid_barrier(C); }
    if (PH(15) && !probe) { moe_tables(tb, WSP(int, WS_CTL), D / 256, C.wid); pg8::MoeOrder S{tb, WSP(int, WS_TOKOF), D / 256, C.G, C.bid, false, (size_t)D * FE / 2, FE / 128, true}; phase_moecombine(C, tb, S.pieces(tb[8])); }
}

extern "C" void kernel_launch(void* const* d_in, const int* in_sizes, int n_in, void* d_out, int out_size, void* d_ws, size_t ws_size, hipStream_t stream) {
    if (n_in != 23 || out_size != T * D || ws_size < WS_END) { fprintf(stderr, "kernel_launch: bad shapes n_in %d out %d ws %zu (need %zu)\n", n_in, out_size, ws_size, (size_t)WS_END); return; }
    static int grid_blocks = 0;
    if (!grid_blocks) {
        int dev = 0, cus = 0, per_cu = 0;
        (void)hipGetDevice(&dev); (void)hipDeviceGetAttribute(&cus, hipDeviceAttributeMultiprocessorCount, dev);
        (void)hipFuncSetAttribute((const void*)fwd_megakernel, hipFuncAttributeMaxDynamicSharedMemorySize, LDS_BYTES);
        (void)hipOccupancyMaxActiveBlocksPerMultiprocessor(&per_cu, (const void*)fwd_megakernel, NTHREADS, LDS_BYTES);
        if (per_cu < 1) { fprintf(stderr, "kernel_launch: occupancy query says %d blocks per CU\n", per_cu); per_cu = 1; }
        grid_blocks = cus * 1;
    }
    if (hipMemsetAsync((char*)d_ws + WS_CTL, 0, WS_CTLBYTES, stream) != hipSuccess) { fprintf(stderr, "kernel_launch: memset failed\n"); return; }
    Params p{};
    for (int i = 0; i < 23; ++i) p.in[i] = (const float*)d_in[i];
    p.out = (float*)d_out; p.ws = (unsigned char*)d_ws;
    p.mask = 0xffffu & ~(1u << 7); p.probe = 0;
    void* args[] = {&p};
    hipError_t e = hipLaunchCooperativeKernel((const void*)fwd_megakernel, dim3(grid_blocks), dim3(NTHREADS), args, LDS_BYTES, stream);
    if (e != hipSuccess) fprintf(stderr, "cooperative launch failed: %s (grid %d)\n", hipGetErrorString(e), grid_blocks);
#ifndef PROBE_MODE
#define PROBE_MODE 1
#endif
#ifdef PROBE_MASK
    (void)hipMemsetAsync((char*)d_ws + WS_CTL + 4096, 0, WS_CTLBYTES - 4096, stream);
    Params p2 = p; p2.mask = PROBE_MASK; p2.probe = PROBE_MODE; void* args2[] = {&p2};
    (void)hipLaunchCooperativeKernel((const void*)fwd_megakernel, dim3(grid_blocks), dim3(NTHREADS), args2, LDS_BYTES, stream);
#endif
}
```

```cpp
#include <hip/hip_runtime.h>
#include <hip/hip_cooperative_groups.h>
#include <cstdio>
#include <cstdint>

#define LAS __attribute__((address_space(3)))
typedef unsigned short bf16_t;
typedef short bf16x8 __attribute__((ext_vector_type(8)));
typedef float f32x4 __attribute__((ext_vector_type(4)));
typedef float f32x2 __attribute__((ext_vector_type(2)));
typedef float f32x16 __attribute__((ext_vector_type(16)));
typedef unsigned u32x4 __attribute__((ext_vector_type(4)));
typedef unsigned u32x2 __attribute__((ext_vector_type(2)));
typedef int v8i __attribute__((ext_vector_type(8)));

constexpr int T = 16384, D = 1024, SEQ = 4096, NBATCH = 4;
constexpr int CONV = 512, GM = 512, NPROJ = 2560;
constexpr int FF = 2816, NGU = 2 * FF;
constexpr int NH = 8, HD = 128, NQKV = 3072;
constexpr int NE = 8, FE = 3584, NGUE = 2 * FE;
constexpr int MB = 256, NBLK = SEQ / MB;
constexpr float EPS = 1e-6f;

constexpr size_t al256(size_t x) { return (x + 255) & ~(size_t)255; }
constexpr size_t WS_CTL = 0;
constexpr int NSS = 4;
constexpr size_t WS_CTLBYTES = 32768;
constexpr int CW_BKT = 64;
constexpr int CW_BAR = 1024;
constexpr size_t WS_SS0 = WS_CTLBYTES;
constexpr size_t WS_SS1 = WS_SS0 + (size_t)T * NSS * 4;
constexpr size_t WS_SS2 = WS_SS1 + (size_t)T * NSS * 4;
constexpr size_t WS_SS3 = WS_SS2 + (size_t)T * NSS * 4;
constexpr size_t WS_ROPE = WS_SS3 + (size_t)T * NSS * 4;
constexpr size_t WS_KMEAN = WS_ROPE + (size_t)SEQ * 16 * 2 * 4;
constexpr size_t WS_TOKOF = WS_KMEAN + (size_t)NBATCH * NH * NBLK * HD * 4;
constexpr size_t WS_GATEOF = WS_TOKOF + (size_t)NE * T * 4;
constexpr size_t WS_TSLOT = al256(WS_GATEOF + (size_t)NE * T * 4);
constexpr size_t WS_MINFO = al256(WS_TSLOT + (size_t)T * 2 * 4);
constexpr size_t WS_W = al256(WS_MINFO + (size_t)NE * T * 16);
constexpr size_t WS_WIN = WS_W;
constexpr size_t WS_WOUT = WS_WIN + (size_t)NPROJ * D * 2;
constexpr size_t WS_WGU = WS_WOUT + (size_t)D * D * 2;
constexpr size_t WS_WDN = WS_WGU + (size_t)NGU * D * 2;
constexpr size_t WS_WQKV = WS_WDN + (size_t)D * FF * 2;
constexpr size_t WS_WO = WS_WQKV + (size_t)NQKV * D * 2;
constexpr size_t WS_MGU = WS_WO + (size_t)D * D * 2;
constexpr size_t WS_MDN = WS_MGU + (size_t)NE * NGUE * D;
constexpr size_t WS_ARENA = WS_MDN + (size_t)NE * D * FE;
constexpr size_t SZ_TD2 = (size_t)T * D * 2;
constexpr size_t AR_XB = 0, AR_PROJ = SZ_TD2, AR_Y = 0, AR_H1B = SZ_TD2, AR_ACT = 2 * SZ_TD2, AR_H2B = 0, AR_QKV = SZ_TD2,
                 AR_O = SZ_TD2 + (size_t)T * NQKV * 2, AR_H3B = 0, AR_MACT = (size_t)68 << 20;
constexpr int BKT_CAP = 3840;
constexpr size_t WS_BLIST = WS_WIN;
constexpr size_t WS_LPART = WS_BLIST + (size_t)512 * BKT_CAP * 4;
constexpr size_t WS_H38 = WS_WIN;
constexpr size_t AR_OPART = AR_O;
static_assert(WS_LPART + (size_t)T * NH * 4 * 4 <= WS_WQKV && WS_H38 + (size_t)T * D <= WS_WQKV, "attention lists / h3 fp8 fit the layer-0 weight copies");
static_assert(AR_OPART + (size_t)T * NH * 4 * HD * 2 <= SZ_TD2 + (size_t)(2 * T + 256) * FE * 2, "attention partials fit the arena");
constexpr size_t AR_YPART = SZ_TD2;
constexpr size_t AR_Y2 = (size_t)186 << 20;
static_assert(AR_YPART + (size_t)256 * 256 * 256 * 2 <= AR_MACT && AR_MACT + (size_t)(2 * T + 256) * FE <= AR_Y2 && AR_Y2 + (size_t)2 * T * D * 2 <= SZ_TD2 + (size_t)(2 * T + 256) * FE * 2, "MoE down arena");
constexpr size_t WS_END = WS_ARENA + SZ_TD2 + (size_t)(2 * T + 256) * FE * 2;
static_assert(AR_ACT + (size_t)T * FF * 2 <= SZ_TD2 + (size_t)2 * T * FE * 2, "arena");
static_assert(WS_END <= 486079488ull, "workspace budget");

__device__ __forceinline__ unsigned f2bf(float f) { unsigned u = __builtin_bit_cast(unsigned, f); return (u + 0x7fffu + ((u >> 16) & 1u)) >> 16; }
__device__ __forceinline__ float bf2f(unsigned b) { return __builtin_bit_cast(float, b << 16); }
__device__ __forceinline__ unsigned pk2(float lo, float hi) { return f2bf(lo) | (f2bf(hi) << 16); }
__device__ __forceinline__ unsigned cvt_pk_bf16(float lo, float hi) { unsigned r; asm volatile("v_cvt_pk_bf16_f32 %0, %1, %2" : "=v"(r) : "v"(lo), "v"(hi)); return r; }
__device__ __forceinline__ int opaque_tid(int wid) { int l; asm volatile("v_mbcnt_lo_u32_b32 %0, -1, 0\n\tv_mbcnt_hi_u32_b32 %0, -1, %0" : "=v"(l)); return wid * 64 + l; }
__device__ __forceinline__ float wave_sum(float v) {
#pragma unroll
    for (int o = 1; o < 64; o <<= 1) v += __shfl_xor(v, o);
    return v;
}
__device__ __forceinline__ float rscale_of(const f32x4 p) { return rsqrtf(((p[0] + p[1]) + (p[2] + p[3])) * (1.0f / D) + EPS); }
__device__ __forceinline__ float row_rscale(const float* ssp, int row) { return rscale_of(*(const f32x4*)(ssp + (size_t)row * NSS)); }
__device__ __forceinline__ unsigned pk_fp8x4(float a, float b, float c, float d) {
    a = fminf(fmaxf(a, -448.f), 448.f); b = fminf(fmaxf(b, -448.f), 448.f); c = fminf(fmaxf(c, -448.f), 448.f); d = fminf(fmaxf(d, -448.f), 448.f);
    int p = __builtin_amdgcn_cvt_pk_fp8_f32(a, b, 0, false); p = __builtin_amdgcn_cvt_pk_fp8_f32(c, d, p, true); return (unsigned)p; }
__device__ __forceinline__ float silu_f(float g) { return g * __builtin_amdgcn_rcpf(1.0f + __builtin_amdgcn_exp2f(g * -1.4426950408889634f)); }

namespace pg8 {
constexpr int BM = 256, BK = 64, HALF = 128, HTB = HALF * BK * 2, STAGE_BYTES = 8 * HTB, NXCD = 8, WGM = 8;
constexpr int RI_OFF = STAGE_BYTES, RI_BYTES = 4 * 4096;
constexpr int EPI_OFF = RI_OFF + RI_BYTES, EPI_TILE = 8 * 144;
__host__ __device__ __forceinline__ int lds_byte(int r, int c) { const int st = (r >> 4) * 2 + (c >> 5), rr = r & 15, cc = c & 31, ob = rr * 64 + cc * 2; return st * 1024 + (ob ^ (((ob >> 9) & 1) << 5)); }
__host__ __device__ __forceinline__ void stage_rc(int b, int& R, int& C) { const int st = b / 1024, sb = b % 1024, swz = sb ^ (((sb >> 9) & 1) << 5); R = (st >> 1) * 16 + swz / 64; C = (st & 1) * 32 + (swz % 64) / 2; }
__host__ __device__ __forceinline__ int perm32(int rho) { const int n = rho >> 4, i = rho & 15; return 8 * (i >> 2) + 4 * n + (i & 3); }

struct Unit { int row0, pn, e, nvalid, kt0, nkt, piece; };

struct DenseOrder {
    int nM, nN, nwg, G, c, nkt;
    __device__ void init(int M, int N, int K, int G_, int c_) { nM = M / BM; nN = N / BM; nwg = nM * nN; G = G_; c = c_; nkt = K / BK; }
    __device__ __forceinline__ bool next(int i, Unit& u) const {
        const long L = (long)i * G + c; if (L >= nwg) return false;
        int wgid = (int)L; { const int q = nwg / NXCD, r = nwg % NXCD, xcd = wgid % NXCD, off = wgid / NXCD; wgid = (xcd < r ? xcd * (q + 1) : r * (q + 1) + (xcd - r) * q) + off; }
        const int nig = WGM * nN, gid = wgid / nig, fm = gid * WGM, gsz = (nM - fm) < WGM ? (nM - fm) : WGM;
        u.row0 = (fm + ((wgid % nig) % gsz)) * BM; u.pn = (wgid % nig) / gsz; u.e = 0; u.nvalid = BM; u.kt0 = 0; u.nkt = nkt; u.piece = -1; return true;
    }
    __device__ __forceinline__ int src_row(const Unit& u, int r) const { return u.row0 + r; }
    __device__ __forceinline__ unsigned tbl_off(const Unit& u) const { return (unsigned)u.row0 * 16u; }
    __device__ __forceinline__ size_t b_off(const Unit&) const { return 0; }
};
struct MoeOrder {
    __device__ __forceinline__ int tbv(int i) const { return __builtin_amdgcn_readfirstlane(tb[i]); }
    const LAS int* tb; const int* tokof; int nN, G, c; bool gather; size_t bstride; int nkt; bool splitk;
    __device__ __forceinline__ void tile(int L, Unit& u) const {
        const int nwg = tbv(8);
        int wgid = L; { const int q = nwg / NXCD, r = nwg % NXCD, xcd = wgid % NXCD, off = wgid / NXCD; wgid = (xcd < r ? xcd * (q + 1) : r * (q + 1) + (xcd - r) * q) + off; }
        int e = 0;
#pragma unroll
        for (int j = 1; j < 8; ++j) e += (wgid >= tbv(j)) ? 1 : 0;
        const int w = wgid - tbv(e), cnt = tbv(32 + e), nM = (cnt + BM - 1) / BM;
        const int nig = WGM * nN, gid = w / nig, fm = gid * WGM, gsz = (nM - fm) < WGM ? (nM - fm) : WGM;
        const int pm = fm + ((w % nig) % gsz); u.pn = (w % nig) / gsz; u.e = e; u.row0 = pm * BM; u.nvalid = (cnt - pm * BM) < BM ? (cnt - pm * BM) : BM;
    }
    __device__ __forceinline__ void tile_nat(int wg, Unit& u) const {
        int e = 0;
#pragma unroll
        for (int j = 1; j < 8; ++j) e += (wg >= tbv(j)) ? 1 : 0;
        const int w = wg - tbv(e), cnt = tbv(32 + e), pm = w / nN; u.pn = w % nN; u.e = e; u.row0 = pm * BM; u.nvalid = (cnt - pm * BM) < BM ? (cnt - pm * BM) : BM;
    }
    __device__ __forceinline__ int pieces(int nwg) const { const int base = (nwg / G) * G, R = nwg - base, ntrip = nkt / 2; int p = 1; if (R * 2 <= G && ntrip % 2 == 0) p = 2; if (R * 7 <= G && ntrip % 7 == 0) p = 7; return p; }
    __device__ __forceinline__ bool next(int i, Unit& u) const {
        const long L = (long)i * G + c; const int nwg = tbv(8);
        if (!splitk) { if (L >= nwg) return false; tile((int)L, u); u.kt0 = 0; u.nkt = nkt; u.piece = -1; return true; }
        const int base = (nwg / G) * G, R = nwg - base;
        if (L < base) { const int wg = ((int)L % NXCD) * (base / NXCD) + (int)L / NXCD; tile_nat(wg, u); u.kt0 = 0; u.nkt = nkt; u.piece = -1; return true; }
        if (R == 0) return false;
        const int p = pieces(nwg), j = (int)(L - base); if (j >= R * p) return false;
        tile_nat(base + j / p, u); const int per = nkt / p; u.kt0 = (j % p) * per; u.nkt = per; u.piece = j; return true;
    }
    __device__ __forceinline__ int src_row(const Unit& u, int r) const {
        if (gather) return (r < u.nvalid) ? tokof[u.e * T + u.row0 + r] : 0;
        return tbv(16 + u.e) + u.row0 + r;
    }
    __device__ __forceinline__ unsigned tbl_off(const Unit& u) const { return (unsigned)(u.e * T + u.row0) * 16u; }
    __device__ __forceinline__ size_t b_off(const Unit& u) const { return (size_t)u.e * bstride; }
};

struct EpiScaleBf16 {
    static constexpr bool PERM = true;
    bf16_t* O; int ldc; const float* ss;
    __device__ __forceinline__ void operator()(const f32x4 (&acc)[2][2][4][2], const Unit& u, int wr, int wc, int fr, int fq, const LAS f32x4* tbl) const {
        const int col0 = u.pn * BM + wc * 32 + 8 * fq; float rs[2][4]; const LAS f32x4* tb0 = tbl + (wr * 64 + fr); asm volatile("" : "+v"(tb0));
#pragma unroll
        for (int ai = 0; ai < 2; ++ai)
#pragma unroll
            for (int m = 0; m < 4; ++m) rs[ai][m] = rscale_of(tb0[ai * HALF + m * 16]);
#pragma unroll
        for (int ai = 0; ai < 2; ++ai)
#pragma unroll
            for (int m = 0; m < 4; ++m) { const int row = u.row0 + ai * HALF + wr * 64 + m * 16 + fr; const float r = rs[ai][m];
                bf16_t* rowp = O + (size_t)row * ldc + col0;
#pragma unroll
                for (int bj = 0; bj < 2; ++bj) { const f32x4 v0 = acc[ai][bj][m][0] * r, v1 = acc[ai][bj][m][1] * r;
                    u32x4 w; w.x = cvt_pk_bf16(v0[0], v0[1]); w.y = cvt_pk_bf16(v0[2], v0[3]); w.z = cvt_pk_bf16(v1[0], v1[1]); w.w = cvt_pk_bf16(v1[2], v1[3]);
                    *(u32x4*)(rowp + bj * HALF) = w; } }
    }
};
struct EpiQKV {
    static constexpr bool PERM = true;
    bf16_t* O; const float* qg; const float* kg; const float* rope; float* kmean; LAS unsigned char* lds; int wid;
    __device__ __forceinline__ void operator()(const f32x4 (&acc)[2][2][4][2], const Unit& u, int wr, int wc, int, int, const LAS f32x4* tbl) const {
        const int lane = opaque_tid(wid) & 63, fr = lane & 15, fq = lane >> 4;
        const int col0 = u.pn * BM + wc * 32 + 8 * fq; const LAS f32x4* tb0 = tbl + (wr * 64 + fr);
        float rr[2][4];
#pragma unroll
        for (int ai = 0; ai < 2; ++ai)
#pragma unroll
            for (int m = 0; m < 4; ++m) rr[ai][m] = rscale_of(tb0[ai * HALF + m * 16]);
        if (u.pn >= 8) {
#pragma unroll
            for (int ai = 0; ai < 2; ++ai)
#pragma unroll
                for (int m = 0; m < 4; ++m) { const int row = u.row0 + ai * HALF + wr * 64 + m * 16 + fr; bf16_t* rowp = O + (size_t)row * NQKV + col0; const float r = rr[ai][m];
#pragma unroll
                    for (int bj = 0; bj < 2; ++bj) { const f32x4 v0 = acc[ai][bj][m][0] * r, v1 = acc[ai][bj][m][1] * r;
                        u32x4 w; w.x = cvt_pk_bf16(v0[0], v0[1]); w.y = cvt_pk_bf16(v0[2], v0[3]); w.z = cvt_pk_bf16(v1[0], v1[1]); w.w = cvt_pk_bf16(v1[2], v1[3]);
                        *(u32x4*)(rowp + bj * HALF) = w; } }
            return; }
        LAS float* sc = (LAS float*)(lds + EPI_OFF);
#pragma unroll
        for (int ai = 0; ai < 2; ++ai)
#pragma unroll
            for (int m = 0; m < 4; ++m) { const int tr = ai * HALF + wr * 64 + m * 16 + fr; const float r = rr[ai][m];
#pragma unroll
                for (int bj = 0; bj < 2; ++bj) { const f32x4 v0 = acc[ai][bj][m][0] * r, v1 = acc[ai][bj][m][1] * r;
                    float q = ((v0[0] * v0[0] + v0[1] * v0[1]) + (v0[2] * v0[2] + v0[3] * v0[3])) + ((v1[0] * v1[0] + v1[1] * v1[1]) + (v1[2] * v1[2] + v1[3] * v1[3]));
                    q += __shfl_xor(q, 16); q += __shfl_xor(q, 32);
                    if (fq == 0) sc[(tr * 2 + bj) * 4 + wc] = q; } }
        asm volatile("s_waitcnt lgkmcnt(0)" ::: "memory"); __builtin_amdgcn_s_barrier(); asm volatile("" ::: "memory");
        const bool isk = u.pn >= 4; const float* gp = (isk ? kg : qg) + wc * 32 + 8 * fq; const f32x4 g0 = *(const f32x4*)gp, g1 = *(const f32x4*)(gp + 4);
        const int b = u.row0 / SEQ, nblk = (u.row0 % SEQ) / MB, h0 = (u.pn & 3) * 2;
        float cs[2][2][4];
#pragma unroll
        for (int bj = 0; bj < 2; ++bj)
#pragma unroll
            for (int n = 0; n < 2; ++n)
#pragma unroll
                for (int j = 0; j < 4; ++j) cs[bj][n][j] = 0.f;
#pragma unroll
        for (int ai = 0; ai < 2; ++ai)
#pragma unroll
            for (int m = 0; m < 4; ++m) { const int tr = ai * HALF + wr * 64 + m * 16 + fr, row = u.row0 + tr; const float r = rr[ai][m]; bf16_t* rowp = O + (size_t)row * NQKV + col0;
                f32x4 rc0 = (f32x4){1.f, 0.f, 1.f, 0.f}, rc1 = rc0, rc2 = rc0, rc3 = rc0;
                if (wc == 0) { const f32x4* rp = (const f32x4*)(rope + ((size_t)(row % SEQ) * 16 + 8 * (fq & 1)) * 2); rc0 = rp[0]; rc1 = rp[1]; rc2 = rp[2]; rc3 = rp[3]; }
#pragma unroll
                for (int bj = 0; bj < 2; ++bj) { const f32x4 p4 = *(const LAS f32x4*)(sc + (tr * 2 + bj) * 4); const float rn = rsqrtf(((p4[0] + p4[1]) + (p4[2] + p4[3])) * (1.0f / HD) + EPS) * r;
                    f32x4 v0 = acc[ai][bj][m][0] * rn * g0, v1 = acc[ai][bj][m][1] * rn * g1;
                    if (wc == 0) {
                        const float c[8] = {rc0[0], rc0[2], rc1[0], rc1[2], rc2[0], rc2[2], rc3[0], rc3[2]}, sn[8] = {rc0[1], rc0[3], rc1[1], rc1[3], rc2[1], rc2[3], rc3[1], rc3[3]};
#pragma unroll
                        for (int j = 0; j < 4; ++j) { const float p0 = __shfl_xor(v0[j], 32), p1 = __shfl_xor(v1[j], 32);
                            v0[j] = (fq < 2) ? v0[j] * c[j] - p0 * sn[j] : v0[j] * c[j] + p0 * sn[j]; v1[j] = (fq < 2) ? v1[j] * c[4 + j] - p1 * sn[4 + j] : v1[j] * c[4 + j] + p1 * sn[4 + j]; } }
                    u32x4 w; w.x = cvt_pk_bf16(v0[0], v0[1]); w.y = cvt_pk_bf16(v0[2], v0[3]); w.z = cvt_pk_bf16(v1[0], v1[1]); w.w = cvt_pk_bf16(v1[2], v1[3]);
                    *(u32x4*)(rowp + bj * HALF) = w;
                    if (isk) { cs[bj][0][0] += bf2f(w.x & 0xffffu); cs[bj][0][1] += __builtin_bit_cast(float, w.x & 0xffff0000u); cs[bj][0][2] += bf2f(w.y & 0xffffu); cs[bj][0][3] += __builtin_bit_cast(float, w.y & 0xffff0000u);
                               cs[bj][1][0] += bf2f(w.z & 0xffffu); cs[bj][1][1] += __builtin_bit_cast(float, w.z & 0xffff0000u); cs[bj][1][2] += bf2f(w.w & 0xffffu); cs[bj][1][3] += __builtin_bit_cast(float, w.w & 0xffff0000u); } } }
        if (isk) {
#pragma unroll
            for (int bj = 0; bj < 2; ++bj)
#pragma unroll
                for (int n = 0; n < 2; ++n)
#pragma unroll
                    for (int j = 0; j < 4; ++j) { float v = cs[bj][n][j]; v += __shfl_xor(v, 1); v += __shfl_xor(v, 2); v += __shfl_xor(v, 4); v += __shfl_xor(v, 8);
                        if (fr == 0) atomicAdd(kmean + ((size_t)(b * NH + h0 + bj) * NBLK + nblk) * HD + wc * 32 + 8 * fq + 4 * n + j, v * (1.0f / MB)); } }
    }
};
struct EpiSwiglu {
    static constexpr bool PERM = true;
    bf16_t* O; int ldc; const float* ss; const int* tokof; const LAS int* tb; bool moe;
    __device__ __forceinline__ void operator()(const f32x4 (&acc)[2][2][4][2], const Unit& u, int wr, int wc, int fr, int fq, const LAS f32x4* tbl) const {
        const int col0 = u.pn * HALF + wc * 32 + 8 * fq; float rs[2][4]; int orow[2][4]; int trb = wr * 64 + fr; asm volatile("" : "+v"(trb));
#pragma unroll
        for (int ai = 0; ai < 2; ++ai)
#pragma unroll
            for (int m = 0; m < 4; ++m) { const int tr = ai * HALF + m * 16 + trb; int srow;
                if (moe) { const bool ok = tr < u.nvalid; srow = ok ? tokof[u.e * T + u.row0 + tr] : 0; orow[ai][m] = ok ? tb[16 + u.e] + u.row0 + tr : -1; } else { srow = u.row0 + tr; orow[ai][m] = srow; }
                rs[ai][m] = moe ? tbl[tr][0] : rscale_of(tbl[tr]); }
#pragma unroll
        for (int ai = 0; ai < 2; ++ai)
#pragma unroll
            for (int m = 0; m < 4; ++m) { const float r = rs[ai][m];
                f32x4 a[2];
#pragma unroll
                for (int n = 0; n < 2; ++n) { const f32x4 g = acc[ai][0][m][n] * r, up = acc[ai][1][m][n] * r;
#pragma unroll
                    for (int j = 0; j < 4; ++j) a[n][j] = silu_f(g[j]) * up[j]; }
                if (moe) { u32x2 w8; w8.x = pk_fp8x4(a[0][0] * 4.f, a[0][1] * 4.f, a[0][2] * 4.f, a[0][3] * 4.f); w8.y = pk_fp8x4(a[1][0] * 4.f, a[1][1] * 4.f, a[1][2] * 4.f, a[1][3] * 4.f);
                    if (orow[ai][m] >= 0) *(u32x2*)((unsigned char*)O + (size_t)orow[ai][m] * ldc + col0) = w8; }
                else { u32x4 w; w.x = cvt_pk_bf16(a[0][0], a[0][1]); w.y = cvt_pk_bf16(a[0][2], a[0][3]); w.z = cvt_pk_bf16(a[1][0], a[1][1]); w.w = cvt_pk_bf16(a[1][2], a[1][3]);
                    if (orow[ai][m] >= 0) *(u32x4*)(O + (size_t)orow[ai][m] * ldc + col0) = w; } }
    }
};
template <bool BASE16, bool F8COPY> struct EpiResid {
    static constexpr bool PERM = false;
    const void* base; bf16_t* hb; unsigned char* h8; float* ssout; LAS unsigned char* lds; int wid;
    __device__ __forceinline__ void operator()(const f32x4 (&acc)[2][2][4][2], const Unit& u, int wr, int wc, int fr, int fq, const LAS f32x4*) const {
        const int col0 = u.pn * BM + wc * 32 + 4 * fq; LAS float* sc = (LAS float*)(lds + EPI_OFF);
#pragma unroll
        for (int ai = 0; ai < 2; ++ai)
#pragma unroll
            for (int m = 0; m < 4; ++m) { const int tr = ai * HALF + wr * 64 + m * 16 + fr, row = u.row0 + tr; const size_t off = (size_t)row * D + col0; float q = 0.f;
#pragma unroll
                for (int bj = 0; bj < 2; ++bj)
#pragma unroll
                    for (int n = 0; n < 2; ++n) { f32x4 bv;
                        if (BASE16) { const u32x2 r = *(const u32x2*)((const bf16_t*)base + off + bj * HALF + n * 16); bv[0] = bf2f(r.x & 0xffffu); bv[1] = __builtin_bit_cast(float, r.x & 0xffff0000u); bv[2] = bf2f(r.y & 0xffffu); bv[3] = __builtin_bit_cast(float, r.y & 0xffff0000u); }
                        else bv = *(const f32x4*)((const float*)base + off + bj * HALF + n * 16);
                        const f32x4 h = bv + acc[ai][bj][m][n]; q += (h[0] * h[0] + h[1] * h[1]) + (h[2] * h[2] + h[3] * h[3]);
                        u32x2 w; w.x = cvt_pk_bf16(h[0], h[1]); w.y = cvt_pk_bf16(h[2], h[3]); *(u32x2*)(hb + off + bj * HALF + n * 16) = w;
                        if (F8COPY) *(unsigned*)(h8 + off + bj * HALF + n * 16) = pk_fp8x4(h[0], h[1], h[2], h[3]); }
                q += __shfl_xor(q, 16); q += __shfl_xor(q, 32);
                if (fq == 0) sc[tr * 4 + wc] = q;
                asm volatile("" ::: "memory"); }
        asm volatile("s_waitcnt lgkmcnt(0)" ::: "memory"); __builtin_amdgcn_s_barrier(); asm volatile("" ::: "memory");
        { const int t2 = opaque_tid(wid); if (t2 < 256) { const f32x4 p = *(const LAS f32x4*)(sc + t2 * 4); ssout[(size_t)(u.row0 + t2) * NSS + u.pn] = (p[0] + p[1]) + (p[2] + p[3]); } }
        asm volatile("s_waitcnt lgkmcnt(0)" ::: "memory"); __builtin_amdgcn_s_barrier(); asm volatile("" ::: "memory");
    }
};
struct EpiMoeDown {
    static constexpr bool PERM = true;
    bf16_t* y2; bf16_t* ypart; const float* gateof; const LAS int* tb; int wid;
    __device__ __forceinline__ void operator()(const f32x4 (&acc)[2][2][4][2], const Unit& u, int wr, int wc, int, int, const LAS f32x4*) const {
        const int lane = opaque_tid(wid) & 63, fr = lane & 15, fq = lane >> 4;
        const int cloc = wc * 32 + 8 * fq, trb = wr * 64 + fr;
        bf16_t* ob = (u.piece >= 0) ? ypart + (size_t)u.piece * (BM * BM) + cloc : y2 + (size_t)(tb[16 + u.e] + u.row0) * D + u.pn * BM + cloc; const int ld = (u.piece >= 0) ? BM : D;
#pragma unroll
        for (int ai = 0; ai < 2; ++ai)
#pragma unroll
            for (int m = 0; m < 4; ++m) { const int tr = ai * HALF + m * 16 + trb; const bool ok = tr < u.nvalid; const float gt = ok ? gateof[u.e * T + u.row0 + tr] : 0.f;
#pragma unroll
                for (int bj = 0; bj < 2; ++bj) { const f32x4 v0 = acc[ai][bj][m][0] * gt, v1 = acc[ai][bj][m][1] * gt;
                    u32x4 w; w.x = cvt_pk_bf16(v0[0], v0[1]); w.y = cvt_pk_bf16(v0[2], v0[3]); w.z = cvt_pk_bf16(v1[0], v1[1]); w.w = cvt_pk_bf16(v1[2], v1[3]);
                    if (ok) *(u32x4*)(ob + (size_t)tr * ld + bj * HALF) = w; } }
    }
};

template <class Epi, class Sched, bool ALIGN_EPI, bool F8>
__device__ __forceinline__ void gemm_fast(LAS unsigned char* lds, const void* A, int ldab, const void* Bt, int Kb, const void* tblbase, const Sched& S, const Epi& E, int wid, bool noepi, int sclA, int sclB) {
    const int lane = opaque_tid(wid) & 63, wr = wid >> 2, wc = wid & 3, fr = lane & 15, fq = lane >> 4;
    unsigned voffB[2];
#pragma unroll
    for (int i = 0; i < 2; ++i) { int R, C; stage_rc(opaque_tid(wid) * 16 + i * 8192, R, C); const int Rb = Epi::PERM ? ((R & ~31) + perm32(R & 31)) : R; voffB[i] = (unsigned)Rb * (unsigned)Kb + (unsigned)C * 2u; }
    const unsigned kstep = (unsigned)(BK * 2), hstep = (unsigned)HALF * (unsigned)Kb, tstep = 2u * hstep;
    const unsigned ldsw = (unsigned)wid * 1024u;
    const int fcol = fq * 8; constexpr int KOFF = 1024;
    const int aoff = lds_byte(wr * 64 + fr, fcol), boff = lds_byte(wc * 32 + fr, fcol);
    const __amdgpu_buffer_rsrc_t rA = __builtin_amdgcn_make_buffer_rsrc((void*)A, 0, 0x7fffffff, 0x00020000), rB = __builtin_amdgcn_make_buffer_rsrc((void*)Bt, 0, 0x7fffffff, 0x00020000), rT = __builtin_amdgcn_make_buffer_rsrc((void*)tblbase, 0, 0x7fffffff, 0x00020000);
#define PG8_SA(b, h) (((b) * 2 + (h)) * HTB)
#define PG8_SB(b, h) ((4 + (b) * 2 + (h)) * HTB)
#define PG8_STAGE(bufoff, rsrc, soff, voff) do { _Pragma("unroll") for (int _i = 0; _i < 2; ++_i) \
        __builtin_amdgcn_raw_ptr_buffer_load_lds(rsrc, (LAS void*)(lds + (bufoff) + ldsw + _i * 8192), 16, (voff)[_i], (soff), 0, 0); } while (0)
#define PG8_LDA(dst, b, h) do { _Pragma("unroll") for (int m = 0; m < 4; ++m) _Pragma("unroll") for (int k = 0; k < 2; ++k) dst[m][k] = *(const LAS bf16x8*)(lds + PG8_SA(b, h) + aoff + m * 2048 + k * KOFF); } while (0)
#define PG8_LDB(dst, b, h) do { _Pragma("unroll") for (int n = 0; n < 2; ++n) _Pragma("unroll") for (int k = 0; k < 2; ++k) dst[n][k] = *(const LAS bf16x8*)(lds + PG8_SB(b, h) + boff + n * 2048 + k * KOFF); } while (0)
#define PG8_V8(f) __builtin_shufflevector(__builtin_bit_cast(u32x4, (f)[0]), __builtin_bit_cast(u32x4, (f)[1]), 0, 1, 2, 3, 4, 5, 6, 7)
#define PG8_MMA(ai, bj, At, Bt_) do { __builtin_amdgcn_s_setprio(1); _Pragma("unroll") for (int m = 0; m < 4; ++m) _Pragma("unroll") for (int n = 0; n < 2; ++n) { \
        if constexpr (F8) acc[ai][bj][m][n] = __builtin_amdgcn_mfma_scale_f32_16x16x128_f8f6f4(__builtin_bit_cast(v8i, PG8_V8(Bt_[n])), __builtin_bit_cast(v8i, PG8_V8(At[m])), acc[ai][bj][m][n], 0, 0, 0, sclB, 0, sclA); \
        else { _Pragma("unroll") for (int k = 0; k < 2; ++k) acc[ai][bj][m][n] = __builtin_amdgcn_mfma_f32_16x16x32_bf16(Bt_[n][k], At[m][k], acc[ai][bj][m][n], 0, 0, 0); } } __builtin_amdgcn_s_setprio(0); } while (0)
#define PG8_WAIT_V(n) asm volatile("s_waitcnt vmcnt(" #n ")" ::: "memory")
#define PG8_WAIT_L(n) asm volatile("s_waitcnt lgkmcnt(" #n ")" ::: "memory")
#define PG8_BAR __builtin_amdgcn_s_barrier()
#define PG8_SCHED __builtin_amdgcn_sched_barrier(0)
#define PG8_TBL(u, bf) __builtin_amdgcn_raw_ptr_buffer_load_lds(rT, (LAS void*)(lds + RI_OFF + ((bf) * 2 + wr) * 4096 + wc * 1024), 16, (unsigned)lane * 16u, S.tbl_off(u) + (unsigned)wc * 1024u, 0, 0)
#define PG8_AOFFS(u, ao) do { _Pragma("unroll") for (int _i = 0; _i < 2; ++_i) { int _R, _C; stage_rc(opaque_tid(wid) * 16 + _i * 8192, _R, _C); _Pragma("unroll") for (int _h = 0; _h < 2; ++_h) \
        ao[_h][_i] = (unsigned)S.src_row(u, _h * HALF + _R) * (unsigned)ldab + (unsigned)_C * 2u; } } while (0)
    Unit cur, nxt; int ui = 0;
    if (!S.next(0, cur)) return;
    f32x4 acc[2][2][4][2];
#pragma unroll
    for (int a = 0; a < 2; ++a)
#pragma unroll
        for (int b = 0; b < 2; ++b)
#pragma unroll
            for (int m = 0; m < 4; ++m)
#pragma unroll
                for (int n = 0; n < 2; ++n) acc[a][b][m][n] = (f32x4){0.f, 0.f, 0.f, 0.f};
    bf16x8 At[4][2], B0[2][2], B1[2][2];
    unsigned aoc[2][2], aon[2][2];
    PG8_AOFFS(cur, aoc);
    unsigned sA = (unsigned)cur.kt0 * kstep;
    unsigned sB = (unsigned)(S.b_off(cur) * 2) + (unsigned)cur.pn * tstep + (unsigned)cur.kt0 * kstep;
    PG8_TBL(cur, 0);
    PG8_STAGE(PG8_SB(0, 0), rB, sB, voffB); PG8_STAGE(PG8_SB(0, 1), rB, sB + hstep, voffB); PG8_STAGE(PG8_SA(0, 0), rA, sA, aoc[0]); PG8_STAGE(PG8_SA(0, 1), rA, sA, aoc[1]);
    if (wr == 1) PG8_BAR;
    PG8_WAIT_V(2); PG8_BAR;
    PG8_STAGE(PG8_SB(1, 0), rB, sB + kstep, voffB); PG8_STAGE(PG8_SA(1, 0), rA, sA + kstep, aoc[0]); PG8_STAGE(PG8_SB(1, 1), rB, sB + hstep + kstep, voffB);
    PG8_WAIT_V(6); PG8_BAR;
    for (;;) {
        const bool has_next = S.next(ui + 1, nxt);
        if (has_next) { PG8_AOFFS(nxt, aon); } else {
#pragma unroll
            for (int h = 0; h < 2; ++h)
#pragma unroll
                for (int i = 0; i < 2; ++i) aon[h][i] = aoc[h][i]; }
        const unsigned nsB = has_next ? (unsigned)(S.b_off(nxt) * 2) + (unsigned)nxt.pn * tstep + (unsigned)nxt.kt0 * kstep : sB;
        const unsigned nsA = has_next ? (unsigned)nxt.kt0 * kstep : sA;
        const int nt = cur.nkt; int tsel = has_next ? 0 : -2; asm volatile("" : "+s"(tsel));
        for (int t = 0; t < nt; t += 2) {
            const bool last = (t == nt - 2);
            const unsigned a1 = sA + (unsigned)(t + 1) * kstep;
            const unsigned a2 = last ? nsA : sA + (unsigned)(t + 2) * kstep, b2 = last ? nsB : sB + (unsigned)(t + 2) * kstep;
            const unsigned a3 = a2 + kstep, b3 = b2 + kstep;
            PG8_LDB(B0, 0, 0); PG8_LDB(B1, 0, 1); PG8_SCHED; PG8_LDA(At, 0, 0); PG8_STAGE(PG8_SA(1, 1), rA, a1, aoc[1]);
            if (last) {
#pragma unroll
                for (int h = 0; h < 2; ++h)
#pragma unroll
                    for (int i = 0; i < 2; ++i) aoc[h][i] = aon[h][i]; }
            PG8_WAIT_V(8); PG8_WAIT_L(0); PG8_BAR; PG8_MMA(0, 0, At, B0); PG8_MMA(0, 1, At, B1); PG8_BAR; PG8_SCHED;
            PG8_LDA(At, 0, 1); if (t == tsel) PG8_TBL(nxt, (ui + 1) & 1);
            PG8_STAGE(PG8_SB(0, 0), rB, b2, voffB); PG8_STAGE(PG8_SB(0, 1), rB, b2 + hstep, voffB); PG8_STAGE(PG8_SA(0, 0), rA, a2, aoc[0]);
            PG8_WAIT_V(8); PG8_WAIT_L(0); PG8_BAR; PG8_MMA(1, 0, At, B0); PG8_MMA(1, 1, At, B1); PG8_BAR; PG8_SCHED;
            PG8_LDB(B0, 1, 0); PG8_LDB(B1, 1, 1); PG8_SCHED; PG8_LDA(At, 1, 0); PG8_STAGE(PG8_SA(0, 1), rA, a2, aoc[1]);
            PG8_WAIT_V(8); PG8_WAIT_L(0); PG8_BAR; PG8_MMA(0, 0, At, B0); PG8_MMA(0, 1, At, B1); PG8_BAR; PG8_SCHED;
            PG8_LDA(At, 1, 1); PG8_STAGE(PG8_SB(1, 0), rB, b3, voffB); PG8_STAGE(PG8_SB(1, 1), rB, b3 + hstep, voffB); PG8_STAGE(PG8_SA(1, 0), rA, a3, aoc[0]);
            PG8_WAIT_V(8); PG8_WAIT_L(0); PG8_BAR; PG8_MMA(1, 0, At, B0); PG8_MMA(1, 1, At, B1); PG8_BAR; PG8_SCHED;
        }
        if constexpr (ALIGN_EPI) { if (wr == 0) PG8_BAR; }
        if (!noepi) E(acc, cur, wr, wc, fr, fq, (const LAS f32x4*)(lds + RI_OFF + ((ui & 1) * 2 + wr) * 4096));
        if (!has_next) break;
#pragma unroll
        for (int a = 0; a < 2; ++a)
#pragma unroll
            for (int b = 0; b < 2; ++b)
#pragma unroll
                for (int m = 0; m < 4; ++m)
#pragma unroll
                    for (int n = 0; n < 2; ++n) acc[a][b][m][n] = (f32x4){0.f, 0.f, 0.f, 0.f};
        cur = nxt; sB = nsB; sA = nsA; ++ui;
        if constexpr (ALIGN_EPI) { if (wr == 1) PG8_BAR; }
    }
    PG8_WAIT_V(0);
    if constexpr (!ALIGN_EPI) { if (wr == 0) PG8_BAR; }
    PG8_BAR;
#undef PG8_SA
#undef PG8_SB
#undef PG8_STAGE
#undef PG8_LDA
#undef PG8_LDB
#undef PG8_MMA
#undef PG8_V8
#undef PG8_WAIT_V
#undef PG8_WAIT_L
#undef PG8_BAR
#undef PG8_SCHED
#undef PG8_AOFFS
#undef PG8_TBL
}
}

namespace cg = cooperative_groups;
constexpr int NTHREADS = 512, NWAVES = 8;
constexpr int LDS_BYTES = 163840;
constexpr int LDS_TB = LDS_BYTES - 1024;
constexpr int LDS_PTR = LDS_TB + 256;
constexpr int LDS_BST = LDS_PTR + 256;

struct Params {
    const float* in[23];
    float* out; unsigned char* ws;
    unsigned mask; int probe;
};
enum { I_X = 0, I_EMIXN, I_EWIN, I_ECONVW, I_ELNG, I_ELNB, I_EWSP, I_EBSP, I_EWOUT, I_EFFNN, I_EWGATE, I_EWUP, I_EWDOWN, I_OMIXN, I_OWQKV, I_OQN, I_OKN, I_OWO, I_OFFNN, I_OWR, I_OWGATE, I_OWUP, I_OWDOWN, I_OUT, I_WS };
struct Ctx { LAS unsigned char* lds; int wid, bid, G; bool noepi;
    template <class Tp> __device__ __forceinline__ Tp* ptr(int i) const { const unsigned long long v = ((const volatile LAS unsigned long long*)(lds + LDS_PTR))[i];
        const unsigned lo = __builtin_amdgcn_readfirstlane((unsigned)v), hi = __builtin_amdgcn_readfirstlane((unsigned)(v >> 32)); return (Tp*)(((unsigned long long)hi << 32) | lo); }
    __device__ __forceinline__ const float* in(int i) const { return ptr<const float>(i); }
    __device__ __forceinline__ unsigned char* ws() const { return ptr<unsigned char>(I_WS); }
    __device__ __forceinline__ float* out() const { return ptr<float>(I_OUT); }
};

#define XB_TMO      128
#define XB_XCNT(j)  (256  + 64 * (j))
#define XB_XSUB(j)  (1280 + 64 * (j))
#define XB_XGEN(j)  (2304 + 64 * (j))
#define XB_TOP      3328
#define XB_TOPGEN   3392
#define XCD_BAR_WORDS 3456
#define XB_SPIN_CAP (1u << 20)
__device__ __forceinline__ unsigned xb_ld(unsigned* p)              { return __hip_atomic_load(p, __ATOMIC_RELAXED, __HIP_MEMORY_SCOPE_AGENT); }
__device__ __forceinline__ unsigned xb_add(unsigned* p, unsigned v) { return __hip_atomic_fetch_add(p, v, __ATOMIC_RELAXED, __HIP_MEMORY_SCOPE_AGENT); }
__device__ __forceinline__ unsigned xb_xcc_id() { return (unsigned)__builtin_amdgcn_s_getreg((3 << 11) | 20) & 0xFu; }
#define XB_SPIN(cond, bar) do { unsigned _sp = 0; while (cond) { __builtin_amdgcn_s_sleep(1); \
    if ((++_sp & 255u) == 0u) { if (xb_ld(&(bar)[XB_TMO])) break; if (_sp > XB_SPIN_CAP) { atomicAdd(&(bar)[XB_TMO], 1u); break; } } } } while (0)
__device__ __forceinline__ void xcd_barrier_complete(unsigned* bar, unsigned x, unsigned G, unsigned& nloc, unsigned& nx) {
    unsigned sum, cnt, mine, sp = 0u;
    for (;;) {
        sum = 0u; cnt = 0u; mine = 0u;
#pragma unroll
        for (unsigned j = 0; j < 16; ++j) { const unsigned c = xb_ld(&bar[XB_XCNT(j)]); sum += c; cnt += (c > 0u) ? 1u : 0u; mine = (j == x) ? c : mine; }
        if (sum == G) break;
        __builtin_amdgcn_s_sleep(1);
        if ((++sp & 255u) == 0u) { if (xb_ld(&bar[XB_TMO])) break; if (sp > XB_SPIN_CAP) { atomicAdd(&bar[XB_TMO], 1u); break; } }
    }
    nloc = mine > 0u ? mine : 1u; nx = cnt > 0u ? cnt : 1u;
}
__device__ __forceinline__ void grid_barrier(const Ctx& C) {
    asm volatile("s_waitcnt vmcnt(0)" ::: "memory");
    __syncthreads();
    if (opaque_tid(C.wid) == 0) {
        unsigned* bar = (unsigned*)C.ws() + CW_BAR; volatile LAS unsigned* st = (volatile LAS unsigned*)(C.lds + LDS_BST); const unsigned x = xb_xcc_id();
        __builtin_amdgcn_s_waitcnt(0);
        unsigned nloc = st[0], nx = st[1];
        if (nloc == 0u) { xcd_barrier_complete(bar, x, (unsigned)C.G, nloc, nx); st[0] = nloc; st[1] = nx; }
        const unsigned old = xb_add(&bar[XB_XSUB(x)], 1u);
        const unsigned gen = old / nloc;
        if (old + 1u == (gen + 1u) * nloc) {
            __builtin_amdgcn_fence(__ATOMIC_RELEASE, "agent");
            asm volatile("s_waitcnt vmcnt(0)" ::: "memory");
            const unsigned og = xb_add(&bar[XB_TOP], 1u);
            const unsigned tg = og / nx;
            if (og + 1u == (tg + 1u) * nx) xb_add(&bar[XB_TOPGEN], 1u);
            else XB_SPIN(xb_ld(&bar[XB_TOPGEN]) == tg, bar);
            __builtin_amdgcn_fence(__ATOMIC_ACQUIRE, "agent");
            xb_add(&bar[XB_XGEN(x)], 1u);
            asm volatile("s_waitcnt vmcnt(0)" ::: "memory");
        } else {
            XB_SPIN(xb_ld(&bar[XB_XGEN(x)]) == gen, bar);
            __builtin_amdgcn_fence(__ATOMIC_ACQUIRE, "agent");
            asm volatile("s_waitcnt vmcnt(0)" ::: "memory");
        }
    }
    __syncthreads();
}

__device__ __forceinline__ void p0_transpose_item(const float* W, int K, int N, bf16_t* WT, const float* fold, int inter, int which, LAS float* scr, int item, int lane) {
    const int nblk = N / 32, kb = item / nblk, nb = item % nblk, k0 = 64 * kb, n0 = 32 * nb;
    const int kr = lane >> 3, c4 = lane & 7; f32x4 v[8]; float f[8];
#pragma unroll
    for (int i = 0; i < 8; ++i) v[i] = *(const f32x4*)(W + (size_t)(k0 + 8 * i + kr) * N + n0 + 4 * c4);
#pragma unroll
    for (int i = 0; i < 8; ++i) f[i] = fold ? fold[k0 + 8 * i + kr] : 1.0f;
#pragma unroll
    for (int i = 0; i < 8; ++i) { LAS float* d = scr + (8 * i + kr) * 33 + 4 * c4; d[0] = v[i][0] * f[i]; d[1] = v[i][1] * f[i]; d[2] = v[i][2] * f[i]; d[3] = v[i][3] * f[i]; }
    asm volatile("s_waitcnt lgkmcnt(0)" ::: "memory");
    const int c = lane & 7;
#pragma unroll
    for (int j = 0; j < 4; ++j) { const int nl = (lane >> 3) + 8 * j, n = n0 + nl; const LAS float* sp = scr + (8 * c) * 33 + nl;
        u32x4 o; o.x = pk2(sp[0 * 33], sp[1 * 33]); o.y = pk2(sp[2 * 33], sp[3 * 33]); o.z = pk2(sp[4 * 33], sp[5 * 33]); o.w = pk2(sp[6 * 33], sp[7 * 33]);
        const int dr = inter ? (n / 128) * 256 + which * 128 + (n % 128) : n;
        *(u32x4*)(WT + (size_t)dr * K + k0 + 8 * c) = o; }
    asm volatile("s_waitcnt lgkmcnt(0)" ::: "memory");
}
__device__ __forceinline__ void p0_transpose_item8(const float* W, int K, int N, unsigned char* WT, const float* fold, int inter, int which, LAS float* scr, int item, int lane) {
    const int nblk = N / 32, kb = item / nblk, nb = item % nblk, k0 = 64 * kb, n0 = 32 * nb;
    const int kr = lane >> 3, c4 = lane & 7; f32x4 v[8]; float f[8];
#pragma unroll
    for (int i = 0; i < 8; ++i) v[i] = *(const f32x4*)(W + (size_t)(k0 + 8 * i + kr) * N + n0 + 4 * c4);
#pragma unroll
    for (int i = 0; i < 8; ++i) f[i] = (fold ? fold[k0 + 8 * i + kr] : 1.0f) * 64.0f;
#pragma unroll
    for (int i = 0; i < 8; ++i) { LAS float* d = scr + (8 * i + kr) * 33 + 4 * c4; d[0] = v[i][0] * f[i]; d[1] = v[i][1] * f[i]; d[2] = v[i][2] * f[i]; d[3] = v[i][3] * f[i]; }
    asm volatile("s_waitcnt lgkmcnt(0)" ::: "memory");
    const int c = lane & 7;
#pragma unroll
    for (int j = 0; j < 4; ++j) { const int nl = (lane >> 3) + 8 * j, n = n0 + nl; const LAS float* sp = scr + (8 * c) * 33 + nl;
        u32x2 o; o.x = pk_fp8x4(sp[0 * 33], sp[1 * 33], sp[2 * 33], sp[3 * 33]); o.y = pk_fp8x4(sp[4 * 33], sp[5 * 33], sp[6 * 33], sp[7 * 33]);
        const int dr = inter ? (n / 128) * 256 + which * 128 + (n % 128) : n;
        *(u32x2*)(WT + (size_t)dr * K + k0 + 8 * c) = o; }
    asm volatile("s_waitcnt lgkmcnt(0)" ::: "memory");
}
__device__ __forceinline__ void phase_prep(const Ctx& C) {
    LAS unsigned char* lds = C.lds; const int bid = C.bid, G = C.G; unsigned char* ws = C.ws(); const int tid = opaque_tid(C.wid), lane = tid & 63, wave = C.wid;
    const int gw = bid * NWAVES + wave, NGW = G * NWAVES;
    LAS float* scr = (LAS float*)(lds + wave * 16384);
    constexpr int I_IN = (D / 64) * (NPROJ / 32), I_OUT = (D / 64) * (D / 32), I_G = (D / 64) * (FF / 32), I_DN = (FF / 64) * (D / 32), I_QKV = (D / 64) * (NQKV / 32),
                  I_MG = (D / 64) * (FE / 32), I_MD = (FE / 64) * (D / 32);
    constexpr int NITEMS = I_IN + I_OUT + 2 * I_G + I_DN + I_QKV + I_OUT + NE * (2 * I_MG + I_MD);
    for (int it = gw; it < NITEMS; it += NGW) {
        int r = it;
        if (r < I_IN) { p0_transpose_item(C.in(I_EWIN), D, NPROJ, (bf16_t*)(ws + WS_WIN), C.in(I_EMIXN), 0, 0, scr, r, lane); continue; } r -= I_IN;
        if (r < I_OUT) { p0_transpose_item(C.in(I_EWOUT), D, D, (bf16_t*)(ws + WS_WOUT), nullptr, 0, 0, scr, r, lane); continue; } r -= I_OUT;
        if (r < I_G) { p0_transpose_item(C.in(I_EWGATE), D, FF, (bf16_t*)(ws + WS_WGU), C.in(I_EFFNN), 1, 0, scr, r, lane); continue; } r -= I_G;
        if (r < I_G) { p0_transpose_item(C.in(I_EWUP), D, FF, (bf16_t*)(ws + WS_WGU), C.in(I_EFFNN), 1, 1, scr, r, lane); continue; } r -= I_G;
        if (r < I_DN) { p0_transpose_item(C.in(I_EWDOWN), FF, D, (bf16_t*)(ws + WS_WDN), nullptr, 0, 0, scr, r, lane); continue; } r -= I_DN;
        if (r < I_QKV) { p0_transpose_item(C.in(I_OWQKV), D, NQKV, (bf16_t*)(ws + WS_WQKV), C.in(I_OMIXN), 0, 0, scr, r, lane); continue; } r -= I_QKV;
        if (r < I_OUT) { p0_transpose_item(C.in(I_OWO), D, D, (bf16_t*)(ws + WS_WO), nullptr, 0, 0, scr, r, lane); continue; } r -= I_OUT;
        if (r < NE * I_MG) { const int e = r / I_MG; p0_transpose_item8(C.in(I_OWGATE) + (size_t)e * D * FE, D, FE, ws + WS_MGU + (size_t)e * NGUE * D, C.in(I_OFFNN), 1, 0, scr, r % I_MG, lane); continue; } r -= NE * I_MG;
        if (r < NE * I_MG) { const int e = r / I_MG; p0_transpose_item8(C.in(I_OWUP) + (size_t)e * D * FE, D, FE, ws + WS_MGU + (size_t)e * NGUE * D, C.in(I_OFFNN), 1, 1, scr, r % I_MG, lane); continue; } r -= NE * I_MG;
        { const int e = r / I_MD; p0_transpose_item8(C.in(I_OWDOWN) + (size_t)e * FE * D, FE, D, ws + WS_MDN + (size_t)e * D * FE, nullptr, 0, 0, scr, r % I_MD, lane); }
    }
    bf16_t* xb = (bf16_t*)(ws + WS_ARENA + AR_XB); float* ss0 = (float*)(ws + WS_SS0); const float* xin = C.in(I_X);
    for (int row = gw; row < T; row += NGW) {
        const f32x4* xr = (const f32x4*)(xin + (size_t)row * D) + lane; float sq = 0.f; u32x2* o = (u32x2*)(xb + (size_t)row * D) + lane;
#pragma unroll
        for (int j = 0; j < 4; ++j) { const f32x4 v = xr[64 * j]; sq += (v[0] * v[0] + v[1] * v[1]) + (v[2] * v[2] + v[3] * v[3]); u32x2 w; w.x = pk2(v[0], v[1]); w.y = pk2(v[2], v[3]); o[64 * j] = w; }
        sq = wave_sum(sq);
        if (lane < NSS) ss0[(size_t)row * NSS + lane] = (lane == 0) ? sq : 0.f;
    }
    { float* km = (float*)(ws + WS_KMEAN); for (int i = bid * NTHREADS + tid; i < NBATCH * NH * NBLK * HD; i += G * NTHREADS) km[i] = 0.f; }
    float* tab = (float*)(ws + WS_ROPE);
    for (int i = bid * NTHREADS + tid; i < SEQ * 16; i += G * NTHREADS) { const int sp = i / 16, f = i % 16; const double inv = pow(500000.0, -(double)f / 16.0); const double ang = (double)sp * inv;
        tab[2 * i] = (float)cos(ang); tab[2 * i + 1] = (float)sin(ang); }
}

constexpr int MX_VROW = 520, MX_MU = 256 * MX_VROW;
__device__ __forceinline__ void phase_mixer(const Ctx& C) {
    LAS unsigned char* lds = C.lds; const int bid = C.bid, G = C.G; unsigned char* ws = C.ws();
    const float* conv_w = C.in(I_ECONVW); const float* ln_g = C.in(I_ELNG); const float* ln_b = C.in(I_ELNB); const float* w_sp = C.in(I_EWSP); const float* b_sp = C.in(I_EBSP);
    const bf16_t* proj = (const bf16_t*)(ws + WS_ARENA + AR_PROJ); bf16_t* y = (bf16_t*)(ws + WS_ARENA + AR_Y);
    LAS float* mu = (LAS float*)(lds + MX_MU); LAS float* rstd = mu + 128;
    const int tid = opaque_tid(C.wid), lane = tid & 63, wave = C.wid, r31 = lane & 31, hh = lane >> 5;
    for (int unit = bid; unit < (T / 128) * 2; unit += G) {
        const int c = unit >> 1, hf = unit & 1, t0 = c * 128;
        { u32x4 vv[16];
#pragma unroll
          for (int i = 0; i < 16; ++i) vv[i] = *(const u32x4*)(proj + (size_t)(t0 + wave * 16 + i) * NPROJ + 3 * CONV + GM + lane * 8);
#pragma unroll
          for (int i = 0; i < 16; ++i) { const int sl = wave * 16 + i; const u32x4 v = vv[i];
            const float x0 = bf2f(v.x & 0xffffu), x1 = __builtin_bit_cast(float, v.x & 0xffff0000u), x2 = bf2f(v.y & 0xffffu), x3 = __builtin_bit_cast(float, v.y & 0xffff0000u),
                        x4 = bf2f(v.z & 0xffffu), x5 = __builtin_bit_cast(float, v.z & 0xffff0000u), x6 = bf2f(v.w & 0xffffu), x7 = __builtin_bit_cast(float, v.w & 0xffff0000u);
            float sm = ((x0 + x1) + (x2 + x3)) + ((x4 + x5) + (x6 + x7)), sq = ((x0 * x0 + x1 * x1) + (x2 * x2 + x3 * x3)) + ((x4 * x4 + x5 * x5) + (x6 * x6 + x7 * x7));
            sm = wave_sum(sm); sq = wave_sum(sq); const float m = sm * (1.0f / GM), var = sq * (1.0f / GM) - m * m;
            if (lane == 0) { mu[sl] = m; rstd[sl] = rsqrtf(fmaxf(var, 0.f) + EPS); } } }
        { const int co = tid & 31, sg = tid >> 5, ch = 256 * hf + 8 * co; float w0[8], w1[8], w2[8];
#pragma unroll
          for (int j = 0; j < 8; ++j) { w0[j] = conv_w[ch + j]; w1[j] = conv_w[CONV + ch + j]; w2[j] = conv_w[2 * CONV + ch + j]; }
          float zm2[8], zm1[8];
#pragma unroll
          for (int j = 0; j < 8; ++j) { zm2[j] = 0.f; zm1[j] = 0.f; }
#pragma unroll
          for (int i = -2; i < 8; ++i) { const int t = t0 + 8 * sg + i; const bool inseq = (i >= 0) || ((t0 + 8 * sg) % SEQ != 0);
              const bf16_t* pr = proj + (size_t)(inseq ? t : t0) * NPROJ + ch; const u32x4 ah = *(const u32x4*)pr, ac = *(const u32x4*)(pr + CONV);
              float z[8];
              z[0] = bf2f(ah.x & 0xffffu) * bf2f(ac.x & 0xffffu); z[1] = __builtin_bit_cast(float, ah.x & 0xffff0000u) * __builtin_bit_cast(float, ac.x & 0xffff0000u);
              z[2] = bf2f(ah.y & 0xffffu) * bf2f(ac.y & 0xffffu); z[3] = __builtin_bit_cast(float, ah.y & 0xffff0000u) * __builtin_bit_cast(float, ac.y & 0xffff0000u);
              z[4] = bf2f(ah.z & 0xffffu) * bf2f(ac.z & 0xffffu); z[5] = __builtin_bit_cast(float, ah.z & 0xffff0000u) * __builtin_bit_cast(float, ac.z & 0xffff0000u);
              z[6] = bf2f(ah.w & 0xffffu) * bf2f(ac.w & 0xffffu); z[7] = __builtin_bit_cast(float, ah.w & 0xffff0000u) * __builtin_bit_cast(float, ac.w & 0xffff0000u);
              if (!inseq) {
#pragma unroll
                  for (int j = 0; j < 8; ++j) z[j] = 0.f; }
              if (i >= 0) { const u32x4 ab = *(const u32x4*)(pr + 2 * CONV); float o[8];
#pragma unroll
                  for (int j = 0; j < 8; ++j) o[j] = w0[j] * zm2[j] + w1[j] * zm1[j] + w2[j] * z[j];
                  u32x4 w; w.x = pk2(bf2f(ab.x & 0xffffu) * o[0], __builtin_bit_cast(float, ab.x & 0xffff0000u) * o[1]); w.y = pk2(bf2f(ab.y & 0xffffu) * o[2], __builtin_bit_cast(float, ab.y & 0xffff0000u) * o[3]);
                  w.z = pk2(bf2f(ab.z & 0xffffu) * o[4], __builtin_bit_cast(float, ab.z & 0xffff0000u) * o[5]); w.w = pk2(bf2f(ab.w & 0xffffu) * o[6], __builtin_bit_cast(float, ab.w & 0xffff0000u) * o[7]);
                  *(u32x4*)(y + (size_t)t * D + ch) = w; }
#pragma unroll
              for (int j = 0; j < 8; ++j) { zm2[j] = zm1[j]; zm1[j] = z[j]; } } }
        __syncthreads();
#pragma unroll
        for (int i = 0; i < 4; ++i) { const int v = tid + 512 * i, sq4 = v >> 6, cq = v & 63, chl = 4 * cq, chg = 256 * hf + chl; const bf16_t* src = proj + (size_t)(t0 + 4 * sq4) * NPROJ + 3 * CONV + GM + chg;
            const f32x4 gg = *(const f32x4*)(ln_g + chg), bb = *(const f32x4*)(ln_b + chg);
            unsigned e[4][4];
#pragma unroll
            for (int r = 0; r < 4; ++r) { const u32x2 rv = *(const u32x2*)(src + (size_t)r * NPROJ); const float m = mu[4 * sq4 + r], rs = rstd[4 * sq4 + r];
                e[r][0] = f2bf((bf2f(rv.x & 0xffffu) - m) * rs * gg[0] + bb[0]); e[r][1] = f2bf((__builtin_bit_cast(float, rv.x & 0xffff0000u) - m) * rs * gg[1] + bb[1]);
                e[r][2] = f2bf((bf2f(rv.y & 0xffffu) - m) * rs * gg[2] + bb[2]); e[r][3] = f2bf((__builtin_bit_cast(float, rv.y & 0xffff0000u) - m) * rs * gg[3] + bb[3]); }
            LAS unsigned char* dst = lds + chl * MX_VROW + sq4 * 8;
#pragma unroll
            for (int d = 0; d < 4; ++d) { u32x2 w; w.x = e[0][d] | (e[1][d] << 16); w.y = e[2][d] | (e[3][d] << 16); *(LAS u32x2*)(dst + d * MX_VROW) = w; } }
        __syncthreads();
        { const int gl = wave >> 1, dt = wave & 1, g = 4 * hf + gl, chl = 64 * gl + 32 * dt + r31;
          bf16x8 bfr[8];
#pragma unroll
          for (int ks = 0; ks < 8; ++ks) { const LAS unsigned char* vp = lds + chl * MX_VROW + (16 * ks + 8 * hh) * 2; const u32x2 v0 = *(const LAS u32x2*)vp, v1 = *(const LAS u32x2*)(vp + 8);
              u32x4 w; w.x = v0.x; w.y = v0.y; w.z = v1.x; w.w = v1.y; bfr[ks] = __builtin_bit_cast(bf16x8, w); }
#pragma unroll
          for (int tt = 0; tt < 4; ++tt) { f32x16 acc;
#pragma unroll
              for (int i = 0; i < 16; ++i) acc[i] = 0.f;
              const int trow = 32 * tt + r31; const float* wrow = w_sp + ((size_t)g * 128 + trow) * 128 + 8 * hh;
#pragma unroll
              for (int ks = 0; ks < 8; ++ks) if (ks < 2 * tt + 2) { const f32x4 a0 = *(const f32x4*)(wrow + 16 * ks), a1 = *(const f32x4*)(wrow + 16 * ks + 4); float av[8] = {a0[0], a0[1], a0[2], a0[3], a1[0], a1[1], a1[2], a1[3]};
                  if (ks >= 2 * tt) {
#pragma unroll
                      for (int j = 0; j < 8; ++j) if (16 * ks + 8 * hh + j > trow) av[j] = 0.f; }
                  u32x4 w; w.x = pk2(av[0], av[1]); w.y = pk2(av[2], av[3]); w.z = pk2(av[4], av[5]); w.w = pk2(av[6], av[7]);
                  acc = __builtin_amdgcn_mfma_f32_32x32x16_bf16(bfr[ks], __builtin_bit_cast(bf16x8, w), acc, 0, 0, 0); }
              const int chg0 = 256 * hf + 64 * gl + 32 * dt + 4 * hh, t = t0 + trow; const float bias = b_sp[g * 128 + trow];
              const bf16_t* gp = proj + (size_t)t * NPROJ + 3 * CONV + chg0; bf16_t* yp = y + (size_t)t * D + CONV + chg0;
#pragma unroll
              for (int g4 = 0; g4 < 4; ++g4) { const u32x2 gu = *(const u32x2*)(gp + 8 * g4); u32x2 o;
                  o.x = pk2(bf2f(gu.x & 0xffffu) * (acc[4 * g4 + 0] + bias), __builtin_bit_cast(float, gu.x & 0xffff0000u) * (acc[4 * g4 + 1] + bias));
                  o.y = pk2(bf2f(gu.y & 0xffffu) * (acc[4 * g4 + 2] + bias), __builtin_bit_cast(float, gu.y & 0xffff0000u) * (acc[4 * g4 + 3] + bias)); *(u32x2*)(yp + 8 * g4) = o; } } }
        __syncthreads();
    }
}

__device__ __forceinline__ void phase_qkprep(const Ctx& C) {
    LAS unsigned char* lds = C.lds; const int bid = C.bid, G = C.G; unsigned char* ws = C.ws(); const float* qn = C.in(I_OQN); const float* kn = C.in(I_OKN);
    bf16_t* qkv = (bf16_t*)(ws + WS_ARENA + AR_QKV); const float* rope = (const float*)(ws + WS_ROPE); float* kmean = (float*)(ws + WS_KMEAN);
    LAS float* red = (LAS float*)lds;
    const int tid = opaque_tid(C.wid), lane = tid & 63, wave = C.wid, c16 = lane & 15, sub = lane >> 4;
    float gq[8], gk[8];
#pragma unroll
    for (int j = 0; j < 8; ++j) { gq[j] = qn[8 * c16 + j]; gk[j] = kn[8 * c16 + j]; }
    for (int item = bid; item < NBATCH * NBLK * NH; item += G) {
        const int h = item % NH, n = (item / NH) % NBLK, b = item / (NH * NBLK); float ks[8];
#pragma unroll
        for (int j = 0; j < 8; ++j) ks[j] = 0.f;
#pragma unroll 4
        for (int it = 0; it < 8; ++it) { const int sq = n * MB + wave * 32 + it * 4 + sub, t = b * SEQ + sq;
            float cs[8], sn[8];
            { const f32x4* rp = (const f32x4*)(rope + (sq * 16 + 8 * (c16 & 1)) * 2); f32x4 r0 = (f32x4){1.f, 0.f, 1.f, 0.f}, r1 = r0, r2 = r0, r3 = r0; if (c16 < 4) { r0 = rp[0]; r1 = rp[1]; r2 = rp[2]; r3 = rp[3]; }
              cs[0] = r0[0]; sn[0] = r0[1]; cs[1] = r0[2]; sn[1] = r0[3]; cs[2] = r1[0]; sn[2] = r1[1]; cs[3] = r1[2]; sn[3] = r1[3];
              cs[4] = r2[0]; sn[4] = r2[1]; cs[5] = r2[2]; sn[5] = r2[3]; cs[6] = r3[0]; sn[6] = r3[1]; cs[7] = r3[2]; sn[7] = r3[3]; }
#pragma unroll
            for (int which = 0; which < 2; ++which) { bf16_t* p = qkv + (size_t)t * NQKV + which * D + h * HD + 8 * c16; const u32x4 raw = *(const u32x4*)p;
                float v[8] = {bf2f(raw.x & 0xffffu), __builtin_bit_cast(float, raw.x & 0xffff0000u), bf2f(raw.y & 0xffffu), __builtin_bit_cast(float, raw.y & 0xffff0000u),
                              bf2f(raw.z & 0xffffu), __builtin_bit_cast(float, raw.z & 0xffff0000u), bf2f(raw.w & 0xffffu), __builtin_bit_cast(float, raw.w & 0xffff0000u)};
                float q = ((v[0] * v[0] + v[1] * v[1]) + (v[2] * v[2] + v[3] * v[3])) + ((v[4] * v[4] + v[5] * v[5]) + (v[6] * v[6] + v[7] * v[7]));
                q += __shfl_xor(q, 1); q += __shfl_xor(q, 2); q += __shfl_xor(q, 4); q += __shfl_xor(q, 8);
                const float r = rsqrtf(q * (1.0f / HD) + EPS);
#pragma unroll
                for (int j = 0; j < 8; ++j) v[j] = v[j] * r * (which ? gk[j] : gq[j]);
#pragma unroll
                for (int j = 0; j < 8; ++j) { const float pt = __shfl_xor(v[j], 2); if (c16 < 2) v[j] = v[j] * cs[j] - pt * sn[j]; else if (c16 < 4) v[j] = v[j] * cs[j] + pt * sn[j]; }
                u32x4 w; w.x = pk2(v[0], v[1]); w.y = pk2(v[2], v[3]); w.z = pk2(v[4], v[5]); w.w = pk2(v[6], v[7]);
                *(u32x4*)p = w;
                if (which) { ks[0] += bf2f(w.x & 0xffffu); ks[1] += __builtin_bit_cast(float, w.x & 0xffff0000u); ks[2] += bf2f(w.y & 0xffffu); ks[3] += __builtin_bit_cast(float, w.y & 0xffff0000u);
                             ks[4] += bf2f(w.z & 0xffffu); ks[5] += __builtin_bit_cast(float, w.z & 0xffff0000u); ks[6] += bf2f(w.w & 0xffffu); ks[7] += __builtin_bit_cast(float, w.w & 0xffff0000u); } } }
#pragma unroll
        for (int j = 0; j < 8; ++j) { ks[j] += __shfl_xor(ks[j], 16); ks[j] += __shfl_xor(ks[j], 32); }
        if (sub == 0) {
#pragma unroll
            for (int j = 0; j < 8; ++j) red[wave * 128 + 8 * c16 + j] = ks[j]; }
        __syncthreads();
        if (tid < 128) { float a = 0.f;
#pragma unroll
            for (int w = 0; w < NWAVES; ++w) a += red[w * 128 + tid];
            kmean[((size_t)(b * NH + h) * NBLK + n) * HD + tid] = a * (1.0f / MB); }
        __syncthreads();
    }
}

__device__ __forceinline__ void phase_select(const Ctx& C, bool probe) {
    const int bid = C.bid, G = C.G; unsigned char* ws = C.ws();
    const bf16_t* qkv = (const bf16_t*)(ws + WS_ARENA + AR_QKV); const float* kmean = (const float*)(ws + WS_KMEAN);
    unsigned* bcnt = (unsigned*)ws + (probe ? 5120 : CW_BKT); int* blist = (int*)(ws + (probe ? WS_ARENA + ((size_t)100 << 20) : WS_BLIST));
    const int tid = opaque_tid(C.wid), lane = tid & 63;
    for (int wt = bid * NWAVES + C.wid; wt < (T / 64) * NH; wt += G * NWAVES) {
        const int h = wt & 7, tg = wt >> 3, t = tg * 64 + lane, b = (tg * 64) / SEQ, sq = t % SEQ, qb = ((tg * 64) % SEQ) / MB;
        if (qb == 0) continue;
        const bf16_t* qp = qkv + (size_t)t * NQKV + h * HD; const float* km = kmean + (size_t)(b * NH + h) * NBLK * HD;
        float acc[NBLK];
#pragma unroll
        for (int n = 0; n < NBLK; ++n) acc[n] = 0.f;
#pragma unroll 4
        for (int ch = 0; ch < 16; ++ch) { const u32x4 raw = *(const u32x4*)(qp + 8 * ch);
            const float q0 = bf2f(raw.x & 0xffffu), q1 = __builtin_bit_cast(float, raw.x & 0xffff0000u), q2 = bf2f(raw.y & 0xffffu), q3 = __builtin_bit_cast(float, raw.y & 0xffff0000u),
                        q4 = bf2f(raw.z & 0xffffu), q5 = __builtin_bit_cast(float, raw.z & 0xffff0000u), q6 = bf2f(raw.w & 0xffffu), q7 = __builtin_bit_cast(float, raw.w & 0xffff0000u);
#pragma unroll
            for (int n = 0; n < NBLK; ++n) { const float* kp = km + n * HD + 8 * ch;
                acc[n] += ((q0 * kp[0] + q1 * kp[1]) + (q2 * kp[2] + q3 * kp[3])) + ((q4 * kp[4] + q5 * kp[5]) + (q6 * kp[6] + q7 * kp[7])); } }
        const int nsel = qb < 3 ? qb : 3; int sel0 = -1, sel1 = -1, sel2 = -1;
#pragma unroll
        for (int j = 0; j < 3; ++j) { float bv = -INFINITY; int bi = 0;
#pragma unroll
            for (int n = 0; n < NBLK - 1; ++n) { const float v = (n < qb) ? acc[n] : -INFINITY; if (v > bv) { bv = v; bi = n; } }
#pragma unroll
            for (int n = 0; n < NBLK - 1; ++n) if (n == bi) acc[n] = -INFINITY;
            if (j < nsel) { if (j == 0) sel0 = bi; if (j == 1) sel1 = bi; if (j == 2) sel2 = bi; } }
        const unsigned long long lt = (1ull << lane) - 1ull; int mytot = 0;
        for (int n = 0; n < qb; ++n) { const int tot = __popcll(__ballot(sel0 == n)) + __popcll(__ballot(sel1 == n)) + __popcll(__ballot(sel2 == n)); if (lane == n) mytot = tot; }
        unsigned mybase = 0; if (lane < qb && mytot > 0) mybase = atomicAdd(bcnt + (b * NH + h) * NBLK + lane, (unsigned)mytot);
        for (int n = 0; n < qb; ++n) { const unsigned long long m0 = __ballot(sel0 == n), m1 = __ballot(sel1 == n), m2 = __ballot(sel2 == n); const int c0 = __popcll(m0), c1 = __popcll(m1);
            const unsigned base = (unsigned)__shfl((int)mybase, n); int j = -1, rank = 0;
            if (sel0 == n) { j = 0; rank = __popcll(m0 & lt); } else if (sel1 == n) { j = 1; rank = c0 + __popcll(m1 & lt); } else if (sel2 == n) { j = 2; rank = c0 + c1 + __popcll(m2 & lt); }
            if (j >= 0) blist[(size_t)((b * NH + h) * NBLK + n) * BKT_CAP + base + rank] = (sq << 2) | j; }
    }
}

constexpr int AT_KS = 0, AT_KROW = 272, AT_VT = 256 * AT_KROW, AT_VROW = 520, AT_CUM = AT_VT + 128 * AT_VROW;
constexpr int AT_OT = AT_CUM + 3072, AT_OTW = 32 * 80;
static_assert(AT_CUM + 540 * 4 <= AT_OT && AT_OT + 8 * AT_OTW <= LDS_TB, "attention LDS map");
constexpr int CW_AQ = 600;
__device__ __forceinline__ void phase_attn(const Ctx& C, bool probe, unsigned pflags) {
    LAS unsigned char* lds = C.lds; unsigned char* ws = C.ws();
    const bf16_t* qkv = (const bf16_t*)(ws + WS_ARENA + AR_QKV); const unsigned* bcnt = (const unsigned*)ws + (probe ? 5120 : CW_BKT); const int* blist = (const int*)(ws + (probe ? WS_ARENA + ((size_t)100 << 20) : WS_BLIST));
    bf16_t* opart = (bf16_t*)(ws + WS_ARENA + AR_OPART); float* lpart = (float*)(ws + WS_LPART);
    const int tid = opaque_tid(C.wid), lane = tid & 63, wave = C.wid, r31 = lane & 31, hh = lane >> 5;
    LAS int* cum = (LAS int*)(lds + AT_CUM); LAS int* misc = cum + 520;
    { const int n = tid >> 5, bh = tid & 31; const int c = (int)bcnt[bh * NBLK + n]; int v = (c + 511) >> 9; v = v < 1 ? 1 : v;
#pragma unroll
      for (int o = 1; o < 64; o <<= 1) { const int u = __shfl_up(v, o); if (lane >= o) v += u; }
      if (lane == 63) misc[wave] = v;
      __syncthreads();
      int base = 0;
#pragma unroll
      for (int w = 0; w < NWAVES; ++w) base += (w < wave) ? misc[w] : 0;
      cum[tid + 1] = v + base; if (tid == 0) cum[0] = 0;
      __syncthreads(); }
    const int nitems = cum[512];
    const float cexp = 0.12751743f;
    LAS unsigned char* otile = lds + AT_OT + wave * AT_OTW;
    if (tid == 0) misc[8] = (int)atomicAdd((unsigned*)C.ws() + CW_AQ + (probe ? 1 : 0), 1u);
    __syncthreads();
    int item = misc[8];
    int n = 0, h = 0, b = 0, bk = 0, chunk = 0, cnt = 0, nown = 0, nrg = 0; int ent[3]; bool val[3];
#define AT_DECODE(it_) do { int lo = 0, hi = 512; while (hi - lo > 1) { const int mid = (lo + hi) >> 1; if (cum[mid] <= (it_)) lo = mid; else hi = mid; } \
        chunk = (it_) - cum[lo]; n = lo >> 5; { const int bh = lo & 31; h = bh & 7; b = bh >> 3; bk = bh * NBLK + n; } cnt = (int)bcnt[bk]; \
        { const int rem = cnt - chunk * 512; const int nsrg = ((rem < 512 ? rem : 512) + 31) >> 5; nown = (chunk == 0) ? 8 : 0; nrg = nown + (nsrg > 0 ? nsrg : 0); } } while (0)
#define AT_ENTS() do { _Pragma("unroll") for (int it = 0; it < 3; ++it) { const int rg = wave + 8 * it; val[it] = false; ent[it] = 0; \
        if (rg < nrg) { if (rg < nown) { ent[it] = ((n * MB + (7 - rg) * 32 + r31) << 2) | 3; val[it] = true; } \
                        else { const int ei = chunk * 512 + (rg - nown) * 32 + r31; val[it] = ei < cnt; ent[it] = val[it] ? blist[(size_t)bk * BKT_CAP + ei] : 0; } } } } while (0)
    if (item < nitems) { AT_DECODE(item); AT_ENTS(); }
    while (item < nitems) {
        __syncthreads();
        const int tid = opaque_tid(C.wid), lane = tid & 63, r31 = lane & 31, hh = lane >> 5;
        if (tid == 0) misc[8] = (int)atomicAdd((unsigned*)C.ws() + CW_AQ + (probe ? 1 : 0), 1u);
        const int cn = n, ch = h, cb = b, cnown = nown, cnrg = nrg; int cent[3]; bool cval[3];
#pragma unroll
        for (int it = 0; it < 3; ++it) { cent[it] = ent[it]; cval[it] = val[it]; }
        bf16x8 qn[8];
        { const bf16_t* qp = qkv + (size_t)(cb * SEQ + (cent[0] >> 2)) * NQKV + ch * HD + 8 * hh;
#pragma unroll
          for (int s8 = 0; s8 < 8; ++s8) qn[s8] = *(const bf16x8*)(qp + 16 * s8); }
        {
          const int tl = tid;
          const bf16_t* kb = qkv + (size_t)(cb * SEQ + cn * MB) * NQKV + D + ch * HD;
#pragma unroll
          for (int i = 0; i < 8; ++i) { const int c = tl + 512 * i, row = c >> 4, c16 = c & 15; const u32x4 v = *(const u32x4*)(kb + (size_t)row * NQKV + c16 * 8); *(LAS u32x4*)(lds + AT_KS + row * AT_KROW + c16 * 16) = v; }
          const bf16_t* vb = kb + D;
#pragma unroll
          for (int i = 0; i < 4; ++i) { const int v = tl + 512 * i, kq = v >> 5, dq = v & 31; const bf16_t* src = vb + (size_t)(4 * kq) * NQKV + 4 * dq;
              const u32x2 r0 = *(const u32x2*)src, r1 = *(const u32x2*)(src + NQKV), r2 = *(const u32x2*)(src + 2 * NQKV), r3 = *(const u32x2*)(src + 3 * NQKV);
              LAS unsigned char* dst = lds + AT_VT + (4 * dq) * AT_VROW + kq * 8;
              u32x2 w;
              w.x = (r0.x & 0xffffu) | (r1.x << 16); w.y = (r2.x & 0xffffu) | (r3.x << 16); *(LAS u32x2*)(dst) = w;
              w.x = (r0.x >> 16) | (r1.x & 0xffff0000u); w.y = (r2.x >> 16) | (r3.x & 0xffff0000u); *(LAS u32x2*)(dst + AT_VROW) = w;
              w.x = (r0.y & 0xffffu) | (r1.y << 16); w.y = (r2.y & 0xffffu) | (r3.y << 16); *(LAS u32x2*)(dst + 2 * AT_VROW) = w;
              w.x = (r0.y >> 16) | (r1.y & 0xffff0000u); w.y = (r2.y >> 16) | (r3.y & 0xffff0000u); *(LAS u32x2*)(dst + 3 * AT_VROW) = w; } }
        __syncthreads();
        const int nextitem = misc[8];
        if (nextitem < nitems) { AT_DECODE(nextitem); AT_ENTS(); }
#pragma unroll
        for (int it = 0; it < 3; ++it) { const int rg = wave + 8 * it;
            if (rg < cnrg) {
            const bool own = rg < cnown; const int og = 7 - rg;
            const int sq = cent[it] >> 2, slot = cent[it] & 3, tq = cb * SEQ + sq;
            bf16x8 qf[8];
#pragma unroll
            for (int s8 = 0; s8 < 8; ++s8) qf[s8] = qn[s8];
            if (it < 2 && rg + 8 < cnrg) { const bf16_t* qp = qkv + (size_t)(cb * SEQ + (cent[it < 2 ? it + 1 : 2] >> 2)) * NQKV + ch * HD + 8 * hh;
#pragma unroll
                for (int s8 = 0; s8 < 8; ++s8) qn[s8] = *(const bf16x8*)(qp + 16 * s8); }
            f32x16 oacc[4];
#pragma unroll
            for (int dt = 0; dt < 4; ++dt)
#pragma unroll
                for (int i = 0; i < 16; ++i) oacc[dt][i] = 0.f;
            float lsum = 0.f;
            const int nkt = own ? (og + 1) : 8;
            const LAS unsigned char* kbase = lds + AT_KS + r31 * AT_KROW + 16 * hh;
            const LAS unsigned char* vbase = lds + AT_VT + r31 * AT_VROW + 8 * hh;
            for (int kt = 0; kt < nkt; ++kt) {
                f32x16 sacc;
#pragma unroll
                for (int i = 0; i < 16; ++i) sacc[i] = 0.f;
#pragma unroll
                for (int s8 = 0; s8 < 8; ++s8) { const bf16x8 kf = *(const LAS bf16x8*)(kbase + kt * 32 * AT_KROW + 32 * s8); sacc = __builtin_amdgcn_mfma_f32_32x32x16_bf16(kf, qf[s8], sacc, 0, 0, 0); }
                const bool diag = own && (kt == og);
                float p[16];
#pragma unroll
                for (int i = 0; i < 16; ++i) { const int krow = (i & 3) + 8 * (i >> 2) + 4 * hh; float e = __builtin_amdgcn_exp2f(sacc[i] * cexp); if (diag && krow > r31) e = 0.f; p[i] = e; lsum += e; }
                bf16x8 pb[2];
#pragma unroll
                for (int s2 = 0; s2 < 2; ++s2) { u32x4 w; w.x = cvt_pk_bf16(p[8 * s2 + 0], p[8 * s2 + 1]); w.y = cvt_pk_bf16(p[8 * s2 + 2], p[8 * s2 + 3]); w.z = cvt_pk_bf16(p[8 * s2 + 4], p[8 * s2 + 5]); w.w = cvt_pk_bf16(p[8 * s2 + 6], p[8 * s2 + 7]);
                    pb[s2] = __builtin_bit_cast(bf16x8, w); }
#pragma unroll
                for (int dt = 0; dt < 4; ++dt)
#pragma unroll
                    for (int s2 = 0; s2 < 2; ++s2) { const LAS unsigned char* vp = vbase + dt * 32 * AT_VROW + (kt * 32 + 16 * s2) * 2;
                        const u32x2 v0 = *(const LAS u32x2*)vp, v1 = *(const LAS u32x2*)(vp + 16); u32x4 w; w.x = v0.x; w.y = v0.y; w.z = v1.x; w.w = v1.y;
                        oacc[dt] = __builtin_amdgcn_mfma_f32_32x32x16_bf16(__builtin_bit_cast(bf16x8, w), pb[s2], oacc[dt], 0, 0, 0); }
            }
            { const auto sw = __builtin_amdgcn_permlane32_swap(__builtin_bit_cast(unsigned, lsum), __builtin_bit_cast(unsigned, lsum), false, false);
              lsum = __builtin_bit_cast(float, sw[0]) + __builtin_bit_cast(float, sw[1]); }
            const int pidx = cval[it] ? (int)(((unsigned)tq * NH + ch) * 4 + slot) : -1;
            if (hh == 0 && pidx >= 0) lpart[pidx] = lsum;
            const int l2 = lane, r2 = r31, h2 = hh;
#pragma unroll
            for (int dt = 0; dt < 4; ++dt) {
#pragma unroll
                for (int g4 = 0; g4 < 4; ++g4) { u32x2 w; w.x = cvt_pk_bf16(oacc[dt][4 * g4 + 0], oacc[dt][4 * g4 + 1]); w.y = cvt_pk_bf16(oacc[dt][4 * g4 + 2], oacc[dt][4 * g4 + 3]); *(LAS u32x2*)(otile + r2 * 80 + (8 * g4 + 4 * h2) * 2) = w; }
                asm volatile("s_waitcnt lgkmcnt(0)" ::: "memory");
#pragma unroll
                for (int hf = 0; hf < 2; ++hf) { const int row = (l2 >> 2) + 16 * hf, c4 = l2 & 3; const u32x4 v = *(const LAS u32x4*)(otile + row * 80 + c4 * 16); const int pr = __shfl(pidx, row);
                    if (pr >= 0 && !(pflags & 4u)) *(u32x4*)(opart + (size_t)pr * HD + 32 * dt + 8 * c4) = v; }
                asm volatile("s_waitcnt lgkmcnt(0)" ::: "memory"); }
            } }
        item = nextitem;
    }
#undef AT_DECODE
#undef AT_ENTS
}

__device__ __forceinline__ void phase_combine(const Ctx& C) {
    const int bid = C.bid, G = C.G; unsigned char* ws = C.ws();
    bf16_t* qkv = (bf16_t*)(ws + WS_ARENA + AR_QKV); const bf16_t* opart = (const bf16_t*)(ws + WS_ARENA + AR_OPART); const float* lpart = (const float*)(ws + WS_LPART);
    const int tid = opaque_tid(C.wid), lane = tid & 63, sub = lane >> 4, c16 = lane & 15;
#pragma unroll 4
    for (int p0 = (bid * NWAVES + C.wid) * 4; p0 < T * NH; p0 += G * NWAVES * 4) {
        const int pr = p0 + sub, h = pr & 7, t = pr >> 3, qb = (t % SEQ) / MB, nsel = qb < 3 ? qb : 3;
        float acc[8]; float l = 0.f;
#pragma unroll
        for (int i = 0; i < 8; ++i) acc[i] = 0.f;
#pragma unroll
        for (int j = 0; j < 4; ++j) { if (j < nsel || j == 3) { const size_t pidx = (size_t)pr * 4 + j; const u32x4 v = *(const u32x4*)(opart + pidx * HD + c16 * 8); l += lpart[pidx];
            acc[0] += bf2f(v.x & 0xffffu); acc[1] += __builtin_bit_cast(float, v.x & 0xffff0000u); acc[2] += bf2f(v.y & 0xffffu); acc[3] += __builtin_bit_cast(float, v.y & 0xffff0000u);
            acc[4] += bf2f(v.z & 0xffffu); acc[5] += __builtin_bit_cast(float, v.z & 0xffff0000u); acc[6] += bf2f(v.w & 0xffffu); acc[7] += __builtin_bit_cast(float, v.w & 0xffff0000u); } }
        const float inv = 1.0f / l;
        u32x4 w; w.x = pk2(acc[0] * inv, acc[1] * inv); w.y = pk2(acc[2] * inv, acc[3] * inv); w.z = pk2(acc[4] * inv, acc[5] * inv); w.w = pk2(acc[6] * inv, acc[7] * inv);
        *(u32x4*)(qkv + (size_t)t * NQKV + h * HD + c16 * 8) = w;
    }
}

__device__ __forceinline__ void phase_router(const Ctx& C, bool probe) {
    const int bid = C.bid, G = C.G; unsigned char* ws = C.ws(); const float* ffn_g = C.in(I_OFFNN); const float* w_r = C.in(I_OWR);
    const bf16_t* h3 = (const bf16_t*)(ws + WS_ARENA + AR_H3B); const float* ss3 = (const float*)(ws + WS_SS3); int* cnt = (int*)(ws + WS_CTL) + (probe ? 6144 : 0); int* tslot = (int*)(ws + (probe ? WS_ARENA + ((size_t)103 << 20) : WS_TSLOT)); int* tokof = (int*)(ws + (probe ? WS_ARENA + ((size_t)100 << 20) : WS_TOKOF)); float* gateof = (float*)(ws + (probe ? WS_ARENA + ((size_t)101 << 20) : WS_GATEOF)); f32x4* minfo = (f32x4*)(ws + (probe ? WS_ARENA + ((size_t)102 << 20) : WS_MINFO));
    const int tid = opaque_tid(C.wid), lane = tid & 63, w = C.wid;
    LAS int* lcnt = (LAS int*)C.lds; LAS int* lbase = lcnt + 8; LAS int* te = lcnt + 16; LAS int* trank = te + 128; LAS float* tp = (LAS float*)(trank + 128); LAS float* trs = tp + 128;
    float wg[16][NE];
#pragma unroll
    for (int i = 0; i < 16; ++i) { const int c = lane * 16 + i; const float g = ffn_g[c]; const f32x4 a = *(const f32x4*)(w_r + c * NE), b2 = *(const f32x4*)(w_r + c * NE + 4);
        wg[i][0] = a[0] * g; wg[i][1] = a[1] * g; wg[i][2] = a[2] * g; wg[i][3] = a[3] * g; wg[i][4] = b2[0] * g; wg[i][5] = b2[1] * g; wg[i][6] = b2[2] * g; wg[i][7] = b2[3] * g; }
    for (int grp = bid; grp < T / 64; grp += G) {
        if (tid < 8) lcnt[tid] = 0;
        __syncthreads();
        for (int i8 = 0; i8 < 8; ++i8) { const int tl = w * 8 + i8, t = grp * 64 + tl; const u32x4* hp = (const u32x4*)(h3 + (size_t)t * D + lane * 16); const u32x4 r0 = hp[0], r1 = hp[1];
            const float xv[16] = {bf2f(r0.x & 0xffffu), __builtin_bit_cast(float, r0.x & 0xffff0000u), bf2f(r0.y & 0xffffu), __builtin_bit_cast(float, r0.y & 0xffff0000u), bf2f(r0.z & 0xffffu), __builtin_bit_cast(float, r0.z & 0xffff0000u), bf2f(r0.w & 0xffffu), __builtin_bit_cast(float, r0.w & 0xffff0000u),
                                  bf2f(r1.x & 0xffffu), __builtin_bit_cast(float, r1.x & 0xffff0000u), bf2f(r1.y & 0xffffu), __builtin_bit_cast(float, r1.y & 0xffff0000u), bf2f(r1.z & 0xffffu), __builtin_bit_cast(float, r1.z & 0xffff0000u), bf2f(r1.w & 0xffffu), __builtin_bit_cast(float, r1.w & 0xffff0000u)};
            float lg[NE];
#pragma unroll
            for (int e = 0; e < NE; ++e) lg[e] = 0.f;
#pragma unroll
            for (int i = 0; i < 16; ++i)
#pragma unroll
                for (int e = 0; e < NE; ++e) lg[e] += xv[i] * wg[i][e];
            const float r = row_rscale(ss3, t);
#pragma unroll
            for (int e = 0; e < NE; ++e) lg[e] = wave_sum(lg[e]) * r;
            if (lane == 0) { int e1 = 0; float v1 = lg[0];
#pragma unroll
                for (int e = 1; e < NE; ++e) if (lg[e] > v1) { v1 = lg[e]; e1 = e; }
                int e2 = -1; float v2 = -INFINITY;
#pragma unroll
                for (int e = 0; e < NE; ++e) if (e != e1 && lg[e] > v2) { v2 = lg[e]; e2 = e; }
                if (e2 < 0) { e2 = (e1 == 0) ? 1 : 0; v2 = v1; }
                const float p1 = 1.0f / (1.0f + __expf(v2 - v1)), p2 = 1.0f - p1;
                te[2 * tl] = e1; te[2 * tl + 1] = e2; tp[2 * tl] = p1; tp[2 * tl + 1] = p2; trs[tl] = r;
                trank[2 * tl] = __hip_atomic_fetch_add(lcnt + e1, 1, __ATOMIC_RELAXED, __HIP_MEMORY_SCOPE_WORKGROUP); trank[2 * tl + 1] = __hip_atomic_fetch_add(lcnt + e2, 1, __ATOMIC_RELAXED, __HIP_MEMORY_SCOPE_WORKGROUP); } }
        __syncthreads();
        if (tid < 8) lbase[tid] = atomicAdd(cnt + tid, lcnt[tid]);
        __syncthreads();
        if (tid < 128) { const int e = te[tid], pos = lbase[e] + trank[tid]; tokof[e * T + pos] = grp * 64 + (tid >> 1); gateof[e * T + pos] = tp[tid]; tslot[grp * 128 + tid] = e * T + pos;
            f32x4 rec; rec[0] = trs[tid >> 1]; rec[1] = __builtin_bit_cast(float, grp * 64 + (tid >> 1)); rec[2] = tp[tid]; rec[3] = 0.f; minfo[(size_t)e * T + pos] = rec; }
        __syncthreads();
    }
}

__device__ __forceinline__ void phase_moecombine(const Ctx& C, const LAS int* tb, int p) {
    const int bid = C.bid, G = C.G; unsigned char* ws = C.ws(); float* out = C.out();
    const int* tslot = (const int*)(ws + WS_TSLOT); const bf16_t* y2 = (const bf16_t*)(ws + WS_ARENA + AR_Y2); const bf16_t* ypart = (const bf16_t*)(ws + WS_ARENA + AR_YPART);
    const int lane = opaque_tid(C.wid) & 63, pn = lane >> 4, cl = (lane & 15) * 16; const int nwg = tb[8], base = (nwg / G) * G;
    for (int t = bid * NWAVES + C.wid; t < T; t += G * NWAVES) {
        f32x4 a[4]; { const u32x4* hp = (const u32x4*)((const bf16_t*)(ws + WS_ARENA + AR_H3B) + (size_t)t * D + lane * 16); const u32x4 r0 = hp[0], r1 = hp[1];
            a[0][0] = bf2f(r0.x & 0xffffu); a[0][1] = __builtin_bit_cast(float, r0.x & 0xffff0000u); a[0][2] = bf2f(r0.y & 0xffffu); a[0][3] = __builtin_bit_cast(float, r0.y & 0xffff0000u);
            a[1][0] = bf2f(r0.z & 0xffffu); a[1][1] = __builtin_bit_cast(float, r0.z & 0xffff0000u); a[1][2] = bf2f(r0.w & 0xffffu); a[1][3] = __builtin_bit_cast(float, r0.w & 0xffff0000u);
            a[2][0] = bf2f(r1.x & 0xffffu); a[2][1] = __builtin_bit_cast(float, r1.x & 0xffff0000u); a[2][2] = bf2f(r1.y & 0xffffu); a[2][3] = __builtin_bit_cast(float, r1.y & 0xffff0000u);
            a[3][0] = bf2f(r1.z & 0xffffu); a[3][1] = __builtin_bit_cast(float, r1.z & 0xffff0000u); a[3][2] = bf2f(r1.w & 0xffffu); a[3][3] = __builtin_bit_cast(float, r1.w & 0xffff0000u); }
#pragma unroll
        for (int sl = 0; sl < 2; ++sl) { const int code = tslot[t * 2 + sl], e = code / T, pos = code % T; const int wg = tb[e] + (pos >> 8) * 4 + pn;
            const bf16_t* src; int nsum, stride;
            if (wg < base) { src = y2 + (size_t)(tb[16 + e] + pos) * D + pn * 256 + cl; nsum = 1; stride = 0; }
            else { src = ypart + ((size_t)(wg - base) * p * 256 + (pos & 255)) * 256 + cl; nsum = p; stride = 256 * 256; }
            for (int q = 0; q < nsum; ++q) { const u32x4 v0 = *(const u32x4*)(src + (size_t)q * stride), v1 = *(const u32x4*)(src + (size_t)q * stride + 8);
                a[0][0] += bf2f(v0.x & 0xffffu); a[0][1] += __builtin_bit_cast(float, v0.x & 0xffff0000u); a[0][2] += bf2f(v0.y & 0xffffu); a[0][3] += __builtin_bit_cast(float, v0.y & 0xffff0000u);
                a[1][0] += bf2f(v0.z & 0xffffu); a[1][1] += __builtin_bit_cast(float, v0.z & 0xffff0000u); a[1][2] += bf2f(v0.w & 0xffffu); a[1][3] += __builtin_bit_cast(float, v0.w & 0xffff0000u);
                a[2][0] += bf2f(v1.x & 0xffffu); a[2][1] += __builtin_bit_cast(float, v1.x & 0xffff0000u); a[2][2] += bf2f(v1.y & 0xffffu); a[2][3] += __builtin_bit_cast(float, v1.y & 0xffff0000u);
                a[3][0] += bf2f(v1.z & 0xffffu); a[3][1] += __builtin_bit_cast(float, v1.z & 0xffff0000u); a[3][2] += bf2f(v1.w & 0xffffu); a[3][3] += __builtin_bit_cast(float, v1.w & 0xffff0000u); } }
        { f32x4* hp = (f32x4*)(out + (size_t)t * D + lane * 16); hp[0] = a[0]; hp[1] = a[1]; hp[2] = a[2]; hp[3] = a[3]; }
    }
}

__device__ __forceinline__ void moe_tables(LAS int* tb, const int* cnt, int nN, int wid) {
    if (opaque_tid(wid) == 0) { int cu = 0, off = 0; for (int e = 0; e < NE; ++e) { const int c = cnt[e]; tb[e] = cu; tb[16 + e] = off; tb[32 + e] = c; cu += ((c + 255) / 256) * nN; off += c; } tb[8] = cu; tb[24] = off; }
    __syncthreads();
}
template <class Epi, class Sched>
__device__ __forceinline__ void gemm_run(const Ctx& C, const bf16_t* A, int lda, const bf16_t* Bt, int K, const void* tblbase, const Sched& S, const Epi& E) { pg8::gemm_fast<Epi, Sched, true, false>(C.lds, A, lda * 2, Bt, K * 2, tblbase, S, E, C.wid, C.noepi, 0, 0); }
template <class Epi, class Sched>
__device__ __forceinline__ void gemm_run8(const Ctx& C, const void* A, int lda, const void* Bt, int K, const void* tblbase, const Sched& S, const Epi& E, int ea, int eb) { pg8::gemm_fast<Epi, Sched, true, true>(C.lds, A, lda, Bt, K, tblbase, S, E, C.wid, C.noepi, ea * 0x01010101, eb * 0x01010101); }

__global__ void __launch_bounds__(NTHREADS) fwd_megakernel(Params P) {
    extern __shared__ __attribute__((aligned(16))) unsigned char lds_raw[];
    Ctx C; C.lds = (LAS unsigned char*)lds_raw; C.wid = __builtin_amdgcn_readfirstlane(threadIdx.x >> 6); C.bid = blockIdx.x; C.G = gridDim.x;
    if (threadIdx.x < 25) { const unsigned long long v = (threadIdx.x < 23) ? (unsigned long long)P.in[threadIdx.x] : (threadIdx.x == 23 ? (unsigned long long)P.out : (unsigned long long)P.ws);
        ((LAS unsigned long long*)(C.lds + LDS_PTR))[threadIdx.x] = v; }
    if (threadIdx.x < 2) ((LAS unsigned*)(C.lds + LDS_BST))[threadIdx.x] = 0u;
    if (threadIdx.x == 2) { ((LAS unsigned*)(C.lds + LDS_BST))[4] = P.mask; ((LAS unsigned*)(C.lds + LDS_BST))[5] = (unsigned)P.probe; }
    if (threadIdx.x == 0) (void)xb_add((unsigned*)P.ws + CW_BAR + XB_XCNT(xb_xcc_id()), 1u);
    __syncthreads();
    if (P.ws == nullptr) cg::this_grid().sync();
    LAS int* tb = (LAS int*)(C.lds + LDS_TB);
#define WSP(T_, off) ((T_*)(C.ws() + (off)))
#define ARP(off) ((bf16_t*)(C.ws() + WS_ARENA + (off)))

    const unsigned mask = __builtin_amdgcn_readfirstlane(((const volatile LAS unsigned*)(C.lds + LDS_BST))[4]); const unsigned probev = __builtin_amdgcn_readfirstlane(((const volatile LAS unsigned*)(C.lds + LDS_BST))[5]); const bool probe = probev != 0u; C.noepi = (probev & 2u) != 0u;
#define PH(k) (mask & (1u << (k)))
    float* d_f32 = (float*)(C.ws() + WS_ARENA); bf16_t* d_b16 = ARP((size_t)64 << 20); float* d_ss = (float*)(C.ws() + WS_ARENA + ((size_t)96 << 20));

    if (PH(0)) { phase_prep(C); grid_barrier(C); }
    if (PH(1)) { pg8::DenseOrder S; S.init(T, NPROJ, D, C.G, C.bid); pg8::EpiScaleBf16 E{ARP(AR_PROJ), NPROJ, WSP(float, WS_SS0)}; gemm_run(C, ARP(AR_XB), D, WSP(bf16_t, WS_WIN), D, WSP(float, WS_SS0), S, E); grid_barrier(C); }
    if (PH(2)) { phase_mixer(C); grid_barrier(C); }
    if (PH(3)) { pg8::DenseOrder S; S.init(T, D, D, C.G, C.bid); pg8::EpiResid<false, false> E{C.in(I_X), probe ? d_b16 : ARP(AR_H1B), nullptr, probe ? d_ss : WSP(float, WS_SS1), C.lds, C.wid}; gemm_run(C, ARP(AR_Y), D, WSP(bf16_t, WS_WOUT), D, WSP(float, WS_SS0), S, E); grid_barrier(C); }
    if (PH(4)) { pg8::DenseOrder S; S.init(T, NGU, D, C.G, C.bid); pg8::EpiSwiglu E{ARP(AR_ACT), FF, WSP(float, WS_SS1), nullptr, tb, false}; gemm_run(C, ARP(AR_H1B), D, WSP(bf16_t, WS_WGU), D, WSP(float, WS_SS1), S, E); grid_barrier(C); }
    if (PH(5)) { pg8::DenseOrder S; S.init(T, D, FF, C.G, C.bid); pg8::EpiResid<true, false> E{ARP(AR_H1B), probe ? d_b16 : ARP(AR_H2B), nullptr, probe ? d_ss : WSP(float, WS_SS2), C.lds, C.wid}; gemm_run(C, ARP(AR_ACT), FF, WSP(bf16_t, WS_WDN), FF, WSP(float, WS_SS0), S, E); grid_barrier(C); }
    if (PH(6)) { pg8::DenseOrder S; S.init(T, NQKV, D, C.G, C.bid); pg8::EpiQKV E{ARP(AR_QKV), C.in(I_OQN), C.in(I_OKN), WSP(float, WS_ROPE), WSP(float, WS_KMEAN), C.lds, C.wid}; gemm_run(C, ARP(AR_H2B), D, WSP(bf16_t, WS_WQKV), D, WSP(float, WS_SS2), S, E); grid_barrier(C); }
    if (PH(7)) { phase_qkprep(C); grid_barrier(C); }
    if (PH(8)) { phase_select(C, probe); grid_barrier(C); }
    if (PH(9)) { phase_attn(C, probe, probev); grid_barrier(C); }
    if (PH(10)) { phase_combine(C); grid_barrier(C); }
    if (PH(11)) { pg8::DenseOrder S; S.init(T, D, D, C.G, C.bid); pg8::EpiResid<true, true> E{ARP(AR_H2B), probe ? d_b16 : ARP(AR_H3B), probe ? (unsigned char*)d_f32 : WSP(unsigned char, WS_H38), probe ? d_ss : WSP(float, WS_SS3), C.lds, C.wid}; gemm_run(C, ARP(AR_QKV), NQKV, WSP(bf16_t, WS_WO), D, WSP(float, WS_SS0), S, E); grid_barrier(C); }
    if (PH(12)) { phase_router(C, probe); grid_barrier(C); }
    if (PH(13)) { moe_tables(tb, WSP(int, WS_CTL), NGUE / 256, C.wid); pg8::MoeOrder S{tb, WSP(int, WS_TOKOF), NGUE / 256, C.G, C.bid, true, (size_t)NGUE * D / 2, D / 128, false};
        pg8::EpiSwiglu E{ARP(AR_MACT), FE, WSP(float, WS_SS3), WSP(int, WS_TOKOF), tb, true}; gemm_run8(C, WSP(unsigned char, WS_H38), D, WSP(unsigned char, WS_MGU), D, WSP(float, WS_MINFO), S, E, 127, 121); grid_barrier(C); }
    if (PH(14)) { moe_tables(tb, WSP(int, WS_CTL), D / 256, C.wid); pg8::MoeOrder S{tb, WSP(int, WS_TOKOF), D / 256, C.G, C.bid, false, (size_t)D * FE / 2, FE / 128, true};
        pg8::EpiMoeDown E{ARP(AR_Y2), ARP(AR_YPART), WSP(float, WS_GATEOF), tb, C.wid}; gemm_run8(C, ARP(AR_MACT), FE, WSP(unsigned char, WS_MDN), FE, WSP(float, WS_MINFO), S, E, 125, 121); grid_barrier(C); }
    if (PH(15) && !probe) { moe_tables(tb, WSP(int, WS_CTL), D / 256, C.wid); pg8::MoeOrder S{tb, WSP(int, WS_TOKOF), D / 256, C.G, C.bid, false, (size_t)D * FE / 2, FE / 128, true}; phase_moecombine(C, tb, S.pieces(tb[8])); }
}

extern "C" void kernel_launch(void* const* d_in, const int* in_sizes, int n_in, void* d_out, int out_size, void* d_ws, size_t ws_size, hipStream_t stream) {
    if (n_in != 23 || out_size != T * D || ws_size < WS_END) { fprintf(stderr, "kernel_launch: bad shapes n_in %d out %d ws %zu (need %zu)\n", n_in, out_size, ws_size, (size_t)WS_END); return; }
    static int grid_blocks = 0;
    if (!grid_blocks) {
        int dev = 0, cus = 0, per_cu = 0;
        (void)hipGetDevice(&dev); (void)hipDeviceGetAttribute(&cus, hipDeviceAttributeMultiprocessorCount, dev);
        (void)hipFuncSetAttribute((const void*)fwd_megakernel, hipFuncAttributeMaxDynamicSharedMemorySize, LDS_BYTES);
        (void)hipOccupancyMaxActiveBlocksPerMultiprocessor(&per_cu, (const void*)fwd_megakernel, NTHREADS, LDS_BYTES);
        if (per_cu < 1) { fprintf(stderr, "kernel_launch: occupancy query says %d blocks per CU\n", per_cu); per_cu = 1; }
        grid_blocks = cus * 1;
    }
    if (hipMemsetAsync((char*)d_ws + WS_CTL, 0, WS_CTLBYTES, stream) != hipSuccess) { fprintf(stderr, "kernel_launch: memset failed\n"); return; }
    Params p{};
    for (int i = 0; i < 23; ++i) p.in[i] = (const float*)d_in[i];
    p.out = (float*)d_out; p.ws = (unsigned char*)d_ws;
    p.mask = 0xffffu & ~(1u << 7); p.probe = 0;
    void* args[] = {&p};
    hipError_t e = hipLaunchCooperativeKernel((const void*)fwd_megakernel, dim3(grid_blocks), dim3(NTHREADS), args, LDS_BYTES, stream);
    if (e != hipSuccess) fprintf(stderr, "cooperative launch failed: %s (grid %d)\n", hipGetErrorString(e), grid_blocks);
#ifndef PROBE_MODE
#define PROBE_MODE 1
#endif
#ifdef PROBE_MASK
    (void)hipMemsetAsync((char*)d_ws + WS_CTL + 4096, 0, WS_CTLBYTES - 4096, stream);
    Params p2 = p; p2.mask = PROBE_MASK; p2.probe = PROBE_MODE; void* args2[] = {&p2};
    (void)hipLaunchCooperativeKernel((const void*)fwd_megakernel, dim3(grid_blocks), dim3(NTHREADS), args2, LDS_BYTES, stream);
#endif
}
```

```cpp
#include <hip/hip_runtime.h>
#include <hip/hip_cooperative_groups.h>
#include <cstdio>
#include <cstdint>

#define LAS __attribute__((address_space(3)))
typedef unsigned short bf16_t;
typedef short bf16x8 __attribute__((ext_vector_type(8)));
typedef float f32x4 __attribute__((ext_vector_type(4)));
typedef float f32x2 __attribute__((ext_vector_type(2)));
typedef float f32x16 __attribute__((ext_vector_type(16)));
typedef unsigned u32x4 __attribute__((ext_vector_type(4)));
typedef unsigned u32x2 __attribute__((ext_vector_type(2)));
typedef int v8i __attribute__((ext_vector_type(8)));

constexpr int T = 16384, D = 1024, SEQ = 4096, NBATCH = 4;
constexpr int CONV = 512, GM = 512, NPROJ = 2560;
constexpr int FF = 2816, NGU = 2 * FF;
constexpr int NH = 8, HD = 128, NQKV = 3072;
constexpr int NE = 8, FE = 3584, NGUE = 2 * FE;
constexpr int MB = 256, NBLK = SEQ / MB;
constexpr float EPS = 1e-6f;

constexpr size_t al256(size_t x) { return (x + 255) & ~(size_t)255; }
constexpr size_t WS_CTL = 0;
constexpr int NSS = 4;
constexpr size_t WS_CTLBYTES = 32768;
constexpr int CW_BKT = 64;
constexpr int CW_BAR = 1024;
constexpr size_t WS_SS0 = WS_CTLBYTES;
constexpr size_t WS_SS1 = WS_SS0 + (size_t)T * NSS * 4;
constexpr size_t WS_SS2 = WS_SS1 + (size_t)T * NSS * 4;
constexpr size_t WS_SS3 = WS_SS2 + (size_t)T * NSS * 4;
constexpr size_t WS_ROPE = WS_SS3 + (size_t)T * NSS * 4;
constexpr size_t WS_KMEAN = WS_ROPE + (size_t)SEQ * 16 * 2 * 4;
constexpr size_t WS_TOKOF = WS_KMEAN + (size_t)NBATCH * NH * NBLK * HD * 4;
constexpr size_t WS_GATEOF = WS_TOKOF + (size_t)NE * T * 4;
constexpr size_t WS_TSLOT = al256(WS_GATEOF + (size_t)NE * T * 4);
constexpr size_t WS_MINFO = al256(WS_TSLOT + (size_t)T * 2 * 4);
constexpr size_t WS_W = al256(WS_MINFO + (size_t)NE * T * 16);
constexpr size_t WS_WIN = WS_W;
constexpr size_t WS_WOUT = WS_WIN + (size_t)NPROJ * D * 2;
constexpr size_t WS_WGU = WS_WOUT + (size_t)D * D * 2;
constexpr size_t WS_WDN = WS_WGU + (size_t)NGU * D * 2;
constexpr size_t WS_WQKV = WS_WDN + (size_t)D * FF * 2;
constexpr size_t WS_WO = WS_WQKV + (size_t)NQKV * D * 2;
constexpr size_t WS_MGU = WS_WO + (size_t)D * D * 2;
constexpr size_t WS_MDN = WS_MGU + (size_t)NE * NGUE * D;
constexpr size_t WS_ARENA = WS_MDN + (size_t)NE * D * FE;
constexpr size_t SZ_TD2 = (size_t)T * D * 2;
constexpr size_t AR_XB = 0, AR_PROJ = SZ_TD2, AR_Y = 0, AR_H1B = SZ_TD2, AR_ACT = 2 * SZ_TD2, AR_H2B = 0, AR_QKV = SZ_TD2,
                 AR_O = SZ_TD2 + (size_t)T * NQKV * 2, AR_H3B = 0, AR_MACT = (size_t)68 << 20;
constexpr int BKT_CAP = 3840;
constexpr size_t WS_BLIST = WS_WIN;
constexpr size_t WS_LPART = WS_BLIST + (size_t)512 * BKT_CAP * 4;
constexpr size_t WS_H38 = WS_WIN;
constexpr size_t AR_OPART = AR_O;
static_assert(WS_LPART + (size_t)T * NH * 4 * 4 <= WS_WQKV && WS_H38 + (size_t)T * D <= WS_WQKV, "attention lists / h3 fp8 fit the layer-0 weight copies");
static_assert(AR_OPART + (size_t)T * NH * 4 * HD * 2 <= SZ_TD2 + (size_t)(2 * T + 256) * FE * 2, "attention partials fit the arena");
constexpr size_t AR_YPART = SZ_TD2;
constexpr size_t AR_Y2 = (size_t)186 << 20;
static_assert(AR_YPART + (size_t)256 * 256 * 256 * 2 <= AR_MACT && AR_MACT + (size_t)(2 * T + 256) * FE <= AR_Y2 && AR_Y2 + (size_t)2 * T * D * 2 <= SZ_TD2 + (size_t)(2 * T + 256) * FE * 2, "MoE down arena");
constexpr size_t WS_END = WS_ARENA + SZ_TD2 + (size_t)(2 * T + 256) * FE * 2;
static_assert(AR_ACT + (size_t)T * FF * 2 <= SZ_TD2 + (size_t)2 * T * FE * 2, "arena");
static_assert(WS_END <= 486079488ull, "workspace budget");

__device__ __forceinline__ unsigned f2bf(float f) { unsigned u = __builtin_bit_cast(unsigned, f); return (u + 0x7fffu + ((u >> 16) & 1u)) >> 16; }
__device__ __forceinline__ float bf2f(unsigned b) { return __builtin_bit_cast(float, b << 16); }
__device__ __forceinline__ unsigned pk2(float lo, float hi) { return f2bf(lo) | (f2bf(hi) << 16); }
__device__ __forceinline__ unsigned cvt_pk_bf16(float lo, float hi) { unsigned r; asm volatile("v_cvt_pk_bf16_f32 %0, %1, %2" : "=v"(r) : "v"(lo), "v"(hi)); return r; }
__device__ __forceinline__ int opaque_tid(int wid) { int l; asm volatile("v_mbcnt_lo_u32_b32 %0, -1, 0\n\tv_mbcnt_hi_u32_b32 %0, -1, %0" : "=v"(l)); return wid * 64 + l; }
__device__ __forceinline__ float wave_sum(float v) {
#pragma unroll
    for (int o = 1; o < 64; o <<= 1) v += __shfl_xor(v, o);
    return v;
}
__device__ __forceinline__ float rscale_of(const f32x4 p) { return rsqrtf(((p[0] + p[1]) + (p[2] + p[3])) * (1.0f / D) + EPS); }
__device__ __forceinline__ float row_rscale(const float* ssp, int row) { return rscale_of(*(const f32x4*)(ssp + (size_t)row * NSS)); }
__device__ __forceinline__ unsigned pk_fp8x4(float a, float b, float c, float d) {
    a = fminf(fmaxf(a, -448.f), 448.f); b = fminf(fmaxf(b, -448.f), 448.f); c = fminf(fmaxf(c, -448.f), 448.f); d = fminf(fmaxf(d, -448.f), 448.f);
    int p = __builtin_amdgcn_cvt_pk_fp8_f32(a, b, 0, false); p = __builtin_amdgcn_cvt_pk_fp8_f32(c, d, p, true); return (unsigned)p; }
__device__ __forceinline__ float silu_f(float g) { return g * __builtin_amdgcn_rcpf(1.0f + __builtin_amdgcn_exp2f(g * -1.4426950408889634f)); }

namespace pg8 {
constexpr int BM = 256, BK = 64, HALF = 128, HTB = HALF * BK * 2, STAGE_BYTES = 8 * HTB, NXCD = 8, WGM = 4;
constexpr int RI_OFF = STAGE_BYTES, RI_BYTES = 4 * 4096;
constexpr int EPI_OFF = RI_OFF + RI_BYTES, EPI_TILE = 8 * 144;
__host__ __device__ __forceinline__ int lds_byte(int r, int c) { const int st = (r >> 4) * 2 + (c >> 5), rr = r & 15, cc = c & 31, ob = rr * 64 + cc * 2; return st * 1024 + (ob ^ (((ob >> 9) & 1) << 5)); }
__host__ __device__ __forceinline__ void stage_rc(int b, int& R, int& C) { const int st = b / 1024, sb = b % 1024, swz = sb ^ (((sb >> 9) & 1) << 5); R = (st >> 1) * 16 + swz / 64; C = (st & 1) * 32 + (swz % 64) / 2; }
__host__ __device__ __forceinline__ int perm32(int rho) { const int n = rho >> 4, i = rho & 15; return 8 * (i >> 2) + 4 * n + (i & 3); }

struct Unit { int row0, pn, e, nvalid, kt0, nkt, piece; };

struct DenseOrder {
    int nM, nN, nwg, G, c, nkt;
    __device__ void init(int M, int N, int K, int G_, int c_) { nM = M / BM; nN = N / BM; nwg = nM * nN; G = G_; c = c_; nkt = K / BK; }
    __device__ __forceinline__ bool next(int i, Unit& u) const {
        const long L = (long)i * G + c; if (L >= nwg) return false;
        int wgid = (int)L; { const int q = nwg / NXCD, r = nwg % NXCD, xcd = wgid % NXCD, off = wgid / NXCD; wgid = (xcd < r ? xcd * (q + 1) : r * (q + 1) + (xcd - r) * q) + off; }
        const int nig = WGM * nN, gid = wgid / nig, fm = gid * WGM, gsz = (nM - fm) < WGM ? (nM - fm) : WGM;
        u.row0 = (fm + ((wgid % nig) % gsz)) * BM; u.pn = (wgid % nig) / gsz; u.e = 0; u.nvalid = BM; u.kt0 = 0; u.nkt = nkt; u.piece = -1; return true;
    }
    __device__ __forceinline__ int src_row(const Unit& u, int r) const { return u.row0 + r; }
    __device__ __forceinline__ unsigned tbl_off(const Unit& u) const { return (unsigned)u.row0 * 16u; }
    __device__ __forceinline__ size_t b_off(const Unit&) const { return 0; }
};
struct MoeOrder {
    __device__ __forceinline__ int tbv(int i) const { return __builtin_amdgcn_readfirstlane(tb[i]); }
    const LAS int* tb; const int* tokof; int nN, G, c; bool gather; size_t bstride; int nkt; bool splitk;
    __device__ __forceinline__ void tile(int L, Unit& u) const {
        const int nwg = tbv(8);
        int wgid = L; { const int q = nwg / NXCD, r = nwg % NXCD, xcd = wgid % NXCD, off = wgid / NXCD; wgid = (xcd < r ? xcd * (q + 1) : r * (q + 1) + (xcd - r) * q) + off; }
        int e = 0;
#pragma unroll
        for (int j = 1; j < 8; ++j) e += (wgid >= tbv(j)) ? 1 : 0;
        const int w = wgid - tbv(e), cnt = tbv(32 + e), nM = (cnt + BM - 1) / BM;
        const int nig = WGM * nN, gid = w / nig, fm = gid * WGM, gsz = (nM - fm) < WGM ? (nM - fm) : WGM;
        const int pm = fm + ((w % nig) % gsz); u.pn = (w % nig) / gsz; u.e = e; u.row0 = pm * BM; u.nvalid = (cnt - pm * BM) < BM ? (cnt - pm * BM) : BM;
    }
    __device__ __forceinline__ void tile_nat(int wg, Unit& u) const {
        int e = 0;
#pragma unroll
        for (int j = 1; j < 8; ++j) e += (wg >= tbv(j)) ? 1 : 0;
        const int w = wg - tbv(e), cnt = tbv(32 + e), pm = w / nN; u.pn = w % nN; u.e = e; u.row0 = pm * BM; u.nvalid = (cnt - pm * BM) < BM ? (cnt - pm * BM) : BM;
    }
    __device__ __forceinline__ int pieces(int nwg) const { const int base = (nwg / G) * G, R = nwg - base, ntrip = nkt / 2; int p = 1; if (R * 2 <= G && ntrip % 2 == 0) p = 2; if (R * 7 <= G && ntrip % 7 == 0) p = 7; return p; }
    __device__ __forceinline__ bool next(int i, Unit& u) const {
        const long L = (long)i * G + c; const int nwg = tbv(8);
        if (!splitk) { if (L >= nwg) return false; tile((int)L, u); u.kt0 = 0; u.nkt = nkt; u.piece = -1; return true; }
        const int base = (nwg / G) * G, R = nwg - base;
        if (L < base) { const int wg = ((int)L % NXCD) * (base / NXCD) + (int)L / NXCD; tile_nat(wg, u); u.kt0 = 0; u.nkt = nkt; u.piece = -1; return true; }
        if (R == 0) return false;
        const int p = pieces(nwg), j = (int)(L - base); if (j >= R * p) return false;
        tile_nat(base + j / p, u); const int per = nkt / p; u.kt0 = (j % p) * per; u.nkt = per; u.piece = j; return true;
    }
    __device__ __forceinline__ int src_row(const Unit& u, int r) const {
        if (gather) return (r < u.nvalid) ? tokof[u.e * T + u.row0 + r] : 0;
        return tbv(16 + u.e) + u.row0 + r;
    }
    __device__ __forceinline__ unsigned tbl_off(const Unit& u) const { return (unsigned)(u.e * T + u.row0) * 16u; }
    __device__ __forceinline__ size_t b_off(const Unit& u) const { return (size_t)u.e * bstride; }
};

struct EpiScaleBf16 {
    static constexpr bool PERM = true;
    bf16_t* O; int ldc; const float* ss;
    __device__ __forceinline__ void operator()(const f32x4 (&acc)[2][2][4][2], const Unit& u, int wr, int wc, int fr, int fq, const LAS f32x4* tbl) const {
        const int col0 = u.pn * BM + wc * 32 + 8 * fq; float rs[2][4]; const LAS f32x4* tb0 = tbl + (wr * 64 + fr); asm volatile("" : "+v"(tb0));
#pragma unroll
        for (int ai = 0; ai < 2; ++ai)
#pragma unroll
            for (int m = 0; m < 4; ++m) rs[ai][m] = rscale_of(tb0[ai * HALF + m * 16]);
#pragma unroll
        for (int ai = 0; ai < 2; ++ai)
#pragma unroll
            for (int m = 0; m < 4; ++m) { const int row = u.row0 + ai * HALF + wr * 64 + m * 16 + fr; const float r = rs[ai][m];
                bf16_t* rowp = O + (size_t)row * ldc + col0;
#pragma unroll
                for (int bj = 0; bj < 2; ++bj) { const f32x4 v0 = acc[ai][bj][m][0] * r, v1 = acc[ai][bj][m][1] * r;
                    u32x4 w; w.x = cvt_pk_bf16(v0[0], v0[1]); w.y = cvt_pk_bf16(v0[2], v0[3]); w.z = cvt_pk_bf16(v1[0], v1[1]); w.w = cvt_pk_bf16(v1[2], v1[3]);
                    *(u32x4*)(rowp + bj * HALF) = w; } }
    }
};
struct EpiQKV {
    static constexpr bool PERM = true;
    bf16_t* O; const float* qg; const float* kg; const float* rope; float* kmean; LAS unsigned char* lds; int wid;
    __device__ __forceinline__ void operator()(const f32x4 (&acc)[2][2][4][2], const Unit& u, int wr, int wc, int, int, const LAS f32x4* tbl) const {
        const int lane = opaque_tid(wid) & 63, fr = lane & 15, fq = lane >> 4;
        const int col0 = u.pn * BM + wc * 32 + 8 * fq; const LAS f32x4* tb0 = tbl + (wr * 64 + fr);
        float rr[2][4];
#pragma unroll
        for (int ai = 0; ai < 2; ++ai)
#pragma unroll
            for (int m = 0; m < 4; ++m) rr[ai][m] = rscale_of(tb0[ai * HALF + m * 16]);
        if (u.pn >= 8) {
#pragma unroll
            for (int ai = 0; ai < 2; ++ai)
#pragma unroll
                for (int m = 0; m < 4; ++m) { const int row = u.row0 + ai * HALF + wr * 64 + m * 16 + fr; bf16_t* rowp = O + (size_t)row * NQKV + col0; const float r = rr[ai][m];
#pragma unroll
                    for (int bj = 0; bj < 2; ++bj) { const f32x4 v0 = acc[ai][bj][m][0] * r, v1 = acc[ai][bj][m][1] * r;
                        u32x4 w; w.x = cvt_pk_bf16(v0[0], v0[1]); w.y = cvt_pk_bf16(v0[2], v0[3]); w.z = cvt_pk_bf16(v1[0], v1[1]); w.w = cvt_pk_bf16(v1[2], v1[3]);
                        *(u32x4*)(rowp + bj * HALF) = w; } }
            return; }
        LAS float* sc = (LAS float*)(lds + EPI_OFF);
#pragma unroll
        for (int ai = 0; ai < 2; ++ai)
#pragma unroll
            for (int m = 0; m < 4; ++m) { const int tr = ai * HALF + wr * 64 + m * 16 + fr; const float r = rr[ai][m];
#pragma unroll
                for (int bj = 0; bj < 2; ++bj) { const f32x4 v0 = acc[ai][bj][m][0] * r, v1 = acc[ai][bj][m][1] * r;
                    float q = ((v0[0] * v0[0] + v0[1] * v0[1]) + (v0[2] * v0[2] + v0[3] * v0[3])) + ((v1[0] * v1[0] + v1[1] * v1[1]) + (v1[2] * v1[2] + v1[3] * v1[3]));
                    q += __shfl_xor(q, 16); q += __shfl_xor(q, 32);
                    if (fq == 0) sc[(tr * 2 + bj) * 4 + wc] = q; } }
        asm volatile("s_waitcnt lgkmcnt(0)" ::: "memory"); __builtin_amdgcn_s_barrier(); asm volatile("" ::: "memory");
        const bool isk = u.pn >= 4; const float* gp = (isk ? kg : qg) + wc * 32 + 8 * fq; const f32x4 g0 = *(const f32x4*)gp, g1 = *(const f32x4*)(gp + 4);
        const int b = u.row0 / SEQ, nblk = (u.row0 % SEQ) / MB, h0 = (u.pn & 3) * 2;
        float cs[2][2][4];
#pragma unroll
        for (int bj = 0; bj < 2; ++bj)
#pragma unroll
            for (int n = 0; n < 2; ++n)
#pragma unroll
                for (int j = 0; j < 4; ++j) cs[bj][n][j] = 0.f;
#pragma unroll
        for (int ai = 0; ai < 2; ++ai)
#pragma unroll
            for (int m = 0; m < 4; ++m) { const int tr = ai * HALF + wr * 64 + m * 16 + fr, row = u.row0 + tr; const float r = rr[ai][m]; bf16_t* rowp = O + (size_t)row * NQKV + col0;
                f32x4 rc0 = (f32x4){1.f, 0.f, 1.f, 0.f}, rc1 = rc0, rc2 = rc0, rc3 = rc0;
                if (wc == 0) { const f32x4* rp = (const f32x4*)(rope + ((size_t)(row % SEQ) * 16 + 8 * (fq & 1)) * 2); rc0 = rp[0]; rc1 = rp[1]; rc2 = rp[2]; rc3 = rp[3]; }
#pragma unroll
                for (int bj = 0; bj < 2; ++bj) { const f32x4 p4 = *(const LAS f32x4*)(sc + (tr * 2 + bj) * 4); const float rn = rsqrtf(((p4[0] + p4[1]) + (p4[2] + p4[3])) * (1.0f / HD) + EPS) * r;
                    f32x4 v0 = acc[ai][bj][m][0] * rn * g0, v1 = acc[ai][bj][m][1] * rn * g1;
                    if (wc == 0) {
                        const float c[8] = {rc0[0], rc0[2], rc1[0], rc1[2], rc2[0], rc2[2], rc3[0], rc3[2]}, sn[8] = {rc0[1], rc0[3], rc1[1], rc1[3], rc2[1], rc2[3], rc3[1], rc3[3]};
#pragma unroll
                        for (int j = 0; j < 4; ++j) { const float p0 = __shfl_xor(v0[j], 32), p1 = __shfl_xor(v1[j], 32);
                            v0[j] = (fq < 2) ? v0[j] * c[j] - p0 * sn[j] : v0[j] * c[j] + p0 * sn[j]; v1[j] = (fq < 2) ? v1[j] * c[4 + j] - p1 * sn[4 + j] : v1[j] * c[4 + j] + p1 * sn[4 + j]; } }
                    u32x4 w; w.x = cvt_pk_bf16(v0[0], v0[1]); w.y = cvt_pk_bf16(v0[2], v0[3]); w.z = cvt_pk_bf16(v1[0], v1[1]); w.w = cvt_pk_bf16(v1[2], v1[3]);
                    *(u32x4*)(rowp + bj * HALF) = w;
                    if (isk) { cs[bj][0][0] += bf2f(w.x & 0xffffu); cs[bj][0][1] += __builtin_bit_cast(float, w.x & 0xffff0000u); cs[bj][0][2] += bf2f(w.y & 0xffffu); cs[bj][0][3] += __builtin_bit_cast(float, w.y & 0xffff0000u);
                               cs[bj][1][0] += bf2f(w.z & 0xffffu); cs[bj][1][1] += __builtin_bit_cast(float, w.z & 0xffff0000u); cs[bj][1][2] += bf2f(w.w & 0xffffu); cs[bj][1][3] += __builtin_bit_cast(float, w.w & 0xffff0000u); } } }
        if (isk) {
#pragma unroll
            for (int bj = 0; bj < 2; ++bj)
#pragma unroll
                for (int n = 0; n < 2; ++n)
#pragma unroll
                    for (int j = 0; j < 4; ++j) { float v = cs[bj][n][j]; v += __shfl_xor(v, 1); v += __shfl_xor(v, 2); v += __shfl_xor(v, 4); v += __shfl_xor(v, 8);
                        if (fr == 0) atomicAdd(kmean + ((size_t)(b * NH + h0 + bj) * NBLK + nblk) * HD + wc * 32 + 8 * fq + 4 * n + j, v * (1.0f / MB)); } }
    }
};
struct EpiSwiglu {
    static constexpr bool PERM = true;
    bf16_t* O; int ldc; const float* ss; const int* tokof; const LAS int* tb; bool moe;
    __device__ __forceinline__ void operator()(const f32x4 (&acc)[2][2][4][2], const Unit& u, int wr, int wc, int fr, int fq, const LAS f32x4* tbl) const {
        const int col0 = u.pn * HALF + wc * 32 + 8 * fq; float rs[2][4]; int orow[2][4]; int trb = wr * 64 + fr; asm volatile("" : "+v"(trb));
#pragma unroll
        for (int ai = 0; ai < 2; ++ai)
#pragma unroll
            for (int m = 0; m < 4; ++m) { const int tr = ai * HALF + m * 16 + trb; int srow;
                if (moe) { const bool ok = tr < u.nvalid; srow = ok ? tokof[u.e * T + u.row0 + tr] : 0; orow[ai][m] = ok ? tb[16 + u.e] + u.row0 + tr : -1; } else { srow = u.row0 + tr; orow[ai][m] = srow; }
                rs[ai][m] = moe ? tbl[tr][0] : rscale_of(tbl[tr]); }
#pragma unroll
        for (int ai = 0; ai < 2; ++ai)
#pragma unroll
            for (int m = 0; m < 4; ++m) { const float r = rs[ai][m];
                f32x4 a[2];
#pragma unroll
                for (int n = 0; n < 2; ++n) { const f32x4 g = acc[ai][0][m][n] * r, up = acc[ai][1][m][n] * r;
#pragma unroll
                    for (int j = 0; j < 4; ++j) a[n][j] = silu_f(g[j]) * up[j]; }
                if (moe) { u32x2 w8; w8.x = pk_fp8x4(a[0][0] * 4.f, a[0][1] * 4.f, a[0][2] * 4.f, a[0][3] * 4.f); w8.y = pk_fp8x4(a[1][0] * 4.f, a[1][1] * 4.f, a[1][2] * 4.f, a[1][3] * 4.f);
                    if (orow[ai][m] >= 0) *(u32x2*)((unsigned char*)O + (size_t)orow[ai][m] * ldc + col0) = w8; }
                else { u32x4 w; w.x = cvt_pk_bf16(a[0][0], a[0][1]); w.y = cvt_pk_bf16(a[0][2], a[0][3]); w.z = cvt_pk_bf16(a[1][0], a[1][1]); w.w = cvt_pk_bf16(a[1][2], a[1][3]);
                    if (orow[ai][m] >= 0) *(u32x4*)(O + (size_t)orow[ai][m] * ldc + col0) = w; } }
    }
};
template <bool BASE16, bool F8COPY> struct EpiResid {
    static constexpr bool PERM = false;
    const void* base; bf16_t* hb; unsigned char* h8; float* ssout; LAS unsigned char* lds; int wid;
    __device__ __forceinline__ void operator()(const f32x4 (&acc)[2][2][4][2], const Unit& u, int wr, int wc, int fr, int fq, const LAS f32x4*) const {
        const int col0 = u.pn * BM + wc * 32 + 4 * fq; LAS float* sc = (LAS float*)(lds + EPI_OFF);
#pragma unroll
        for (int ai = 0; ai < 2; ++ai)
#pragma unroll
            for (int m = 0; m < 4; ++m) { const int tr = ai * HALF + wr * 64 + m * 16 + fr, row = u.row0 + tr; const size_t off = (size_t)row * D + col0; float q = 0.f;
#pragma unroll
                for (int bj = 0; bj < 2; ++bj)
#pragma unroll
                    for (int n = 0; n < 2; ++n) { f32x4 bv;
                        if (BASE16) { const u32x2 r = *(const u32x2*)((const bf16_t*)base + off + bj * HALF + n * 16); bv[0] = bf2f(r.x & 0xffffu); bv[1] = __builtin_bit_cast(float, r.x & 0xffff0000u); bv[2] = bf2f(r.y & 0xffffu); bv[3] = __builtin_bit_cast(float, r.y & 0xffff0000u); }
                        else bv = *(const f32x4*)((const float*)base + off + bj * HALF + n * 16);
                        const f32x4 h = bv + acc[ai][bj][m][n]; q += (h[0] * h[0] + h[1] * h[1]) + (h[2] * h[2] + h[3] * h[3]);
                        u32x2 w; w.x = cvt_pk_bf16(h[0], h[1]); w.y = cvt_pk_bf16(h[2], h[3]); *(u32x2*)(hb + off + bj * HALF + n * 16) = w;
                        if (F8COPY) *(unsigned*)(h8 + off + bj * HALF + n * 16) = pk_fp8x4(h[0], h[1], h[2], h[3]); }
                q += __shfl_xor(q, 16); q += __shfl_xor(q, 32);
                if (fq == 0) sc[tr * 4 + wc] = q;
                asm volatile("" ::: "memory"); }
        asm volatile("s_waitcnt lgkmcnt(0)" ::: "memory"); __builtin_amdgcn_s_barrier(); asm volatile("" ::: "memory");
        { const int t2 = opaque_tid(wid); if (t2 < 256) { const f32x4 p = *(const LAS f32x4*)(sc + t2 * 4); ssout[(size_t)(u.row0 + t2) * NSS + u.pn] = (p[0] + p[1]) + (p[2] + p[3]); } }
        asm volatile("s_waitcnt lgkmcnt(0)" ::: "memory"); __builtin_amdgcn_s_barrier(); asm volatile("" ::: "memory");
    }
};
struct EpiMoeDown {
    static constexpr bool PERM = true;
    bf16_t* y2; bf16_t* ypart; const float* gateof; const LAS int* tb; int wid;
    __device__ __forceinline__ void operator()(const f32x4 (&acc)[2][2][4][2], const Unit& u, int wr, int wc, int, int, const LAS f32x4*) const {
        const int lane = opaque_tid(wid) & 63, fr = lane & 15, fq = lane >> 4;
        const int cloc = wc * 32 + 8 * fq, trb = wr * 64 + fr;
        bf16_t* ob = (u.piece >= 0) ? ypart + (size_t)u.piece * (BM * BM) + cloc : y2 + (size_t)(tb[16 + u.e] + u.row0) * D + u.pn * BM + cloc; const int ld = (u.piece >= 0) ? BM : D;
#pragma unroll
        for (int ai = 0; ai < 2; ++ai)
#pragma unroll
            for (int m = 0; m < 4; ++m) { const int tr = ai * HALF + m * 16 + trb; const bool ok = tr < u.nvalid; const float gt = ok ? gateof[u.e * T + u.row0 + tr] : 0.f;
#pragma unroll
                for (int bj = 0; bj < 2; ++bj) { const f32x4 v0 = acc[ai][bj][m][0] * gt, v1 = acc[ai][bj][m][1] * gt;
                    u32x4 w; w.x = cvt_pk_bf16(v0[0], v0[1]); w.y = cvt_pk_bf16(v0[2], v0[3]); w.z = cvt_pk_bf16(v1[0], v1[1]); w.w = cvt_pk_bf16(v1[2], v1[3]);
                    if (ok) *(u32x4*)(ob + (size_t)tr * ld + bj * HALF) = w; } }
    }
};

template <class Epi, class Sched, bool ALIGN_EPI, bool F8>
__device__ __forceinline__ void gemm_fast(LAS unsigned char* lds, const void* A, int ldab, const void* Bt, int Kb, const void* tblbase, const Sched& S, const Epi& E, int wid, bool noepi, int sclA, int sclB) {
    const int lane = opaque_tid(wid) & 63, wr = wid >> 2, wc = wid & 3, fr = lane & 15, fq = lane >> 4;
    unsigned voffB[2];
#pragma unroll
    for (int i = 0; i < 2; ++i) { int R, C; stage_rc(opaque_tid(wid) * 16 + i * 8192, R, C); const int Rb = Epi::PERM ? ((R & ~31) + perm32(R & 31)) : R; voffB[i] = (unsigned)Rb * (unsigned)Kb + (unsigned)C * 2u; }
    const unsigned kstep = (unsigned)(BK * 2), hstep = (unsigned)HALF * (unsigned)Kb, tstep = 2u * hstep;
    const unsigned ldsw = (unsigned)wid * 1024u;
    const int fcol = fq * 8; constexpr int KOFF = 1024;
    const int aoff = lds_byte(wr * 64 + fr, fcol), boff = lds_byte(wc * 32 + fr, fcol);
    const __amdgpu_buffer_rsrc_t rA = __builtin_amdgcn_make_buffer_rsrc((void*)A, 0, 0x7fffffff, 0x00020000), rB = __builtin_amdgcn_make_buffer_rsrc((void*)Bt, 0, 0x7fffffff, 0x00020000), rT = __builtin_amdgcn_make_buffer_rsrc((void*)tblbase, 0, 0x7fffffff, 0x00020000);
#define PG8_SA(b, h) (((b) * 2 + (h)) * HTB)
#define PG8_SB(b, h) ((4 + (b) * 2 + (h)) * HTB)
#define PG8_STAGE(bufoff, rsrc, soff, voff) do { _Pragma("unroll") for (int _i = 0; _i < 2; ++_i) \
        __builtin_amdgcn_raw_ptr_buffer_load_lds(rsrc, (LAS void*)(lds + (bufoff) + ldsw + _i * 8192), 16, (voff)[_i], (soff), 0, 0); } while (0)
#define PG8_LDA(dst, b, h) do { _Pragma("unroll") for (int m = 0; m < 4; ++m) _Pragma("unroll") for (int k = 0; k < 2; ++k) dst[m][k] = *(const LAS bf16x8*)(lds + PG8_SA(b, h) + aoff + m * 2048 + k * KOFF); } while (0)
#define PG8_LDB(dst, b, h) do { _Pragma("unroll") for (int n = 0; n < 2; ++n) _Pragma("unroll") for (int k = 0; k < 2; ++k) dst[n][k] = *(const LAS bf16x8*)(lds + PG8_SB(b, h) + boff + n * 2048 + k * KOFF); } while (0)
#define PG8_V8(f) __builtin_shufflevector(__builtin_bit_cast(u32x4, (f)[0]), __builtin_bit_cast(u32x4, (f)[1]), 0, 1, 2, 3, 4, 5, 6, 7)
#define PG8_MMA(ai, bj, At, Bt_) do { __builtin_amdgcn_s_setprio(1); _Pragma("unroll") for (int m = 0; m < 4; ++m) _Pragma("unroll") for (int n = 0; n < 2; ++n) { \
        if constexpr (F8) acc[ai][bj][m][n] = __builtin_amdgcn_mfma_scale_f32_16x16x128_f8f6f4(__builtin_bit_cast(v8i, PG8_V8(Bt_[n])), __builtin_bit_cast(v8i, PG8_V8(At[m])), acc[ai][bj][m][n], 0, 0, 0, sclB, 0, sclA); \
        else { _Pragma("unroll") for (int k = 0; k < 2; ++k) acc[ai][bj][m][n] = __builtin_amdgcn_mfma_f32_16x16x32_bf16(Bt_[n][k], At[m][k], acc[ai][bj][m][n], 0, 0, 0); } } __builtin_amdgcn_s_setprio(0); } while (0)
#define PG8_WAIT_V(n) asm volatile("s_waitcnt vmcnt(" #n ")" ::: "memory")
#define PG8_WAIT_L(n) asm volatile("s_waitcnt lgkmcnt(" #n ")" ::: "memory")
#define PG8_BAR __builtin_amdgcn_s_barrier()
#define PG8_SCHED __builtin_amdgcn_sched_barrier(0)
#define PG8_TBL(u, bf) __builtin_amdgcn_raw_ptr_buffer_load_lds(rT, (LAS void*)(lds + RI_OFF + ((bf) * 2 + wr) * 4096 + wc * 1024), 16, (unsigned)lane * 16u, S.tbl_off(u) + (unsigned)wc * 1024u, 0, 0)
#define PG8_AOFFS(u, ao) do { _Pragma("unroll") for (int _i = 0; _i < 2; ++_i) { int _R, _C; stage_rc(opaque_tid(wid) * 16 + _i * 8192, _R, _C); _Pragma("unroll") for (int _h = 0; _h < 2; ++_h) \
        ao[_h][_i] = (unsigned)S.src_row(u, _h * HALF + _R) * (unsigned)ldab + (unsigned)_C * 2u; } } while (0)
    Unit cur, nxt; int ui = 0;
    if (!S.next(0, cur)) return;
    f32x4 acc[2][2][4][2];
#pragma unroll
    for (int a = 0; a < 2; ++a)
#pragma unroll
        for (int b = 0; b < 2; ++b)
#pragma unroll
            for (int m = 0; m < 4; ++m)
#pragma unroll
                for (int n = 0; n < 2; ++n) acc[a][b][m][n] = (f32x4){0.f, 0.f, 0.f, 0.f};
    bf16x8 At[4][2], B0[2][2], B1[2][2];
    unsigned aoc[2][2], aon[2][2];
    PG8_AOFFS(cur, aoc);
    unsigned sA = (unsigned)cur.kt0 * kstep;
    unsigned sB = (unsigned)(S.b_off(cur) * 2) + (unsigned)cur.pn * tstep + (unsigned)cur.kt0 * kstep;
    PG8_TBL(cur, 0);
    PG8_STAGE(PG8_SB(0, 0), rB, sB, voffB); PG8_STAGE(PG8_SB(0, 1), rB, sB + hstep, voffB); PG8_STAGE(PG8_SA(0, 0), rA, sA, aoc[0]); PG8_STAGE(PG8_SA(0, 1), rA, sA, aoc[1]);
    if (wr == 1) PG8_BAR;
    PG8_WAIT_V(2); PG8_BAR;
    PG8_STAGE(PG8_SB(1, 0), rB, sB + kstep, voffB); PG8_STAGE(PG8_SA(1, 0), rA, sA + kstep, aoc[0]); PG8_STAGE(PG8_SB(1, 1), rB, sB + hstep + kstep, voffB);
    PG8_WAIT_V(6); PG8_BAR;
    for (;;) {
        const bool has_next = S.next(ui + 1, nxt);
        if (has_next) { PG8_AOFFS(nxt, aon); } else {
#pragma unroll
            for (int h = 0; h < 2; ++h)
#pragma unroll
                for (int i = 0; i < 2; ++i) aon[h][i] = aoc[h][i]; }
        const unsigned nsB = has_next ? (unsigned)(S.b_off(nxt) * 2) + (unsigned)nxt.pn * tstep + (unsigned)nxt.kt0 * kstep : sB;
        const unsigned nsA = has_next ? (unsigned)nxt.kt0 * kstep : sA;
        const int nt = cur.nkt; int tsel = has_next ? 0 : -2; asm volatile("" : "+s"(tsel));
        for (int t = 0; t < nt; t += 2) {
            const bool last = (t == nt - 2);
            const unsigned a1 = sA + (unsigned)(t + 1) * kstep;
            const unsigned a2 = last ? nsA : sA + (unsigned)(t + 2) * kstep, b2 = last ? nsB : sB + (unsigned)(t + 2) * kstep;
            const unsigned a3 = a2 + kstep, b3 = b2 + kstep;
            PG8_LDB(B0, 0, 0); PG8_LDB(B1, 0, 1); PG8_SCHED; PG8_LDA(At, 0, 0); PG8_STAGE(PG8_SA(1, 1), rA, a1, aoc[1]);
            if (last) {
#pragma unroll
                for (int h = 0; h < 2; ++h)
#pragma unroll
                    for (int i = 0; i < 2; ++i) aoc[h][i] = aon[h][i]; }
            PG8_WAIT_V(8); PG8_WAIT_L(0); PG8_BAR; PG8_MMA(0, 0, At, B0); PG8_MMA(0, 1, At, B1); PG8_BAR; PG8_SCHED;
            PG8_LDA(At, 0, 1); if (t == tsel) PG8_TBL(nxt, (ui + 1) & 1);
            PG8_STAGE(PG8_SB(0, 0), rB, b2, voffB); PG8_STAGE(PG8_SB(0, 1), rB, b2 + hstep, voffB); PG8_STAGE(PG8_SA(0, 0), rA, a2, aoc[0]);
            PG8_WAIT_V(8); PG8_WAIT_L(0); PG8_BAR; PG8_MMA(1, 0, At, B0); PG8_MMA(1, 1, At, B1); PG8_BAR; PG8_SCHED;
            PG8_LDB(B0, 1, 0); PG8_LDB(B1, 1, 1); PG8_SCHED; PG8_LDA(At, 1, 0); PG8_STAGE(PG8_SA(0, 1), rA, a2, aoc[1]);
            PG8_WAIT_V(8); PG8_WAIT_L(0); PG8_BAR; PG8_MMA(0, 0, At, B0); PG8_MMA(0, 1, At, B1); PG8_BAR; PG8_SCHED;
            PG8_LDA(At, 1, 1); PG8_STAGE(PG8_SB(1, 0), rB, b3, voffB); PG8_STAGE(PG8_SB(1, 1), rB, b3 + hstep, voffB); PG8_STAGE(PG8_SA(1, 0), rA, a3, aoc[0]);
            PG8_WAIT_V(8); PG8_WAIT_L(0); PG8_BAR; PG8_MMA(1, 0, At, B0); PG8_MMA(1, 1, At, B1); PG8_BAR; PG8_SCHED;
        }
        if constexpr (ALIGN_EPI) { if (wr == 0) PG8_BAR; }
        if (!noepi) E(acc, cur, wr, wc, fr, fq, (const LAS f32x4*)(lds + RI_OFF + ((ui & 1) * 2 + wr) * 4096));
        if (!has_next) break;
#pragma unroll
        for (int a = 0; a < 2; ++a)
#pragma unroll
            for (int b = 0; b < 2; ++b)
#pragma unroll
                for (int m = 0; m < 4; ++m)
#pragma unroll
                    for (int n = 0; n < 2; ++n) acc[a][b][m][n] = (f32x4){0.f, 0.f, 0.f, 0.f};
        cur = nxt; sB = nsB; sA = nsA; ++ui;
        if constexpr (ALIGN_EPI) { if (wr == 1) PG8_BAR; }
    }
    PG8_WAIT_V(0);
    if constexpr (!ALIGN_EPI) { if (wr == 0) PG8_BAR; }
    PG8_BAR;
#undef PG8_SA
#undef PG8_SB
#undef PG8_STAGE
#undef PG8_LDA
#undef PG8_LDB
#undef PG8_MMA
#undef PG8_V8
#undef PG8_WAIT_V
#undef PG8_WAIT_L
#undef PG8_BAR
#undef PG8_SCHED
#undef PG8_AOFFS
#undef PG8_TBL
}
}

namespace cg = cooperative_groups;
constexpr int NTHREADS = 512, NWAVES = 8;
constexpr int LDS_BYTES = 163840;
constexpr int LDS_TB = LDS_BYTES - 1024;
constexpr int LDS_PTR = LDS_TB + 256;
constexpr int LDS_BST = LDS_PTR + 256;

struct Params {
    const float* in[23];
    float* out; unsigned char* ws;
    unsigned mask; int probe;
};
enum { I_X = 0, I_EMIXN, I_EWIN, I_ECONVW, I_ELNG, I_ELNB, I_EWSP, I_EBSP, I_EWOUT, I_EFFNN, I_EWGATE, I_EWUP, I_EWDOWN, I_OMIXN, I_OWQKV, I_OQN, I_OKN, I_OWO, I_OFFNN, I_OWR, I_OWGATE, I_OWUP, I_OWDOWN, I_OUT, I_WS };
struct Ctx { LAS unsigned char* lds; int wid, bid, G; bool noepi;
    template <class Tp> __device__ __forceinline__ Tp* ptr(int i) const { const unsigned long long v = ((const volatile LAS unsigned long long*)(lds + LDS_PTR))[i];
        const unsigned lo = __builtin_amdgcn_readfirstlane((unsigned)v), hi = __builtin_amdgcn_readfirstlane((unsigned)(v >> 32)); return (Tp*)(((unsigned long long)hi << 32) | lo); }
    __device__ __forceinline__ const float* in(int i) const { return ptr<const float>(i); }
    __device__ __forceinline__ unsigned char* ws() const { return ptr<unsigned char>(I_WS); }
    __device__ __forceinline__ float* out() const { return ptr<float>(I_OUT); }
};

#define XB_TMO      128
#define XB_XCNT(j)  (256  + 64 * (j))
#define XB_XSUB(j)  (1280 + 64 * (j))
#define XB_XGEN(j)  (2304 + 64 * (j))
#define XB_TOP      3328
#define XB_TOPGEN   3392
#define XCD_BAR_WORDS 3456
#define XB_SPIN_CAP (1u << 20)
__device__ __forceinline__ unsigned xb_ld(unsigned* p)              { return __hip_atomic_load(p, __ATOMIC_RELAXED, __HIP_MEMORY_SCOPE_AGENT); }
__device__ __forceinline__ unsigned xb_add(unsigned* p, unsigned v) { return __hip_atomic_fetch_add(p, v, __ATOMIC_RELAXED, __HIP_MEMORY_SCOPE_AGENT); }
__device__ __forceinline__ unsigned xb_xcc_id() { return (unsigned)__builtin_amdgcn_s_getreg((3 << 11) | 20) & 0xFu; }
#define XB_SPIN(cond, bar) do { unsigned _sp = 0; while (cond) { __builtin_amdgcn_s_sleep(1); \
    if ((++_sp & 255u) == 0u) { if (xb_ld(&(bar)[XB_TMO])) break; if (_sp > XB_SPIN_CAP) { atomicAdd(&(bar)[XB_TMO], 1u); break; } } } } while (0)
__device__ __forceinline__ void xcd_barrier_complete(unsigned* bar, unsigned x, unsigned G, unsigned& nloc, unsigned& nx) {
    unsigned sum, cnt, mine, sp = 0u;
    for (;;) {
        sum = 0u; cnt = 0u; mine = 0u;
#pragma unroll
        for (unsigned j = 0; j < 16; ++j) { const unsigned c = xb_ld(&bar[XB_XCNT(j)]); sum += c; cnt += (c > 0u) ? 1u : 0u; mine = (j == x) ? c : mine; }
        if (sum == G) break;
        __builtin_amdgcn_s_sleep(1);
        if ((++sp & 255u) == 0u) { if (xb_ld(&bar[XB_TMO])) break; if (sp > XB_SPIN_CAP) { atomicAdd(&bar[XB_TMO], 1u); break; } }
    }
    nloc = mine > 0u ? mine : 1u; nx = cnt > 0u ? cnt : 1u;
}
__device__ __forceinline__ void grid_barrier(const Ctx& C) {
    asm volatile("s_waitcnt vmcnt(0)" ::: "memory");
    __syncthreads();
    if (opaque_tid(C.wid) == 0) {
        unsigned* bar = (unsigned*)C.ws() + CW_BAR; volatile LAS unsigned* st = (volatile LAS unsigned*)(C.lds + LDS_BST); const unsigned x = xb_xcc_id();
        __builtin_amdgcn_s_waitcnt(0);
        unsigned nloc = st[0], nx = st[1];
        if (nloc == 0u) { xcd_barrier_complete(bar, x, (unsigned)C.G, nloc, nx); st[0] = nloc; st[1] = nx; }
        const unsigned old = xb_add(&bar[XB_XSUB(x)], 1u);
        const unsigned gen = old / nloc;
        if (old + 1u == (gen + 1u) * nloc) {
            __builtin_amdgcn_fence(__ATOMIC_RELEASE, "agent");
            asm volatile("s_waitcnt vmcnt(0)" ::: "memory");
            const unsigned og = xb_add(&bar[XB_TOP], 1u);
            const unsigned tg = og / nx;
            if (og + 1u == (tg + 1u) * nx) xb_add(&bar[XB_TOPGEN], 1u);
            else XB_SPIN(xb_ld(&bar[XB_TOPGEN]) == tg, bar);
            __builtin_amdgcn_fence(__ATOMIC_ACQUIRE, "agent");
            xb_add(&bar[XB_XGEN(x)], 1u);
            asm volatile("s_waitcnt vmcnt(0)" ::: "memory");
        } else {
            XB_SPIN(xb_ld(&bar[XB_XGEN(x)]) == gen, bar);
            __builtin_amdgcn_fence(__ATOMIC_ACQUIRE, "agent");
            asm volatile("s_waitcnt vmcnt(0)" ::: "memory");
        }
    }
    __syncthreads();
}

__device__ __forceinline__ void p0_transpose_item(const float* W, int K, int N, bf16_t* WT, const float* fold, int inter, int which, LAS float* scr, int item, int lane) {
    const int nblk = N / 32, kb = item / nblk, nb = item % nblk, k0 = 64 * kb, n0 = 32 * nb;
    const int kr = lane >> 3, c4 = lane & 7; f32x4 v[8]; float f[8];
#pragma unroll
    for (int i = 0; i < 8; ++i) v[i] = *(const f32x4*)(W + (size_t)(k0 + 8 * i + kr) * N + n0 + 4 * c4);
#pragma unroll
    for (int i = 0; i < 8; ++i) f[i] = fold ? fold[k0 + 8 * i + kr] : 1.0f;
#pragma unroll
    for (int i = 0; i < 8; ++i) { LAS float* d = scr + (8 * i + kr) * 33 + 4 * c4; d[0] = v[i][0] * f[i]; d[1] = v[i][1] * f[i]; d[2] = v[i][2] * f[i]; d[3] = v[i][3] * f[i]; }
    asm volatile("s_waitcnt lgkmcnt(0)" ::: "memory");
    const int c = lane & 7;
#pragma unroll
    for (int j = 0; j < 4; ++j) { const int nl = (lane >> 3) + 8 * j, n = n0 + nl; const LAS float* sp = scr + (8 * c) * 33 + nl;
        u32x4 o; o.x = pk2(sp[0 * 33], sp[1 * 33]); o.y = pk2(sp[2 * 33], sp[3 * 33]); o.z = pk2(sp[4 * 33], sp[5 * 33]); o.w = pk2(sp[6 * 33], sp[7 * 33]);
        const int dr = inter ? (n / 128) * 256 + which * 128 + (n % 128) : n;
        *(u32x4*)(WT + (size_t)dr * K + k0 + 8 * c) = o; }
    asm volatile("s_waitcnt lgkmcnt(0)" ::: "memory");
}
__device__ __forceinline__ void p0_transpose_item8(const float* W, int K, int N, unsigned char* WT, const float* fold, int inter, int which, LAS float* scr, int item, int lane) {
    const int nblk = N / 32, kb = item / nblk, nb = item % nblk, k0 = 64 * kb, n0 = 32 * nb;
    const int kr = lane >> 3, c4 = lane & 7; f32x4 v[8]; float f[8];
#pragma unroll
    for (int i = 0; i < 8; ++i) v[i] = *(const f32x4*)(W + (size_t)(k0 + 8 * i + kr) * N + n0 + 4 * c4);
#pragma unroll
    for (int i = 0; i < 8; ++i) f[i] = (fold ? fold[k0 + 8 * i + kr] : 1.0f) * 64.0f;
#pragma unroll
    for (int i = 0; i < 8; ++i) { LAS float* d = scr + (8 * i + kr) * 33 + 4 * c4; d[0] = v[i][0] * f[i]; d[1] = v[i][1] * f[i]; d[2] = v[i][2] * f[i]; d[3] = v[i][3] * f[i]; }
    asm volatile("s_waitcnt lgkmcnt(0)" ::: "memory");
    const int c = lane & 7;
#pragma unroll
    for (int j = 0; j < 4; ++j) { const int nl = (lane >> 3) + 8 * j, n = n0 + nl; const LAS float* sp = scr + (8 * c) * 33 + nl;
        u32x2 o; o.x = pk_fp8x4(sp[0 * 33], sp[1 * 33], sp[2 * 33], sp[3 * 33]); o.y = pk_fp8x4(sp[4 * 33], sp[5 * 33], sp[6 * 33], sp[7 * 33]);
        const int dr = inter ? (n / 128) * 256 + which * 128 + (n % 128) : n;
        *(u32x2*)(WT + (size_t)dr * K + k0 + 8 * c) = o; }
    asm volatile("s_waitcnt lgkmcnt(0)" ::: "memory");
}
__device__ __forceinline__ void phase_prep(const Ctx& C) {
    LAS unsigned char* lds = C.lds; const int bid = C.bid, G = C.G; unsigned char* ws = C.ws(); const int tid = opaque_tid(C.wid), lane = tid & 63, wave = C.wid;
    const int gw = bid * NWAVES + wave, NGW = G * NWAVES;
    LAS float* scr = (LAS float*)(lds + wave * 16384);
    constexpr int I_IN = (D / 64) * (NPROJ / 32), I_OUT = (D / 64) * (D / 32), I_G = (D / 64) * (FF / 32), I_DN = (FF / 64) * (D / 32), I_QKV = (D / 64) * (NQKV / 32),
                  I_MG = (D / 64) * (FE / 32), I_MD = (FE / 64) * (D / 32);
    constexpr int NITEMS = I_IN + I_OUT + 2 * I_G + I_DN + I_QKV + I_OUT + NE * (2 * I_MG + I_MD);
    for (int it = gw; it < NITEMS; it += NGW) {
        int r = it;
        if (r < I_IN) { p0_transpose_item(C.in(I_EWIN), D, NPROJ, (bf16_t*)(ws + WS_WIN), C.in(I_EMIXN), 0, 0, scr, r, lane); continue; } r -= I_IN;
        if (r < I_OUT) { p0_transpose_item(C.in(I_EWOUT), D, D, (bf16_t*)(ws + WS_WOUT), nullptr, 0, 0, scr, r, lane); continue; } r -= I_OUT;
        if (r < I_G) { p0_transpose_item(C.in(I_EWGATE), D, FF, (bf16_t*)(ws + WS_WGU), C.in(I_EFFNN), 1, 0, scr, r, lane); continue; } r -= I_G;
        if (r < I_G) { p0_transpose_item(C.in(I_EWUP), D, FF, (bf16_t*)(ws + WS_WGU), C.in(I_EFFNN), 1, 1, scr, r, lane); continue; } r -= I_G;
        if (r < I_DN) { p0_transpose_item(C.in(I_EWDOWN), FF, D, (bf16_t*)(ws + WS_WDN), nullptr, 0, 0, scr, r, lane); continue; } r -= I_DN;
        if (r < I_QKV) { p0_transpose_item(C.in(I_OWQKV), D, NQKV, (bf16_t*)(ws + WS_WQKV), C.in(I_OMIXN), 0, 0, scr, r, lane); continue; } r -= I_QKV;
        if (r < I_OUT) { p0_transpose_item(C.in(I_OWO), D, D, (bf16_t*)(ws + WS_WO), nullptr, 0, 0, scr, r, lane); continue; } r -= I_OUT;
        if (r < NE * I_MG) { const int e = r / I_MG; p0_transpose_item8(C.in(I_OWGATE) + (size_t)e * D * FE, D, FE, ws + WS_MGU + (size_t)e * NGUE * D, C.in(I_OFFNN), 1, 0, scr, r % I_MG, lane); continue; } r -= NE * I_MG;
        if (r < NE * I_MG) { const int e = r / I_MG; p0_transpose_item8(C.in(I_OWUP) + (size_t)e * D * FE, D, FE, ws + WS_MGU + (size_t)e * NGUE * D, C.in(I_OFFNN), 1, 1, scr, r % I_MG, lane); continue; } r -= NE * I_MG;
        { const int e = r / I_MD; p0_transpose_item8(C.in(I_OWDOWN) + (size_t)e * FE * D, FE, D, ws + WS_MDN + (size_t)e * D * FE, nullptr, 0, 0, scr, r % I_MD, lane); }
    }
    bf16_t* xb = (bf16_t*)(ws + WS_ARENA + AR_XB); float* ss0 = (float*)(ws + WS_SS0); const float* xin = C.in(I_X);
    for (int row = gw; row < T; row += NGW) {
        const f32x4* xr = (const f32x4*)(xin + (size_t)row * D) + lane; float sq = 0.f; u32x2* o = (u32x2*)(xb + (size_t)row * D) + lane;
#pragma unroll
        for (int j = 0; j < 4; ++j) { const f32x4 v = xr[64 * j]; sq += (v[0] * v[0] + v[1] * v[1]) + (v[2] * v[2] + v[3] * v[3]); u32x2 w; w.x = pk2(v[0], v[1]); w.y = pk2(v[2], v[3]); o[64 * j] = w; }
        sq = wave_sum(sq);
        if (lane < NSS) ss0[(size_t)row * NSS + lane] = (lane == 0) ? sq : 0.f;
    }
    { float* km = (float*)(ws + WS_KMEAN); for (int i = bid * NTHREADS + tid; i < NBATCH * NH * NBLK * HD; i += G * NTHREADS) km[i] = 0.f; }
    float* tab = (float*)(ws + WS_ROPE);
    for (int i = bid * NTHREADS + tid; i < SEQ * 16; i += G * NTHREADS) { const int sp = i / 16, f = i % 16; const double inv = pow(500000.0, -(double)f / 16.0); const double ang = (double)sp * inv;
        tab[2 * i] = (float)cos(ang); tab[2 * i + 1] = (float)sin(ang); }
}

constexpr int MX_VROW = 520, MX_MU = 256 * MX_VROW;
__device__ __forceinline__ void phase_mixer(const Ctx& C) {
    LAS unsigned char* lds = C.lds; const int bid = C.bid, G = C.G; unsigned char* ws = C.ws();
    const float* conv_w = C.in(I_ECONVW); const float* ln_g = C.in(I_ELNG); const float* ln_b = C.in(I_ELNB); const float* w_sp = C.in(I_EWSP); const float* b_sp = C.in(I_EBSP);
    const bf16_t* proj = (const bf16_t*)(ws + WS_ARENA + AR_PROJ); bf16_t* y = (bf16_t*)(ws + WS_ARENA + AR_Y);
    LAS float* mu = (LAS float*)(lds + MX_MU); LAS float* rstd = mu + 128;
    const int tid = opaque_tid(C.wid), lane = tid & 63, wave = C.wid, r31 = lane & 31, hh = lane >> 5;
    for (int unit = bid; unit < (T / 128) * 2; unit += G) {
        const int c = unit >> 1, hf = unit & 1, t0 = c * 128;
        { u32x4 vv[16];
#pragma unroll
          for (int i = 0; i < 16; ++i) vv[i] = *(const u32x4*)(proj + (size_t)(t0 + wave * 16 + i) * NPROJ + 3 * CONV + GM + lane * 8);
#pragma unroll
          for (int i = 0; i < 16; ++i) { const int sl = wave * 16 + i; const u32x4 v = vv[i];
            const float x0 = bf2f(v.x & 0xffffu), x1 = __builtin_bit_cast(float, v.x & 0xffff0000u), x2 = bf2f(v.y & 0xffffu), x3 = __builtin_bit_cast(float, v.y & 0xffff0000u),
                        x4 = bf2f(v.z & 0xffffu), x5 = __builtin_bit_cast(float, v.z & 0xffff0000u), x6 = bf2f(v.w & 0xffffu), x7 = __builtin_bit_cast(float, v.w & 0xffff0000u);
            float sm = ((x0 + x1) + (x2 + x3)) + ((x4 + x5) + (x6 + x7)), sq = ((x0 * x0 + x1 * x1) + (x2 * x2 + x3 * x3)) + ((x4 * x4 + x5 * x5) + (x6 * x6 + x7 * x7));
            sm = wave_sum(sm); sq = wave_sum(sq); const float m = sm * (1.0f / GM), var = sq * (1.0f / GM) - m * m;
            if (lane == 0) { mu[sl] = m; rstd[sl] = rsqrtf(fmaxf(var, 0.f) + EPS); } } }
        { const int co = tid & 31, sg = tid >> 5, ch = 256 * hf + 8 * co; float w0[8], w1[8], w2[8];
#pragma unroll
          for (int j = 0; j < 8; ++j) { w0[j] = conv_w[ch + j]; w1[j] = conv_w[CONV + ch + j]; w2[j] = conv_w[2 * CONV + ch + j]; }
          float zm2[8], zm1[8];
#pragma unroll
          for (int j = 0; j < 8; ++j) { zm2[j] = 0.f; zm1[j] = 0.f; }
#pragma unroll
          for (int i = -2; i < 8; ++i) { const int t = t0 + 8 * sg + i; const bool inseq = (i >= 0) || ((t0 + 8 * sg) % SEQ != 0);
              const bf16_t* pr = proj + (size_t)(inseq ? t : t0) * NPROJ + ch; const u32x4 ah = *(const u32x4*)pr, ac = *(const u32x4*)(pr + CONV);
              float z[8];
              z[0] = bf2f(ah.x & 0xffffu) * bf2f(ac.x & 0xffffu); z[1] = __builtin_bit_cast(float, ah.x & 0xffff0000u) * __builtin_bit_cast(float, ac.x & 0xffff0000u);
              z[2] = bf2f(ah.y & 0xffffu) * bf2f(ac.y & 0xffffu); z[3] = __builtin_bit_cast(float, ah.y & 0xffff0000u) * __builtin_bit_cast(float, ac.y & 0xffff0000u);
              z[4] = bf2f(ah.z & 0xffffu) * bf2f(ac.z & 0xffffu); z[5] = __builtin_bit_cast(float, ah.z & 0xffff0000u) * __builtin_bit_cast(float, ac.z & 0xffff0000u);
              z[6] = bf2f(ah.w & 0xffffu) * bf2f(ac.w & 0xffffu); z[7] = __builtin_bit_cast(float, ah.w & 0xffff0000u) * __builtin_bit_cast(float, ac.w & 0xffff0000u);
              if (!inseq) {
#pragma unroll
                  for (int j = 0; j < 8; ++j) z[j] = 0.f; }
              if (i >= 0) { const u32x4 ab = *(const u32x4*)(pr + 2 * CONV); float o[8];
#pragma unroll
                  for (int j = 0; j < 8; ++j) o[j] = w0[j] * zm2[j] + w1[j] * zm1[j] + w2[j] * z[j];
                  u32x4 w; w.x = pk2(bf2f(ab.x & 0xffffu) * o[0], __builtin_bit_cast(float, ab.x & 0xffff0000u) * o[1]); w.y = pk2(bf2f(ab.y & 0xffffu) * o[2], __builtin_bit_cast(float, ab.y & 0xffff0000u) * o[3]);
                  w.z = pk2(bf2f(ab.z & 0xffffu) * o[4], __builtin_bit_cast(float, ab.z & 0xffff0000u) * o[5]); w.w = pk2(bf2f(ab.w & 0xffffu) * o[6], __builtin_bit_cast(float, ab.w & 0xffff0000u) * o[7]);
                  *(u32x4*)(y + (size_t)t * D + ch) = w; }
#pragma unroll
              for (int j = 0; j < 8; ++j) { zm2[j] = zm1[j]; zm1[j] = z[j]; } } }
        __syncthreads();
#pragma unroll
        for (int i = 0; i < 4; ++i) { const int v = tid + 512 * i, sq4 = v >> 6, cq = v & 63, chl = 4 * cq, chg = 256 * hf + chl; const bf16_t* src = proj + (size_t)(t0 + 4 * sq4) * NPROJ + 3 * CONV + GM + chg;
            const f32x4 gg = *(const f32x4*)(ln_g + chg), bb = *(const f32x4*)(ln_b + chg);
            unsigned e[4][4];
#pragma unroll
            for (int r = 0; r < 4; ++r) { const u32x2 rv = *(const u32x2*)(src + (size_t)r * NPROJ); const float m = mu[4 * sq4 + r], rs = rstd[4 * sq4 + r];
                e[r][0] = f2bf((bf2f(rv.x & 0xffffu) - m) * rs * gg[0] + bb[0]); e[r][1] = f2bf((__builtin_bit_cast(float, rv.x & 0xffff0000u) - m) * rs * gg[1] + bb[1]);
                e[r][2] = f2bf((bf2f(rv.y & 0xffffu) - m) * rs * gg[2] + bb[2]); e[r][3] = f2bf((__builtin_bit_cast(float, rv.y & 0xffff0000u) - m) * rs * gg[3] + bb[3]); }
            LAS unsigned char* dst = lds + chl * MX_VROW + sq4 * 8;
#pragma unroll
            for (int d = 0; d < 4; ++d) { u32x2 w; w.x = e[0][d] | (e[1][d] << 16); w.y = e[2][d] | (e[3][d] << 16); *(LAS u32x2*)(dst + d * MX_VROW) = w; } }
        __syncthreads();
        { const int gl = wave >> 1, dt = wave & 1, g = 4 * hf + gl, chl = 64 * gl + 32 * dt + r31;
          bf16x8 bfr[8];
#pragma unroll
          for (int ks = 0; ks < 8; ++ks) { const LAS unsigned char* vp = lds + chl * MX_VROW + (16 * ks + 8 * hh) * 2; const u32x2 v0 = *(const LAS u32x2*)vp, v1 = *(const LAS u32x2*)(vp + 8);
              u32x4 w; w.x = v0.x; w.y = v0.y; w.z = v1.x; w.w = v1.y; bfr[ks] = __builtin_bit_cast(bf16x8, w); }
#pragma unroll
          for (int tt = 0; tt < 4; ++tt) { f32x16 acc;
#pragma unroll
              for (int i = 0; i < 16; ++i) acc[i] = 0.f;
              const int trow = 32 * tt + r31; const float* wrow = w_sp + ((size_t)g * 128 + trow) * 128 + 8 * hh;
#pragma unroll
              for (int ks = 0; ks < 8; ++ks) if (ks < 2 * tt + 2) { const f32x4 a0 = *(const f32x4*)(wrow + 16 * ks), a1 = *(const f32x4*)(wrow + 16 * ks + 4); float av[8] = {a0[0], a0[1], a0[2], a0[3], a1[0], a1[1], a1[2], a1[3]};
                  if (ks >= 2 * tt) {
#pragma unroll
                      for (int j = 0; j < 8; ++j) if (16 * ks + 8 * hh + j > trow) av[j] = 0.f; }
                  u32x4 w; w.x = pk2(av[0], av[1]); w.y = pk2(av[2], av[3]); w.z = pk2(av[4], av[5]); w.w = pk2(av[6], av[7]);
                  acc = __builtin_amdgcn_mfma_f32_32x32x16_bf16(bfr[ks], __builtin_bit_cast(bf16x8, w), acc, 0, 0, 0); }
              const int chg0 = 256 * hf + 64 * gl + 32 * dt + 4 * hh, t = t0 + trow; const float bias = b_sp[g * 128 + trow];
              const bf16_t* gp = proj + (size_t)t * NPROJ + 3 * CONV + chg0; bf16_t* yp = y + (size_t)t * D + CONV + chg0;
#pragma unroll
              for (int g4 = 0; g4 < 4; ++g4) { const u32x2 gu = *(const u32x2*)(gp + 8 * g4); u32x2 o;
                  o.x = pk2(bf2f(gu.x & 0xffffu) * (acc[4 * g4 + 0] + bias), __builtin_bit_cast(float, gu.x & 0xffff0000u) * (acc[4 * g4 + 1] + bias));
                  o.y = pk2(bf2f(gu.y & 0xffffu) * (acc[4 * g4 + 2] + bias), __builtin_bit_cast(float, gu.y & 0xffff0000u) * (acc[4 * g4 + 3] + bias)); *(u32x2*)(yp + 8 * g4) = o; } } }
        __syncthreads();
    }
}

__device__ __forceinline__ void phase_qkprep(const Ctx& C) {
    LAS unsigned char* lds = C.lds; const int bid = C.bid, G = C.G; unsigned char* ws = C.ws(); const float* qn = C.in(I_OQN); const float* kn = C.in(I_OKN);
    bf16_t* qkv = (bf16_t*)(ws + WS_ARENA + AR_QKV); const float* rope = (const float*)(ws + WS_ROPE); float* kmean = (float*)(ws + WS_KMEAN);
    LAS float* red = (LAS float*)lds;
    const int tid = opaque_tid(C.wid), lane = tid & 63, wave = C.wid, c16 = lane & 15, sub = lane >> 4;
    float gq[8], gk[8];
#pragma unroll
    for (int j = 0; j < 8; ++j) { gq[j] = qn[8 * c16 + j]; gk[j] = kn[8 * c16 + j]; }
    for (int item = bid; item < NBATCH * NBLK * NH; item += G) {
        const int h = item % NH, n = (item / NH) % NBLK, b = item / (NH * NBLK); float ks[8];
#pragma unroll
        for (int j = 0; j < 8; ++j) ks[j] = 0.f;
#pragma unroll 4
        for (int it = 0; it < 8; ++it) { const int sq = n * MB + wave * 32 + it * 4 + sub, t = b * SEQ + sq;
            float cs[8], sn[8];
            { const f32x4* rp = (const f32x4*)(rope + (sq * 16 + 8 * (c16 & 1)) * 2); f32x4 r0 = (f32x4){1.f, 0.f, 1.f, 0.f}, r1 = r0, r2 = r0, r3 = r0; if (c16 < 4) { r0 = rp[0]; r1 = rp[1]; r2 = rp[2]; r3 = rp[3]; }
              cs[0] = r0[0]; sn[0] = r0[1]; cs[1] = r0[2]; sn[1] = r0[3]; cs[2] = r1[0]; sn[2] = r1[1]; cs[3] = r1[2]; sn[3] = r1[3];
              cs[4] = r2[0]; sn[4] = r2[1]; cs[5] = r2[2]; sn[5] = r2[3]; cs[6] = r3[0]; sn[6] = r3[1]; cs[7] = r3[2]; sn[7] = r3[3]; }
#pragma unroll
            for (int which = 0; which < 2; ++which) { bf16_t* p = qkv + (size_t)t * NQKV + which * D + h * HD + 8 * c16; const u32x4 raw = *(const u32x4*)p;
                float v[8] = {bf2f(raw.x & 0xffffu), __builtin_bit_cast(float, raw.x & 0xffff0000u), bf2f(raw.y & 0xffffu), __builtin_bit_cast(float, raw.y & 0xffff0000u),
                              bf2f(raw.z & 0xffffu), __builtin_bit_cast(float, raw.z & 0xffff0000u), bf2f(raw.w & 0xffffu), __builtin_bit_cast(float, raw.w & 0xffff0000u)};
                float q = ((v[0] * v[0] + v[1] * v[1]) + (v[2] * v[2] + v[3] * v[3])) + ((v[4] * v[4] + v[5] * v[5]) + (v[6] * v[6] + v[7] * v[7]));
                q += __shfl_xor(q, 1); q += __shfl_xor(q, 2); q += __shfl_xor(q, 4); q += __shfl_xor(q, 8);
                const float r = rsqrtf(q * (1.0f / HD) + EPS);
#pragma unroll
                for (int j = 0; j < 8; ++j) v[j] = v[j] * r * (which ? gk[j] : gq[j]);
#pragma unroll
                for (int j = 0; j < 8; ++j) { const float pt = __shfl_xor(v[j], 2); if (c16 < 2) v[j] = v[j] * cs[j] - pt * sn[j]; else if (c16 < 4) v[j] = v[j] * cs[j] + pt * sn[j]; }
                u32x4 w; w.x = pk2(v[0], v[1]); w.y = pk2(v[2], v[3]); w.z = pk2(v[4], v[5]); w.w = pk2(v[6], v[7]);
                *(u32x4*)p = w;
                if (which) { ks[0] += bf2f(w.x & 0xffffu); ks[1] += __builtin_bit_cast(float, w.x & 0xffff0000u); ks[2] += bf2f(w.y & 0xffffu); ks[3] += __builtin_bit_cast(float, w.y & 0xffff0000u);
                             ks[4] += bf2f(w.z & 0xffffu); ks[5] += __builtin_bit_cast(float, w.z & 0xffff0000u); ks[6] += bf2f(w.w & 0xffffu); ks[7] += __builtin_bit_cast(float, w.w & 0xffff0000u); } } }
#pragma unroll
        for (int j = 0; j < 8; ++j) { ks[j] += __shfl_xor(ks[j], 16); ks[j] += __shfl_xor(ks[j], 32); }
        if (sub == 0) {
#pragma unroll
            for (int j = 0; j < 8; ++j) red[wave * 128 + 8 * c16 + j] = ks[j]; }
        __syncthreads();
        if (tid < 128) { float a = 0.f;
#pragma unroll
            for (int w = 0; w < NWAVES; ++w) a += red[w * 128 + tid];
            kmean[((size_t)(b * NH + h) * NBLK + n) * HD + tid] = a * (1.0f / MB); }
        __syncthreads();
    }
}

__device__ __forceinline__ void phase_select(const Ctx& C, bool probe) {
    const int bid = C.bid, G = C.G; unsigned char* ws = C.ws();
    const bf16_t* qkv = (const bf16_t*)(ws + WS_ARENA + AR_QKV); const float* kmean = (const float*)(ws + WS_KMEAN);
    unsigned* bcnt = (unsigned*)ws + (probe ? 5120 : CW_BKT); int* blist = (int*)(ws + (probe ? WS_ARENA + ((size_t)100 << 20) : WS_BLIST));
    const int tid = opaque_tid(C.wid), lane = tid & 63;
    for (int wt = bid * NWAVES + C.wid; wt < (T / 64) * NH; wt += G * NWAVES) {
        const int h = wt & 7, tg = wt >> 3, t = tg * 64 + lane, b = (tg * 64) / SEQ, sq = t % SEQ, qb = ((tg * 64) % SEQ) / MB;
        if (qb == 0) continue;
        const bf16_t* qp = qkv + (size_t)t * NQKV + h * HD; const float* km = kmean + (size_t)(b * NH + h) * NBLK * HD;
        float acc[NBLK];
#pragma unroll
        for (int n = 0; n < NBLK; ++n) acc[n] = 0.f;
#pragma unroll 4
        for (int ch = 0; ch < 16; ++ch) { const u32x4 raw = *(const u32x4*)(qp + 8 * ch);
            const float q0 = bf2f(raw.x & 0xffffu), q1 = __builtin_bit_cast(float, raw.x & 0xffff0000u), q2 = bf2f(raw.y & 0xffffu), q3 = __builtin_bit_cast(float, raw.y & 0xffff0000u),
                        q4 = bf2f(raw.z & 0xffffu), q5 = __builtin_bit_cast(float, raw.z & 0xffff0000u), q6 = bf2f(raw.w & 0xffffu), q7 = __builtin_bit_cast(float, raw.w & 0xffff0000u);
#pragma unroll
            for (int n = 0; n < NBLK; ++n) { const float* kp = km + n * HD + 8 * ch;
                acc[n] += ((q0 * kp[0] + q1 * kp[1]) + (q2 * kp[2] + q3 * kp[3])) + ((q4 * kp[4] + q5 * kp[5]) + (q6 * kp[6] + q7 * kp[7])); } }
        const int nsel = qb < 3 ? qb : 3; int sel0 = -1, sel1 = -1, sel2 = -1;
#pragma unroll
        for (int j = 0; j < 3; ++j) { float bv = -INFINITY; int bi = 0;
#pragma unroll
            for (int n = 0; n < NBLK - 1; ++n) { const float v = (n < qb) ? acc[n] : -INFINITY; if (v > bv) { bv = v; bi = n; } }
#pragma unroll
            for (int n = 0; n < NBLK - 1; ++n) if (n == bi) acc[n] = -INFINITY;
            if (j < nsel) { if (j == 0) sel0 = bi; if (j == 1) sel1 = bi; if (j == 2) sel2 = bi; } }
        const unsigned long long lt = (1ull << lane) - 1ull; int mytot = 0;
        for (int n = 0; n < qb; ++n) { const int tot = __popcll(__ballot(sel0 == n)) + __popcll(__ballot(sel1 == n)) + __popcll(__ballot(sel2 == n)); if (lane == n) mytot = tot; }
        unsigned mybase = 0; if (lane < qb && mytot > 0) mybase = atomicAdd(bcnt + (b * NH + h) * NBLK + lane, (unsigned)mytot);
        for (int n = 0; n < qb; ++n) { const unsigned long long m0 = __ballot(sel0 == n), m1 = __ballot(sel1 == n), m2 = __ballot(sel2 == n); const int c0 = __popcll(m0), c1 = __popcll(m1);
            const unsigned base = (unsigned)__shfl((int)mybase, n); int j = -1, rank = 0;
            if (sel0 == n) { j = 0; rank = __popcll(m0 & lt); } else if (sel1 == n) { j = 1; rank = c0 + __popcll(m1 & lt); } else if (sel2 == n) { j = 2; rank = c0 + c1 + __popcll(m2 & lt); }
            if (j >= 0) blist[(size_t)((b * NH + h) * NBLK + n) * BKT_CAP + base + rank] = (sq << 2) | j; }
    }
}

constexpr int AT_KS = 0, AT_KROW = 272, AT_VT = 256 * AT_KROW, AT_VROW = 520, AT_CUM = AT_VT + 128 * AT_VROW;
constexpr int AT_OT = AT_CUM + 3072, AT_OTW = 32 * 80;
static_assert(AT_CUM + 540 * 4 <= AT_OT && AT_OT + 8 * AT_OTW <= LDS_TB, "attention LDS map");
constexpr int CW_AQ = 600;
__device__ __forceinline__ void phase_attn(const Ctx& C, bool probe, unsigned pflags) {
    LAS unsigned char* lds = C.lds; unsigned char* ws = C.ws();
    const bf16_t* qkv = (const bf16_t*)(ws + WS_ARENA + AR_QKV); const unsigned* bcnt = (const unsigned*)ws + (probe ? 5120 : CW_BKT); const int* blist = (const int*)(ws + (probe ? WS_ARENA + ((size_t)100 << 20) : WS_BLIST));
    bf16_t* opart = (bf16_t*)(ws + WS_ARENA + AR_OPART); float* lpart = (float*)(ws + WS_LPART);
    const int tid = opaque_tid(C.wid), lane = tid & 63, wave = C.wid, r31 = lane & 31, hh = lane >> 5;
    LAS int* cum = (LAS int*)(lds + AT_CUM); LAS int* misc = cum + 520;
    { const int n = tid >> 5, bh = tid & 31; const int c = (int)bcnt[bh * NBLK + n]; int v = (c + 511) >> 9; v = v < 1 ? 1 : v;
#pragma unroll
      for (int o = 1; o < 64; o <<= 1) { const int u = __shfl_up(v, o); if (lane >= o) v += u; }
      if (lane == 63) misc[wave] = v;
      __syncthreads();
      int base = 0;
#pragma unroll
      for (int w = 0; w < NWAVES; ++w) base += (w < wave) ? misc[w] : 0;
      cum[tid + 1] = v + base; if (tid == 0) cum[0] = 0;
      __syncthreads(); }
    const int nitems = cum[512];
    const float cexp = 0.12751743f;
    LAS unsigned char* otile = lds + AT_OT + wave * AT_OTW;
    if (tid == 0) misc[8] = (int)atomicAdd((unsigned*)C.ws() + CW_AQ + (probe ? 1 : 0), 1u);
    __syncthreads();
    int item = misc[8];
    int n = 0, h = 0, b = 0, bk = 0, chunk = 0, cnt = 0, nown = 0, nrg = 0; int ent[3]; bool val[3];
#define AT_DECODE(it_) do { int lo = 0, hi = 512; while (hi - lo > 1) { const int mid = (lo + hi) >> 1; if (cum[mid] <= (it_)) lo = mid; else hi = mid; } \
        chunk = (it_) - cum[lo]; n = lo >> 5; { const int bh = lo & 31; h = bh & 7; b = bh >> 3; bk = bh * NBLK + n; } cnt = (int)bcnt[bk]; \
        { const int rem = cnt - chunk * 512; const int nsrg = ((rem < 512 ? rem : 512) + 31) >> 5; nown = (chunk == 0) ? 8 : 0; nrg = nown + (nsrg > 0 ? nsrg : 0); } } while (0)
#define AT_ENTS() do { _Pragma("unroll") for (int it = 0; it < 3; ++it) { const int rg = wave + 8 * it; val[it] = false; ent[it] = 0; \
        if (rg < nrg) { if (rg < nown) { ent[it] = ((n * MB + (7 - rg) * 32 + r31) << 2) | 3; val[it] = true; } \
                        else { const int ei = chunk * 512 + (rg - nown) * 32 + r31; val[it] = ei < cnt; ent[it] = val[it] ? blist[(size_t)bk * BKT_CAP + ei] : 0; } } } } while (0)
    if (item < nitems) { AT_DECODE(item); AT_ENTS(); }
    while (item < nitems) {
        __syncthreads();
        const int tid = opaque_tid(C.wid), lane = tid & 63, r31 = lane & 31, hh = lane >> 5;
        if (tid == 0) misc[8] = (int)atomicAdd((unsigned*)C.ws() + CW_AQ + (probe ? 1 : 0), 1u);
        const int cn = n, ch = h, cb = b, cnown = nown, cnrg = nrg; int cent[3]; bool cval[3];
#pragma unroll
        for (int it = 0; it < 3; ++it) { cent[it] = ent[it]; cval[it] = val[it]; }
        bf16x8 qn[8];
        { const bf16_t* qp = qkv + (size_t)(cb * SEQ + (cent[0] >> 2)) * NQKV + ch * HD + 8 * hh;
#pragma unroll
          for (int s8 = 0; s8 < 8; ++s8) qn[s8] = *(const bf16x8*)(qp + 16 * s8); }
        {
          const int tl = tid;
          const bf16_t* kb = qkv + (size_t)(cb * SEQ + cn * MB) * NQKV + D + ch * HD;
#pragma unroll
          for (int i = 0; i < 8; ++i) { const int c = tl + 512 * i, row = c >> 4, c16 = c & 15; const u32x4 v = *(const u32x4*)(kb + (size_t)row * NQKV + c16 * 8); *(LAS u32x4*)(lds + AT_KS + row * AT_KROW + c16 * 16) = v; }
          const bf16_t* vb = kb + D;
#pragma unroll
          for (int i = 0; i < 4; ++i) { const int v = tl + 512 * i, kq = v >> 5, dq = v & 31; const bf16_t* src = vb + (size_t)(4 * kq) * NQKV + 4 * dq;
              const u32x2 r0 = *(const u32x2*)src, r1 = *(const u32x2*)(src + NQKV), r2 = *(const u32x2*)(src + 2 * NQKV), r3 = *(const u32x2*)(src + 3 * NQKV);
              LAS unsigned char* dst = lds + AT_VT + (4 * dq) * AT_VROW + kq * 8;
              u32x2 w;
              w.x = (r0.x & 0xffffu) | (r1.x << 16); w.y = (r2.x & 0xffffu) | (r3.x << 16); *(LAS u32x2*)(dst) = w;
              w.x = (r0.x >> 16) | (r1.x & 0xffff0000u); w.y = (r2.x >> 16) | (r3.x & 0xffff0000u); *(LAS u32x2*)(dst + AT_VROW) = w;
              w.x = (r0.y & 0xffffu) | (r1.y << 16); w.y = (r2.y & 0xffffu) | (r3.y << 16); *(LAS u32x2*)(dst + 2 * AT_VROW) = w;
              w.x = (r0.y >> 16) | (r1.y & 0xffff0000u); w.y = (r2.y >> 16) | (r3.y & 0xffff0000u); *(LAS u32x2*)(dst + 3 * AT_VROW) = w; } }
        __syncthreads();
        const int nextitem = misc[8];
        if (nextitem < nitems) { AT_DECODE(nextitem); AT_ENTS(); }
#pragma unroll
        for (int it = 0; it < 3; ++it) { const int rg = wave + 8 * it;
            if (rg < cnrg) {
            const bool own = rg < cnown; const int og = 7 - rg;
            const int sq = cent[it] >> 2, slot = cent[it] & 3, tq = cb * SEQ + sq;
            bf16x8 qf[8];
#pragma unroll
            for (int s8 = 0; s8 < 8; ++s8) qf[s8] = qn[s8];
            if (it < 2 && rg + 8 < cnrg) { const bf16_t* qp = qkv + (size_t)(cb * SEQ + (cent[it < 2 ? it + 1 : 2] >> 2)) * NQKV + ch * HD + 8 * hh;
#pragma unroll
                for (int s8 = 0; s8 < 8; ++s8) qn[s8] = *(const bf16x8*)(qp + 16 * s8); }
            f32x16 oacc[4];
#pragma unroll
            for (int dt = 0; dt < 4; ++dt)
#pragma unroll
                for (int i = 0; i < 16; ++i) oacc[dt][i] = 0.f;
            float lsum = 0.f;
            const int nkt = own ? (og + 1) : 8;
            const LAS unsigned char* kbase = lds + AT_KS + r31 * AT_KROW + 16 * hh;
            const LAS unsigned char* vbase = lds + AT_VT + r31 * AT_VROW + 8 * hh;
            for (int kt = 0; kt < nkt; ++kt) {
                f32x16 sacc;
#pragma unroll
                for (int i = 0; i < 16; ++i) sacc[i] = 0.f;
#pragma unroll
                for (int s8 = 0; s8 < 8; ++s8) { const bf16x8 kf = *(const LAS bf16x8*)(kbase + kt * 32 * AT_KROW + 32 * s8); sacc = __builtin_amdgcn_mfma_f32_32x32x16_bf16(kf, qf[s8], sacc, 0, 0, 0); }
                const bool diag = own && (kt == og);
                float p[16];
#pragma unroll
                for (int i = 0; i < 16; ++i) { const int krow = (i & 3) + 8 * (i >> 2) + 4 * hh; float e = __builtin_amdgcn_exp2f(sacc[i] * cexp); if (diag && krow > r31) e = 0.f; p[i] = e; lsum += e; }
                bf16x8 pb[2];
#pragma unroll
                for (int s2 = 0; s2 < 2; ++s2) { u32x4 w; w.x = cvt_pk_bf16(p[8 * s2 + 0], p[8 * s2 + 1]); w.y = cvt_pk_bf16(p[8 * s2 + 2], p[8 * s2 + 3]); w.z = cvt_pk_bf16(p[8 * s2 + 4], p[8 * s2 + 5]); w.w = cvt_pk_bf16(p[8 * s2 + 6], p[8 * s2 + 7]);
                    pb[s2] = __builtin_bit_cast(bf16x8, w); }
#pragma unroll
                for (int dt = 0; dt < 4; ++dt)
#pragma unroll
                    for (int s2 = 0; s2 < 2; ++s2) { const LAS unsigned char* vp = vbase + dt * 32 * AT_VROW + (kt * 32 + 16 * s2) * 2;
                        const u32x2 v0 = *(const LAS u32x2*)vp, v1 = *(const LAS u32x2*)(vp + 16); u32x4 w; w.x = v0.x; w.y = v0.y; w.z = v1.x; w.w = v1.y;
                        oacc[dt] = __builtin_amdgcn_mfma_f32_32x32x16_bf16(__builtin_bit_cast(bf16x8, w), pb[s2], oacc[dt], 0, 0, 0); }
            }
            { const auto sw = __builtin_amdgcn_permlane32_swap(__builtin_bit_cast(unsigned, lsum), __builtin_bit_cast(unsigned, lsum), false, false);
              lsum = __builtin_bit_cast(float, sw[0]) + __builtin_bit_cast(float, sw[1]); }
            const int pidx = cval[it] ? (int)(((unsigned)tq * NH + ch) * 4 + slot) : -1;
            if (hh == 0 && pidx >= 0) lpart[pidx] = lsum;
            const int l2 = lane, r2 = r31, h2 = hh;
#pragma unroll
            for (int dt = 0; dt < 4; ++dt) {
#pragma unroll
                for (int g4 = 0; g4 < 4; ++g4) { u32x2 w; w.x = cvt_pk_bf16(oacc[dt][4 * g4 + 0], oacc[dt][4 * g4 + 1]); w.y = cvt_pk_bf16(oacc[dt][4 * g4 + 2], oacc[dt][4 * g4 + 3]); *(LAS u32x2*)(otile + r2 * 80 + (8 * g4 + 4 * h2) * 2) = w; }
                asm volatile("s_waitcnt lgkmcnt(0)" ::: "memory");
#pragma unroll
                for (int hf = 0; hf < 2; ++hf) { const int row = (l2 >> 2) + 16 * hf, c4 = l2 & 3; const u32x4 v = *(const LAS u32x4*)(otile + row * 80 + c4 * 16); const int pr = __shfl(pidx, row);
                    if (pr >= 0 && !(pflags & 4u)) *(u32x4*)(opart + (size_t)pr * HD + 32 * dt + 8 * c4) = v; }
                asm volatile("s_waitcnt lgkmcnt(0)" ::: "memory"); }
            } }
        item = nextitem;
    }
#undef AT_DECODE
#undef AT_ENTS
}

__device__ __forceinline__ void phase_combine(const Ctx& C) {
    const int bid = C.bid, G = C.G; unsigned char* ws = C.ws();
    bf16_t* qkv = (bf16_t*)(ws + WS_ARENA + AR_QKV); const bf16_t* opart = (const bf16_t*)(ws + WS_ARENA + AR_OPART); const float* lpart = (const float*)(ws + WS_LPART);
    const int tid = opaque_tid(C.wid), lane = tid & 63, sub = lane >> 4, c16 = lane & 15;
#pragma unroll 4
    for (int p0 = (bid * NWAVES + C.wid) * 4; p0 < T * NH; p0 += G * NWAVES * 4) {
        const int pr = p0 + sub, h = pr & 7, t = pr >> 3, qb = (t % SEQ) / MB, nsel = qb < 3 ? qb : 3;
        float acc[8]; float l = 0.f;
#pragma unroll
        for (int i = 0; i < 8; ++i) acc[i] = 0.f;
#pragma unroll
        for (int j = 0; j < 4; ++j) { if (j < nsel || j == 3) { const size_t pidx = (size_t)pr * 4 + j; const u32x4 v = *(const u32x4*)(opart + pidx * HD + c16 * 8); l += lpart[pidx];
            acc[0] += bf2f(v.x & 0xffffu); acc[1] += __builtin_bit_cast(float, v.x & 0xffff0000u); acc[2] += bf2f(v.y & 0xffffu); acc[3] += __builtin_bit_cast(float, v.y & 0xffff0000u);
            acc[4] += bf2f(v.z & 0xffffu); acc[5] += __builtin_bit_cast(float, v.z & 0xffff0000u); acc[6] += bf2f(v.w & 0xffffu); acc[7] += __builtin_bit_cast(float, v.w & 0xffff0000u); } }
        const float inv = 1.0f / l;
        u32x4 w; w.x = pk2(acc[0] * inv, acc[1] * inv); w.y = pk2(acc[2] * inv, acc[3] * inv); w.z = pk2(acc[4] * inv, acc[5] * inv); w.w = pk2(acc[6] * inv, acc[7] * inv);
        *(u32x4*)(qkv + (size_t)t * NQKV + h * HD + c16 * 8) = w;
    }
}

__device__ __forceinline__ void phase_router(const Ctx& C, bool probe) {
    const int bid = C.bid, G = C.G; unsigned char* ws = C.ws(); const float* ffn_g = C.in(I_OFFNN); const float* w_r = C.in(I_OWR);
    const bf16_t* h3 = (const bf16_t*)(ws + WS_ARENA + AR_H3B); const float* ss3 = (const float*)(ws + WS_SS3); int* cnt = (int*)(ws + WS_CTL) + (probe ? 6144 : 0); int* tslot = (int*)(ws + (probe ? WS_ARENA + ((size_t)103 << 20) : WS_TSLOT)); int* tokof = (int*)(ws + (probe ? WS_ARENA + ((size_t)100 << 20) : WS_TOKOF)); float* gateof = (float*)(ws + (probe ? WS_ARENA + ((size_t)101 << 20) : WS_GATEOF)); f32x4* minfo = (f32x4*)(ws + (probe ? WS_ARENA + ((size_t)102 << 20) : WS_MINFO));
    const int tid = opaque_tid(C.wid), lane = tid & 63, w = C.wid;
    LAS int* lcnt = (LAS int*)C.lds; LAS int* lbase = lcnt + 8; LAS int* te = lcnt + 16; LAS int* trank = te + 128; LAS float* tp = (LAS float*)(trank + 128); LAS float* trs = tp + 128;
    float wg[16][NE];
#pragma unroll
    for (int i = 0; i < 16; ++i) { const int c = lane * 16 + i; const float g = ffn_g[c]; const f32x4 a = *(const f32x4*)(w_r + c * NE), b2 = *(const f32x4*)(w_r + c * NE + 4);
        wg[i][0] = a[0] * g; wg[i][1] = a[1] * g; wg[i][2] = a[2] * g; wg[i][3] = a[3] * g; wg[i][4] = b2[0] * g; wg[i][5] = b2[1] * g; wg[i][6] = b2[2] * g; wg[i][7] = b2[3] * g; }
    for (int grp = bid; grp < T / 64; grp += G) {
        if (tid < 8) lcnt[tid] = 0;
        __syncthreads();
        for (int i8 = 0; i8 < 8; ++i8) { const int tl = w * 8 + i8, t = grp * 64 + tl; const u32x4* hp = (const u32x4*)(h3 + (size_t)t * D + lane * 16); const u32x4 r0 = hp[0], r1 = hp[1];
            const float xv[16] = {bf2f(r0.x & 0xffffu), __builtin_bit_cast(float, r0.x & 0xffff0000u), bf2f(r0.y & 0xffffu), __builtin_bit_cast(float, r0.y & 0xffff0000u), bf2f(r0.z & 0xffffu), __builtin_bit_cast(float, r0.z & 0xffff0000u), bf2f(r0.w & 0xffffu), __builtin_bit_cast(float, r0.w & 0xffff0000u),
                                  bf2f(r1.x & 0xffffu), __builtin_bit_cast(float, r1.x & 0xffff0000u), bf2f(r1.y & 0xffffu), __builtin_bit_cast(float, r1.y & 0xffff0000u), bf2f(r1.z & 0xffffu), __builtin_bit_cast(float, r1.z & 0xffff0000u), bf2f(r1.w & 0xffffu), __builtin_bit_cast(float, r1.w & 0xffff0000u)};
            float lg[NE];
#pragma unroll
            for (int e = 0; e < NE; ++e) lg[e] = 0.f;
#pragma unroll
            for (int i = 0; i < 16; ++i)
#pragma unroll
                for (int e = 0; e < NE; ++e) lg[e] += xv[i] * wg[i][e];
            const float r = row_rscale(ss3, t);
#pragma unroll
            for (int e = 0; e < NE; ++e) lg[e] = wave_sum(lg[e]) * r;
            if (lane == 0) { int e1 = 0; float v1 = lg[0];
#pragma unroll
                for (int e = 1; e < NE; ++e) if (lg[e] > v1) { v1 = lg[e]; e1 = e; }
                int e2 = -1; float v2 = -INFINITY;
#pragma unroll
                for (int e = 0; e < NE; ++e) if (e != e1 && lg[e] > v2) { v2 = lg[e]; e2 = e; }
                if (e2 < 0) { e2 = (e1 == 0) ? 1 : 0; v2 = v1; }
                const float p1 = 1.0f / (1.0f + __expf(v2 - v1)), p2 = 1.0f - p1;
                te[2 * tl] = e1; te[2 * tl + 1] = e2; tp[2 * tl] = p1; tp[2 * tl + 1] = p2; trs[tl] = r;
                trank[2 * tl] = __hip_atomic_fetch_add(lcnt + e1, 1, __ATOMIC_RELAXED, __HIP_MEMORY_SCOPE_WORKGROUP); trank[2 * tl + 1] = __hip_atomic_fetch_add(lcnt + e2, 1, __ATOMIC_RELAXED, __HIP_MEMORY_SCOPE_WORKGROUP); } }
        __syncthreads();
        if (tid < 8) lbase[tid] = atomicAdd(cnt + tid, lcnt[tid]);
        __syncthreads();
        if (tid < 128) { const int e = te[tid], pos = lbase[e] + trank[tid]; tokof[e * T + pos] = grp * 64 + (tid >> 1); gateof[e * T + pos] = tp[tid]; tslot[grp * 128 + tid] = e * T + pos;
            f32x4 rec; rec[0] = trs[tid >> 1]; rec[1] = __builtin_bit_cast(float, grp * 64 + (tid >> 1)); rec[2] = tp[tid]; rec[3] = 0.f; minfo[(size_t)e * T + pos] = rec; }
        __syncthreads();
    }
}

__device__ __forceinline__ void phase_moecombine(const Ctx& C, const LAS int* tb, int p) {
    const int bid = C.bid, G = C.G; unsigned char* ws = C.ws(); float* out = C.out();
    const int* tslot = (const int*)(ws + WS_TSLOT); const bf16_t* y2 = (const bf16_t*)(ws + WS_ARENA + AR_Y2); const bf16_t* ypart = (const bf16_t*)(ws + WS_ARENA + AR_YPART);
    const int lane = opaque_tid(C.wid) & 63, pn = lane >> 4, cl = (lane & 15) * 16; const int nwg = tb[8], base = (nwg / G) * G;
    for (int t = bid * NWAVES + C.wid; t < T; t += G * NWAVES) {
        f32x4 a[4]; { const u32x4* hp = (const u32x4*)((const bf16_t*)(ws + WS_ARENA + AR_H3B) + (size_t)t * D + lane * 16); const u32x4 r0 = hp[0], r1 = hp[1];
            a[0][0] = bf2f(r0.x & 0xffffu); a[0][1] = __builtin_bit_cast(float, r0.x & 0xffff0000u); a[0][2] = bf2f(r0.y & 0xffffu); a[0][3] = __builtin_bit_cast(float, r0.y & 0xffff0000u);
            a[1][0] = bf2f(r0.z & 0xffffu); a[1][1] = __builtin_bit_cast(float, r0.z & 0xffff0000u); a[1][2] = bf2f(r0.w & 0xffffu); a[1][3] = __builtin_bit_cast(float, r0.w & 0xffff0000u);
            a[2][0] = bf2f(r1.x & 0xffffu); a[2][1] = __builtin_bit_cast(float, r1.x & 0xffff0000u); a[2][2] = bf2f(r1.y & 0xffffu); a[2][3] = __builtin_bit_cast(float, r1.y & 0xffff0000u);
            a[3][0] = bf2f(r1.z & 0xffffu); a[3][1] = __builtin_bit_cast(float, r1.z & 0xffff0000u); a[3][2] = bf2f(r1.w & 0xffffu); a[3][3] = __builtin_bit_cast(float, r1.w & 0xffff0000u); }
#pragma unroll
        for (int sl = 0; sl < 2; ++sl) { const int code = tslot[t * 2 + sl], e = code / T, pos = code % T; const int wg = tb[e] + (pos >> 8) * 4 + pn;
            const bf16_t* src; int nsum, stride;
            if (wg < base) { src = y2 + (size_t)(tb[16 + e] + pos) * D + pn * 256 + cl; nsum = 1; stride = 0; }
            else { src = ypart + ((size_t)(wg - base) * p * 256 + (pos & 255)) * 256 + cl; nsum = p; stride = 256 * 256; }
            for (int q = 0; q < nsum; ++q) { const u32x4 v0 = *(const u32x4*)(src + (size_t)q * stride), v1 = *(const u32x4*)(src + (size_t)q * stride + 8);
                a[0][0] += bf2f(v0.x & 0xffffu); a[0][1] += __builtin_bit_cast(float, v0.x & 0xffff0000u); a[0][2] += bf2f(v0.y & 0xffffu); a[0][3] += __builtin_bit_cast(float, v0.y & 0xffff0000u);
                a[1][0] += bf2f(v0.z & 0xffffu); a[1][1] += __builtin_bit_cast(float, v0.z & 0xffff0000u); a[1][2] += bf2f(v0.w & 0xffffu); a[1][3] += __builtin_bit_cast(float, v0.w & 0xffff0000u);
                a[2][0] += bf2f(v1.x & 0xffffu); a[2][1] += __builtin_bit_cast(float, v1.x & 0xffff0000u); a[2][2] += bf2f(v1.y & 0xffffu); a[2][3] += __builtin_bit_cast(float, v1.y & 0xffff0000u);
                a[3][0] += bf2f(v1.z & 0xffffu); a[3][1] += __builtin_bit_cast(float, v1.z & 0xffff0000u); a[3][2] += bf2f(v1.w & 0xffffu); a[3][3] += __builtin_bit_cast(float, v1.w & 0xffff0000u); } }
        { f32x4* hp = (f32x4*)(out + (size_t)t * D + lane * 16); hp[0] = a[0]; hp[1] = a[1]; hp[2] = a[2]; hp[3] = a[3]; }
    }
}

__device__ __forceinline__ void moe_tables(LAS int* tb, const int* cnt, int nN, int wid) {
    if (opaque_tid(wid) == 0) { int cu = 0, off = 0; for (int e = 0; e < NE; ++e) { const int c = cnt[e]; tb[e] = cu; tb[16 + e] = off; tb[32 + e] = c; cu += ((c + 255) / 256) * nN; off += c; } tb[8] = cu; tb[24] = off; }
    __syncthreads();
}
template <class Epi, class Sched>
__device__ __forceinline__ void gemm_run(const Ctx& C, const bf16_t* A, int lda, const bf16_t* Bt, int K, const void* tblbase, const Sched& S, const Epi& E) { pg8::gemm_fast<Epi, Sched, true, false>(C.lds, A, lda * 2, Bt, K * 2, tblbase, S, E, C.wid, C.noepi, 0, 0); }
template <class Epi, class Sched>
__device__ __forceinline__ void gemm_run8(const Ctx& C, const void* A, int lda, const void* Bt, int K, const void* tblbase, const Sched& S, const Epi& E, int ea, int eb) { pg8::gemm_fast<Epi, Sched, true, true>(C.lds, A, lda, Bt, K, tblbase, S, E, C.wid, C.noepi, ea * 0x01010101, eb * 0x01010101); }

__global__ void __launch_bounds__(NTHREADS) fwd_megakernel(Params P) {
    extern __shared__ __attribute__((aligned(16))) unsigned char lds_raw[];
    Ctx C; C.lds = (LAS unsigned char*)lds_raw; C.wid = __builtin_amdgcn_readfirstlane(threadIdx.x >> 6); C.bid = blockIdx.x; C.G = gridDim.x;
    if (threadIdx.x < 25) { const unsigned long long v = (threadIdx.x < 23) ? (unsigned long long)P.in[threadIdx.x] : (threadIdx.x == 23 ? (unsigned long long)P.out : (unsigned long long)P.ws);
        ((LAS unsigned long long*)(C.lds + LDS_PTR))[threadIdx.x] = v; }
    if (threadIdx.x < 2) ((LAS unsigned*)(C.lds + LDS_BST))[threadIdx.x] = 0u;
    if (threadIdx.x == 2) { ((LAS unsigned*)(C.lds + LDS_BST))[4] = P.mask; ((LAS unsigned*)(C.lds + LDS_BST))[5] = (unsigned)P.probe; }
    if (threadIdx.x == 0) (void)xb_add((unsigned*)P.ws + CW_BAR + XB_XCNT(xb_xcc_id()), 1u);
    __syncthreads();
    if (P.ws == nullptr) cg::this_grid().sync();
    LAS int* tb = (LAS int*)(C.lds + LDS_TB);
#define WSP(T_, off) ((T_*)(C.ws() + (off)))
#define ARP(off) ((bf16_t*)(C.ws() + WS_ARENA + (off)))

    const unsigned mask = __builtin_amdgcn_readfirstlane(((const volatile LAS unsigned*)(C.lds + LDS_BST))[4]); const unsigned probev = __builtin_amdgcn_readfirstlane(((const volatile LAS unsigned*)(C.lds + LDS_BST))[5]); const bool probe = probev != 0u; C.noepi = (probev & 2u) != 0u;
#define PH(k) (mask & (1u << (k)))
    float* d_f32 = (float*)(C.ws() + WS_ARENA); bf16_t* d_b16 = ARP((size_t)64 << 20); float* d_ss = (float*)(C.ws() + WS_ARENA + ((size_t)96 << 20));

    if (PH(0)) { phase_prep(C); grid_barrier(C); }
    if (PH(1)) { pg8::DenseOrder S; S.init(T, NPROJ, D, C.G, C.bid); pg8::EpiScaleBf16 E{ARP(AR_PROJ), NPROJ, WSP(float, WS_SS0)}; gemm_run(C, ARP(AR_XB), D, WSP(bf16_t, WS_WIN), D, WSP(float, WS_SS0), S, E); grid_barrier(C); }
    if (PH(2)) { phase_mixer(C); grid_barrier(C); }
    if (PH(3)) { pg8::DenseOrder S; S.init(T, D, D, C.G, C.bid); pg8::EpiResid<false, false> E{C.in(I_X), probe ? d_b16 : ARP(AR_H1B), nullptr, probe ? d_ss : WSP(float, WS_SS1), C.lds, C.wid}; gemm_run(C, ARP(AR_Y), D, WSP(bf16_t, WS_WOUT), D, WSP(float, WS_SS0), S, E); grid_barrier(C); }
    if (PH(4)) { pg8::DenseOrder S; S.init(T, NGU, D, C.G, C.bid); pg8::EpiSwiglu E{ARP(AR_ACT), FF, WSP(float, WS_SS1), nullptr, tb, false}; gemm_run(C, ARP(AR_H1B), D, WSP(bf16_t, WS_WGU), D, WSP(float, WS_SS1), S, E); grid_barrier(C); }
    if (PH(5)) { pg8::DenseOrder S; S.init(T, D, FF, C.G, C.bid); pg8::EpiResid<true, false> E{ARP(AR_H1B), probe ? d_b16 : ARP(AR_H2B), nullptr, probe ? d_ss : WSP(float, WS_SS2), C.lds, C.wid}; gemm_run(C, ARP(AR_ACT), FF, WSP(bf16_t, WS_WDN), FF, WSP(float, WS_SS0), S, E); grid_barrier(C); }
    if (PH(6)) { pg8::DenseOrder S; S.init(T, NQKV, D, C.G, C.bid); pg8::EpiQKV E{ARP(AR_QKV), C.in(I_OQN), C.in(I_OKN), WSP(float, WS_ROPE), WSP(float, WS_KMEAN), C.lds, C.wid}; gemm_run(C, ARP(AR_H2B), D, WSP(bf16_t, WS_WQKV), D, WSP(float, WS_SS2), S, E); grid_barrier(C); }
    if (PH(7)) { phase_qkprep(C); grid_barrier(C); }
    if (PH(8)) { phase_select(C, probe); grid_barrier(C); }
    if (PH(9)) { phase_attn(C, probe, probev); grid_barrier(C); }
    if (PH(10)) { phase_combine(C); grid_barrier(C); }
    if (PH(11)) { pg8::DenseOrder S; S.init(T, D, D, C.G, C.bid); pg8::EpiResid<true, true> E{ARP(AR_H2B), probe ? d_b16 : ARP(AR_H3B), probe ? (unsigned char*)d_f32 : WSP(unsigned char, WS_H38), probe ? d_ss : WSP(float, WS_SS3), C.lds, C.wid}; gemm_run(C, ARP(AR_QKV), NQKV, WSP(bf16_t, WS_WO), D, WSP(float, WS_SS0), S, E); grid_barrier(C); }
    if (PH(12)) { phase_router(C, probe); grid_barrier(C); }
    if (PH(13)) { moe_tables(tb, WSP(int, WS_CTL), NGUE / 256, C.wid); pg8::MoeOrder S{tb, WSP(int, WS_TOKOF), NGUE / 256, C.G, C.bid, true, (size_t)NGUE * D / 2, D / 128, false};
        pg8::EpiSwiglu E{ARP(AR_MACT), FE, WSP(float, WS_SS3), WSP(int, WS_TOKOF), tb, true}; gemm_run8(C, WSP(unsigned char, WS_H38), D, WSP(unsigned char, WS_MGU), D, WSP(float, WS_MINFO), S, E, 127, 121); grid_barrier(C); }
    if (PH(14)) { moe_tables(tb, WSP(int, WS_CTL), D / 256, C.wid); pg8::MoeOrder S{tb, WSP(int, WS_TOKOF), D / 256, C.G, C.bid, false, (size_t)D * FE / 2, FE / 128, true};
        pg8::EpiMoeDown E{ARP(AR_Y2), ARP(AR_YPART), WSP(float, WS_GATEOF), tb, C.wid}; gemm_run8(C, ARP(AR_MACT), FE, WSP(unsigned char, WS_MDN), FE, WSP(float, WS_MINFO), S, E, 125, 121); grid_barrier(C); }
    if (PH(15) && !probe) { moe_tables(tb, WSP(int, WS_CTL), D / 256, C.wid); pg8::MoeOrder S{tb, WSP(int, WS_TOKOF), D / 256, C.G, C.bid, false, (size_t)D * FE / 2, FE / 128, true}; phase_moecombine(C, tb, S.pieces(tb[8])); }
}

extern "C" void kernel_launch(void* const* d_in, const int* in_sizes, int n_in, void* d_out, int out_size, void* d_ws, size_t ws_size, hipStream_t stream) {
    if (n_in != 23 || out_size != T * D || ws_size < WS_END) { fprintf(stderr, "kernel_launch: bad shapes n_in %d out %d ws %zu (need %zu)\n", n_in, out_size, ws_size, (size_t)WS_END); return; }
    static int grid_blocks = 0;
    if (!grid_blocks) {
        int dev = 0, cus = 0, per_cu = 0;
        (void)hipGetDevice(&dev); (void)hipDeviceGetAttribute(&cus, hipDeviceAttributeMultiprocessorCount, dev);
        (void)hipFuncSetAttribute((const void*)fwd_megakernel, hipFuncAttributeMaxDynamicSharedMemorySize, LDS_BYTES);
        (void)hipOccupancyMaxActiveBlocksPerMultiprocessor(&per_cu, (const void*)fwd_megakernel, NTHREADS, LDS_BYTES);
        if (per_cu < 1) { fprintf(stderr, "kernel_launch: occupancy query says %d blocks per CU\n", per_cu); per_cu = 1; }
        grid_blocks = cus * 1;
    }
    if (hipMemsetAsync((char*)d_ws + WS_CTL, 0, WS_CTLBYTES, stream) != hipSuccess) { fprintf(stderr, "kernel_launch: memset failed\n"); return; }
    Params p{};
    for (int i = 0; i < 23; ++i) p.in[i] = (const float*)d_in[i];
    p.out = (float*)d_out; p.ws = (unsigned char*)d_ws;
    p.mask = 0xffffu & ~(1u << 7); p.probe = 0;
    void* args[] = {&p};
    hipError_t e = hipLaunchCooperativeKernel((const void*)fwd_megakernel, dim3(grid_blocks), dim3(NTHREADS), args, LDS_BYTES, stream);
    if (e != hipSuccess) fprintf(stderr, "cooperative launch failed: %s (grid %d)\n", hipGetErrorString(e), grid_blocks);
#ifndef PROBE_MODE
#define PROBE_MODE 1
#endif
#ifdef PROBE_MASK
    (void)hipMemsetAsync((char*)d_ws + WS_CTL + 4096, 0, WS_CTLBYTES - 4096, stream);
    Params p2 = p; p2.mask = PROBE_MASK; p2.probe = PROBE_MODE; void* args2[] = {&p2};
    (void)hipLaunchCooperativeKernel((const void*)fwd_megakernel, dim3(grid_blocks), dim3(NTHREADS), args2, LDS_BYTES, stream);
#endif
}
```

```cpp
#include <hip/hip_runtime.h>
#include <hip/hip_cooperative_groups.h>
#include <cstdio>
#include <cstdint>

#define LAS __attribute__((address_space(3)))
typedef unsigned short bf16_t;
typedef short bf16x8 __attribute__((ext_vector_type(8)));
typedef float f32x4 __attribute__((ext_vector_type(4)));
typedef float f32x2 __attribute__((ext_vector_type(2)));
typedef float f32x16 __attribute__((ext_vector_type(16)));
typedef unsigned u32x4 __attribute__((ext_vector_type(4)));
typedef unsigned u32x2 __attribute__((ext_vector_type(2)));
typedef int v8i __attribute__((ext_vector_type(8)));

constexpr int T = 16384, D = 1024, SEQ = 4096, NBATCH = 4;
constexpr int CONV = 512, GM = 512, NPROJ = 2560;
constexpr int FF = 2816, NGU = 2 * FF;
constexpr int NH = 8, HD = 128, NQKV = 3072;
constexpr int NE = 8, FE = 3584, NGUE = 2 * FE;
constexpr int MB = 256, NBLK = SEQ / MB;
constexpr float EPS = 1e-6f;

constexpr size_t al256(size_t x) { return (x + 255) & ~(size_t)255; }
constexpr size_t WS_CTL = 0;
constexpr int NSS = 4;
constexpr size_t WS_CTLBYTES = 32768;
constexpr int CW_BKT = 64;
constexpr int CW_BAR = 1024;
constexpr size_t WS_SS0 = WS_CTLBYTES;
constexpr size_t WS_SS1 = WS_SS0 + (size_t)T * NSS * 4;
constexpr size_t WS_SS2 = WS_SS1 + (size_t)T * NSS * 4;
constexpr size_t WS_SS3 = WS_SS2 + (size_t)T * NSS * 4;
constexpr size_t WS_ROPE = WS_SS3 + (size_t)T * NSS * 4;
constexpr size_t WS_KMEAN = WS_ROPE + (size_t)SEQ * 16 * 2 * 4;
constexpr size_t WS_TOKOF = WS_KMEAN + (size_t)NBATCH * NH * NBLK * HD * 4;
constexpr size_t WS_GATEOF = WS_TOKOF + (size_t)NE * T * 4;
constexpr size_t WS_TSLOT = al256(WS_GATEOF + (size_t)NE * T * 4);
constexpr size_t WS_MINFO = al256(WS_TSLOT + (size_t)T * 2 * 4);
constexpr size_t WS_W = al256(WS_MINFO + (size_t)NE * T * 16);
constexpr size_t WS_WIN = WS_W;
constexpr size_t WS_WOUT = WS_WIN + (size_t)NPROJ * D * 2;
constexpr size_t WS_WGU = WS_WOUT + (size_t)D * D * 2;
constexpr size_t WS_WDN = WS_WGU + (size_t)NGU * D * 2;
constexpr size_t WS_WQKV = WS_WDN + (size_t)D * FF * 2;
constexpr size_t WS_WO = WS_WQKV + (size_t)NQKV * D * 2;
constexpr size_t WS_MGU = WS_WO + (size_t)D * D * 2;
constexpr size_t WS_MDN = WS_MGU + (size_t)NE * NGUE * D;
constexpr size_t WS_ARENA = WS_MDN + (size_t)NE * D * FE;
constexpr size_t SZ_TD2 = (size_t)T * D * 2;
constexpr size_t AR_XB = 0, AR_PROJ = SZ_TD2, AR_Y = 0, AR_H1B = SZ_TD2, AR_ACT = 2 * SZ_TD2, AR_H2B = 0, AR_QKV = SZ_TD2,
                 AR_O = SZ_TD2 + (size_t)T * NQKV * 2, AR_H3B = 0, AR_MACT = (size_t)68 << 20;
constexpr int BKT_CAP = 3840;
constexpr size_t WS_BLIST = WS_WIN;
constexpr size_t WS_LPART = WS_BLIST + (size_t)512 * BKT_CAP * 4;
constexpr size_t WS_H38 = WS_WIN;
constexpr size_t AR_OPART = AR_O;
static_assert(WS_LPART + (size_t)T * NH * 4 * 4 <= WS_WQKV && WS_H38 + (size_t)T * D <= WS_WQKV, "attention lists / h3 fp8 fit the layer-0 weight copies");
static_assert(AR_OPART + (size_t)T * NH * 4 * HD * 2 <= SZ_TD2 + (size_t)(2 * T + 256) * FE * 2, "attention partials fit the arena");
constexpr size_t AR_YPART = SZ_TD2;
constexpr size_t AR_Y2 = (size_t)186 << 20;
static_assert(AR_YPART + (size_t)256 * 256 * 256 * 2 <= AR_MACT && AR_MACT + (size_t)(2 * T + 256) * FE <= AR_Y2 && AR_Y2 + (size_t)2 * T * D * 2 <= SZ_TD2 + (size_t)(2 * T + 256) * FE * 2, "MoE down arena");
constexpr size_t WS_END = WS_ARENA + SZ_TD2 + (size_t)(2 * T + 256) * FE * 2;
static_assert(AR_ACT + (size_t)T * FF * 2 <= SZ_TD2 + (size_t)2 * T * FE * 2, "arena");
static_assert(WS_END <= 486079488ull, "workspace budget");

__device__ __forceinline__ unsigned f2bf(float f) { unsigned u = __builtin_bit_cast(unsigned, f); return (u + 0x7fffu + ((u >> 16) & 1u)) >> 16; }
__device__ __forceinline__ float bf2f(unsigned b) { return __builtin_bit_cast(float, b << 16); }
__device__ __forceinline__ unsigned pk2(float lo, float hi) { return f2bf(lo) | (f2bf(hi) << 16); }
__device__ __forceinline__ unsigned cvt_pk_bf16(float lo, float hi) { unsigned r; asm volatile("v_cvt_pk_bf16_f32 %0, %1, %2" : "=v"(r) : "v"(lo), "v"(hi)); return r; }
__device__ __forceinline__ int opaque_tid(int wid) { int l; asm volatile("v_mbcnt_lo_u32_b32 %0, -1, 0\n\tv_mbcnt_hi_u32_b32 %0, -1, %0" : "=v"(l)); return wid * 64 + l; }
__device__ __forceinline__ float wave_sum(float v) {
#pragma unroll
    for (int o = 1; o < 64; o <<= 1) v += __shfl_xor(v, o);
    return v;
}
__device__ __forceinline__ float rscale_of(const f32x4 p) { return rsqrtf(((p[0] + p[1]) + (p[2] + p[3])) * (1.0f / D) + EPS); }
__device__ __forceinline__ float row_rscale(const float* ssp, int row) { return rscale_of(*(const f32x4*)(ssp + (size_t)row * NSS)); }
__device__ __forceinline__ unsigned pk_fp8x4(float a, float b, float c, float d) {
    a = fminf(fmaxf(a, -448.f), 448.f); b = fminf(fmaxf(b, -448.f), 448.f); c = fminf(fmaxf(c, -448.f), 448.f); d = fminf(fmaxf(d, -448.f), 448.f);
    int p = __builtin_amdgcn_cvt_pk_fp8_f32(a, b, 0, false); p = __builtin_amdgcn_cvt_pk_fp8_f32(c, d, p, true); return (unsigned)p; }
__device__ __forceinline__ float silu_f(float g) { return g * __builtin_amdgcn_rcpf(1.0f + __builtin_amdgcn_exp2f(g * -1.4426950408889634f)); }

namespace pg8 {
constexpr int BM = 256, BK = 64, HALF = 128, HTB = HALF * BK * 2, STAGE_BYTES = 8 * HTB, NXCD = 8, WGM = 4;
constexpr int RI_OFF = STAGE_BYTES, RI_BYTES = 4 * 4096;
constexpr int EPI_OFF = RI_OFF + RI_BYTES, EPI_TILE = 8 * 144;
__host__ __device__ __forceinline__ int lds_byte(int r, int c) { const int st = (r >> 4) * 2 + (c >> 5), rr = r & 15, cc = c & 31, ob = rr * 64 + cc * 2; return st * 1024 + (ob ^ (((ob >> 9) & 1) << 5)); }
__host__ __device__ __forceinline__ void stage_rc(int b, int& R, int& C) { const int st = b / 1024, sb = b % 1024, swz = sb ^ (((sb >> 9) & 1) << 5); R = (st >> 1) * 16 + swz / 64; C = (st & 1) * 32 + (swz % 64) / 2; }
__host__ __device__ __forceinline__ int perm32(int rho) { const int n = rho >> 4, i = rho & 15; return 8 * (i >> 2) + 4 * n + (i & 3); }

struct Unit { int row0, pn, e, nvalid, kt0, nkt, piece; };

struct DenseOrder {
    int nM, nN, nwg, G, c, nkt;
    __device__ void init(int M, int N, int K, int G_, int c_) { nM = M / BM; nN = N / BM; nwg = nM * nN; G = G_; c = c_; nkt = K / BK; }
    __device__ __forceinline__ bool next(int i, Unit& u) const {
        const long L = (long)i * G + c; if (L >= nwg) return false;
        int wgid = (int)L; { const int q = nwg / NXCD, r = nwg % NXCD, xcd = wgid % NXCD, off = wgid / NXCD; wgid = (xcd < r ? xcd * (q + 1) : r * (q + 1) + (xcd - r) * q) + off; }
        const int nig = WGM * nN, gid = wgid / nig, fm = gid * WGM, gsz = (nM - fm) < WGM ? (nM - fm) : WGM;
        u.row0 = (fm + ((wgid % nig) % gsz)) * BM; u.pn = (wgid % nig) / gsz; u.e = 0; u.nvalid = BM; u.kt0 = 0; u.nkt = nkt; u.piece = -1; return true;
    }
    __device__ __forceinline__ int src_row(const Unit& u, int r) const { return u.row0 + r; }
    __device__ __forceinline__ unsigned tbl_off(const Unit& u) const { return (unsigned)u.row0 * 16u; }
    __device__ __forceinline__ size_t b_off(const Unit&) const { return 0; }
};
struct MoeOrder {
    __device__ __forceinline__ int tbv(int i) const { return __builtin_amdgcn_readfirstlane(tb[i]); }
    const LAS int* tb; const int* tokof; int nN, G, c; bool gather; size_t bstride; int nkt; bool splitk;
    __device__ __forceinline__ void tile(int L, Unit& u) const {
        const int nwg = tbv(8);
        int wgid = L; { const int q = nwg / NXCD, r = nwg % NXCD, xcd = wgid % NXCD, off = wgid / NXCD; wgid = (xcd < r ? xcd * (q + 1) : r * (q + 1) + (xcd - r) * q) + off; }
        int e = 0;
#pragma unroll
        for (int j = 1; j < 8; ++j) e += (wgid >= tbv(j)) ? 1 : 0;
        const int w = wgid - tbv(e), cnt = tbv(32 + e), nM = (cnt + BM - 1) / BM;
        const int nig = WGM * nN, gid = w / nig, fm = gid * WGM, gsz = (nM - fm) < WGM ? (nM - fm) : WGM;
        const int pm = fm + ((w % nig) % gsz); u.pn = (w % nig) / gsz; u.e = e; u.row0 = pm * BM; u.nvalid = (cnt - pm * BM) < BM ? (cnt - pm * BM) : BM;
    }
    __device__ __forceinline__ void tile_nat(int wg, Unit& u) const {
        int e = 0;
#pragma unroll
        for (int j = 1; j < 8; ++j) e += (wg >= tbv(j)) ? 1 : 0;
        const int w = wg - tbv(e), cnt = tbv(32 + e), pm = w / nN; u.pn = w % nN; u.e = e; u.row0 = pm * BM; u.nvalid = (cnt - pm * BM) < BM ? (cnt - pm * BM) : BM;
    }
    __device__ __forceinline__ int pieces(int nwg) const { const int base = (nwg / G) * G, R = nwg - base, ntrip = nkt / 2; int p = 1; if (R * 2 <= G && ntrip % 2 == 0) p = 2; if (R * 7 <= G && ntrip % 7 == 0) p = 7; return p; }
    __device__ __forceinline__ bool next(int i, Unit& u) const {
        const long L = (long)i * G + c; const int nwg = tbv(8);
        if (!splitk) { if (L >= nwg) return false; tile((int)L, u); u.kt0 = 0; u.nkt = nkt; u.piece = -1; return true; }
        const int base = (nwg / G) * G, R = nwg - base;
        if (L < base) { const int wg = ((int)L % NXCD) * (base / NXCD) + (int)L / NXCD; tile_nat(wg, u); u.kt0 = 0; u.nkt = nkt; u.piece = -1; return true; }
        if (R == 0) return false;
        const int p = pieces(nwg), j = (int)(L - base); if (j >= R * p) return false;
        tile_nat(base + j / p, u); const int per = nkt / p; u.kt0 = (j % p) * per; u.nkt = per; u.piece = j; return true;
    }
    __device__ __forceinline__ int src_row(const Unit& u, int r) const {
        if (gather) return (r < u.nvalid) ? tokof[u.e * T + u.row0 + r] : 0;
        return tbv(16 + u.e) + u.row0 + r;
    }
    __device__ __forceinline__ unsigned tbl_off(const Unit& u) const { return (unsigned)(u.e * T + u.row0) * 16u; }
    __device__ __forceinline__ size_t b_off(const Unit& u) const { return (size_t)u.e * bstride; }
};

struct EpiScaleBf16 {
    static constexpr bool PERM = true;
    bf16_t* O; int ldc; const float* ss;
    __device__ __forceinline__ void operator()(const f32x4 (&acc)[2][2][4][2], const Unit& u, int wr, int wc, int fr, int fq, const LAS f32x4* tbl) const {
        const int col0 = u.pn * BM + wc * 32 + 8 * fq; float rs[2][4]; const LAS f32x4* tb0 = tbl + (wr * 64 + fr); asm volatile("" : "+v"(tb0));
#pragma unroll
        for (int ai = 0; ai < 2; ++ai)
#pragma unroll
            for (int m = 0; m < 4; ++m) rs[ai][m] = rscale_of(tb0[ai * HALF + m * 16]);
#pragma unroll
        for (int ai = 0; ai < 2; ++ai)
#pragma unroll
            for (int m = 0; m < 4; ++m) { const int row = u.row0 + ai * HALF + wr * 64 + m * 16 + fr; const float r = rs[ai][m];
                bf16_t* rowp = O + (size_t)row * ldc + col0;
#pragma unroll
                for (int bj = 0; bj < 2; ++bj) { const f32x4 v0 = acc[ai][bj][m][0] * r, v1 = acc[ai][bj][m][1] * r;
                    u32x4 w; w.x = cvt_pk_bf16(v0[0], v0[1]); w.y = cvt_pk_bf16(v0[2], v0[3]); w.z = cvt_pk_bf16(v1[0], v1[1]); w.w = cvt_pk_bf16(v1[2], v1[3]);
                    *(u32x4*)(rowp + bj * HALF) = w; } }
    }
};
struct EpiQKV {
    static constexpr bool PERM = true;
    bf16_t* O; const float* qg; const float* kg; const float* rope; float* kmean; LAS unsigned char* lds; int wid;
    __device__ __forceinline__ void operator()(const f32x4 (&acc)[2][2][4][2], const Unit& u, int wr, int wc, int, int, const LAS f32x4* tbl) const {
        const int lane = opaque_tid(wid) & 63, fr = lane & 15, fq = lane >> 4;
        const int col0 = u.pn * BM + wc * 32 + 8 * fq; const LAS f32x4* tb0 = tbl + (wr * 64 + fr);
        float rr[2][4];
#pragma unroll
        for (int ai = 0; ai < 2; ++ai)
#pragma unroll
            for (int m = 0; m < 4; ++m) rr[ai][m] = rscale_of(tb0[ai * HALF + m * 16]);
        if (u.pn >= 8) {
#pragma unroll
            for (int ai = 0; ai < 2; ++ai)
#pragma unroll
                for (int m = 0; m < 4; ++m) { const int row = u.row0 + ai * HALF + wr * 64 + m * 16 + fr; bf16_t* rowp = O + (size_t)row * NQKV + col0; const float r = rr[ai][m];
#pragma unroll
                    for (int bj = 0; bj < 2; ++bj) { const f32x4 v0 = acc[ai][bj][m][0] * r, v1 = acc[ai][bj][m][1] * r;
                        u32x4 w; w.x = cvt_pk_bf16(v0[0], v0[1]); w.y = cvt_pk_bf16(v0[2], v0[3]); w.z = cvt_pk_bf16(v1[0], v1[1]); w.w = cvt_pk_bf16(v1[2], v1[3]);
                        *(u32x4*)(rowp + bj * HALF) = w; } }
            return; }
        LAS float* sc = (LAS float*)(lds + EPI_OFF);
#pragma unroll
        for (int ai = 0; ai < 2; ++ai)
#pragma unroll
            for (int m = 0; m < 4; ++m) { const int tr = ai * HALF + wr * 64 + m * 16 + fr; const float r = rr[ai][m];
#pragma unroll
                for (int bj = 0; bj < 2; ++bj) { const f32x4 v0 = acc[ai][bj][m][0] * r, v1 = acc[ai][bj][m][1] * r;
                    float q = ((v0[0] * v0[0] + v0[1] * v0[1]) + (v0[2] * v0[2] + v0[3] * v0[3])) + ((v1[0] * v1[0] + v1[1] * v1[1]) + (v1[2] * v1[2] + v1[3] * v1[3]));
                    q += __shfl_xor(q, 16); q += __shfl_xor(q, 32);
                    if (fq == 0) sc[(tr * 2 + bj) * 4 + wc] = q; } }
        asm volatile("s_waitcnt lgkmcnt(0)" ::: "memory"); __builtin_amdgcn_s_barrier(); asm volatile("" ::: "memory");
        const bool isk = u.pn >= 4; const float* gp = (isk ? kg : qg) + wc * 32 + 8 * fq; const f32x4 g0 = *(const f32x4*)gp, g1 = *(const f32x4*)(gp + 4);
        const int b = u.row0 / SEQ, nblk = (u.row0 % SEQ) / MB, h0 = (u.pn & 3) * 2;
        float cs[2][2][4];
#pragma unroll
        for (int bj = 0; bj < 2; ++bj)
#pragma unroll
            for (int n = 0; n < 2; ++n)
#pragma unroll
                for (int j = 0; j < 4; ++j) cs[bj][n][j] = 0.f;
#pragma unroll
        for (int ai = 0; ai < 2; ++ai)
#pragma unroll
            for (int m = 0; m < 4; ++m) { const int tr = ai * HALF + wr * 64 + m * 16 + fr, row = u.row0 + tr; const float r = rr[ai][m]; bf16_t* rowp = O + (size_t)row * NQKV + col0;
                f32x4 rc0 = (f32x4){1.f, 0.f, 1.f, 0.f}, rc1 = rc0, rc2 = rc0, rc3 = rc0;
                if (wc == 0) { const f32x4* rp = (const f32x4*)(rope + ((size_t)(row % SEQ) * 16 + 8 * (fq & 1)) * 2); rc0 = rp[0]; rc1 = rp[1]; rc2 = rp[2]; rc3 = rp[3]; }
#pragma unroll
                for (int bj = 0; bj < 2; ++bj) { const f32x4 p4 = *(const LAS f32x4*)(sc + (tr * 2 + bj) * 4); const float rn = rsqrtf(((p4[0] + p4[1]) + (p4[2] + p4[3])) * (1.0f / HD) + EPS) * r;
                    f32x4 v0 = acc[ai][bj][m][0] * rn * g0, v1 = acc[ai][bj][m][1] * rn * g1;
                    if (wc == 0) {
                        const float c[8] = {rc0[0], rc0[2], rc1[0], rc1[2], rc2[0], rc2[2], rc3[0], rc3[2]}, sn[8] = {rc0[1], rc0[3], rc1[1], rc1[3], rc2[1], rc2[3], rc3[1], rc3[3]};
#pragma unroll
                        for (int j = 0; j < 4; ++j) { const float p0 = __shfl_xor(v0[j], 32), p1 = __shfl_xor(v1[j], 32);
                            v0[j] = (fq < 2) ? v0[j] * c[j] - p0 * sn[j] : v0[j] * c[j] + p0 * sn[j]; v1[j] = (fq < 2) ? v1[j] * c[4 + j] - p1 * sn[4 + j] : v1[j] * c[4 + j] + p1 * sn[4 + j]; } }
                    u32x4 w; w.x = cvt_pk_bf16(v0[0], v0[1]); w.y = cvt_pk_bf16(v0[2], v0[3]); w.z = cvt_pk_bf16(v1[0], v1[1]); w.w = cvt_pk_bf16(v1[2], v1[3]);
                    *(u32x4*)(rowp + bj * HALF) = w;
                    if (isk) { cs[bj][0][0] += bf2f(w.x & 0xffffu); cs[bj][0][1] += __builtin_bit_cast(float, w.x & 0xffff0000u); cs[bj][0][2] += bf2f(w.y & 0xffffu); cs[bj][0][3] += __builtin_bit_cast(float, w.y & 0xffff0000u);
                               cs[bj][1][0] += bf2f(w.z & 0xffffu); cs[bj][1][1] += __builtin_bit_cast(float, w.z & 0xffff0000u); cs[bj][1][2] += bf2f(w.w & 0xffffu); cs[bj][1][3] += __builtin_bit_cast(float, w.w & 0xffff0000u); } } }
        if (isk) {
#pragma unroll
            for (int bj = 0; bj < 2; ++bj)
#pragma unroll
                for (int n = 0; n < 2; ++n)
#pragma unroll
                    for (int j = 0; j < 4; ++j) { float v = cs[bj][n][j]; v += __shfl_xor(v, 1); v += __shfl_xor(v, 2); v += __shfl_xor(v, 4); v += __shfl_xor(v, 8);
                        if (fr == 0) atomicAdd(kmean + ((size_t)(b * NH + h0 + bj) * NBLK + nblk) * HD + wc * 32 + 8 * fq + 4 * n + j, v * (1.0f / MB)); } }
    }
};
struct EpiSwiglu {
    static constexpr bool PERM = true;
    bf16_t* O; int ldc; const float* ss; const int* tokof; const LAS int* tb; bool moe;
    __device__ __forceinline__ void operator()(const f32x4 (&acc)[2][2][4][2], const Unit& u, int wr, int wc, int fr, int fq, const LAS f32x4* tbl) const {
        const int col0 = u.pn * HALF + wc * 32 + 8 * fq; float rs[2][4]; int orow[2][4]; int trb = wr * 64 + fr; asm volatile("" : "+v"(trb));
#pragma unroll
        for (int ai = 0; ai < 2; ++ai)
#pragma unroll
            for (int m = 0; m < 4; ++m) { const int tr = ai * HALF + m * 16 + trb; int srow;
                if (moe) { const bool ok = tr < u.nvalid; srow = ok ? tokof[u.e * T + u.row0 + tr] : 0; orow[ai][m] = ok ? tb[16 + u.e] + u.row0 + tr : -1; } else { srow = u.row0 + tr; orow[ai][m] = srow; }
                rs[ai][m] = moe ? tbl[tr][0] : rscale_of(tbl[tr]); }
#pragma unroll
        for (int ai = 0; ai < 2; ++ai)
#pragma unroll
            for (int m = 0; m < 4; ++m) { const float r = rs[ai][m];
                f32x4 a[2];
#pragma unroll
                for (int n = 0; n < 2; ++n) { const f32x4 g = acc[ai][0][m][n] * r, up = acc[ai][1][m][n] * r;
#pragma unroll
                    for (int j = 0; j < 4; ++j) a[n][j] = silu_f(g[j]) * up[j]; }
                if (moe) { u32x2 w8; w8.x = pk_fp8x4(a[0][0] * 4.f, a[0][1] * 4.f, a[0][2] * 4.f, a[0][3] * 4.f); w8.y = pk_fp8x4(a[1][0] * 4.f, a[1][1] * 4.f, a[1][2] * 4.f, a[1][3] * 4.f);
                    if (orow[ai][m] >= 0) *(u32x2*)((unsigned char*)O + (size_t)orow[ai][m] * ldc + col0) = w8; }
                else { u32x4 w; w.x = cvt_pk_bf16(a[0][0], a[0][1]); w.y = cvt_pk_bf16(a[0][2], a[0][3]); w.z = cvt_pk_bf16(a[1][0], a[1][1]); w.w = cvt_pk_bf16(a[1][2], a[1][3]);
                    if (orow[ai][m] >= 0) *(u32x4*)(O + (size_t)orow[ai][m] * ldc + col0) = w; } }
    }
};
template <bool BASE16, bool F8COPY> struct EpiResid {
    static constexpr bool PERM = false;
    const void* base; bf16_t* hb; unsigned char* h8; float* ssout; LAS unsigned char* lds; int wid;
    __device__ __forceinline__ void operator()(const f32x4 (&acc)[2][2][4][2], const Unit& u, int wr, int wc, int fr, int fq, const LAS f32x4*) const {
        const int col0 = u.pn * BM + wc * 32 + 4 * fq; LAS float* sc = (LAS float*)(lds + EPI_OFF);
#pragma unroll
        for (int ai = 0; ai < 2; ++ai)
#pragma unroll
            for (int m = 0; m < 4; ++m) { const int tr = ai * HALF + wr * 64 + m * 16 + fr, row = u.row0 + tr; const size_t off = (size_t)row * D + col0; float q = 0.f;
#pragma unroll
                for (int bj = 0; bj < 2; ++bj)
#pragma unroll
                    for (int n = 0; n < 2; ++n) { f32x4 bv;
                        if (BASE16) { const u32x2 r = *(const u32x2*)((const bf16_t*)base + off + bj * HALF + n * 16); bv[0] = bf2f(r.x & 0xffffu); bv[1] = __builtin_bit_cast(float, r.x & 0xffff0000u); bv[2] = bf2f(r.y & 0xffffu); bv[3] = __builtin_bit_cast(float, r.y & 0xffff0000u); }
                        else bv = *(const f32x4*)((const float*)base + off + bj * HALF + n * 16);
                        const f32x4 h = bv + acc[ai][bj][m][n]; q += (h[0] * h[0] + h[1] * h[1]) + (h[2] * h[2] + h[3] * h[3]);
                        u32x2 w; w.x = cvt_pk_bf16(h[0], h[1]); w.y = cvt_pk_bf16(h[2], h[3]); *(u32x2*)(hb + off + bj * HALF + n * 16) = w;
                        if (F8COPY) *(unsigned*)(h8 + off + bj * HALF + n * 16) = pk_fp8x4(h[0], h[1], h[2], h[3]); }
                q += __shfl_xor(q, 16); q += __shfl_xor(q, 32);
                if (fq == 0) sc[tr * 4 + wc] = q;
                asm volatile("" ::: "memory"); }
        asm volatile("s_waitcnt lgkmcnt(0)" ::: "memory"); __builtin_amdgcn_s_barrier(); asm volatile("" ::: "memory");
        { const int t2 = opaque_tid(wid); if (t2 < 256) { const f32x4 p = *(const LAS f32x4*)(sc + t2 * 4); ssout[(size_t)(u.row0 + t2) * NSS + u.pn] = (p[0] + p[1]) + (p[2] + p[3]); } }
        asm volatile("s_waitcnt lgkmcnt(0)" ::: "memory"); __builtin_amdgcn_s_barrier(); asm volatile("" ::: "memory");
    }
};
struct EpiMoeDown {
    static constexpr bool PERM = true;
    bf16_t* y2; bf16_t* ypart; const float* gateof; const LAS int* tb; int wid;
    __device__ __forceinline__ void operator()(const f32x4 (&acc)[2][2][4][2], const Unit& u, int wr, int wc, int, int, const LAS f32x4*) const {
        const int lane = opaque_tid(wid) & 63, fr = lane & 15, fq = lane >> 4;
        const int cloc = wc * 32 + 8 * fq, trb = wr * 64 + fr;
        bf16_t* ob = (u.piece >= 0) ? ypart + (size_t)u.piece * (BM * BM) + cloc : y2 + (size_t)(tb[16 + u.e] + u.row0) * D + u.pn * BM + cloc; const int ld = (u.piece >= 0) ? BM : D;
#pragma unroll
        for (int ai = 0; ai < 2; ++ai)
#pragma unroll
            for (int m = 0; m < 4; ++m) { const int tr = ai * HALF + m * 16 + trb; const bool ok = tr < u.nvalid; const float gt = ok ? gateof[u.e * T + u.row0 + tr] : 0.f;
#pragma unroll
                for (int bj = 0; bj < 2; ++bj) { const f32x4 v0 = acc[ai][bj][m][0] * gt, v1 = acc[ai][bj][m][1] * gt;
                    u32x4 w; w.x = cvt_pk_bf16(v0[0], v0[1]); w.y = cvt_pk_bf16(v0[2], v0[3]); w.z = cvt_pk_bf16(v1[0], v1[1]); w.w = cvt_pk_bf16(v1[2], v1[3]);
                    if (ok) *(u32x4*)(ob + (size_t)tr * ld + bj * HALF) = w; } }
    }
};

template <class Epi, class Sched, bool ALIGN_EPI, bool F8>
__device__ __forceinline__ void gemm_fast(LAS unsigned char* lds, const void* A, int ldab, const void* Bt, int Kb, const void* tblbase, const Sched& S, const Epi& E, int wid, bool noepi, int sclA, int sclB) {
    const int lane = opaque_tid(wid) & 63, wr = wid >> 2, wc = wid & 3, fr = lane & 15, fq = lane >> 4;
    unsigned voffB[2];
#pragma unroll
    for (int i = 0; i < 2; ++i) { int R, C; stage_rc(opaque_tid(wid) * 16 + i * 8192, R, C); const int Rb = Epi::PERM ? ((R & ~31) + perm32(R & 31)) : R; voffB[i] = (unsigned)Rb * (unsigned)Kb + (unsigned)C * 2u; }
    const unsigned kstep = (unsigned)(BK * 2), hstep = (unsigned)HALF * (unsigned)Kb, tstep = 2u * hstep;
    const unsigned ldsw = (unsigned)wid * 1024u;
    const int fcol = fq * 8; constexpr int KOFF = 1024;
    const int aoff = lds_byte(wr * 64 + fr, fcol), boff = lds_byte(wc * 32 + fr, fcol);
    const __amdgpu_buffer_rsrc_t rA = __builtin_amdgcn_make_buffer_rsrc((void*)A, 0, 0x7fffffff, 0x00020000), rB = __builtin_amdgcn_make_buffer_rsrc((void*)Bt, 0, 0x7fffffff, 0x00020000), rT = __builtin_amdgcn_make_buffer_rsrc((void*)tblbase, 0, 0x7fffffff, 0x00020000);
#define PG8_SA(b, h) (((b) * 2 + (h)) * HTB)
#define PG8_SB(b, h) ((4 + (b) * 2 + (h)) * HTB)
#define PG8_STAGE(bufoff, rsrc, soff, voff) do { _Pragma("unroll") for (int _i = 0; _i < 2; ++_i) \
        __builtin_amdgcn_raw_ptr_buffer_load_lds(rsrc, (LAS void*)(lds + (bufoff) + ldsw + _i * 8192), 16, (voff)[_i], (soff), 0, 0); } while (0)
#define PG8_LDA(dst, b, h) do { _Pragma("unroll") for (int m = 0; m < 4; ++m) _Pragma("unroll") for (int k = 0; k < 2; ++k) dst[m][k] = *(const LAS bf16x8*)(lds + PG8_SA(b, h) + aoff + m * 2048 + k * KOFF); } while (0)
#define PG8_LDB(dst, b, h) do { _Pragma("unroll") for (int n = 0; n < 2; ++n) _Pragma("unroll") for (int k = 0; k < 2; ++k) dst[n][k] = *(const LAS bf16x8*)(lds + PG8_SB(b, h) + boff + n * 2048 + k * KOFF); } while (0)
#define PG8_V8(f) __builtin_shufflevector(__builtin_bit_cast(u32x4, (f)[0]), __builtin_bit_cast(u32x4, (f)[1]), 0, 1, 2, 3, 4, 5, 6, 7)
#define PG8_MMA(ai, bj, At, Bt_) do { __builtin_amdgcn_s_setprio(1); _Pragma("unroll") for (int m = 0; m < 4; ++m) _Pragma("unroll") for (int n = 0; n < 2; ++n) { \
        if constexpr (F8) acc[ai][bj][m][n] = __builtin_amdgcn_mfma_scale_f32_16x16x128_f8f6f4(__builtin_bit_cast(v8i, PG8_V8(Bt_[n])), __builtin_bit_cast(v8i, PG8_V8(At[m])), acc[ai][bj][m][n], 0, 0, 0, sclB, 0, sclA); \
        else { _Pragma("unroll") for (int k = 0; k < 2; ++k) acc[ai][bj][m][n] = __builtin_amdgcn_mfma_f32_16x16x32_bf16(Bt_[n][k], At[m][k], acc[ai][bj][m][n], 0, 0, 0); } } __builtin_amdgcn_s_setprio(0); } while (0)
#define PG8_WAIT_V(n) asm volatile("s_waitcnt vmcnt(" #n ")" ::: "memory")
#define PG8_WAIT_L(n) asm volatile("s_waitcnt lgkmcnt(" #n ")" ::: "memory")
#define PG8_BAR __builtin_amdgcn_s_barrier()
#define PG8_SCHED __builtin_amdgcn_sched_barrier(0)
#define PG8_TBL(u, bf) __builtin_amdgcn_raw_ptr_buffer_load_lds(rT, (LAS void*)(lds + RI_OFF + ((bf) * 2 + wr) * 4096 + wc * 1024), 16, (unsigned)lane * 16u, S.tbl_off(u) + (unsigned)wc * 1024u, 0, 0)
#define PG8_AOFFS(u, ao) do { _Pragma("unroll") for (int _i = 0; _i < 2; ++_i) { int _R, _C; stage_rc(opaque_tid(wid) * 16 + _i * 8192, _R, _C); _Pragma("unroll") for (int _h = 0; _h < 2; ++_h) \
        ao[_h][_i] = (unsigned)S.src_row(u, _h * HALF + _R) * (unsigned)ldab + (unsigned)_C * 2u; } } while (0)
    Unit cur, nxt; int ui = 0;
    if (!S.next(0, cur)) return;
    f32x4 acc[2][2][4][2];
#pragma unroll
    for (int a = 0; a < 2; ++a)
#pragma unroll
        for (int b = 0; b < 2; ++b)
#pragma unroll
            for (int m = 0; m < 4; ++m)
#pragma unroll
                for (int n = 0; n < 2; ++n) acc[a][b][m][n] = (f32x4){0.f, 0.f, 0.f, 0.f};
    bf16x8 At[4][2], B0[2][2], B1[2][2];
    unsigned aoc[2][2], aon[2][2];
    PG8_AOFFS(cur, aoc);
    unsigned sA = (unsigned)cur.kt0 * kstep;
    unsigned sB = (unsigned)(S.b_off(cur) * 2) + (unsigned)cur.pn * tstep + (unsigned)cur.kt0 * kstep;
    PG8_TBL(cur, 0);
    PG8_STAGE(PG8_SB(0, 0), rB, sB, voffB); PG8_STAGE(PG8_SB(0, 1), rB, sB + hstep, voffB); PG8_STAGE(PG8_SA(0, 0), rA, sA, aoc[0]); PG8_STAGE(PG8_SA(0, 1), rA, sA, aoc[1]);
    if (wr == 1) PG8_BAR;
    PG8_WAIT_V(2); PG8_BAR;
    PG8_STAGE(PG8_SB(1, 0), rB, sB + kstep, voffB); PG8_STAGE(PG8_SA(1, 0), rA, sA + kstep, aoc[0]); PG8_STAGE(PG8_SB(1, 1), rB, sB + hstep + kstep, voffB);
    PG8_WAIT_V(6); PG8_BAR;
    for (;;) {
        const bool has_next = S.next(ui + 1, nxt);
        if (has_next) { PG8_AOFFS(nxt, aon); } else {
#pragma unroll
            for (int h = 0; h < 2; ++h)
#pragma unroll
                for (int i = 0; i < 2; ++i) aon[h][i] = aoc[h][i]; }
        const unsigned nsB = has_next ? (unsigned)(S.b_off(nxt) * 2) + (unsigned)nxt.pn * tstep + (unsigned)nxt.kt0 * kstep : sB;
        const unsigned nsA = has_next ? (unsigned)nxt.kt0 * kstep : sA;
        const int nt = cur.nkt; int tsel = has_next ? 0 : -2; asm volatile("" : "+s"(tsel));
        for (int t = 0; t < nt; t += 2) {
            const bool last = (t == nt - 2);
            const unsigned a1 = sA + (unsigned)(t + 1) * kstep;
            const unsigned a2 = last ? nsA : sA + (unsigned)(t + 2) * kstep, b2 = last ? nsB : sB + (unsigned)(t + 2) * kstep;
            const unsigned a3 = a2 + kstep, b3 = b2 + kstep;
            PG8_LDB(B0, 0, 0); PG8_LDB(B1, 0, 1); PG8_SCHED; PG8_LDA(At, 0, 0); PG8_STAGE(PG8_SA(1, 1), rA, a1, aoc[1]);
            if (last) {
#pragma unroll
                for (int h = 0; h < 2; ++h)
#pragma unroll
                    for (int i = 0; i < 2; ++i) aoc[h][i] = aon[h][i]; }
            PG8_WAIT_V(8); PG8_WAIT_L(0); PG8_BAR; PG8_MMA(0, 0, At, B0); PG8_MMA(0, 1, At, B1); PG8_BAR; PG8_SCHED;
            PG8_LDA(At, 0, 1); if (t == tsel) PG8_TBL(nxt, (ui + 1) & 1);
            PG8_STAGE(PG8_SB(0, 0), rB, b2, voffB); PG8_STAGE(PG8_SB(0, 1), rB, b2 + hstep, voffB); PG8_STAGE(PG8_SA(0, 0), rA, a2, aoc[0]);
            PG8_WAIT_V(8); PG8_WAIT_L(0); PG8_BAR; PG8_MMA(1, 0, At, B0); PG8_MMA(1, 1, At, B1); PG8_BAR; PG8_SCHED;
            PG8_LDB(B0, 1, 0); PG8_LDB(B1, 1, 1); PG8_SCHED; PG8_LDA(At, 1, 0); PG8_STAGE(PG8_SA(0, 1), rA, a2, aoc[1]);
            PG8_WAIT_V(8); PG8_WAIT_L(0); PG8_BAR; PG8_MMA(0, 0, At, B0); PG8_MMA(0, 1, At, B1); PG8_BAR; PG8_SCHED;
            PG8_LDA(At, 1, 1); PG8_STAGE(PG8_SB(1, 0), rB, b3, voffB); PG8_STAGE(PG8_SB(1, 1), rB, b3 + hstep, voffB); PG8_STAGE(PG8_SA(1, 0), rA, a3, aoc[0]);
            PG8_WAIT_V(8); PG8_WAIT_L(0); PG8_BAR; PG8_MMA(1, 0, At, B0); PG8_MMA(1, 1, At, B1); PG8_BAR; PG8_SCHED;
        }
        if constexpr (ALIGN_EPI) { if (wr == 0) PG8_BAR; }
        if (!noepi) E(acc, cur, wr, wc, fr, fq, (const LAS f32x4*)(lds + RI_OFF + ((ui & 1) * 2 + wr) * 4096));
        if (!has_next) break;
#pragma unroll
        for (int a = 0; a < 2; ++a)
#pragma unroll
            for (int b = 0; b < 2; ++b)
#pragma unroll
                for (int m = 0; m < 4; ++m)
#pragma unroll
                    for (int n = 0; n < 2; ++n) acc[a][b][m][n] = (f32x4){0.f, 0.f, 0.f, 0.f};
        cur = nxt; sB = nsB; sA = nsA; ++ui;
        if constexpr (ALIGN_EPI) { if (wr == 1) PG8_BAR; }
    }
    PG8_WAIT_V(0);
    if constexpr (!ALIGN_EPI) { if (wr == 0) PG8_BAR; }
    PG8_BAR;
#undef PG8_SA
#undef PG8_SB
#undef PG8_STAGE
#undef PG8_LDA
#undef PG8_LDB
#undef PG8_MMA
#undef PG8_V8
#undef PG8_WAIT_V
#undef PG8_WAIT_L
#undef PG8_BAR
#undef PG8_SCHED
#undef PG8_AOFFS
#undef PG8_TBL
}
}

namespace cg = cooperative_groups;
constexpr int NTHREADS = 512, NWAVES = 8;
constexpr int LDS_BYTES = 163840;
constexpr int LDS_TB = LDS_BYTES - 1024;
constexpr int LDS_PTR = LDS_TB + 256;
constexpr int LDS_BST = LDS_PTR + 256;

struct Params {
    const float* in[23];
    float* out; unsigned char* ws;
    unsigned mask; int probe;
};
enum { I_X = 0, I_EMIXN, I_EWIN, I_ECONVW, I_ELNG, I_ELNB, I_EWSP, I_EBSP, I_EWOUT, I_EFFNN, I_EWGATE, I_EWUP, I_EWDOWN, I_OMIXN, I_OWQKV, I_OQN, I_OKN, I_OWO, I_OFFNN, I_OWR, I_OWGATE, I_OWUP, I_OWDOWN, I_OUT, I_WS };
struct Ctx { LAS unsigned char* lds; int wid, bid, G; bool noepi;
    template <class Tp> __device__ __forceinline__ Tp* ptr(int i) const { const unsigned long long v = ((const volatile LAS unsigned long long*)(lds + LDS_PTR))[i];
        const unsigned lo = __builtin_amdgcn_readfirstlane((unsigned)v), hi = __builtin_amdgcn_readfirstlane((unsigned)(v >> 32)); return (Tp*)(((unsigned long long)hi << 32) | lo); }
    __device__ __forceinline__ const float* in(int i) const { return ptr<const float>(i); }
    __device__ __forceinline__ unsigned char* ws() const { return ptr<unsigned char>(I_WS); }
    __device__ __forceinline__ float* out() const { return ptr<float>(I_OUT); }
};

#define XB_TMO      128
#define XB_XCNT(j)  (256  + 64 * (j))
#define XB_XSUB(j)  (1280 + 64 * (j))
#define XB_XGEN(j)  (2304 + 64 * (j))
#define XB_TOP      3328
#define XB_TOPGEN   3392
#define XCD_BAR_WORDS 3456
#define XB_SPIN_CAP (1u << 20)
__device__ __forceinline__ unsigned xb_ld(unsigned* p)              { return __hip_atomic_load(p, __ATOMIC_RELAXED, __HIP_MEMORY_SCOPE_AGENT); }
__device__ __forceinline__ unsigned xb_add(unsigned* p, unsigned v) { return __hip_atomic_fetch_add(p, v, __ATOMIC_RELAXED, __HIP_MEMORY_SCOPE_AGENT); }
__device__ __forceinline__ unsigned xb_xcc_id() { return (unsigned)__builtin_amdgcn_s_getreg((3 << 11) | 20) & 0xFu; }
#define XB_SPIN(cond, bar) do { unsigned _sp = 0; while (cond) { __builtin_amdgcn_s_sleep(1); \
    if ((++_sp & 255u) == 0u) { if (xb_ld(&(bar)[XB_TMO])) break; if (_sp > XB_SPIN_CAP) { atomicAdd(&(bar)[XB_TMO], 1u); break; } } } } while (0)
__device__ __forceinline__ void xcd_barrier_complete(unsigned* bar, unsigned x, unsigned G, unsigned& nloc, unsigned& nx) {
    unsigned sum, cnt, mine, sp = 0u;
    for (;;) {
        sum = 0u; cnt = 0u; mine = 0u;
#pragma unroll
        for (unsigned j = 0; j < 16; ++j) { const unsigned c = xb_ld(&bar[XB_XCNT(j)]); sum += c; cnt += (c > 0u) ? 1u : 0u; mine = (j == x) ? c : mine; }
        if (sum == G) break;
        __builtin_amdgcn_s_sleep(1);
        if ((++sp & 255u) == 0u) { if (xb_ld(&bar[XB_TMO])) break; if (sp > XB_SPIN_CAP) { atomicAdd(&bar[XB_TMO], 1u); break; } }
    }
    nloc = mine > 0u ? mine : 1u; nx = cnt > 0u ? cnt : 1u;
}
__device__ __forceinline__ void grid_barrier(const Ctx& C) {
    asm volatile("s_waitcnt vmcnt(0)" ::: "memory");
    __syncthreads();
    if (opaque_tid(C.wid) == 0) {
        unsigned* bar = (unsigned*)C.ws() + CW_BAR; volatile LAS unsigned* st = (volatile LAS unsigned*)(C.lds + LDS_BST); const unsigned x = xb_xcc_id();
        __builtin_amdgcn_s_waitcnt(0);
        unsigned nloc = st[0], nx = st[1];
        if (nloc == 0u) { xcd_barrier_complete(bar, x, (unsigned)C.G, nloc, nx); st[0] = nloc; st[1] = nx; }
        const unsigned old = xb_add(&bar[XB_XSUB(x)], 1u);
        const unsigned gen = old / nloc;
        if (old + 1u == (gen + 1u) * nloc) {
            __builtin_amdgcn_fence(__ATOMIC_RELEASE, "agent");
            asm volatile("s_waitcnt vmcnt(0)" ::: "memory");
            const unsigned og = xb_add(&bar[XB_TOP], 1u);
            const unsigned tg = og / nx;
            if (og + 1u == (tg + 1u) * nx) xb_add(&bar[XB_TOPGEN], 1u);
            else XB_SPIN(xb_ld(&bar[XB_TOPGEN]) == tg, bar);
            __builtin_amdgcn_fence(__ATOMIC_ACQUIRE, "agent");
            xb_add(&bar[XB_XGEN(x)], 1u);
            asm volatile("s_waitcnt vmcnt(0)" ::: "memory");
        } else {
            XB_SPIN(xb_ld(&bar[XB_XGEN(x)]) == gen, bar);
            __builtin_amdgcn_fence(__ATOMIC_ACQUIRE, "agent");
            asm volatile("s_waitcnt vmcnt(0)" ::: "memory");
        }
    }
    __syncthreads();
}

__device__ __forceinline__ void p0_transpose_item(const float* W, int K, int N, bf16_t* WT, const float* fold, int inter, int which, LAS float* scr, int item, int lane) {
    const int nblk = N / 32, kb = item / nblk, nb = item % nblk, k0 = 64 * kb, n0 = 32 * nb;
    const int kr = lane >> 3, c4 = lane & 7; f32x4 v[8]; float f[8];
#pragma unroll
    for (int i = 0; i < 8; ++i) v[i] = *(const f32x4*)(W + (size_t)(k0 + 8 * i + kr) * N + n0 + 4 * c4);
#pragma unroll
    for (int i = 0; i < 8; ++i) f[i] = fold ? fold[k0 + 8 * i + kr] : 1.0f;
#pragma unroll
    for (int i = 0; i < 8; ++i) { LAS float* d = scr + (8 * i + kr) * 33 + 4 * c4; d[0] = v[i][0] * f[i]; d[1] = v[i][1] * f[i]; d[2] = v[i][2] * f[i]; d[3] = v[i][3] * f[i]; }
    asm volatile("s_waitcnt lgkmcnt(0)" ::: "memory");
    const int c = lane & 7;
#pragma unroll
    for (int j = 0; j < 4; ++j) { const int nl = (lane >> 3) + 8 * j, n = n0 + nl; const LAS float* sp = scr + (8 * c) * 33 + nl;
        u32x4 o; o.x = pk2(sp[0 * 33], sp[1 * 33]); o.y = pk2(sp[2 * 33], sp[3 * 33]); o.z = pk2(sp[4 * 33], sp[5 * 33]); o.w = pk2(sp[6 * 33], sp[7 * 33]);
        const int dr = inter ? (n / 128) * 256 + which * 128 + (n % 128) : n;
        *(u32x4*)(WT + (size_t)dr * K + k0 + 8 * c) = o; }
    asm volatile("s_waitcnt lgkmcnt(0)" ::: "memory");
}
__device__ __forceinline__ void p0_transpose_item8(const float* W, int K, int N, unsigned char* WT, const float* fold, int inter, int which, LAS float* scr, int item, int lane) {
    const int nblk = N / 32, kb = item / nblk, nb = item % nblk, k0 = 64 * kb, n0 = 32 * nb;
    const int kr = lane >> 3, c4 = lane & 7; f32x4 v[8]; float f[8];
#pragma unroll
    for (int i = 0; i < 8; ++i) v[i] = *(const f32x4*)(W + (size_t)(k0 + 8 * i + kr) * N + n0 + 4 * c4);
#pragma unroll
    for (int i = 0; i < 8; ++i) f[i] = (fold ? fold[k0 + 8 * i + kr] : 1.0f) * 64.0f;
#pragma unroll
    for (int i = 0; i < 8; ++i) { LAS float* d = scr + (8 * i + kr) * 33 + 4 * c4; d[0] = v[i][0] * f[i]; d[1] = v[i][1] * f[i]; d[2] = v[i][2] * f[i]; d[3] = v[i][3] * f[i]; }
    asm volatile("s_waitcnt lgkmcnt(0)" ::: "memory");
    const int c = lane & 7;
#pragma unroll
    for (int j = 0; j < 4; ++j) { const int nl = (lane >> 3) + 8 * j, n = n0 + nl; const LAS float* sp = scr + (8 * c) * 33 + nl;
        u32x2 o; o.x = pk_fp8x4(sp[0 * 33], sp[1 * 33], sp[2 * 33], sp[3 * 33]); o.y = pk_fp8x4(sp[4 * 33], sp[5 * 33], sp[6 * 33], sp[7 * 33]);
        const int dr = inter ? (n / 128) * 256 + which * 128 + (n % 128) : n;
        *(u32x2*)(WT + (size_t)dr * K + k0 + 8 * c) = o; }
    asm volatile("s_waitcnt lgkmcnt(0)" ::: "memory");
}
constexpr int CW_CVT = 960, CW_DONE = 976;
constexpr int CV_IMG = (D / 64) * (FE / 32), CV_IMD = (FE / 64) * (D / 32), CV_NITEMS = NE * (2 * CV_IMG + CV_IMD), CV_BATCH = 2 * NWAVES;
constexpr int CV_SCR = 2 * 64 * 33 * 4, CV_BC = NWAVES * CV_SCR;
static_assert(CV_BC + 64 <= LDS_TB, "cvt LDS map");
struct CvItem { const float* W; unsigned char* WT; const float* fold; int K, N, inter, which, k0, n0; };
__device__ __forceinline__ CvItem cv_decode(const Ctx& C, int r) {
    CvItem it; unsigned char* ws = C.ws(); int item;
    if (r < 2 * NE * CV_IMG) { const int which = r >= NE * CV_IMG ? 1 : 0, rr = r - which * NE * CV_IMG, e = rr / CV_IMG; item = rr % CV_IMG;
        it.W = C.in(which ? I_OWUP : I_OWGATE) + (size_t)e * D * FE; it.K = D; it.N = FE; it.WT = ws + WS_MGU + (size_t)e * NGUE * D; it.fold = C.in(I_OFFNN); it.inter = 1; it.which = which; }
    else { const int rr = r - 2 * NE * CV_IMG, e = rr / CV_IMD; item = rr % CV_IMD;
        it.W = C.in(I_OWDOWN) + (size_t)e * FE * D; it.K = FE; it.N = D; it.WT = ws + WS_MDN + (size_t)e * D * FE; it.fold = nullptr; it.inter = 0; it.which = 0; }
    const int nblk = it.N / 32; it.k0 = 64 * (item / nblk); it.n0 = 32 * (item % nblk);
    return it;
}
__device__ __forceinline__ void cv_load(const CvItem& it, int lane, f32x4 (&v)[8], float (&f)[8]) {
    const int kr = lane >> 3, c4 = lane & 7;
#pragma unroll
    for (int i = 0; i < 8; ++i) v[i] = *(const f32x4*)(it.W + (size_t)(it.k0 + 8 * i + kr) * it.N + it.n0 + 4 * c4);
#pragma unroll
    for (int i = 0; i < 8; ++i) f[i] = (it.fold ? it.fold[it.k0 + 8 * i + kr] : 1.0f) * 64.0f;
}
__device__ __forceinline__ void cv_finish(const CvItem& it, int lane, const f32x4 (&v)[8], const float (&f)[8], LAS float* scr) {
    const int kr = lane >> 3, c4 = lane & 7;
#pragma unroll
    for (int i = 0; i < 8; ++i) { LAS float* d = scr + (8 * i + kr) * 33 + 4 * c4; d[0] = v[i][0] * f[i]; d[1] = v[i][1] * f[i]; d[2] = v[i][2] * f[i]; d[3] = v[i][3] * f[i]; }
    asm volatile("s_waitcnt lgkmcnt(0)" ::: "memory");
    const int c = lane & 7;
#pragma unroll
    for (int j = 0; j < 4; ++j) { const int nl = (lane >> 3) + 8 * j, n = it.n0 + nl; const LAS float* sp = scr + (8 * c) * 33 + nl;
        u32x2 o; o.x = pk_fp8x4(sp[0 * 33], sp[1 * 33], sp[2 * 33], sp[3 * 33]); o.y = pk_fp8x4(sp[4 * 33], sp[5 * 33], sp[6 * 33], sp[7 * 33]);
        const int dr = it.inter ? (n / 128) * 256 + it.which * 128 + (n % 128) : n;
        *(u32x2*)(it.WT + (size_t)dr * it.K + it.k0 + 8 * c) = o; }
}
__device__ __forceinline__ void moe_cvt_fill(const Ctx& C, int slot, unsigned stop) {
    unsigned* ctl = (unsigned*)C.ws();
    const int tid = opaque_tid(C.wid), lane = tid & 63, wave = C.wid;
    LAS float* scr = (LAS float*)(C.lds + wave * CV_SCR); volatile LAS unsigned* bc = (volatile LAS unsigned*)(C.lds + CV_BC);
    __syncthreads();
    if (tid == 0) { unsigned d = 0u; if (slot >= 0) d = xb_add(&ctl[CW_DONE + 16 * slot], 1u) + 1u; bc[0] = (slot >= 0 && d >= stop) ? 0xffffffffu : xb_add(&ctl[CW_CVT], (unsigned)CV_BATCH); }
    __syncthreads();
    unsigned base = bc[0]; int par = 0;
    while (base < (unsigned)CV_NITEMS) {
        unsigned nxt = 0u, dn = 0u;
        if (tid == 0) { nxt = xb_add(&ctl[CW_CVT], (unsigned)CV_BATCH); if (slot >= 0) dn = xb_ld(&ctl[CW_DONE + 16 * slot]); }
        const int r0 = (int)base + wave, r1 = r0 + NWAVES;
        const CvItem a = cv_decode(C, r0); f32x4 va[8]; float fa[8]; cv_load(a, lane, va, fa);
        if (r1 < CV_NITEMS) { const CvItem b = cv_decode(C, r1); f32x4 vb[8]; float fb[8]; cv_load(b, lane, vb, fb);
            cv_finish(a, lane, va, fa, scr); cv_finish(b, lane, vb, fb, scr + 64 * 33); }
        else cv_finish(a, lane, va, fa, scr);
        par ^= 1;
        if (tid == 0) bc[par] = nxt, bc[2 + par] = dn;
        __syncthreads();
        base = bc[par]; const unsigned dseen = bc[2 + par];
        if (slot >= 0 && dseen >= stop) {
            if (base < (unsigned)CV_NITEMS) { const int q0 = (int)base + wave, q1 = q0 + NWAVES;
                const CvItem a2 = cv_decode(C, q0); f32x4 v2[8]; float f2[8]; cv_load(a2, lane, v2, f2);
                if (q1 < CV_NITEMS) { const CvItem b2 = cv_decode(C, q1); f32x4 v3[8]; float f3[8]; cv_load(b2, lane, v3, f3); cv_finish(a2, lane, v2, f2, scr); cv_finish(b2, lane, v3, f3, scr + 64 * 33); }
                else cv_finish(a2, lane, v2, f2, scr); }
            break; }
    }
}
__device__ __forceinline__ void phase_prep(const Ctx& C) {
    LAS unsigned char* lds = C.lds; const int bid = C.bid, G = C.G; unsigned char* ws = C.ws(); const int tid = opaque_tid(C.wid), lane = tid & 63, wave = C.wid;
    const int gw = bid * NWAVES + wave, NGW = G * NWAVES;
    LAS float* scr = (LAS float*)(lds + wave * 16384);
    constexpr int I_IN = (D / 64) * (NPROJ / 32), I_OUT = (D / 64) * (D / 32), I_G = (D / 64) * (FF / 32), I_DN = (FF / 64) * (D / 32), I_QKV = (D / 64) * (NQKV / 32);
    constexpr int NITEMS = I_IN + I_OUT + 2 * I_G + I_DN + I_QKV + I_OUT;
    for (int it = gw; it < NITEMS; it += NGW) {
        int r = it;
        if (r < I_IN) { p0_transpose_item(C.in(I_EWIN), D, NPROJ, (bf16_t*)(ws + WS_WIN), C.in(I_EMIXN), 0, 0, scr, r, lane); continue; } r -= I_IN;
        if (r < I_OUT) { p0_transpose_item(C.in(I_EWOUT), D, D, (bf16_t*)(ws + WS_WOUT), nullptr, 0, 0, scr, r, lane); continue; } r -= I_OUT;
        if (r < I_G) { p0_transpose_item(C.in(I_EWGATE), D, FF, (bf16_t*)(ws + WS_WGU), C.in(I_EFFNN), 1, 0, scr, r, lane); continue; } r -= I_G;
        if (r < I_G) { p0_transpose_item(C.in(I_EWUP), D, FF, (bf16_t*)(ws + WS_WGU), C.in(I_EFFNN), 1, 1, scr, r, lane); continue; } r -= I_G;
        if (r < I_DN) { p0_transpose_item(C.in(I_EWDOWN), FF, D, (bf16_t*)(ws + WS_WDN), nullptr, 0, 0, scr, r, lane); continue; } r -= I_DN;
        if (r < I_QKV) { p0_transpose_item(C.in(I_OWQKV), D, NQKV, (bf16_t*)(ws + WS_WQKV), C.in(I_OMIXN), 0, 0, scr, r, lane); continue; } r -= I_QKV;
        { p0_transpose_item(C.in(I_OWO), D, D, (bf16_t*)(ws + WS_WO), nullptr, 0, 0, scr, r, lane); }
    }
    bf16_t* xb = (bf16_t*)(ws + WS_ARENA + AR_XB); float* ss0 = (float*)(ws + WS_SS0); const float* xin = C.in(I_X);
    for (int row = gw; row < T; row += NGW) {
        const f32x4* xr = (const f32x4*)(xin + (size_t)row * D) + lane; float sq = 0.f; u32x2* o = (u32x2*)(xb + (size_t)row * D) + lane;
#pragma unroll
        for (int j = 0; j < 4; ++j) { const f32x4 v = xr[64 * j]; sq += (v[0] * v[0] + v[1] * v[1]) + (v[2] * v[2] + v[3] * v[3]); u32x2 w; w.x = pk2(v[0], v[1]); w.y = pk2(v[2], v[3]); o[64 * j] = w; }
        sq = wave_sum(sq);
        if (lane < NSS) ss0[(size_t)row * NSS + lane] = (lane == 0) ? sq : 0.f;
    }
    { float* km = (float*)(ws + WS_KMEAN); for (int i = bid * NTHREADS + tid; i < NBATCH * NH * NBLK * HD; i += G * NTHREADS) km[i] = 0.f; }
    float* tab = (float*)(ws + WS_ROPE);
    for (int i = bid * NTHREADS + tid; i < SEQ * 16; i += G * NTHREADS) { const int sp = i / 16, f = i % 16; const double inv = pow(500000.0, -(double)f / 16.0); const double ang = (double)sp * inv;
        tab[2 * i] = (float)cos(ang); tab[2 * i + 1] = (float)sin(ang); }
}

constexpr int MX_VROW = 520, MX_MU = 256 * MX_VROW;
__device__ __forceinline__ void phase_mixer(const Ctx& C) {
    LAS unsigned char* lds = C.lds; const int bid = C.bid, G = C.G; unsigned char* ws = C.ws();
    const float* conv_w = C.in(I_ECONVW); const float* ln_g = C.in(I_ELNG); const float* ln_b = C.in(I_ELNB); const float* w_sp = C.in(I_EWSP); const float* b_sp = C.in(I_EBSP);
    const bf16_t* proj = (const bf16_t*)(ws + WS_ARENA + AR_PROJ); bf16_t* y = (bf16_t*)(ws + WS_ARENA + AR_Y);
    LAS float* mu = (LAS float*)(lds + MX_MU); LAS float* rstd = mu + 128;
    const int tid = opaque_tid(C.wid), lane = tid & 63, wave = C.wid, r31 = lane & 31, hh = lane >> 5;
    for (int unit = bid; unit < (T / 128) * 2; unit += G) {
        const int c = unit >> 1, hf = unit & 1, t0 = c * 128;
        { u32x4 vv[16];
#pragma unroll
          for (int i = 0; i < 16; ++i) vv[i] = *(const u32x4*)(proj + (size_t)(t0 + wave * 16 + i) * NPROJ + 3 * CONV + GM + lane * 8);
#pragma unroll
          for (int i = 0; i < 16; ++i) { const int sl = wave * 16 + i; const u32x4 v = vv[i];
            const float x0 = bf2f(v.x & 0xffffu), x1 = __builtin_bit_cast(float, v.x & 0xffff0000u), x2 = bf2f(v.y & 0xffffu), x3 = __builtin_bit_cast(float, v.y & 0xffff0000u),
                        x4 = bf2f(v.z & 0xffffu), x5 = __builtin_bit_cast(float, v.z & 0xffff0000u), x6 = bf2f(v.w & 0xffffu), x7 = __builtin_bit_cast(float, v.w & 0xffff0000u);
            float sm = ((x0 + x1) + (x2 + x3)) + ((x4 + x5) + (x6 + x7)), sq = ((x0 * x0 + x1 * x1) + (x2 * x2 + x3 * x3)) + ((x4 * x4 + x5 * x5) + (x6 * x6 + x7 * x7));
            sm = wave_sum(sm); sq = wave_sum(sq); const float m = sm * (1.0f / GM), var = sq * (1.0f / GM) - m * m;
            if (lane == 0) { mu[sl] = m; rstd[sl] = rsqrtf(fmaxf(var, 0.f) + EPS); } } }
        { const int co = tid & 31, sg = tid >> 5, ch = 256 * hf + 8 * co; float w0[8], w1[8], w2[8];
#pragma unroll
          for (int j = 0; j < 8; ++j) { w0[j] = conv_w[ch + j]; w1[j] = conv_w[CONV + ch + j]; w2[j] = conv_w[2 * CONV + ch + j]; }
          float zm2[8], zm1[8];
#pragma unroll
          for (int j = 0; j < 8; ++j) { zm2[j] = 0.f; zm1[j] = 0.f; }
#pragma unroll
          for (int i = -2; i < 8; ++i) { const int t = t0 + 8 * sg + i; const bool inseq = (i >= 0) || ((t0 + 8 * sg) % SEQ != 0);
              const bf16_t* pr = proj + (size_t)(inseq ? t : t0) * NPROJ + ch; const u32x4 ah = *(const u32x4*)pr, ac = *(const u32x4*)(pr + CONV);
              float z[8];
              z[0] = bf2f(ah.x & 0xffffu) * bf2f(ac.x & 0xffffu); z[1] = __builtin_bit_cast(float, ah.x & 0xffff0000u) * __builtin_bit_cast(float, ac.x & 0xffff0000u);
              z[2] = bf2f(ah.y & 0xffffu) * bf2f(ac.y & 0xffffu); z[3] = __builtin_bit_cast(float, ah.y & 0xffff0000u) * __builtin_bit_cast(float, ac.y & 0xffff0000u);
              z[4] = bf2f(ah.z & 0xffffu) * bf2f(ac.z & 0xffffu); z[5] = __builtin_bit_cast(float, ah.z & 0xffff0000u) * __builtin_bit_cast(float, ac.z & 0xffff0000u);
              z[6] = bf2f(ah.w & 0xffffu) * bf2f(ac.w & 0xffffu); z[7] = __builtin_bit_cast(float, ah.w & 0xffff0000u) * __builtin_bit_cast(float, ac.w & 0xffff0000u);
              if (!inseq) {
#pragma unroll
                  for (int j = 0; j < 8; ++j) z[j] = 0.f; }
              if (i >= 0) { const u32x4 ab = *(const u32x4*)(pr + 2 * CONV); float o[8];
#pragma unroll
                  for (int j = 0; j < 8; ++j) o[j] = w0[j] * zm2[j] + w1[j] * zm1[j] + w2[j] * z[j];
                  u32x4 w; w.x = pk2(bf2f(ab.x & 0xffffu) * o[0], __builtin_bit_cast(float, ab.x & 0xffff0000u) * o[1]); w.y = pk2(bf2f(ab.y & 0xffffu) * o[2], __builtin_bit_cast(float, ab.y & 0xffff0000u) * o[3]);
                  w.z = pk2(bf2f(ab.z & 0xffffu) * o[4], __builtin_bit_cast(float, ab.z & 0xffff0000u) * o[5]); w.w = pk2(bf2f(ab.w & 0xffffu) * o[6], __builtin_bit_cast(float, ab.w & 0xffff0000u) * o[7]);
                  *(u32x4*)(y + (size_t)t * D + ch) = w; }
#pragma unroll
              for (int j = 0; j < 8; ++j) { zm2[j] = zm1[j]; zm1[j] = z[j]; } } }
        __syncthreads();
#pragma unroll
        for (int i = 0; i < 4; ++i) { const int v = tid + 512 * i, sq4 = v >> 6, cq = v & 63, chl = 4 * cq, chg = 256 * hf + chl; const bf16_t* src = proj + (size_t)(t0 + 4 * sq4) * NPROJ + 3 * CONV + GM + chg;
            const f32x4 gg = *(const f32x4*)(ln_g + chg), bb = *(const f32x4*)(ln_b + chg);
            unsigned e[4][4];
#pragma unroll
            for (int r = 0; r < 4; ++r) { const u32x2 rv = *(const u32x2*)(src + (size_t)r * NPROJ); const float m = mu[4 * sq4 + r], rs = rstd[4 * sq4 + r];
                e[r][0] = f2bf((bf2f(rv.x & 0xffffu) - m) * rs * gg[0] + bb[0]); e[r][1] = f2bf((__builtin_bit_cast(float, rv.x & 0xffff0000u) - m) * rs * gg[1] + bb[1]);
                e[r][2] = f2bf((bf2f(rv.y & 0xffffu) - m) * rs * gg[2] + bb[2]); e[r][3] = f2bf((__builtin_bit_cast(float, rv.y & 0xffff0000u) - m) * rs * gg[3] + bb[3]); }
            LAS unsigned char* dst = lds + chl * MX_VROW + sq4 * 8;
#pragma unroll
            for (int d = 0; d < 4; ++d) { u32x2 w; w.x = e[0][d] | (e[1][d] << 16); w.y = e[2][d] | (e[3][d] << 16); *(LAS u32x2*)(dst + d * MX_VROW) = w; } }
        __syncthreads();
        { const int gl = wave >> 1, dt = wave & 1, g = 4 * hf + gl, chl = 64 * gl + 32 * dt + r31;
          bf16x8 bfr[8];
#pragma unroll
          for (int ks = 0; ks < 8; ++ks) { const LAS unsigned char* vp = lds + chl * MX_VROW + (16 * ks + 8 * hh) * 2; const u32x2 v0 = *(const LAS u32x2*)vp, v1 = *(const LAS u32x2*)(vp + 8);
              u32x4 w; w.x = v0.x; w.y = v0.y; w.z = v1.x; w.w = v1.y; bfr[ks] = __builtin_bit_cast(bf16x8, w); }
#pragma unroll
          for (int tt = 0; tt < 4; ++tt) { f32x16 acc;
#pragma unroll
              for (int i = 0; i < 16; ++i) acc[i] = 0.f;
              const int trow = 32 * tt + r31; const float* wrow = w_sp + ((size_t)g * 128 + trow) * 128 + 8 * hh;
#pragma unroll
              for (int ks = 0; ks < 8; ++ks) if (ks < 2 * tt + 2) { const f32x4 a0 = *(const f32x4*)(wrow + 16 * ks), a1 = *(const f32x4*)(wrow + 16 * ks + 4); float av[8] = {a0[0], a0[1], a0[2], a0[3], a1[0], a1[1], a1[2], a1[3]};
                  if (ks >= 2 * tt) {
#pragma unroll
                      for (int j = 0; j < 8; ++j) if (16 * ks + 8 * hh + j > trow) av[j] = 0.f; }
                  u32x4 w; w.x = pk2(av[0], av[1]); w.y = pk2(av[2], av[3]); w.z = pk2(av[4], av[5]); w.w = pk2(av[6], av[7]);
                  acc = __builtin_amdgcn_mfma_f32_32x32x16_bf16(bfr[ks], __builtin_bit_cast(bf16x8, w), acc, 0, 0, 0); }
              const int chg0 = 256 * hf + 64 * gl + 32 * dt + 4 * hh, t = t0 + trow; const float bias = b_sp[g * 128 + trow];
              const bf16_t* gp = proj + (size_t)t * NPROJ + 3 * CONV + chg0; bf16_t* yp = y + (size_t)t * D + CONV + chg0;
#pragma unroll
              for (int g4 = 0; g4 < 4; ++g4) { const u32x2 gu = *(const u32x2*)(gp + 8 * g4); u32x2 o;
                  o.x = pk2(bf2f(gu.x & 0xffffu) * (acc[4 * g4 + 0] + bias), __builtin_bit_cast(float, gu.x & 0xffff0000u) * (acc[4 * g4 + 1] + bias));
                  o.y = pk2(bf2f(gu.y & 0xffffu) * (acc[4 * g4 + 2] + bias), __builtin_bit_cast(float, gu.y & 0xffff0000u) * (acc[4 * g4 + 3] + bias)); *(u32x2*)(yp + 8 * g4) = o; } } }
        __syncthreads();
    }
}

__device__ __forceinline__ void phase_qkprep(const Ctx& C) {
    LAS unsigned char* lds = C.lds; const int bid = C.bid, G = C.G; unsigned char* ws = C.ws(); const float* qn = C.in(I_OQN); const float* kn = C.in(I_OKN);
    bf16_t* qkv = (bf16_t*)(ws + WS_ARENA + AR_QKV); const float* rope = (const float*)(ws + WS_ROPE); float* kmean = (float*)(ws + WS_KMEAN);
    LAS float* red = (LAS float*)lds;
    const int tid = opaque_tid(C.wid), lane = tid & 63, wave = C.wid, c16 = lane & 15, sub = lane >> 4;
    float gq[8], gk[8];
#pragma unroll
    for (int j = 0; j < 8; ++j) { gq[j] = qn[8 * c16 + j]; gk[j] = kn[8 * c16 + j]; }
    for (int item = bid; item < NBATCH * NBLK * NH; item += G) {
        const int h = item % NH, n = (item / NH) % NBLK, b = item / (NH * NBLK); float ks[8];
#pragma unroll
        for (int j = 0; j < 8; ++j) ks[j] = 0.f;
#pragma unroll 4
        for (int it = 0; it < 8; ++it) { const int sq = n * MB + wave * 32 + it * 4 + sub, t = b * SEQ + sq;
            float cs[8], sn[8];
            { const f32x4* rp = (const f32x4*)(rope + (sq * 16 + 8 * (c16 & 1)) * 2); f32x4 r0 = (f32x4){1.f, 0.f, 1.f, 0.f}, r1 = r0, r2 = r0, r3 = r0; if (c16 < 4) { r0 = rp[0]; r1 = rp[1]; r2 = rp[2]; r3 = rp[3]; }
              cs[0] = r0[0]; sn[0] = r0[1]; cs[1] = r0[2]; sn[1] = r0[3]; cs[2] = r1[0]; sn[2] = r1[1]; cs[3] = r1[2]; sn[3] = r1[3];
              cs[4] = r2[0]; sn[4] = r2[1]; cs[5] = r2[2]; sn[5] = r2[3]; cs[6] = r3[0]; sn[6] = r3[1]; cs[7] = r3[2]; sn[7] = r3[3]; }
#pragma unroll
            for (int which = 0; which < 2; ++which) { bf16_t* p = qkv + (size_t)t * NQKV + which * D + h * HD + 8 * c16; const u32x4 raw = *(const u32x4*)p;
                float v[8] = {bf2f(raw.x & 0xffffu), __builtin_bit_cast(float, raw.x & 0xffff0000u), bf2f(raw.y & 0xffffu), __builtin_bit_cast(float, raw.y & 0xffff0000u),
                              bf2f(raw.z & 0xffffu), __builtin_bit_cast(float, raw.z & 0xffff0000u), bf2f(raw.w & 0xffffu), __builtin_bit_cast(float, raw.w & 0xffff0000u)};
                float q = ((v[0] * v[0] + v[1] * v[1]) + (v[2] * v[2] + v[3] * v[3])) + ((v[4] * v[4] + v[5] * v[5]) + (v[6] * v[6] + v[7] * v[7]));
                q += __shfl_xor(q, 1); q += __shfl_xor(q, 2); q += __shfl_xor(q, 4); q += __shfl_xor(q, 8);
                const float r = rsqrtf(q * (1.0f / HD) + EPS);
#pragma unroll
                for (int j = 0; j < 8; ++j) v[j] = v[j] * r * (which ? gk[j] : gq[j]);
#pragma unroll
                for (int j = 0; j < 8; ++j) { const float pt = __shfl_xor(v[j], 2); if (c16 < 2) v[j] = v[j] * cs[j] - pt * sn[j]; else if (c16 < 4) v[j] = v[j] * cs[j] + pt * sn[j]; }
                u32x4 w; w.x = pk2(v[0], v[1]); w.y = pk2(v[2], v[3]); w.z = pk2(v[4], v[5]); w.w = pk2(v[6], v[7]);
                *(u32x4*)p = w;
                if (which) { ks[0] += bf2f(w.x & 0xffffu); ks[1] += __builtin_bit_cast(float, w.x & 0xffff0000u); ks[2] += bf2f(w.y & 0xffffu); ks[3] += __builtin_bit_cast(float, w.y & 0xffff0000u);
                             ks[4] += bf2f(w.z & 0xffffu); ks[5] += __builtin_bit_cast(float, w.z & 0xffff0000u); ks[6] += bf2f(w.w & 0xffffu); ks[7] += __builtin_bit_cast(float, w.w & 0xffff0000u); } } }
#pragma unroll
        for (int j = 0; j < 8; ++j) { ks[j] += __shfl_xor(ks[j], 16); ks[j] += __shfl_xor(ks[j], 32); }
        if (sub == 0) {
#pragma unroll
            for (int j = 0; j < 8; ++j) red[wave * 128 + 8 * c16 + j] = ks[j]; }
        __syncthreads();
        if (tid < 128) { float a = 0.f;
#pragma unroll
            for (int w = 0; w < NWAVES; ++w) a += red[w * 128 + tid];
            kmean[((size_t)(b * NH + h) * NBLK + n) * HD + tid] = a * (1.0f / MB); }
        __syncthreads();
    }
}

__device__ __forceinline__ void phase_select(const Ctx& C, bool probe) {
    const int bid = C.bid, G = C.G; unsigned char* ws = C.ws();
    const bf16_t* qkv = (const bf16_t*)(ws + WS_ARENA + AR_QKV); const float* kmean = (const float*)(ws + WS_KMEAN);
    unsigned* bcnt = (unsigned*)ws + (probe ? 5120 : CW_BKT); int* blist = (int*)(ws + (probe ? WS_ARENA + ((size_t)100 << 20) : WS_BLIST));
    const int tid = opaque_tid(C.wid), lane = tid & 63;
    for (int wt = bid * NWAVES + C.wid; wt < (T / 64) * NH; wt += G * NWAVES) {
        const int h = wt & 7, tg = wt >> 3, t = tg * 64 + lane, b = (tg * 64) / SEQ, sq = t % SEQ, qb = ((tg * 64) % SEQ) / MB;
        if (qb == 0) continue;
        const bf16_t* qp = qkv + (size_t)t * NQKV + h * HD; const float* km = kmean + (size_t)(b * NH + h) * NBLK * HD;
        float acc[NBLK];
#pragma unroll
        for (int n = 0; n < NBLK; ++n) acc[n] = 0.f;
#pragma unroll 4
        for (int ch = 0; ch < 16; ++ch) { const u32x4 raw = *(const u32x4*)(qp + 8 * ch);
            const float q0 = bf2f(raw.x & 0xffffu), q1 = __builtin_bit_cast(float, raw.x & 0xffff0000u), q2 = bf2f(raw.y & 0xffffu), q3 = __builtin_bit_cast(float, raw.y & 0xffff0000u),
                        q4 = bf2f(raw.z & 0xffffu), q5 = __builtin_bit_cast(float, raw.z & 0xffff0000u), q6 = bf2f(raw.w & 0xffffu), q7 = __builtin_bit_cast(float, raw.w & 0xffff0000u);
#pragma unroll
            for (int n = 0; n < NBLK; ++n) { const float* kp = km + n * HD + 8 * ch;
                acc[n] += ((q0 * kp[0] + q1 * kp[1]) + (q2 * kp[2] + q3 * kp[3])) + ((q4 * kp[4] + q5 * kp[5]) + (q6 * kp[6] + q7 * kp[7])); } }
        const int nsel = qb < 3 ? qb : 3; int sel0 = -1, sel1 = -1, sel2 = -1;
#pragma unroll
        for (int j = 0; j < 3; ++j) { float bv = -INFINITY; int bi = 0;
#pragma unroll
            for (int n = 0; n < NBLK - 1; ++n) { const float v = (n < qb) ? acc[n] : -INFINITY; if (v > bv) { bv = v; bi = n; } }
#pragma unroll
            for (int n = 0; n < NBLK - 1; ++n) if (n == bi) acc[n] = -INFINITY;
            if (j < nsel) { if (j == 0) sel0 = bi; if (j == 1) sel1 = bi; if (j == 2) sel2 = bi; } }
        const unsigned long long lt = (1ull << lane) - 1ull; int mytot = 0;
        for (int n = 0; n < qb; ++n) { const int tot = __popcll(__ballot(sel0 == n)) + __popcll(__ballot(sel1 == n)) + __popcll(__ballot(sel2 == n)); if (lane == n) mytot = tot; }
        unsigned mybase = 0; if (lane < qb && mytot > 0) mybase = atomicAdd(bcnt + (b * NH + h) * NBLK + lane, (unsigned)mytot);
        for (int n = 0; n < qb; ++n) { const unsigned long long m0 = __ballot(sel0 == n), m1 = __ballot(sel1 == n), m2 = __ballot(sel2 == n); const int c0 = __popcll(m0), c1 = __popcll(m1);
            const unsigned base = (unsigned)__shfl((int)mybase, n); int j = -1, rank = 0;
            if (sel0 == n) { j = 0; rank = __popcll(m0 & lt); } else if (sel1 == n) { j = 1; rank = c0 + __popcll(m1 & lt); } else if (sel2 == n) { j = 2; rank = c0 + c1 + __popcll(m2 & lt); }
            if (j >= 0) blist[(size_t)((b * NH + h) * NBLK + n) * BKT_CAP + base + rank] = (sq << 2) | j; }
    }
}

constexpr int AT_KS = 0, AT_KROW = 272, AT_VT = 256 * AT_KROW, AT_VROW = 520, AT_CUM = AT_VT + 128 * AT_VROW;
constexpr int AT_OT = AT_CUM + 3072, AT_OTW = 32 * 80;
static_assert(AT_CUM + 540 * 4 <= AT_OT && AT_OT + 8 * AT_OTW <= LDS_TB, "attention LDS map");
constexpr int CW_AQ = 600;
__device__ __forceinline__ void phase_attn(const Ctx& C, bool probe, unsigned pflags) {
    LAS unsigned char* lds = C.lds; unsigned char* ws = C.ws();
    const bf16_t* qkv = (const bf16_t*)(ws + WS_ARENA + AR_QKV); const unsigned* bcnt = (const unsigned*)ws + (probe ? 5120 : CW_BKT); const int* blist = (const int*)(ws + (probe ? WS_ARENA + ((size_t)100 << 20) : WS_BLIST));
    bf16_t* opart = (bf16_t*)(ws + WS_ARENA + AR_OPART); float* lpart = (float*)(ws + WS_LPART);
    const int tid = opaque_tid(C.wid), lane = tid & 63, wave = C.wid, r31 = lane & 31, hh = lane >> 5;
    LAS int* cum = (LAS int*)(lds + AT_CUM); LAS int* misc = cum + 520;
    { const int n = tid >> 5, bh = tid & 31; const int c = (int)bcnt[bh * NBLK + n]; int v = (c + 511) >> 9; v = v < 1 ? 1 : v;
#pragma unroll
      for (int o = 1; o < 64; o <<= 1) { const int u = __shfl_up(v, o); if (lane >= o) v += u; }
      if (lane == 63) misc[wave] = v;
      __syncthreads();
      int base = 0;
#pragma unroll
      for (int w = 0; w < NWAVES; ++w) base += (w < wave) ? misc[w] : 0;
      cum[tid + 1] = v + base; if (tid == 0) cum[0] = 0;
      __syncthreads(); }
    const int nitems = cum[512];
    const float cexp = 0.12751743f;
    LAS unsigned char* otile = lds + AT_OT + wave * AT_OTW;
    if (tid == 0) misc[8] = (int)atomicAdd((unsigned*)C.ws() + CW_AQ + (probe ? 1 : 0), 1u);
    __syncthreads();
    int item = misc[8];
    int n = 0, h = 0, b = 0, bk = 0, chunk = 0, cnt = 0, nown = 0, nrg = 0; int ent[3]; bool val[3];
#define AT_DECODE(it_) do { int lo = 0, hi = 512; while (hi - lo > 1) { const int mid = (lo + hi) >> 1; if (cum[mid] <= (it_)) lo = mid; else hi = mid; } \
        chunk = (it_) - cum[lo]; n = lo >> 5; { const int bh = lo & 31; h = bh & 7; b = bh >> 3; bk = bh * NBLK + n; } cnt = (int)bcnt[bk]; \
        { const int rem = cnt - chunk * 512; const int nsrg = ((rem < 512 ? rem : 512) + 31) >> 5; nown = (chunk == 0) ? 8 : 0; nrg = nown + (nsrg > 0 ? nsrg : 0); } } while (0)
#define AT_ENTS() do { _Pragma("unroll") for (int it = 0; it < 3; ++it) { const int rg = wave + 8 * it; val[it] = false; ent[it] = 0; \
        if (rg < nrg) { if (rg < nown) { ent[it] = ((n * MB + (7 - rg) * 32 + r31) << 2) | 3; val[it] = true; } \
                        else { const int ei = chunk * 512 + (rg - nown) * 32 + r31; val[it] = ei < cnt; ent[it] = val[it] ? blist[(size_t)bk * BKT_CAP + ei] : 0; } } } } while (0)
    if (item < nitems) { AT_DECODE(item); AT_ENTS(); }
    while (item < nitems) {
        __syncthreads();
        const int tid = opaque_tid(C.wid), lane = tid & 63, r31 = lane & 31, hh = lane >> 5;
        if (tid == 0) misc[8] = (int)atomicAdd((unsigned*)C.ws() + CW_AQ + (probe ? 1 : 0), 1u);
        const int cn = n, ch = h, cb = b, cnown = nown, cnrg = nrg; int cent[3]; bool cval[3];
#pragma unroll
        for (int it = 0; it < 3; ++it) { cent[it] = ent[it]; cval[it] = val[it]; }
        bf16x8 qn[8];
        { const bf16_t* qp = qkv + (size_t)(cb * SEQ + (cent[0] >> 2)) * NQKV + ch * HD + 8 * hh;
#pragma unroll
          for (int s8 = 0; s8 < 8; ++s8) qn[s8] = *(const bf16x8*)(qp + 16 * s8); }
        {
          const int tl = tid;
          const bf16_t* kb = qkv + (size_t)(cb * SEQ + cn * MB) * NQKV + D + ch * HD;
#pragma unroll
          for (int i = 0; i < 8; ++i) { const int c = tl + 512 * i, row = c >> 4, c16 = c & 15; const u32x4 v = *(const u32x4*)(kb + (size_t)row * NQKV + c16 * 8); *(LAS u32x4*)(lds + AT_KS + row * AT_KROW + c16 * 16) = v; }
          const bf16_t* vb = kb + D;
#pragma unroll
          for (int i = 0; i < 4; ++i) { const int v = tl + 512 * i, kq = v >> 5, dq = v & 31; const bf16_t* src = vb + (size_t)(4 * kq) * NQKV + 4 * dq;
              const u32x2 r0 = *(const u32x2*)src, r1 = *(const u32x2*)(src + NQKV), r2 = *(const u32x2*)(src + 2 * NQKV), r3 = *(const u32x2*)(src + 3 * NQKV);
              LAS unsigned char* dst = lds + AT_VT + (4 * dq) * AT_VROW + kq * 8;
              u32x2 w;
              w.x = (r0.x & 0xffffu) | (r1.x << 16); w.y = (r2.x & 0xffffu) | (r3.x << 16); *(LAS u32x2*)(dst) = w;
              w.x = (r0.x >> 16) | (r1.x & 0xffff0000u); w.y = (r2.x >> 16) | (r3.x & 0xffff0000u); *(LAS u32x2*)(dst + AT_VROW) = w;
              w.x = (r0.y & 0xffffu) | (r1.y << 16); w.y = (r2.y & 0xffffu) | (r3.y << 16); *(LAS u32x2*)(dst + 2 * AT_VROW) = w;
              w.x = (r0.y >> 16) | (r1.y & 0xffff0000u); w.y = (r2.y >> 16) | (r3.y & 0xffff0000u); *(LAS u32x2*)(dst + 3 * AT_VROW) = w; } }
        __syncthreads();
        const int nextitem = misc[8];
        if (nextitem < nitems) { AT_DECODE(nextitem); AT_ENTS(); }
#pragma unroll
        for (int it = 0; it < 3; ++it) { const int rg = wave + 8 * it;
            if (rg < cnrg) {
            const bool own = rg < cnown; const int og = 7 - rg;
            const int sq = cent[it] >> 2, slot = cent[it] & 3, tq = cb * SEQ + sq;
            bf16x8 qf[8];
#pragma unroll
            for (int s8 = 0; s8 < 8; ++s8) qf[s8] = qn[s8];
            if (it < 2 && rg + 8 < cnrg) { const bf16_t* qp = qkv + (size_t)(cb * SEQ + (cent[it < 2 ? it + 1 : 2] >> 2)) * NQKV + ch * HD + 8 * hh;
#pragma unroll
                for (int s8 = 0; s8 < 8; ++s8) qn[s8] = *(const bf16x8*)(qp + 16 * s8); }
            f32x16 oacc[4];
#pragma unroll
            for (int dt = 0; dt < 4; ++dt)
#pragma unroll
                for (int i = 0; i < 16; ++i) oacc[dt][i] = 0.f;
            float lsum = 0.f;
            const int nkt = own ? (og + 1) : 8;
            const LAS unsigned char* kbase = lds + AT_KS + r31 * AT_KROW + 16 * hh;
            const LAS unsigned char* vbase = lds + AT_VT + r31 * AT_VROW + 8 * hh;
            for (int kt = 0; kt < nkt; ++kt) {
                f32x16 sacc;
#pragma unroll
                for (int i = 0; i < 16; ++i) sacc[i] = 0.f;
#pragma unroll
                for (int s8 = 0; s8 < 8; ++s8) { const bf16x8 kf = *(const LAS bf16x8*)(kbase + kt * 32 * AT_KROW + 32 * s8); sacc = __builtin_amdgcn_mfma_f32_32x32x16_bf16(kf, qf[s8], sacc, 0, 0, 0); }
                const bool diag = own && (kt == og);
                float p[16];
#pragma unroll
                for (int i = 0; i < 16; ++i) { const int krow = (i & 3) + 8 * (i >> 2) + 4 * hh; float e = __builtin_amdgcn_exp2f(sacc[i] * cexp); if (diag && krow > r31) e = 0.f; p[i] = e; lsum += e; }
                bf16x8 pb[2];
#pragma unroll
                for (int s2 = 0; s2 < 2; ++s2) { u32x4 w; w.x = cvt_pk_bf16(p[8 * s2 + 0], p[8 * s2 + 1]); w.y = cvt_pk_bf16(p[8 * s2 + 2], p[8 * s2 + 3]); w.z = cvt_pk_bf16(p[8 * s2 + 4], p[8 * s2 + 5]); w.w = cvt_pk_bf16(p[8 * s2 + 6], p[8 * s2 + 7]);
                    pb[s2] = __builtin_bit_cast(bf16x8, w); }
#pragma unroll
                for (int dt = 0; dt < 4; ++dt)
#pragma unroll
                    for (int s2 = 0; s2 < 2; ++s2) { const LAS unsigned char* vp = vbase + dt * 32 * AT_VROW + (kt * 32 + 16 * s2) * 2;
                        const u32x2 v0 = *(const LAS u32x2*)vp, v1 = *(const LAS u32x2*)(vp + 16); u32x4 w; w.x = v0.x; w.y = v0.y; w.z = v1.x; w.w = v1.y;
                        oacc[dt] = __builtin_amdgcn_mfma_f32_32x32x16_bf16(__builtin_bit_cast(bf16x8, w), pb[s2], oacc[dt], 0, 0, 0); }
            }
            { const auto sw = __builtin_amdgcn_permlane32_swap(__builtin_bit_cast(unsigned, lsum), __builtin_bit_cast(unsigned, lsum), false, false);
              lsum = __builtin_bit_cast(float, sw[0]) + __builtin_bit_cast(float, sw[1]); }
            const int pidx = cval[it] ? (int)(((unsigned)tq * NH + ch) * 4 + slot) : -1;
            if (hh == 0 && pidx >= 0) lpart[pidx] = lsum;
            const int l2 = lane, r2 = r31, h2 = hh;
#pragma unroll
            for (int dt = 0; dt < 4; ++dt) {
#pragma unroll
                for (int g4 = 0; g4 < 4; ++g4) { u32x2 w; w.x = cvt_pk_bf16(oacc[dt][4 * g4 + 0], oacc[dt][4 * g4 + 1]); w.y = cvt_pk_bf16(oacc[dt][4 * g4 + 2], oacc[dt][4 * g4 + 3]); *(LAS u32x2*)(otile + r2 * 80 + (8 * g4 + 4 * h2) * 2) = w; }
                asm volatile("s_waitcnt lgkmcnt(0)" ::: "memory");
#pragma unroll
                for (int hf = 0; hf < 2; ++hf) { const int row = (l2 >> 2) + 16 * hf, c4 = l2 & 3; const u32x4 v = *(const LAS u32x4*)(otile + row * 80 + c4 * 16); const int pr = __shfl(pidx, row);
                    if (pr >= 0 && !(pflags & 4u)) *(u32x4*)(opart + (size_t)pr * HD + 32 * dt + 8 * c4) = v; }
                asm volatile("s_waitcnt lgkmcnt(0)" ::: "memory"); }
            } }
        item = nextitem;
    }
#undef AT_DECODE
#undef AT_ENTS
}

__device__ __forceinline__ void phase_combine(const Ctx& C) {
    const int bid = C.bid, G = C.G; unsigned char* ws = C.ws();
    bf16_t* qkv = (bf16_t*)(ws + WS_ARENA + AR_QKV); const bf16_t* opart = (const bf16_t*)(ws + WS_ARENA + AR_OPART); const float* lpart = (const float*)(ws + WS_LPART);
    const int tid = opaque_tid(C.wid), lane = tid & 63, sub = lane >> 4, c16 = lane & 15;
#pragma unroll 4
    for (int p0 = (bid * NWAVES + C.wid) * 4; p0 < T * NH; p0 += G * NWAVES * 4) {
        const int pr = p0 + sub, h = pr & 7, t = pr >> 3, qb = (t % SEQ) / MB, nsel = qb < 3 ? qb : 3;
        float acc[8]; float l = 0.f;
#pragma unroll
        for (int i = 0; i < 8; ++i) acc[i] = 0.f;
#pragma unroll
        for (int j = 0; j < 4; ++j) { if (j < nsel || j == 3) { const size_t pidx = (size_t)pr * 4 + j; const u32x4 v = *(const u32x4*)(opart + pidx * HD + c16 * 8); l += lpart[pidx];
            acc[0] += bf2f(v.x & 0xffffu); acc[1] += __builtin_bit_cast(float, v.x & 0xffff0000u); acc[2] += bf2f(v.y & 0xffffu); acc[3] += __builtin_bit_cast(float, v.y & 0xffff0000u);
            acc[4] += bf2f(v.z & 0xffffu); acc[5] += __builtin_bit_cast(float, v.z & 0xffff0000u); acc[6] += bf2f(v.w & 0xffffu); acc[7] += __builtin_bit_cast(float, v.w & 0xffff0000u); } }
        const float inv = 1.0f / l;
        u32x4 w; w.x = pk2(acc[0] * inv, acc[1] * inv); w.y = pk2(acc[2] * inv, acc[3] * inv); w.z = pk2(acc[4] * inv, acc[5] * inv); w.w = pk2(acc[6] * inv, acc[7] * inv);
        *(u32x4*)(qkv + (size_t)t * NQKV + h * HD + c16 * 8) = w;
    }
}

__device__ __forceinline__ void phase_router(const Ctx& C, bool probe) {
    const int bid = C.bid, G = C.G; unsigned char* ws = C.ws(); const float* ffn_g = C.in(I_OFFNN); const float* w_r = C.in(I_OWR);
    const bf16_t* h3 = (const bf16_t*)(ws + WS_ARENA + AR_H3B); const float* ss3 = (const float*)(ws + WS_SS3); int* cnt = (int*)(ws + WS_CTL) + (probe ? 6144 : 0); int* tslot = (int*)(ws + (probe ? WS_ARENA + ((size_t)103 << 20) : WS_TSLOT)); int* tokof = (int*)(ws + (probe ? WS_ARENA + ((size_t)100 << 20) : WS_TOKOF)); float* gateof = (float*)(ws + (probe ? WS_ARENA + ((size_t)101 << 20) : WS_GATEOF)); f32x4* minfo = (f32x4*)(ws + (probe ? WS_ARENA + ((size_t)102 << 20) : WS_MINFO));
    const int tid = opaque_tid(C.wid), lane = tid & 63, w = C.wid;
    LAS int* lcnt = (LAS int*)C.lds; LAS int* lbase = lcnt + 8; LAS int* te = lcnt + 16; LAS int* trank = te + 128; LAS float* tp = (LAS float*)(trank + 128); LAS float* trs = tp + 128;
    float wg[16][NE];
#pragma unroll
    for (int i = 0; i < 16; ++i) { const int c = lane * 16 + i; const float g = ffn_g[c]; const f32x4 a = *(const f32x4*)(w_r + c * NE), b2 = *(const f32x4*)(w_r + c * NE + 4);
        wg[i][0] = a[0] * g; wg[i][1] = a[1] * g; wg[i][2] = a[2] * g; wg[i][3] = a[3] * g; wg[i][4] = b2[0] * g; wg[i][5] = b2[1] * g; wg[i][6] = b2[2] * g; wg[i][7] = b2[3] * g; }
    for (int grp = bid; grp < T / 64; grp += G) {
        if (tid < 8) lcnt[tid] = 0;
        __syncthreads();
        for (int i8 = 0; i8 < 8; ++i8) { const int tl = w * 8 + i8, t = grp * 64 + tl; const u32x4* hp = (const u32x4*)(h3 + (size_t)t * D + lane * 16); const u32x4 r0 = hp[0], r1 = hp[1];
            const float xv[16] = {bf2f(r0.x & 0xffffu), __builtin_bit_cast(float, r0.x & 0xffff0000u), bf2f(r0.y & 0xffffu), __builtin_bit_cast(float, r0.y & 0xffff0000u), bf2f(r0.z & 0xffffu), __builtin_bit_cast(float, r0.z & 0xffff0000u), bf2f(r0.w & 0xffffu), __builtin_bit_cast(float, r0.w & 0xffff0000u),
                                  bf2f(r1.x & 0xffffu), __builtin_bit_cast(float, r1.x & 0xffff0000u), bf2f(r1.y & 0xffffu), __builtin_bit_cast(float, r1.y & 0xffff0000u), bf2f(r1.z & 0xffffu), __builtin_bit_cast(float, r1.z & 0xffff0000u), bf2f(r1.w & 0xffffu), __builtin_bit_cast(float, r1.w & 0xffff0000u)};
            float lg[NE];
#pragma unroll
            for (int e = 0; e < NE; ++e) lg[e] = 0.f;
#pragma unroll
            for (int i = 0; i < 16; ++i)
#pragma unroll
                for (int e = 0; e < NE; ++e) lg[e] += xv[i] * wg[i][e];
            const float r = row_rscale(ss3, t);
#pragma unroll
            for (int e = 0; e < NE; ++e) lg[e] = wave_sum(lg[e]) * r;
            if (lane == 0) { int e1 = 0; float v1 = lg[0];
#pragma unroll
                for (int e = 1; e < NE; ++e) if (lg[e] > v1) { v1 = lg[e]; e1 = e; }
                int e2 = -1; float v2 = -INFINITY;
#pragma unroll
                for (int e = 0; e < NE; ++e) if (e != e1 && lg[e] > v2) { v2 = lg[e]; e2 = e; }
                if (e2 < 0) { e2 = (e1 == 0) ? 1 : 0; v2 = v1; }
                const float p1 = 1.0f / (1.0f + __expf(v2 - v1)), p2 = 1.0f - p1;
                te[2 * tl] = e1; te[2 * tl + 1] = e2; tp[2 * tl] = p1; tp[2 * tl + 1] = p2; trs[tl] = r;
                trank[2 * tl] = __hip_atomic_fetch_add(lcnt + e1, 1, __ATOMIC_RELAXED, __HIP_MEMORY_SCOPE_WORKGROUP); trank[2 * tl + 1] = __hip_atomic_fetch_add(lcnt + e2, 1, __ATOMIC_RELAXED, __HIP_MEMORY_SCOPE_WORKGROUP); } }
        __syncthreads();
        if (tid < 8) lbase[tid] = atomicAdd(cnt + tid, lcnt[tid]);
        __syncthreads();
        if (tid < 128) { const int e = te[tid], pos = lbase[e] + trank[tid]; tokof[e * T + pos] = grp * 64 + (tid >> 1); gateof[e * T + pos] = tp[tid]; tslot[grp * 128 + tid] = e * T + pos;
            f32x4 rec; rec[0] = trs[tid >> 1]; rec[1] = __builtin_bit_cast(float, grp * 64 + (tid >> 1)); rec[2] = tp[tid]; rec[3] = 0.f; minfo[(size_t)e * T + pos] = rec; }
        __syncthreads();
    }
}

__device__ __forceinline__ void phase_moecombine(const Ctx& C, const LAS int* tb, int p) {
    const int bid = C.bid, G = C.G; unsigned char* ws = C.ws(); float* out = C.out();
    const int* tslot = (const int*)(ws + WS_TSLOT); const bf16_t* y2 = (const bf16_t*)(ws + WS_ARENA + AR_Y2); const bf16_t* ypart = (const bf16_t*)(ws + WS_ARENA + AR_YPART);
    const int lane = opaque_tid(C.wid) & 63, pn = lane >> 4, cl = (lane & 15) * 16; const int nwg = tb[8], base = (nwg / G) * G;
    for (int t = bid * NWAVES + C.wid; t < T; t += G * NWAVES) {
        f32x4 a[4]; { const u32x4* hp = (const u32x4*)((const bf16_t*)(ws + WS_ARENA + AR_H3B) + (size_t)t * D + lane * 16); const u32x4 r0 = hp[0], r1 = hp[1];
            a[0][0] = bf2f(r0.x & 0xffffu); a[0][1] = __builtin_bit_cast(float, r0.x & 0xffff0000u); a[0][2] = bf2f(r0.y & 0xffffu); a[0][3] = __builtin_bit_cast(float, r0.y & 0xffff0000u);
            a[1][0] = bf2f(r0.z & 0xffffu); a[1][1] = __builtin_bit_cast(float, r0.z & 0xffff0000u); a[1][2] = bf2f(r0.w & 0xffffu); a[1][3] = __builtin_bit_cast(float, r0.w & 0xffff0000u);
            a[2][0] = bf2f(r1.x & 0xffffu); a[2][1] = __builtin_bit_cast(float, r1.x & 0xffff0000u); a[2][2] = bf2f(r1.y & 0xffffu); a[2][3] = __builtin_bit_cast(float, r1.y & 0xffff0000u);
            a[3][0] = bf2f(r1.z & 0xffffu); a[3][1] = __builtin_bit_cast(float, r1.z & 0xffff0000u); a[3][2] = bf2f(r1.w & 0xffffu); a[3][3] = __builtin_bit_cast(float, r1.w & 0xffff0000u); }
#pragma unroll
        for (int sl = 0; sl < 2; ++sl) { const int code = tslot[t * 2 + sl], e = code / T, pos = code % T; const int wg = tb[e] + (pos >> 8) * 4 + pn;
            const bf16_t* src; int nsum, stride;
            if (wg < base) { src = y2 + (size_t)(tb[16 + e] + pos) * D + pn * 256 + cl; nsum = 1; stride = 0; }
            else { src = ypart + ((size_t)(wg - base) * p * 256 + (pos & 255)) * 256 + cl; nsum = p; stride = 256 * 256; }
            for (int q = 0; q < nsum; ++q) { const u32x4 v0 = *(const u32x4*)(src + (size_t)q * stride), v1 = *(const u32x4*)(src + (size_t)q * stride + 8);
                a[0][0] += bf2f(v0.x & 0xffffu); a[0][1] += __builtin_bit_cast(float, v0.x & 0xffff0000u); a[0][2] += bf2f(v0.y & 0xffffu); a[0][3] += __builtin_bit_cast(float, v0.y & 0xffff0000u);
                a[1][0] += bf2f(v0.z & 0xffffu); a[1][1] += __builtin_bit_cast(float, v0.z & 0xffff0000u); a[1][2] += bf2f(v0.w & 0xffffu); a[1][3] += __builtin_bit_cast(float, v0.w & 0xffff0000u);
                a[2][0] += bf2f(v1.x & 0xffffu); a[2][1] += __builtin_bit_cast(float, v1.x & 0xffff0000u); a[2][2] += bf2f(v1.y & 0xffffu); a[2][3] += __builtin_bit_cast(float, v1.y & 0xffff0000u);
                a[3][0] += bf2f(v1.z & 0xffffu); a[3][1] += __builtin_bit_cast(float, v1.z & 0xffff0000u); a[3][2] += bf2f(v1.w & 0xffffu); a[3][3] += __builtin_bit_cast(float, v1.w & 0xffff0000u); } }
        { f32x4* hp = (f32x4*)(out + (size_t)t * D + lane * 16); hp[0] = a[0]; hp[1] = a[1]; hp[2] = a[2]; hp[3] = a[3]; }
    }
}

__device__ __forceinline__ void moe_tables(LAS int* tb, const int* cnt, int nN, int wid) {
    if (opaque_tid(wid) == 0) { int cu = 0, off = 0; for (int e = 0; e < NE; ++e) { const int c = cnt[e]; tb[e] = cu; tb[16 + e] = off; tb[32 + e] = c; cu += ((c + 255) / 256) * nN; off += c; } tb[8] = cu; tb[24] = off; }
    __syncthreads();
}
template <class Epi, class Sched>
__device__ __forceinline__ void gemm_run(const Ctx& C, const bf16_t* A, int lda, const bf16_t* Bt, int K, const void* tblbase, const Sched& S, const Epi& E) { pg8::gemm_fast<Epi, Sched, true, false>(C.lds, A, lda * 2, Bt, K * 2, tblbase, S, E, C.wid, C.noepi, 0, 0); }
template <class Epi, class Sched>
__device__ __forceinline__ void gemm_run8(const Ctx& C, const void* A, int lda, const void* Bt, int K, const void* tblbase, const Sched& S, const Epi& E, int ea, int eb) { pg8::gemm_fast<Epi, Sched, true, true>(C.lds, A, lda, Bt, K, tblbase, S, E, C.wid, C.noepi, ea * 0x01010101, eb * 0x01010101); }

__global__ void __launch_bounds__(NTHREADS) fwd_megakernel(Params P) {
    extern __shared__ __attribute__((aligned(16))) unsigned char lds_raw[];
    Ctx C; C.lds = (LAS unsigned char*)lds_raw; C.wid = __builtin_amdgcn_readfirstlane(threadIdx.x >> 6); C.bid = blockIdx.x; C.G = gridDim.x;
    if (threadIdx.x < 25) { const unsigned long long v = (threadIdx.x < 23) ? (unsigned long long)P.in[threadIdx.x] : (threadIdx.x == 23 ? (unsigned long long)P.out : (unsigned long long)P.ws);
        ((LAS unsigned long long*)(C.lds + LDS_PTR))[threadIdx.x] = v; }
    if (threadIdx.x < 2) ((LAS unsigned*)(C.lds + LDS_BST))[threadIdx.x] = 0u;
    if (threadIdx.x == 2) { ((LAS unsigned*)(C.lds + LDS_BST))[4] = P.mask; ((LAS unsigned*)(C.lds + LDS_BST))[5] = (unsigned)P.probe; }
    if (threadIdx.x == 0) (void)xb_add((unsigned*)P.ws + CW_BAR + XB_XCNT(xb_xcc_id()), 1u);
    __syncthreads();
    if (P.ws == nullptr) cg::this_grid().sync();
    LAS int* tb = (LAS int*)(C.lds + LDS_TB);
#define WSP(T_, off) ((T_*)(C.ws() + (off)))
#define ARP(off) ((bf16_t*)(C.ws() + WS_ARENA + (off)))

    const unsigned mask = __builtin_amdgcn_readfirstlane(((const volatile LAS unsigned*)(C.lds + LDS_BST))[4]); const unsigned probev = __builtin_amdgcn_readfirstlane(((const volatile LAS unsigned*)(C.lds + LDS_BST))[5]); const bool probe = probev != 0u; C.noepi = (probev & 2u) != 0u;
#define PH(k) (mask & (1u << (k)))
#ifndef FILL_STOP0
#define FILL_STOP0 0u
#define FILL_STOP1 0u
#define FILL_STOP2 0u
#endif
    float* d_f32 = (float*)(C.ws() + WS_ARENA); bf16_t* d_b16 = ARP((size_t)64 << 20); float* d_ss = (float*)(C.ws() + WS_ARENA + ((size_t)96 << 20));

    if (PH(0)) { phase_prep(C); grid_barrier(C); }
    if (PH(1)) { pg8::DenseOrder S; S.init(T, NPROJ, D, C.G, C.bid); pg8::EpiScaleBf16 E{ARP(AR_PROJ), NPROJ, WSP(float, WS_SS0)}; gemm_run(C, ARP(AR_XB), D, WSP(bf16_t, WS_WIN), D, WSP(float, WS_SS0), S, E); moe_cvt_fill(C, 0, FILL_STOP0); grid_barrier(C); }
    if (PH(2)) { phase_mixer(C); grid_barrier(C); }
    if (PH(3)) { pg8::DenseOrder S; S.init(T, D, D, C.G, C.bid); pg8::EpiResid<false, false> E{C.in(I_X), probe ? d_b16 : ARP(AR_H1B), nullptr, probe ? d_ss : WSP(float, WS_SS1), C.lds, C.wid}; gemm_run(C, ARP(AR_Y), D, WSP(bf16_t, WS_WOUT), D, WSP(float, WS_SS0), S, E); grid_barrier(C); }
    if (PH(4)) { pg8::DenseOrder S; S.init(T, NGU, D, C.G, C.bid); pg8::EpiSwiglu E{ARP(AR_ACT), FF, WSP(float, WS_SS1), nullptr, tb, false}; gemm_run(C, ARP(AR_H1B), D, WSP(bf16_t, WS_WGU), D, WSP(float, WS_SS1), S, E); moe_cvt_fill(C, 1, FILL_STOP1); grid_barrier(C); }
    if (PH(5)) { pg8::DenseOrder S; S.init(T, D, FF, C.G, C.bid); pg8::EpiResid<true, false> E{ARP(AR_H1B), probe ? d_b16 : ARP(AR_H2B), nullptr, probe ? d_ss : WSP(float, WS_SS2), C.lds, C.wid}; gemm_run(C, ARP(AR_ACT), FF, WSP(bf16_t, WS_WDN), FF, WSP(float, WS_SS0), S, E); grid_barrier(C); }
    if (PH(6)) { pg8::DenseOrder S; S.init(T, NQKV, D, C.G, C.bid); pg8::EpiQKV E{ARP(AR_QKV), C.in(I_OQN), C.in(I_OKN), WSP(float, WS_ROPE), WSP(float, WS_KMEAN), C.lds, C.wid}; gemm_run(C, ARP(AR_H2B), D, WSP(bf16_t, WS_WQKV), D, WSP(float, WS_SS2), S, E); grid_barrier(C); }
    if (PH(7)) { phase_qkprep(C); grid_barrier(C); }
    if (PH(8)) { phase_select(C, probe); grid_barrier(C); }
    if (PH(9)) { phase_attn(C, probe, probev); moe_cvt_fill(C, 2, FILL_STOP2); grid_barrier(C); }
    if (PH(10)) { phase_combine(C); grid_barrier(C); }
    if (PH(11)) { pg8::DenseOrder S; S.init(T, D, D, C.G, C.bid); pg8::EpiResid<true, true> E{ARP(AR_H2B), probe ? d_b16 : ARP(AR_H3B), probe ? (unsigned char*)d_f32 : WSP(unsigned char, WS_H38), probe ? d_ss : WSP(float, WS_SS3), C.lds, C.wid}; gemm_run(C, ARP(AR_QKV), NQKV, WSP(bf16_t, WS_WO), D, WSP(float, WS_SS0), S, E); grid_barrier(C); }
    if (PH(12)) { phase_router(C, probe); moe_cvt_fill(C, -1, 0u); grid_barrier(C); }
    if (PH(13)) { moe_tables(tb, WSP(int, WS_CTL), NGUE / 256, C.wid); pg8::MoeOrder S{tb, WSP(int, WS_TOKOF), NGUE / 256, C.G, C.bid, true, (size_t)NGUE * D / 2, D / 128, false};
        pg8::EpiSwiglu E{ARP(AR_MACT), FE, WSP(float, WS_SS3), WSP(int, WS_TOKOF), tb, true}; gemm_run8(C, WSP(unsigned char, WS_H38), D, WSP(unsigned char, WS_MGU), D, WSP(float, WS_MINFO), S, E, 127, 121); grid_barrier(C); }
    if (PH(14)) { moe_tables(tb, WSP(int, WS_CTL), D / 256, C.wid); pg8::MoeOrder S{tb, WSP(int, WS_TOKOF), D / 256, C.G, C.bid, false, (size_t)D * FE / 2, FE / 128, true};
        pg8::EpiMoeDown E{ARP(AR_Y2), ARP(AR_YPART), WSP(float, WS_GATEOF), tb, C.wid}; gemm_run8(C, ARP(AR_MACT), FE, WSP(unsigned char, WS_MDN), FE, WSP(float, WS_MINFO), S, E, 125, 121); grid_barrier(C); }
    if (PH(15) && !probe) { moe_tables(tb, WSP(int, WS_CTL), D / 256, C.wid); pg8::MoeOrder S{tb, WSP(int, WS_TOKOF), D / 256, C.G, C.bid, false, (size_t)D * FE / 2, FE / 128, true}; phase_moecombine(C, tb, S.pieces(tb[8])); }
}

extern "C" void kernel_launch(void* const* d_in, const int* in_sizes, int n_in, void* d_out, int out_size, void* d_ws, size_t ws_size, hipStream_t stream) {
    if (n_in != 23 || out_size != T * D || ws_size < WS_END) { fprintf(stderr, "kernel_launch: bad shapes n_in %d out %d ws %zu (need %zu)\n", n_in, out_size, ws_size, (size_t)WS_END); return; }
    static int grid_blocks = 0;
    if (!grid_blocks) {
        int dev = 0, cus = 0, per_cu = 0;
        (void)hipGetDevice(&dev); (void)hipDeviceGetAttribute(&cus, hipDeviceAttributeMultiprocessorCount, dev);
        (void)hipFuncSetAttribute((const void*)fwd_megakernel, hipFuncAttributeMaxDynamicSharedMemorySize, LDS_BYTES);
        (void)hipOccupancyMaxActiveBlocksPerMultiprocessor(&per_cu, (const void*)fwd_megakernel, NTHREADS, LDS_BYTES);
        if (per_cu < 1) { fprintf(stderr, "kernel_launch: occupancy query says %d blocks per CU\n", per_cu); per_cu = 1; }
        grid_blocks = cus * 1;
    }
    if (hipMemsetAsync((char*)d_ws + WS_CTL, 0, WS_CTLBYTES, stream) != hipSuccess) { fprintf(stderr, "kernel_launch: memset failed\n"); return; }
    Params p{};
    for (int i = 0; i < 23; ++i) p.in[i] = (const float*)d_in[i];
    p.out = (float*)d_out; p.ws = (unsigned char*)d_ws;
    p.mask = 0xffffu & ~(1u << 7); p.probe = 0;
    void* args[] = {&p};
    hipError_t e = hipLaunchCooperativeKernel((const void*)fwd_megakernel, dim3(grid_blocks), dim3(NTHREADS), args, LDS_BYTES, stream);
    if (e != hipSuccess) fprintf(stderr, "cooperative launch failed: %s (grid %d)\n", hipGetErrorString(e), grid_blocks);
#ifndef PROBE_MODE
#define PROBE_MODE 1
#endif
#ifdef PROBE_MASK
    (void)hipMemsetAsync((char*)d_ws + WS_CTL + 4096, 0, WS_CTLBYTES - 4096, stream);
    Params p2 = p; p2.mask = PROBE_MASK; p2.probe = PROBE_MODE; void* args2[] = {&p2};
    (void)hipLaunchCooperativeKernel((const void*)fwd_megakernel, dim3(grid_blocks), dim3(NTHREADS), args2, LDS_BYTES, stream);
#endif
}
```

```cpp
#include <hip/hip_runtime.h>
#include <hip/hip_cooperative_groups.h>
#include <cstdio>
#include <cstdint>

#define LAS __attribute__((address_space(3)))
typedef unsigned short bf16_t;
typedef short bf16x8 __attribute__((ext_vector_type(8)));
typedef float f32x4 __attribute__((ext_vector_type(4)));
typedef float f32x2 __attribute__((ext_vector_type(2)));
typedef float f32x16 __attribute__((ext_vector_type(16)));
typedef unsigned u32x4 __attribute__((ext_vector_type(4)));
typedef unsigned u32x2 __attribute__((ext_vector_type(2)));
typedef int v8i __attribute__((ext_vector_type(8)));

constexpr int T = 16384, D = 1024, SEQ = 4096, NBATCH = 4;
constexpr int CONV = 512, GM = 512, NPROJ = 2560;
constexpr int FF = 2816, NGU = 2 * FF;
constexpr int NH = 8, HD = 128, NQKV = 3072;
constexpr int NE = 8, FE = 3584, NGUE = 2 * FE;
constexpr int MB = 256, NBLK = SEQ / MB;
constexpr float EPS = 1e-6f;

constexpr size_t al256(size_t x) { return (x + 255) & ~(size_t)255; }
constexpr size_t WS_CTL = 0;
constexpr int NSS = 4;
constexpr size_t WS_CTLBYTES = 32768;
constexpr int CW_BKT = 64;
constexpr int CW_BAR = 1024;
constexpr size_t WS_SS0 = WS_CTLBYTES;
constexpr size_t WS_SS1 = WS_SS0 + (size_t)T * NSS * 4;
constexpr size_t WS_SS2 = WS_SS1 + (size_t)T * NSS * 4;
constexpr size_t WS_SS3 = WS_SS2 + (size_t)T * NSS * 4;
constexpr size_t WS_ROPE = WS_SS3 + (size_t)T * NSS * 4;
constexpr size_t WS_KMEAN = WS_ROPE + (size_t)SEQ * 16 * 2 * 4;
constexpr size_t WS_TOKOF = WS_KMEAN + (size_t)NBATCH * NH * NBLK * HD * 4;
constexpr size_t WS_GATEOF = WS_TOKOF + (size_t)NE * T * 4;
constexpr size_t WS_TSLOT = al256(WS_GATEOF + (size_t)NE * T * 4);
constexpr size_t WS_MINFO = al256(WS_TSLOT + (size_t)T * 2 * 4);
constexpr size_t WS_W = al256(WS_MINFO + (size_t)NE * T * 16);
constexpr size_t WS_WIN = WS_W;
constexpr size_t WS_WOUT = WS_WIN + (size_t)NPROJ * D * 2;
constexpr size_t WS_WGU = WS_WOUT + (size_t)D * D * 2;
constexpr size_t WS_WDN = WS_WGU + (size_t)NGU * D * 2;
constexpr size_t WS_WQKV = WS_WDN + (size_t)D * FF * 2;
constexpr size_t WS_WO = WS_WQKV + (size_t)NQKV * D * 2;
constexpr size_t WS_MGU = WS_WO + (size_t)D * D * 2;
constexpr size_t WS_MDN = WS_MGU + (size_t)NE * NGUE * D;
constexpr size_t WS_ARENA = WS_MDN + (size_t)NE * D * FE;
constexpr size_t SZ_TD2 = (size_t)T * D * 2;
constexpr size_t AR_XB = 0, AR_PROJ = SZ_TD2, AR_Y = 0, AR_H1B = SZ_TD2, AR_ACT = 2 * SZ_TD2, AR_H2B = 0, AR_QKV = SZ_TD2,
                 AR_O = SZ_TD2 + (size_t)T * NQKV * 2, AR_H3B = 0, AR_MACT = (size_t)68 << 20;
constexpr int BKT_CAP = 3840;
constexpr size_t WS_BLIST = WS_WIN;
constexpr size_t WS_LPART = WS_BLIST + (size_t)512 * BKT_CAP * 4;
constexpr size_t WS_H38 = WS_WIN;
constexpr size_t AR_OPART = AR_O;
static_assert(WS_LPART + (size_t)T * NH * 4 * 4 <= WS_WQKV && WS_H38 + (size_t)T * D <= WS_WQKV, "attention lists / h3 fp8 fit the layer-0 weight copies");
static_assert(AR_OPART + (size_t)T * NH * 4 * HD * 2 <= SZ_TD2 + (size_t)(2 * T + 256) * FE * 2, "attention partials fit the arena");
constexpr size_t AR_YPART = SZ_TD2;
constexpr size_t AR_Y2 = (size_t)186 << 20;
static_assert(AR_YPART + (size_t)256 * 256 * 256 * 2 <= AR_MACT && AR_MACT + (size_t)(2 * T + 256) * FE <= AR_Y2 && AR_Y2 + (size_t)2 * T * D * 2 <= SZ_TD2 + (size_t)(2 * T + 256) * FE * 2, "MoE down arena");
constexpr size_t WS_END = WS_ARENA + SZ_TD2 + (size_t)(2 * T + 256) * FE * 2;
static_assert(AR_ACT + (size_t)T * FF * 2 <= SZ_TD2 + (size_t)2 * T * FE * 2, "arena");
static_assert(WS_END <= 486079488ull, "workspace budget");

__device__ __forceinline__ unsigned f2bf(float f) { unsigned u = __builtin_bit_cast(unsigned, f); return (u + 0x7fffu + ((u >> 16) & 1u)) >> 16; }
__device__ __forceinline__ float bf2f(unsigned b) { return __builtin_bit_cast(float, b << 16); }
__device__ __forceinline__ unsigned pk2(float lo, float hi) { return f2bf(lo) | (f2bf(hi) << 16); }
__device__ __forceinline__ unsigned cvt_pk_bf16(float lo, float hi) { unsigned r; asm volatile("v_cvt_pk_bf16_f32 %0, %1, %2" : "=v"(r) : "v"(lo), "v"(hi)); return r; }
__device__ __forceinline__ int opaque_tid(int wid) { int l; asm volatile("v_mbcnt_lo_u32_b32 %0, -1, 0\n\tv_mbcnt_hi_u32_b32 %0, -1, %0" : "=v"(l)); return wid * 64 + l; }
__device__ __forceinline__ float wave_sum(float v) {
#pragma unroll
    for (int o = 1; o < 64; o <<= 1) v += __shfl_xor(v, o);
    return v;
}
__device__ __forceinline__ float rscale_of(const f32x4 p) { return rsqrtf(((p[0] + p[1]) + (p[2] + p[3])) * (1.0f / D) + EPS); }
__device__ __forceinline__ float row_rscale(const float* ssp, int row) { return rscale_of(*(const f32x4*)(ssp + (size_t)row * NSS)); }
__device__ __forceinline__ unsigned pk_fp8x4(float a, float b, float c, float d) {
    a = fminf(fmaxf(a, -448.f), 448.f); b = fminf(fmaxf(b, -448.f), 448.f); c = fminf(fmaxf(c, -448.f), 448.f); d = fminf(fmaxf(d, -448.f), 448.f);
    int p = __builtin_amdgcn_cvt_pk_fp8_f32(a, b, 0, false); p = __builtin_amdgcn_cvt_pk_fp8_f32(c, d, p, true); return (unsigned)p; }
__device__ __forceinline__ float silu_f(float g) { return g * __builtin_amdgcn_rcpf(1.0f + __builtin_amdgcn_exp2f(g * -1.4426950408889634f)); }

namespace pg8 {
constexpr int BM = 256, BK = 64, HALF = 128, HTB = HALF * BK * 2, STAGE_BYTES = 8 * HTB, NXCD = 8, WGM = 4;
constexpr int RI_OFF = STAGE_BYTES, RI_BYTES = 4 * 4096;
constexpr int EPI_OFF = RI_OFF + RI_BYTES, EPI_TILE = 8 * 144;
__host__ __device__ __forceinline__ int lds_byte(int r, int c) { const int st = (r >> 4) * 2 + (c >> 5), rr = r & 15, cc = c & 31, ob = rr * 64 + cc * 2; return st * 1024 + (ob ^ (((ob >> 9) & 1) << 5)); }
__host__ __device__ __forceinline__ void stage_rc(int b, int& R, int& C) { const int st = b / 1024, sb = b % 1024, swz = sb ^ (((sb >> 9) & 1) << 5); R = (st >> 1) * 16 + swz / 64; C = (st & 1) * 32 + (swz % 64) / 2; }
__host__ __device__ __forceinline__ int perm32(int rho) { const int n = rho >> 4, i = rho & 15; return 8 * (i >> 2) + 4 * n + (i & 3); }

struct Unit { int row0, pn, e, nvalid, kt0, nkt, piece; };

struct DenseOrder {
    int nM, nN, nwg, G, c, nkt;
    __device__ void init(int M, int N, int K, int G_, int c_) { nM = M / BM; nN = N / BM; nwg = nM * nN; G = G_; c = c_; nkt = K / BK; }
    __device__ __forceinline__ bool next(int i, Unit& u) const {
        const long L = (long)i * G + c; if (L >= nwg) return false;
        int wgid = (int)L; { const int q = nwg / NXCD, r = nwg % NXCD, xcd = wgid % NXCD, off = wgid / NXCD; wgid = (xcd < r ? xcd * (q + 1) : r * (q + 1) + (xcd - r) * q) + off; }
        const int nig = WGM * nN, gid = wgid / nig, fm = gid * WGM, gsz = (nM - fm) < WGM ? (nM - fm) : WGM;
        u.row0 = (fm + ((wgid % nig) % gsz)) * BM; u.pn = (wgid % nig) / gsz; u.e = 0; u.nvalid = BM; u.kt0 = 0; u.nkt = nkt; u.piece = -1; return true;
    }
    __device__ __forceinline__ int src_row(const Unit& u, int r) const { return u.row0 + r; }
    __device__ __forceinline__ unsigned tbl_off(const Unit& u) const { return (unsigned)u.row0 * 16u; }
    __device__ __forceinline__ size_t b_off(const Unit&) const { return 0; }
};
struct MoeOrder {
    __device__ __forceinline__ int tbv(int i) const { return __builtin_amdgcn_readfirstlane(tb[i]); }
    const LAS int* tb; const int* tokof; int nN, G, c; bool gather; size_t bstride; int nkt; bool splitk;
    __device__ __forceinline__ void tile(int L, Unit& u) const {
        const int nwg = tbv(8);
        int wgid = L; { const int q = nwg / NXCD, r = nwg % NXCD, xcd = wgid % NXCD, off = wgid / NXCD; wgid = (xcd < r ? xcd * (q + 1) : r * (q + 1) + (xcd - r) * q) + off; }
        int e = 0;
#pragma unroll
        for (int j = 1; j < 8; ++j) e += (wgid >= tbv(j)) ? 1 : 0;
        const int w = wgid - tbv(e), cnt = tbv(32 + e), nM = (cnt + BM - 1) / BM;
        const int nig = WGM * nN, gid = w / nig, fm = gid * WGM, gsz = (nM - fm) < WGM ? (nM - fm) : WGM;
        const int pm = fm + ((w % nig) % gsz); u.pn = (w % nig) / gsz; u.e = e; u.row0 = pm * BM; u.nvalid = (cnt - pm * BM) < BM ? (cnt - pm * BM) : BM;
    }
    __device__ __forceinline__ void tile_nat(int wg, Unit& u) const {
        int e = 0;
#pragma unroll
        for (int j = 1; j < 8; ++j) e += (wg >= tbv(j)) ? 1 : 0;
        const int w = wg - tbv(e), cnt = tbv(32 + e), pm = w / nN; u.pn = w % nN; u.e = e; u.row0 = pm * BM; u.nvalid = (cnt - pm * BM) < BM ? (cnt - pm * BM) : BM;
    }
    __device__ __forceinline__ int pieces(int nwg) const { const int base = (nwg / G) * G, R = nwg - base, ntrip = nkt / 2; int p = 1; if (R * 2 <= G && ntrip % 2 == 0) p = 2; if (R * 7 <= G && ntrip % 7 == 0) p = 7; return p; }
    __device__ __forceinline__ bool next(int i, Unit& u) const {
        const long L = (long)i * G + c; const int nwg = tbv(8);
        if (!splitk) { if (L >= nwg) return false; tile((int)L, u); u.kt0 = 0; u.nkt = nkt; u.piece = -1; return true; }
        const int base = (nwg / G) * G, R = nwg - base;
        if (L < base) { const int wg = ((int)L % NXCD) * (base / NXCD) + (int)L / NXCD; tile_nat(wg, u); u.kt0 = 0; u.nkt = nkt; u.piece = -1; return true; }
        if (R == 0) return false;
        const int p = pieces(nwg), j = (int)(L - base); if (j >= R * p) return false;
        tile_nat(base + j / p, u); const int per = nkt / p; u.kt0 = (j % p) * per; u.nkt = per; u.piece = j; return true;
    }
    __device__ __forceinline__ int src_row(const Unit& u, int r) const {
        if (gather) return (r < u.nvalid) ? tokof[u.e * T + u.row0 + r] : 0;
        return tbv(16 + u.e) + u.row0 + r;
    }
    __device__ __forceinline__ unsigned tbl_off(const Unit& u) const { return (unsigned)(u.e * T + u.row0) * 16u; }
    __device__ __forceinline__ size_t b_off(const Unit& u) const { return (size_t)u.e * bstride; }
};

struct EpiScaleBf16 {
    static constexpr bool PERM = true;
    bf16_t* O; int ldc; const float* ss;
    __device__ __forceinline__ void operator()(const f32x4 (&acc)[2][2][4][2], const Unit& u, int wr, int wc, int fr, int fq, const LAS f32x4* tbl) const {
        const int col0 = u.pn * BM + wc * 32 + 8 * fq; float rs[2][4]; const LAS f32x4* tb0 = tbl + (wr * 64 + fr); asm volatile("" : "+v"(tb0));
#pragma unroll
        for (int ai = 0; ai < 2; ++ai)
#pragma unroll
            for (int m = 0; m < 4; ++m) rs[ai][m] = rscale_of(tb0[ai * HALF + m * 16]);
#pragma unroll
        for (int ai = 0; ai < 2; ++ai)
#pragma unroll
            for (int m = 0; m < 4; ++m) { const int row = u.row0 + ai * HALF + wr * 64 + m * 16 + fr; const float r = rs[ai][m];
                bf16_t* rowp = O + (size_t)row * ldc + col0;
#pragma unroll
                for (int bj = 0; bj < 2; ++bj) { const f32x4 v0 = acc[ai][bj][m][0] * r, v1 = acc[ai][bj][m][1] * r;
                    u32x4 w; w.x = cvt_pk_bf16(v0[0], v0[1]); w.y = cvt_pk_bf16(v0[2], v0[3]); w.z = cvt_pk_bf16(v1[0], v1[1]); w.w = cvt_pk_bf16(v1[2], v1[3]);
                    *(u32x4*)(rowp + bj * HALF) = w; } }
    }
};
struct EpiQKV {
    static constexpr bool PERM = true;
    bf16_t* O; const float* qg; const float* kg; const float* rope; float* kmean; LAS unsigned char* lds; int wid;
    __device__ __forceinline__ void operator()(const f32x4 (&acc)[2][2][4][2], const Unit& u, int wr, int wc, int, int, const LAS f32x4* tbl) const {
        const int lane = opaque_tid(wid) & 63, fr = lane & 15, fq = lane >> 4;
        const int col0 = u.pn * BM + wc * 32 + 8 * fq; const LAS f32x4* tb0 = tbl + (wr * 64 + fr);
        float rr[2][4];
#pragma unroll
        for (int ai = 0; ai < 2; ++ai)
#pragma unroll
            for (int m = 0; m < 4; ++m) rr[ai][m] = rscale_of(tb0[ai * HALF + m * 16]);
        if (u.pn >= 8) {
#pragma unroll
            for (int ai = 0; ai < 2; ++ai)
#pragma unroll
                for (int m = 0; m < 4; ++m) { const int row = u.row0 + ai * HALF + wr * 64 + m * 16 + fr; bf16_t* rowp = O + (size_t)row * NQKV + col0; const float r = rr[ai][m];
#pragma unroll
                    for (int bj = 0; bj < 2; ++bj) { const f32x4 v0 = acc[ai][bj][m][0] * r, v1 = acc[ai][bj][m][1] * r;
                        u32x4 w; w.x = cvt_pk_bf16(v0[0], v0[1]); w.y = cvt_pk_bf16(v0[2], v0[3]); w.z = cvt_pk_bf16(v1[0], v1[1]); w.w = cvt_pk_bf16(v1[2], v1[3]);
                        *(u32x4*)(rowp + bj * HALF) = w; } }
            return; }
        LAS float* sc = (LAS float*)(lds + EPI_OFF);
#pragma unroll
        for (int ai = 0; ai < 2; ++ai)
#pragma unroll
            for (int m = 0; m < 4; ++m) { const int tr = ai * HALF + wr * 64 + m * 16 + fr; const float r = rr[ai][m];
#pragma unroll
                for (int bj = 0; bj < 2; ++bj) { const f32x4 v0 = acc[ai][bj][m][0] * r, v1 = acc[ai][bj][m][1] * r;
                    float q = ((v0[0] * v0[0] + v0[1] * v0[1]) + (v0[2] * v0[2] + v0[3] * v0[3])) + ((v1[0] * v1[0] + v1[1] * v1[1]) + (v1[2] * v1[2] + v1[3] * v1[3]));
                    q += __shfl_xor(q, 16); q += __shfl_xor(q, 32);
                    if (fq == 0) sc[(tr * 2 + bj) * 4 + wc] = q; } }
        asm volatile("s_waitcnt lgkmcnt(0)" ::: "memory"); __builtin_amdgcn_s_barrier(); asm volatile("" ::: "memory");
        const bool isk = u.pn >= 4; const float* gp = (isk ? kg : qg) + wc * 32 + 8 * fq; const f32x4 g0 = *(const f32x4*)gp, g1 = *(const f32x4*)(gp + 4);
        const int b = u.row0 / SEQ, nblk = (u.row0 % SEQ) / MB, h0 = (u.pn & 3) * 2;
        float cs[2][2][4];
#pragma unroll
        for (int bj = 0; bj < 2; ++bj)
#pragma unroll
            for (int n = 0; n < 2; ++n)
#pragma unroll
                for (int j = 0; j < 4; ++j) cs[bj][n][j] = 0.f;
#pragma unroll
        for (int ai = 0; ai < 2; ++ai)
#pragma unroll
            for (int m = 0; m < 4; ++m) { const int tr = ai * HALF + wr * 64 + m * 16 + fr, row = u.row0 + tr; const float r = rr[ai][m]; bf16_t* rowp = O + (size_t)row * NQKV + col0;
                f32x4 rc0 = (f32x4){1.f, 0.f, 1.f, 0.f}, rc1 = rc0, rc2 = rc0, rc3 = rc0;
                if (wc == 0) { const f32x4* rp = (const f32x4*)(rope + ((size_t)(row % SEQ) * 16 + 8 * (fq & 1)) * 2); rc0 = rp[0]; rc1 = rp[1]; rc2 = rp[2]; rc3 = rp[3]; }
#pragma unroll
                for (int bj = 0; bj < 2; ++bj) { const f32x4 p4 = *(const LAS f32x4*)(sc + (tr * 2 + bj) * 4); const float rn = rsqrtf(((p4[0] + p4[1]) + (p4[2] + p4[3])) * (1.0f / HD) + EPS) * r;
                    f32x4 v0 = acc[ai][bj][m][0] * rn * g0, v1 = acc[ai][bj][m][1] * rn * g1;
                    if (wc == 0) {
                        const float c[8] = {rc0[0], rc0[2], rc1[0], rc1[2], rc2[0], rc2[2], rc3[0], rc3[2]}, sn[8] = {rc0[1], rc0[3], rc1[1], rc1[3], rc2[1], rc2[3], rc3[1], rc3[3]};
#pragma unroll
                        for (int j = 0; j < 4; ++j) { const float p0 = __shfl_xor(v0[j], 32), p1 = __shfl_xor(v1[j], 32);
                            v0[j] = (fq < 2) ? v0[j] * c[j] - p0 * sn[j] : v0[j] * c[j] + p0 * sn[j]; v1[j] = (fq < 2) ? v1[j] * c[4 + j] - p1 * sn[4 + j] : v1[j] * c[4 + j] + p1 * sn[4 + j]; } }
                    u32x4 w; w.x = cvt_pk_bf16(v0[0], v0[1]); w.y = cvt_pk_bf16(v0[2], v0[3]); w.z = cvt_pk_bf16(v1[0], v1[1]); w.w = cvt_pk_bf16(v1[2], v1[3]);
                    *(u32x4*)(rowp + bj * HALF) = w;
                    if (isk) { cs[bj][0][0] += bf2f(w.x & 0xffffu); cs[bj][0][1] += __builtin_bit_cast(float, w.x & 0xffff0000u); cs[bj][0][2] += bf2f(w.y & 0xffffu); cs[bj][0][3] += __builtin_bit_cast(float, w.y & 0xffff0000u);
                               cs[bj][1][0] += bf2f(w.z & 0xffffu); cs[bj][1][1] += __builtin_bit_cast(float, w.z & 0xffff0000u); cs[bj][1][2] += bf2f(w.w & 0xffffu); cs[bj][1][3] += __builtin_bit_cast(float, w.w & 0xffff0000u); } } }
        if (isk) {
#pragma unroll
            for (int bj = 0; bj < 2; ++bj)
#pragma unroll
                for (int n = 0; n < 2; ++n)
#pragma unroll
                    for (int j = 0; j < 4; ++j) { float v = cs[bj][n][j]; v += __shfl_xor(v, 1); v += __shfl_xor(v, 2); v += __shfl_xor(v, 4); v += __shfl_xor(v, 8);
                        if (fr == 0) atomicAdd(kmean + ((size_t)(b * NH + h0 + bj) * NBLK + nblk) * HD + wc * 32 + 8 * fq + 4 * n + j, v * (1.0f / MB)); } }
    }
};
struct EpiSwiglu {
    static constexpr bool PERM = true;
    bf16_t* O; int ldc; const float* ss; const int* tokof; const LAS int* tb; bool moe;
    __device__ __forceinline__ void operator()(const f32x4 (&acc)[2][2][4][2], const Unit& u, int wr, int wc, int fr, int fq, const LAS f32x4* tbl) const {
        const int col0 = u.pn * HALF + wc * 32 + 8 * fq; float rs[2][4]; int orow[2][4]; int trb = wr * 64 + fr; asm volatile("" : "+v"(trb));
#pragma unroll
        for (int ai = 0; ai < 2; ++ai)
#pragma unroll
            for (int m = 0; m < 4; ++m) { const int tr = ai * HALF + m * 16 + trb; int srow;
                if (moe) { const bool ok = tr < u.nvalid; srow = ok ? tokof[u.e * T + u.row0 + tr] : 0; orow[ai][m] = ok ? tb[16 + u.e] + u.row0 + tr : -1; } else { srow = u.row0 + tr; orow[ai][m] = srow; }
                rs[ai][m] = moe ? tbl[tr][0] : rscale_of(tbl[tr]); }
#pragma unroll
        for (int ai = 0; ai < 2; ++ai)
#pragma unroll
            for (int m = 0; m < 4; ++m) { const float r = rs[ai][m];
                f32x4 a[2];
#pragma unroll
                for (int n = 0; n < 2; ++n) { const f32x4 g = acc[ai][0][m][n] * r, up = acc[ai][1][m][n] * r;
#pragma unroll
                    for (int j = 0; j < 4; ++j) a[n][j] = silu_f(g[j]) * up[j]; }
                if (moe) { u32x2 w8; w8.x = pk_fp8x4(a[0][0] * 4.f, a[0][1] * 4.f, a[0][2] * 4.f, a[0][3] * 4.f); w8.y = pk_fp8x4(a[1][0] * 4.f, a[1][1] * 4.f, a[1][2] * 4.f, a[1][3] * 4.f);
                    if (orow[ai][m] >= 0) *(u32x2*)((unsigned char*)O + (size_t)orow[ai][m] * ldc + col0) = w8; }
                else { u32x4 w; w.x = cvt_pk_bf16(a[0][0], a[0][1]); w.y = cvt_pk_bf16(a[0][2], a[0][3]); w.z = cvt_pk_bf16(a[1][0], a[1][1]); w.w = cvt_pk_bf16(a[1][2], a[1][3]);
                    if (orow[ai][m] >= 0) *(u32x4*)(O + (size_t)orow[ai][m] * ldc + col0) = w; } }
    }
};
template <bool BASE16, bool F8COPY> struct EpiResid {
    static constexpr bool PERM = false;
    const void* base; bf16_t* hb; unsigned char* h8; float* ssout; LAS unsigned char* lds; int wid;
    __device__ __forceinline__ void operator()(const f32x4 (&acc)[2][2][4][2], const Unit& u, int wr, int wc, int fr, int fq, const LAS f32x4*) const {
        const int col0 = u.pn * BM + wc * 32 + 4 * fq; LAS float* sc = (LAS float*)(lds + EPI_OFF);
#pragma unroll
        for (int ai = 0; ai < 2; ++ai)
#pragma unroll
            for (int m = 0; m < 4; ++m) { const int tr = ai * HALF + wr * 64 + m * 16 + fr, row = u.row0 + tr; const size_t off = (size_t)row * D + col0; float q = 0.f;
#pragma unroll
                for (int bj = 0; bj < 2; ++bj)
#pragma unroll
                    for (int n = 0; n < 2; ++n) { f32x4 bv;
                        if (BASE16) { const u32x2 r = *(const u32x2*)((const bf16_t*)base + off + bj * HALF + n * 16); bv[0] = bf2f(r.x & 0xffffu); bv[1] = __builtin_bit_cast(float, r.x & 0xffff0000u); bv[2] = bf2f(r.y & 0xffffu); bv[3] = __builtin_bit_cast(float, r.y & 0xffff0000u); }
                        else bv = *(const f32x4*)((const float*)base + off + bj * HALF + n * 16);
                        const f32x4 h = bv + acc[ai][bj][m][n]; q += (h[0] * h[0] + h[1] * h[1]) + (h[2] * h[2] + h[3] * h[3]);
                        u32x2 w; w.x = cvt_pk_bf16(h[0], h[1]); w.y = cvt_pk_bf16(h[2], h[3]); *(u32x2*)(hb + off + bj * HALF + n * 16) = w;
                        if (F8COPY) *(unsigned*)(h8 + off + bj * HALF + n * 16) = pk_fp8x4(h[0], h[1], h[2], h[3]); }
                q += __shfl_xor(q, 16); q += __shfl_xor(q, 32);
                if (fq == 0) sc[tr * 4 + wc] = q;
                asm volatile("" ::: "memory"); }
        asm volatile("s_waitcnt lgkmcnt(0)" ::: "memory"); __builtin_amdgcn_s_barrier(); asm volatile("" ::: "memory");
        { const int t2 = opaque_tid(wid); if (t2 < 256) { const f32x4 p = *(const LAS f32x4*)(sc + t2 * 4); ssout[(size_t)(u.row0 + t2) * NSS + u.pn] = (p[0] + p[1]) + (p[2] + p[3]); } }
        asm volatile("s_waitcnt lgkmcnt(0)" ::: "memory"); __builtin_amdgcn_s_barrier(); asm volatile("" ::: "memory");
    }
};
struct EpiMoeDown {
    static constexpr bool PERM = true;
    bf16_t* y2; bf16_t* ypart; const float* gateof; const LAS int* tb; int wid;
    __device__ __forceinline__ void operator()(const f32x4 (&acc)[2][2][4][2], const Unit& u, int wr, int wc, int, int, const LAS f32x4*) const {
        const int lane = opaque_tid(wid) & 63, fr = lane & 15, fq = lane >> 4;
        const int cloc = wc * 32 + 8 * fq, trb = wr * 64 + fr;
        bf16_t* ob = (u.piece >= 0) ? ypart + (size_t)u.piece * (BM * BM) + cloc : y2 + (size_t)(tb[16 + u.e] + u.row0) * D + u.pn * BM + cloc; const int ld = (u.piece >= 0) ? BM : D;
#pragma unroll
        for (int ai = 0; ai < 2; ++ai)
#pragma unroll
            for (int m = 0; m < 4; ++m) { const int tr = ai * HALF + m * 16 + trb; const bool ok = tr < u.nvalid; const float gt = ok ? gateof[u.e * T + u.row0 + tr] : 0.f;
#pragma unroll
                for (int bj = 0; bj < 2; ++bj) { const f32x4 v0 = acc[ai][bj][m][0] * gt, v1 = acc[ai][bj][m][1] * gt;
                    u32x4 w; w.x = cvt_pk_bf16(v0[0], v0[1]); w.y = cvt_pk_bf16(v0[2], v0[3]); w.z = cvt_pk_bf16(v1[0], v1[1]); w.w = cvt_pk_bf16(v1[2], v1[3]);
                    if (ok) *(u32x4*)(ob + (size_t)tr * ld + bj * HALF) = w; } }
    }
};

template <class Epi, class Sched, bool ALIGN_EPI, bool F8>
__device__ __forceinline__ void gemm_fast(LAS unsigned char* lds, const void* A, int ldab, const void* Bt, int Kb, const void* tblbase, const Sched& S, const Epi& E, int wid, bool noepi, int sclA, int sclB) {
    const int lane = opaque_tid(wid) & 63, wr = wid >> 2, wc = wid & 3, fr = lane & 15, fq = lane >> 4;
    unsigned voffB[2];
#pragma unroll
    for (int i = 0; i < 2; ++i) { int R, C; stage_rc(opaque_tid(wid) * 16 + i * 8192, R, C); const int Rb = Epi::PERM ? ((R & ~31) + perm32(R & 31)) : R; voffB[i] = (unsigned)Rb * (unsigned)Kb + (unsigned)C * 2u; }
    const unsigned kstep = (unsigned)(BK * 2), hstep = (unsigned)HALF * (unsigned)Kb, tstep = 2u * hstep;
    const unsigned ldsw = (unsigned)wid * 1024u;
    const int fcol = fq * 8; constexpr int KOFF = 1024;
    const int aoff = lds_byte(wr * 64 + fr, fcol), boff = lds_byte(wc * 32 + fr, fcol);
    const __amdgpu_buffer_rsrc_t rA = __builtin_amdgcn_make_buffer_rsrc((void*)A, 0, 0x7fffffff, 0x00020000), rB = __builtin_amdgcn_make_buffer_rsrc((void*)Bt, 0, 0x7fffffff, 0x00020000), rT = __builtin_amdgcn_make_buffer_rsrc((void*)tblbase, 0, 0x7fffffff, 0x00020000);
#define PG8_SA(b, h) (((b) * 2 + (h)) * HTB)
#define PG8_SB(b, h) ((4 + (b) * 2 + (h)) * HTB)
#define PG8_STAGE(bufoff, rsrc, soff, voff) do { _Pragma("unroll") for (int _i = 0; _i < 2; ++_i) \
        __builtin_amdgcn_raw_ptr_buffer_load_lds(rsrc, (LAS void*)(lds + (bufoff) + ldsw + _i * 8192), 16, (voff)[_i], (soff), 0, 0); } while (0)
#define PG8_LDA(dst, b, h) do { _Pragma("unroll") for (int m = 0; m < 4; ++m) _Pragma("unroll") for (int k = 0; k < 2; ++k) dst[m][k] = *(const LAS bf16x8*)(lds + PG8_SA(b, h) + aoff + m * 2048 + k * KOFF); } while (0)
#define PG8_LDB(dst, b, h) do { _Pragma("unroll") for (int n = 0; n < 2; ++n) _Pragma("unroll") for (int k = 0; k < 2; ++k) dst[n][k] = *(const LAS bf16x8*)(lds + PG8_SB(b, h) + boff + n * 2048 + k * KOFF); } while (0)
#define PG8_V8(f) __builtin_shufflevector(__builtin_bit_cast(u32x4, (f)[0]), __builtin_bit_cast(u32x4, (f)[1]), 0, 1, 2, 3, 4, 5, 6, 7)
#define PG8_MMA(ai, bj, At, Bt_) do { __builtin_amdgcn_s_setprio(1); _Pragma("unroll") for (int m = 0; m < 4; ++m) _Pragma("unroll") for (int n = 0; n < 2; ++n) { \
        if constexpr (F8) acc[ai][bj][m][n] = __builtin_amdgcn_mfma_scale_f32_16x16x128_f8f6f4(__builtin_bit_cast(v8i, PG8_V8(Bt_[n])), __builtin_bit_cast(v8i, PG8_V8(At[m])), acc[ai][bj][m][n], 0, 0, 0, sclB, 0, sclA); \
        else { _Pragma("unroll") for (int k = 0; k < 2; ++k) acc[ai][bj][m][n] = __builtin_amdgcn_mfma_f32_16x16x32_bf16(Bt_[n][k], At[m][k], acc[ai][bj][m][n], 0, 0, 0); } } __builtin_amdgcn_s_setprio(0); } while (0)
#define PG8_WAIT_V(n) asm volatile("s_waitcnt vmcnt(" #n ")" ::: "memory")
#define PG8_WAIT_L(n) asm volatile("s_waitcnt lgkmcnt(" #n ")" ::: "memory")
#define PG8_BAR __builtin_amdgcn_s_barrier()
#define PG8_SCHED __builtin_amdgcn_sched_barrier(0)
#define PG8_TBL(u, bf) __builtin_amdgcn_raw_ptr_buffer_load_lds(rT, (LAS void*)(lds + RI_OFF + ((bf) * 2 + wr) * 4096 + wc * 1024), 16, (unsigned)lane * 16u, S.tbl_off(u) + (unsigned)wc * 1024u, 0, 0)
#define PG8_AOFFS(u, ao) do { _Pragma("unroll") for (int _i = 0; _i < 2; ++_i) { int _R, _C; stage_rc(opaque_tid(wid) * 16 + _i * 8192, _R, _C); _Pragma("unroll") for (int _h = 0; _h < 2; ++_h) \
        ao[_h][_i] = (unsigned)S.src_row(u, _h * HALF + _R) * (unsigned)ldab + (unsigned)_C * 2u; } } while (0)
    Unit cur, nxt; int ui = 0;
    if (!S.next(0, cur)) return;
    f32x4 acc[2][2][4][2];
#pragma unroll
    for (int a = 0; a < 2; ++a)
#pragma unroll
        for (int b = 0; b < 2; ++b)
#pragma unroll
            for (int m = 0; m < 4; ++m)
#pragma unroll
                for (int n = 0; n < 2; ++n) acc[a][b][m][n] = (f32x4){0.f, 0.f, 0.f, 0.f};
    bf16x8 At[4][2], B0[2][2], B1[2][2];
    unsigned aoc[2][2], aon[2][2];
    PG8_AOFFS(cur, aoc);
    unsigned sA = (unsigned)cur.kt0 * kstep;
    unsigned sB = (unsigned)(S.b_off(cur) * 2) + (unsigned)cur.pn * tstep + (unsigned)cur.kt0 * kstep;
    PG8_TBL(cur, 0);
    PG8_STAGE(PG8_SB(0, 0), rB, sB, voffB); PG8_STAGE(PG8_SB(0, 1), rB, sB + hstep, voffB); PG8_STAGE(PG8_SA(0, 0), rA, sA, aoc[0]); PG8_STAGE(PG8_SA(0, 1), rA, sA, aoc[1]);
    if (wr == 1) PG8_BAR;
    PG8_WAIT_V(2); PG8_BAR;
    PG8_STAGE(PG8_SB(1, 0), rB, sB + kstep, voffB); PG8_STAGE(PG8_SA(1, 0), rA, sA + kstep, aoc[0]); PG8_STAGE(PG8_SB(1, 1), rB, sB + hstep + kstep, voffB);
    PG8_WAIT_V(6); PG8_BAR;
    for (;;) {
        const bool has_next = S.next(ui + 1, nxt);
        if (has_next) { PG8_AOFFS(nxt, aon); } else {
#pragma unroll
            for (int h = 0; h < 2; ++h)
#pragma unroll
                for (int i = 0; i < 2; ++i) aon[h][i] = aoc[h][i]; }
        const unsigned nsB = has_next ? (unsigned)(S.b_off(nxt) * 2) + (unsigned)nxt.pn * tstep + (unsigned)nxt.kt0 * kstep : sB;
        const unsigned nsA = has_next ? (unsigned)nxt.kt0 * kstep : sA;
        const int nt = cur.nkt; int tsel = has_next ? 0 : -2; asm volatile("" : "+s"(tsel));
        for (int t = 0; t < nt; t += 2) {
            const bool last = (t == nt - 2);
            const unsigned a1 = sA + (unsigned)(t + 1) * kstep;
            const unsigned a2 = last ? nsA : sA + (unsigned)(t + 2) * kstep, b2 = last ? nsB : sB + (unsigned)(t + 2) * kstep;
            const unsigned a3 = a2 + kstep, b3 = b2 + kstep;
            PG8_LDB(B0, 0, 0); PG8_LDB(B1, 0, 1); PG8_SCHED; PG8_LDA(At, 0, 0); PG8_STAGE(PG8_SA(1, 1), rA, a1, aoc[1]);
            if (last) {
#pragma unroll
                for (int h = 0; h < 2; ++h)
#pragma unroll
                    for (int i = 0; i < 2; ++i) aoc[h][i] = aon[h][i]; }
            PG8_WAIT_V(8); PG8_WAIT_L(0); PG8_BAR; PG8_MMA(0, 0, At, B0); PG8_MMA(0, 1, At, B1); PG8_BAR; PG8_SCHED;
            PG8_LDA(At, 0, 1); if (t == tsel) PG8_TBL(nxt, (ui + 1) & 1);
            PG8_STAGE(PG8_SB(0, 0), rB, b2, voffB); PG8_STAGE(PG8_SB(0, 1), rB, b2 + hstep, voffB); PG8_STAGE(PG8_SA(0, 0), rA, a2, aoc[0]);
            PG8_WAIT_V(8); PG8_WAIT_L(0); PG8_BAR; PG8_MMA(1, 0, At, B0); PG8_MMA(1, 1, At, B1); PG8_BAR; PG8_SCHED;
            PG8_LDB(B0, 1, 0); PG8_LDB(B1, 1, 1); PG8_SCHED; PG8_LDA(At, 1, 0); PG8_STAGE(PG8_SA(0, 1), rA, a2, aoc[1]);
            PG8_WAIT_V(8); PG8_WAIT_L(0); PG8_BAR; PG8_MMA(0, 0, At, B0); PG8_MMA(0, 1, At, B1); PG8_BAR; PG8_SCHED;
            PG8_LDA(At, 1, 1); PG8_STAGE(PG8_SB(1, 0), rB, b3, voffB); PG8_STAGE(PG8_SB(1, 1), rB, b3 + hstep, voffB); PG8_STAGE(PG8_SA(1, 0), rA, a3, aoc[0]);
            PG8_WAIT_V(8); PG8_WAIT_L(0); PG8_BAR; PG8_MMA(1, 0, At, B0); PG8_MMA(1, 1, At, B1); PG8_BAR; PG8_SCHED;
        }
        if constexpr (ALIGN_EPI) { if (wr == 0) PG8_BAR; }
        if (!noepi) E(acc, cur, wr, wc, fr, fq, (const LAS f32x4*)(lds + RI_OFF + ((ui & 1) * 2 + wr) * 4096));
        if (!has_next) break;
#pragma unroll
        for (int a = 0; a < 2; ++a)
#pragma unroll
            for (int b = 0; b < 2; ++b)
#pragma unroll
                for (int m = 0; m < 4; ++m)
#pragma unroll
                    for (int n = 0; n < 2; ++n) acc[a][b][m][n] = (f32x4){0.f, 0.f, 0.f, 0.f};
        cur = nxt; sB = nsB; sA = nsA; ++ui;
        if constexpr (ALIGN_EPI) { if (wr == 1) PG8_BAR; }
    }
    PG8_WAIT_V(0);
    if constexpr (!ALIGN_EPI) { if (wr == 0) PG8_BAR; }
    PG8_BAR;
#undef PG8_SA
#undef PG8_SB
#undef PG8_STAGE
#undef PG8_LDA
#undef PG8_LDB
#undef PG8_MMA
#undef PG8_V8
#undef PG8_WAIT_V
#undef PG8_WAIT_L
#undef PG8_BAR
#undef PG8_SCHED
#undef PG8_AOFFS
#undef PG8_TBL
}
}

namespace cg = cooperative_groups;
constexpr int NTHREADS = 512, NWAVES = 8;
constexpr int LDS_BYTES = 163840;
constexpr int LDS_TB = LDS_BYTES - 1024;
constexpr int LDS_PTR = LDS_TB + 256;
constexpr int LDS_BST = LDS_PTR + 256;

struct Params {
    const float* in[23];
    float* out; unsigned char* ws;
    unsigned mask; int probe;
};
enum { I_X = 0, I_EMIXN, I_EWIN, I_ECONVW, I_ELNG, I_ELNB, I_EWSP, I_EBSP, I_EWOUT, I_EFFNN, I_EWGATE, I_EWUP, I_EWDOWN, I_OMIXN, I_OWQKV, I_OQN, I_OKN, I_OWO, I_OFFNN, I_OWR, I_OWGATE, I_OWUP, I_OWDOWN, I_OUT, I_WS };
struct Ctx { LAS unsigned char* lds; int wid, bid, G; bool noepi;
    template <class Tp> __device__ __forceinline__ Tp* ptr(int i) const { const unsigned long long v = ((const volatile LAS unsigned long long*)(lds + LDS_PTR))[i];
        const unsigned lo = __builtin_amdgcn_readfirstlane((unsigned)v), hi = __builtin_amdgcn_readfirstlane((unsigned)(v >> 32)); return (Tp*)(((unsigned long long)hi << 32) | lo); }
    __device__ __forceinline__ const float* in(int i) const { return ptr<const float>(i); }
    __device__ __forceinline__ unsigned char* ws() const { return ptr<unsigned char>(I_WS); }
    __device__ __forceinline__ float* out() const { return ptr<float>(I_OUT); }
};

#define XB_TMO      128
#define XB_XCNT(j)  (256  + 64 * (j))
#define XB_XSUB(j)  (1280 + 64 * (j))
#define XB_XGEN(j)  (2304 + 64 * (j))
#define XB_TOP      3328
#define XB_TOPGEN   3392
#define XCD_BAR_WORDS 3456
#define XB_SPIN_CAP (1u << 20)
__device__ __forceinline__ unsigned xb_ld(unsigned* p)              { return __hip_atomic_load(p, __ATOMIC_RELAXED, __HIP_MEMORY_SCOPE_AGENT); }
__device__ __forceinline__ unsigned xb_add(unsigned* p, unsigned v) { return __hip_atomic_fetch_add(p, v, __ATOMIC_RELAXED, __HIP_MEMORY_SCOPE_AGENT); }
__device__ __forceinline__ unsigned xb_xcc_id() { return (unsigned)__builtin_amdgcn_s_getreg((3 << 11) | 20) & 0xFu; }
#define XB_SPIN(cond, bar) do { unsigned _sp = 0; while (cond) { __builtin_amdgcn_s_sleep(1); \
    if ((++_sp & 255u) == 0u) { if (xb_ld(&(bar)[XB_TMO])) break; if (_sp > XB_SPIN_CAP) { atomicAdd(&(bar)[XB_TMO], 1u); break; } } } } while (0)
__device__ __forceinline__ void xcd_barrier_complete(unsigned* bar, unsigned x, unsigned G, unsigned& nloc, unsigned& nx) {
    unsigned sum, cnt, mine, sp = 0u;
    for (;;) {
        sum = 0u; cnt = 0u; mine = 0u;
#pragma unroll
        for (unsigned j = 0; j < 16; ++j) { const unsigned c = xb_ld(&bar[XB_XCNT(j)]); sum += c; cnt += (c > 0u) ? 1u : 0u; mine = (j == x) ? c : mine; }
        if (sum == G) break;
        __builtin_amdgcn_s_sleep(1);
        if ((++sp & 255u) == 0u) { if (xb_ld(&bar[XB_TMO])) break; if (sp > XB_SPIN_CAP) { atomicAdd(&bar[XB_TMO], 1u); break; } }
    }
    nloc = mine > 0u ? mine : 1u; nx = cnt > 0u ? cnt : 1u;
}
__device__ __forceinline__ void grid_barrier(const Ctx& C) {
    asm volatile("s_waitcnt vmcnt(0)" ::: "memory");
    __syncthreads();
    if (opaque_tid(C.wid) == 0) {
        unsigned* bar = (unsigned*)C.ws() + CW_BAR; volatile LAS unsigned* st = (volatile LAS unsigned*)(C.lds + LDS_BST); const unsigned x = xb_xcc_id();
        __builtin_amdgcn_s_waitcnt(0);
        unsigned nloc = st[0], nx = st[1];
        if (nloc == 0u) { xcd_barrier_complete(bar, x, (unsigned)C.G, nloc, nx); st[0] = nloc; st[1] = nx; }
        const unsigned old = xb_add(&bar[XB_XSUB(x)], 1u);
        const unsigned gen = old / nloc;
        if (old + 1u == (gen + 1u) * nloc) {
            __builtin_amdgcn_fence(__ATOMIC_RELEASE, "agent");
            asm volatile("s_waitcnt vmcnt(0)" ::: "memory");
            const unsigned og = xb_add(&bar[XB_TOP], 1u);
            const unsigned tg = og / nx;
            if (og + 1u == (tg + 1u) * nx) xb_add(&bar[XB_TOPGEN], 1u);
            else XB_SPIN(xb_ld(&bar[XB_TOPGEN]) == tg, bar);
            __builtin_amdgcn_fence(__ATOMIC_ACQUIRE, "agent");
            xb_add(&bar[XB_XGEN(x)], 1u);
            asm volatile("s_waitcnt vmcnt(0)" ::: "memory");
        } else {
            XB_SPIN(xb_ld(&bar[XB_XGEN(x)]) == gen, bar);
            __builtin_amdgcn_fence(__ATOMIC_ACQUIRE, "agent");
            asm volatile("s_waitcnt vmcnt(0)" ::: "memory");
        }
    }
    __syncthreads();
}

__device__ __forceinline__ void p0_transpose_item(const float* W, int K, int N, bf16_t* WT, const float* fold, int inter, int which, LAS float* scr, int item, int lane) {
    const int nblk = N / 32, kb = item / nblk, nb = item % nblk, k0 = 64 * kb, n0 = 32 * nb;
    const int kr = lane >> 3, c4 = lane & 7; f32x4 v[8]; float f[8];
#pragma unroll
    for (int i = 0; i < 8; ++i) v[i] = *(const f32x4*)(W + (size_t)(k0 + 8 * i + kr) * N + n0 + 4 * c4);
#pragma unroll
    for (int i = 0; i < 8; ++i) f[i] = fold ? fold[k0 + 8 * i + kr] : 1.0f;
#pragma unroll
    for (int i = 0; i < 8; ++i) { LAS float* d = scr + (8 * i + kr) * 33 + 4 * c4; d[0] = v[i][0] * f[i]; d[1] = v[i][1] * f[i]; d[2] = v[i][2] * f[i]; d[3] = v[i][3] * f[i]; }
    asm volatile("s_waitcnt lgkmcnt(0)" ::: "memory");
    const int c = lane & 7;
#pragma unroll
    for (int j = 0; j < 4; ++j) { const int nl = (lane >> 3) + 8 * j, n = n0 + nl; const LAS float* sp = scr + (8 * c) * 33 + nl;
        u32x4 o; o.x = pk2(sp[0 * 33], sp[1 * 33]); o.y = pk2(sp[2 * 33], sp[3 * 33]); o.z = pk2(sp[4 * 33], sp[5 * 33]); o.w = pk2(sp[6 * 33], sp[7 * 33]);
        const int dr = inter ? (n / 128) * 256 + which * 128 + (n % 128) : n;
        *(u32x4*)(WT + (size_t)dr * K + k0 + 8 * c) = o; }
    asm volatile("s_waitcnt lgkmcnt(0)" ::: "memory");
}
__device__ __forceinline__ void p0_transpose_item8(const float* W, int K, int N, unsigned char* WT, const float* fold, int inter, int which, LAS float* scr, int item, int lane) {
    const int nblk = N / 32, kb = item / nblk, nb = item % nblk, k0 = 64 * kb, n0 = 32 * nb;
    const int kr = lane >> 3, c4 = lane & 7; f32x4 v[8]; float f[8];
#pragma unroll
    for (int i = 0; i < 8; ++i) v[i] = *(const f32x4*)(W + (size_t)(k0 + 8 * i + kr) * N + n0 + 4 * c4);
#pragma unroll
    for (int i = 0; i < 8; ++i) f[i] = (fold ? fold[k0 + 8 * i + kr] : 1.0f) * 64.0f;
#pragma unroll
    for (int i = 0; i < 8; ++i) { LAS float* d = scr + (8 * i + kr) * 33 + 4 * c4; d[0] = v[i][0] * f[i]; d[1] = v[i][1] * f[i]; d[2] = v[i][2] * f[i]; d[3] = v[i][3] * f[i]; }
    asm volatile("s_waitcnt lgkmcnt(0)" ::: "memory");
    const int c = lane & 7;
#pragma unroll
    for (int j = 0; j < 4; ++j) { const int nl = (lane >> 3) + 8 * j, n = n0 + nl; const LAS float* sp = scr + (8 * c) * 33 + nl;
        u32x2 o; o.x = pk_fp8x4(sp[0 * 33], sp[1 * 33], sp[2 * 33], sp[3 * 33]); o.y = pk_fp8x4(sp[4 * 33], sp[5 * 33], sp[6 * 33], sp[7 * 33]);
        const int dr = inter ? (n / 128) * 256 + which * 128 + (n % 128) : n;
        *(u32x2*)(WT + (size_t)dr * K + k0 + 8 * c) = o; }
    asm volatile("s_waitcnt lgkmcnt(0)" ::: "memory");
}
constexpr int CW_CVT = 896;
constexpr int CV_IMG = (D / 64) * (FE / 32), CV_IMD = (FE / 64) * (D / 32), CV_NMOE = NE * (2 * CV_IMG + CV_IMD), CV_BATCH = 2 * NWAVES;
constexpr int CV_IIN = (D / 64) * (NPROJ / 32), CV_IOUT = (D / 64) * (D / 32), CV_IG = (D / 64) * (FF / 32), CV_IDN = (FF / 64) * (D / 32), CV_IQKV = (D / 64) * (NQKV / 32);
constexpr int CV_NDENSE = CV_IIN + CV_IOUT + 2 * CV_IG + CV_IDN + CV_IQKV + CV_IOUT;
constexpr int CV_SCR = 2 * 64 * 33 * 4, CV_BC = NWAVES * CV_SCR;
static_assert(CV_BC + 64 <= LDS_TB, "cvt LDS map");
struct CvItem { const float* W; unsigned char* WT; const float* fold; int K, N, inter, which, k0, n0, f8; };
__device__ __forceinline__ CvItem cv_decode(const Ctx& C, int r) {
    CvItem it; unsigned char* ws = C.ws(); int item; it.inter = 0; it.which = 0; it.fold = nullptr; it.f8 = 0;
    if (r < 2 * NE * CV_IMG) { const int which = r >= NE * CV_IMG ? 1 : 0, rr = r - which * NE * CV_IMG, e = rr / CV_IMG; item = rr % CV_IMG;
        it.W = C.in(which ? I_OWUP : I_OWGATE) + (size_t)e * D * FE; it.K = D; it.N = FE; it.WT = ws + WS_MGU + (size_t)e * NGUE * D; it.fold = C.in(I_OFFNN); it.inter = 1; it.which = which; it.f8 = 1; }
    else if (r < CV_NMOE) { const int rr = r - 2 * NE * CV_IMG, e = rr / CV_IMD; item = rr % CV_IMD;
        it.W = C.in(I_OWDOWN) + (size_t)e * FE * D; it.K = FE; it.N = D; it.WT = ws + WS_MDN + (size_t)e * D * FE; it.f8 = 1; }
    else { int q = r - CV_NMOE;
        if (q < CV_IIN) { it.W = C.in(I_EWIN); it.K = D; it.N = NPROJ; it.WT = ws + WS_WIN; it.fold = C.in(I_EMIXN); }
        else if ((q -= CV_IIN) < CV_IOUT) { it.W = C.in(I_EWOUT); it.K = D; it.N = D; it.WT = ws + WS_WOUT; }
        else if ((q -= CV_IOUT) < 2 * CV_IG) { const int which = q >= CV_IG ? 1 : 0; q -= which * CV_IG; it.W = C.in(which ? I_EWUP : I_EWGATE); it.K = D; it.N = FF; it.WT = ws + WS_WGU; it.fold = C.in(I_EFFNN); it.inter = 1; it.which = which; }
        else if ((q -= 2 * CV_IG) < CV_IDN) { it.W = C.in(I_EWDOWN); it.K = FF; it.N = D; it.WT = ws + WS_WDN; }
        else if ((q -= CV_IDN) < CV_IQKV) { it.W = C.in(I_OWQKV); it.K = D; it.N = NQKV; it.WT = ws + WS_WQKV; it.fold = C.in(I_OMIXN); }
        else { q -= CV_IQKV; it.W = C.in(I_OWO); it.K = D; it.N = D; it.WT = ws + WS_WO; }
        item = q; }
    const int nblk = it.N / 32; it.k0 = 64 * (item / nblk); it.n0 = 32 * (item % nblk);
    return it;
}
__device__ __forceinline__ void cv_load(const CvItem& it, int lane, f32x4 (&v)[8], float (&f)[8]) {
    const int kr = lane >> 3, c4 = lane & 7;
#pragma unroll
    for (int i = 0; i < 8; ++i) v[i] = *(const f32x4*)(it.W + (size_t)(it.k0 + 8 * i + kr) * it.N + it.n0 + 4 * c4);
    const float sc = it.f8 ? 64.0f : 1.0f;
#pragma unroll
    for (int i = 0; i < 8; ++i) f[i] = (it.fold ? it.fold[it.k0 + 8 * i + kr] : 1.0f) * sc;
}
__device__ __forceinline__ void cv_finish(const CvItem& it, int lane, const f32x4 (&v)[8], const float (&f)[8], LAS float* scr) {
    const int kr = lane >> 3, c4 = lane & 7;
#pragma unroll
    for (int i = 0; i < 8; ++i) { LAS float* d = scr + (8 * i + kr) * 33 + 4 * c4; d[0] = v[i][0] * f[i]; d[1] = v[i][1] * f[i]; d[2] = v[i][2] * f[i]; d[3] = v[i][3] * f[i]; }
    asm volatile("s_waitcnt lgkmcnt(0)" ::: "memory");
    const int c = lane & 7;
#pragma unroll
    for (int j = 0; j < 4; ++j) { const int nl = (lane >> 3) + 8 * j, n = it.n0 + nl; const LAS float* sp = scr + (8 * c) * 33 + nl;
        const int dr = it.inter ? (n / 128) * 256 + it.which * 128 + (n % 128) : n;
        if (it.f8) { u32x2 o; o.x = pk_fp8x4(sp[0 * 33], sp[1 * 33], sp[2 * 33], sp[3 * 33]); o.y = pk_fp8x4(sp[4 * 33], sp[5 * 33], sp[6 * 33], sp[7 * 33]);
            *(u32x2*)(it.WT + (size_t)dr * it.K + it.k0 + 8 * c) = o; }
        else { u32x4 o; o.x = pk2(sp[0 * 33], sp[1 * 33]); o.y = pk2(sp[2 * 33], sp[3 * 33]); o.z = pk2(sp[4 * 33], sp[5 * 33]); o.w = pk2(sp[6 * 33], sp[7 * 33]);
            *(u32x4*)((bf16_t*)it.WT + (size_t)dr * it.K + it.k0 + 8 * c) = o; } }
}
__device__ __forceinline__ void cvt_queue(const Ctx& C, int q, int first, int last) {
    unsigned* ctr = (unsigned*)C.ws() + CW_CVT + 16 * q;
    const int tid = opaque_tid(C.wid), lane = tid & 63, wave = C.wid;
    LAS float* scr = (LAS float*)(C.lds + wave * CV_SCR); volatile LAS unsigned* bc = (volatile LAS unsigned*)(C.lds + CV_BC);
    __syncthreads();
    if (tid == 0) bc[0] = xb_add(ctr, (unsigned)CV_BATCH);
    __syncthreads();
    int base = first + (int)bc[0], par = 0;
    while (base < last) {
        unsigned nxt = 0u;
        if (tid == 0) nxt = xb_add(ctr, (unsigned)CV_BATCH);
        const int r0 = base + wave, r1 = r0 + NWAVES;
        if (r0 < last) { const CvItem a = cv_decode(C, r0); f32x4 va[8]; float fa[8]; cv_load(a, lane, va, fa);
            if (r1 < last) { const CvItem b = cv_decode(C, r1); f32x4 vb[8]; float fb[8]; cv_load(b, lane, vb, fb); cv_finish(a, lane, va, fa, scr); cv_finish(b, lane, vb, fb, scr + 64 * 33); }
            else cv_finish(a, lane, va, fa, scr); }
        par ^= 1;
        if (tid == 0) bc[par] = nxt;
        __syncthreads();
        base = first + (int)bc[par];
    }
}
__device__ __forceinline__ void phase_prep(const Ctx& C) {
    const int bid = C.bid, G = C.G; unsigned char* ws = C.ws(); const int tid = opaque_tid(C.wid), lane = tid & 63, wave = C.wid;
    const int gw = bid * NWAVES + wave, NGW = G * NWAVES;
    cvt_queue(C, 0, CV_NMOE, CV_NMOE + CV_IIN);
    bf16_t* xb = (bf16_t*)(ws + WS_ARENA + AR_XB); float* ss0 = (float*)(ws + WS_SS0); const float* xin = C.in(I_X);
    for (int row0 = gw; row0 < T; row0 += 4 * NGW) {
        f32x4 v[4][4];
#pragma unroll
        for (int r = 0; r < 4; ++r) { const int row = row0 + r * NGW; const f32x4* xr = (const f32x4*)(xin + (size_t)(row < T ? row : row0) * D) + lane;
#pragma unroll
            for (int j = 0; j < 4; ++j) v[r][j] = xr[64 * j]; }
#pragma unroll
        for (int r = 0; r < 4; ++r) { const int row = row0 + r * NGW; if (row < T) { float sq = 0.f; u32x2* o = (u32x2*)(xb + (size_t)row * D) + lane;
#pragma unroll
            for (int j = 0; j < 4; ++j) { const f32x4 x4 = v[r][j]; sq += (x4[0] * x4[0] + x4[1] * x4[1]) + (x4[2] * x4[2] + x4[3] * x4[3]); u32x2 w; w.x = pk2(x4[0], x4[1]); w.y = pk2(x4[2], x4[3]); o[64 * j] = w; }
            sq = wave_sum(sq);
            if (lane < NSS) ss0[(size_t)row * NSS + lane] = (lane == 0) ? sq : 0.f; } }
    }
    { float* km = (float*)(ws + WS_KMEAN); for (int i = bid * NTHREADS + tid; i < NBATCH * NH * NBLK * HD; i += G * NTHREADS) km[i] = 0.f; }
    float* tab = (float*)(ws + WS_ROPE);
    for (int i = bid * NTHREADS + tid; i < SEQ * 16; i += G * NTHREADS) { const int sp = i / 16, f = i % 16; const double inv = pow(500000.0, -(double)f / 16.0); const double ang = (double)sp * inv;
        tab[2 * i] = (float)cos(ang); tab[2 * i + 1] = (float)sin(ang); }
}

constexpr int MX_VROW = 520, MX_MU = 256 * MX_VROW;
__device__ __forceinline__ void phase_mixer(const Ctx& C) {
    LAS unsigned char* lds = C.lds; const int bid = C.bid, G = C.G; unsigned char* ws = C.ws();
    const float* conv_w = C.in(I_ECONVW); const float* ln_g = C.in(I_ELNG); const float* ln_b = C.in(I_ELNB); const float* w_sp = C.in(I_EWSP); const float* b_sp = C.in(I_EBSP);
    const bf16_t* proj = (const bf16_t*)(ws + WS_ARENA + AR_PROJ); bf16_t* y = (bf16_t*)(ws + WS_ARENA + AR_Y);
    LAS float* mu = (LAS float*)(lds + MX_MU); LAS float* rstd = mu + 128;
    const int tid = opaque_tid(C.wid), lane = tid & 63, wave = C.wid, r31 = lane & 31, hh = lane >> 5;
    for (int unit = bid; unit < (T / 128) * 2; unit += G) {
        const int c = unit >> 1, hf = unit & 1, t0 = c * 128;
        { u32x4 vv[16];
#pragma unroll
          for (int i = 0; i < 16; ++i) vv[i] = *(const u32x4*)(proj + (size_t)(t0 + wave * 16 + i) * NPROJ + 3 * CONV + GM + lane * 8);
#pragma unroll
          for (int i = 0; i < 16; ++i) { const int sl = wave * 16 + i; const u32x4 v = vv[i];
            const float x0 = bf2f(v.x & 0xffffu), x1 = __builtin_bit_cast(float, v.x & 0xffff0000u), x2 = bf2f(v.y & 0xffffu), x3 = __builtin_bit_cast(float, v.y & 0xffff0000u),
                        x4 = bf2f(v.z & 0xffffu), x5 = __builtin_bit_cast(float, v.z & 0xffff0000u), x6 = bf2f(v.w & 0xffffu), x7 = __builtin_bit_cast(float, v.w & 0xffff0000u);
            float sm = ((x0 + x1) + (x2 + x3)) + ((x4 + x5) + (x6 + x7)), sq = ((x0 * x0 + x1 * x1) + (x2 * x2 + x3 * x3)) + ((x4 * x4 + x5 * x5) + (x6 * x6 + x7 * x7));
            sm = wave_sum(sm); sq = wave_sum(sq); const float m = sm * (1.0f / GM), var = sq * (1.0f / GM) - m * m;
            if (lane == 0) { mu[sl] = m; rstd[sl] = rsqrtf(fmaxf(var, 0.f) + EPS); } } }
        { const int co = tid & 31, sg = tid >> 5, ch = 256 * hf + 8 * co; float w0[8], w1[8], w2[8];
#pragma unroll
          for (int j = 0; j < 8; ++j) { w0[j] = conv_w[ch + j]; w1[j] = conv_w[CONV + ch + j]; w2[j] = conv_w[2 * CONV + ch + j]; }
          float zm2[8], zm1[8];
#pragma unroll
          for (int j = 0; j < 8; ++j) { zm2[j] = 0.f; zm1[j] = 0.f; }
#pragma unroll
          for (int i = -2; i < 8; ++i) { const int t = t0 + 8 * sg + i; const bool inseq = (i >= 0) || ((t0 + 8 * sg) % SEQ != 0);
              const bf16_t* pr = proj + (size_t)(inseq ? t : t0) * NPROJ + ch; const u32x4 ah = *(const u32x4*)pr, ac = *(const u32x4*)(pr + CONV);
              float z[8];
              z[0] = bf2f(ah.x & 0xffffu) * bf2f(ac.x & 0xffffu); z[1] = __builtin_bit_cast(float, ah.x & 0xffff0000u) * __builtin_bit_cast(float, ac.x & 0xffff0000u);
              z[2] = bf2f(ah.y & 0xffffu) * bf2f(ac.y & 0xffffu); z[3] = __builtin_bit_cast(float, ah.y & 0xffff0000u) * __builtin_bit_cast(float, ac.y & 0xffff0000u);
              z[4] = bf2f(ah.z & 0xffffu) * bf2f(ac.z & 0xffffu); z[5] = __builtin_bit_cast(float, ah.z & 0xffff0000u) * __builtin_bit_cast(float, ac.z & 0xffff0000u);
              z[6] = bf2f(ah.w & 0xffffu) * bf2f(ac.w & 0xffffu); z[7] = __builtin_bit_cast(float, ah.w & 0xffff0000u) * __builtin_bit_cast(float, ac.w & 0xffff0000u);
              if (!inseq) {
#pragma unroll
                  for (int j = 0; j < 8; ++j) z[j] = 0.f; }
              if (i >= 0) { const u32x4 ab = *(const u32x4*)(pr + 2 * CONV); float o[8];
#pragma unroll
                  for (int j = 0; j < 8; ++j) o[j] = w0[j] * zm2[j] + w1[j] * zm1[j] + w2[j] * z[j];
                  u32x4 w; w.x = pk2(bf2f(ab.x & 0xffffu) * o[0], __builtin_bit_cast(float, ab.x & 0xffff0000u) * o[1]); w.y = pk2(bf2f(ab.y & 0xffffu) * o[2], __builtin_bit_cast(float, ab.y & 0xffff0000u) * o[3]);
                  w.z = pk2(bf2f(ab.z & 0xffffu) * o[4], __builtin_bit_cast(float, ab.z & 0xffff0000u) * o[5]); w.w = pk2(bf2f(ab.w & 0xffffu) * o[6], __builtin_bit_cast(float, ab.w & 0xffff0000u) * o[7]);
                  *(u32x4*)(y + (size_t)t * D + ch) = w; }
#pragma unroll
              for (int j = 0; j < 8; ++j) { zm2[j] = zm1[j]; zm1[j] = z[j]; } } }
        __syncthreads();
#pragma unroll
        for (int i = 0; i < 4; ++i) { const int v = tid + 512 * i, sq4 = v >> 6, cq = v & 63, chl = 4 * cq, chg = 256 * hf + chl; const bf16_t* src = proj + (size_t)(t0 + 4 * sq4) * NPROJ + 3 * CONV + GM + chg;
            const f32x4 gg = *(const f32x4*)(ln_g + chg), bb = *(const f32x4*)(ln_b + chg);
            unsigned e[4][4];
#pragma unroll
            for (int r = 0; r < 4; ++r) { const u32x2 rv = *(const u32x2*)(src + (size_t)r * NPROJ); const float m = mu[4 * sq4 + r], rs = rstd[4 * sq4 + r];
                e[r][0] = f2bf((bf2f(rv.x & 0xffffu) - m) * rs * gg[0] + bb[0]); e[r][1] = f2bf((__builtin_bit_cast(float, rv.x & 0xffff0000u) - m) * rs * gg[1] + bb[1]);
                e[r][2] = f2bf((bf2f(rv.y & 0xffffu) - m) * rs * gg[2] + bb[2]); e[r][3] = f2bf((__builtin_bit_cast(float, rv.y & 0xffff0000u) - m) * rs * gg[3] + bb[3]); }
            LAS unsigned char* dst = lds + chl * MX_VROW + sq4 * 8;
#pragma unroll
            for (int d = 0; d < 4; ++d) { u32x2 w; w.x = e[0][d] | (e[1][d] << 16); w.y = e[2][d] | (e[3][d] << 16); *(LAS u32x2*)(dst + d * MX_VROW) = w; } }
        __syncthreads();
        { const int gl = wave >> 1, dt = wave & 1, g = 4 * hf + gl, chl = 64 * gl + 32 * dt + r31;
          bf16x8 bfr[8];
#pragma unroll
          for (int ks = 0; ks < 8; ++ks) { const LAS unsigned char* vp = lds + chl * MX_VROW + (16 * ks + 8 * hh) * 2; const u32x2 v0 = *(const LAS u32x2*)vp, v1 = *(const LAS u32x2*)(vp + 8);
              u32x4 w; w.x = v0.x; w.y = v0.y; w.z = v1.x; w.w = v1.y; bfr[ks] = __builtin_bit_cast(bf16x8, w); }
#pragma unroll
          for (int tt = 0; tt < 4; ++tt) { f32x16 acc;
#pragma unroll
              for (int i = 0; i < 16; ++i) acc[i] = 0.f;
              const int trow = 32 * tt + r31; const float* wrow = w_sp + ((size_t)g * 128 + trow) * 128 + 8 * hh;
#pragma unroll
              for (int ks = 0; ks < 8; ++ks) if (ks < 2 * tt + 2) { const f32x4 a0 = *(const f32x4*)(wrow + 16 * ks), a1 = *(const f32x4*)(wrow + 16 * ks + 4); float av[8] = {a0[0], a0[1], a0[2], a0[3], a1[0], a1[1], a1[2], a1[3]};
                  if (ks >= 2 * tt) {
#pragma unroll
                      for (int j = 0; j < 8; ++j) if (16 * ks + 8 * hh + j > trow) av[j] = 0.f; }
                  u32x4 w; w.x = pk2(av[0], av[1]); w.y = pk2(av[2], av[3]); w.z = pk2(av[4], av[5]); w.w = pk2(av[6], av[7]);
                  acc = __builtin_amdgcn_mfma_f32_32x32x16_bf16(bfr[ks], __builtin_bit_cast(bf16x8, w), acc, 0, 0, 0); }
              const int chg0 = 256 * hf + 64 * gl + 32 * dt + 4 * hh, t = t0 + trow; const float bias = b_sp[g * 128 + trow];
              const bf16_t* gp = proj + (size_t)t * NPROJ + 3 * CONV + chg0; bf16_t* yp = y + (size_t)t * D + CONV + chg0;
#pragma unroll
              for (int g4 = 0; g4 < 4; ++g4) { const u32x2 gu = *(const u32x2*)(gp + 8 * g4); u32x2 o;
                  o.x = pk2(bf2f(gu.x & 0xffffu) * (acc[4 * g4 + 0] + bias), __builtin_bit_cast(float, gu.x & 0xffff0000u) * (acc[4 * g4 + 1] + bias));
                  o.y = pk2(bf2f(gu.y & 0xffffu) * (acc[4 * g4 + 2] + bias), __builtin_bit_cast(float, gu.y & 0xffff0000u) * (acc[4 * g4 + 3] + bias)); *(u32x2*)(yp + 8 * g4) = o; } } }
        __syncthreads();
    }
}

__device__ __forceinline__ void phase_qkprep(const Ctx& C) {
    LAS unsigned char* lds = C.lds; const int bid = C.bid, G = C.G; unsigned char* ws = C.ws(); const float* qn = C.in(I_OQN); const float* kn = C.in(I_OKN);
    bf16_t* qkv = (bf16_t*)(ws + WS_ARENA + AR_QKV); const float* rope = (const float*)(ws + WS_ROPE); float* kmean = (float*)(ws + WS_KMEAN);
    LAS float* red = (LAS float*)lds;
    const int tid = opaque_tid(C.wid), lane = tid & 63, wave = C.wid, c16 = lane & 15, sub = lane >> 4;
    float gq[8], gk[8];
#pragma unroll
    for (int j = 0; j < 8; ++j) { gq[j] = qn[8 * c16 + j]; gk[j] = kn[8 * c16 + j]; }
    for (int item = bid; item < NBATCH * NBLK * NH; item += G) {
        const int h = item % NH, n = (item / NH) % NBLK, b = item / (NH * NBLK); float ks[8];
#pragma unroll
        for (int j = 0; j < 8; ++j) ks[j] = 0.f;
#pragma unroll 4
        for (int it = 0; it < 8; ++it) { const int sq = n * MB + wave * 32 + it * 4 + sub, t = b * SEQ + sq;
            float cs[8], sn[8];
            { const f32x4* rp = (const f32x4*)(rope + (sq * 16 + 8 * (c16 & 1)) * 2); f32x4 r0 = (f32x4){1.f, 0.f, 1.f, 0.f}, r1 = r0, r2 = r0, r3 = r0; if (c16 < 4) { r0 = rp[0]; r1 = rp[1]; r2 = rp[2]; r3 = rp[3]; }
              cs[0] = r0[0]; sn[0] = r0[1]; cs[1] = r0[2]; sn[1] = r0[3]; cs[2] = r1[0]; sn[2] = r1[1]; cs[3] = r1[2]; sn[3] = r1[3];
              cs[4] = r2[0]; sn[4] = r2[1]; cs[5] = r2[2]; sn[5] = r2[3]; cs[6] = r3[0]; sn[6] = r3[1]; cs[7] = r3[2]; sn[7] = r3[3]; }
#pragma unroll
            for (int which = 0; which < 2; ++which) { bf16_t* p = qkv + (size_t)t * NQKV + which * D + h * HD + 8 * c16; const u32x4 raw = *(const u32x4*)p;
                float v[8] = {bf2f(raw.x & 0xffffu), __builtin_bit_cast(float, raw.x & 0xffff0000u), bf2f(raw.y & 0xffffu), __builtin_bit_cast(float, raw.y & 0xffff0000u),
                              bf2f(raw.z & 0xffffu), __builtin_bit_cast(float, raw.z & 0xffff0000u), bf2f(raw.w & 0xffffu), __builtin_bit_cast(float, raw.w & 0xffff0000u)};
                float q = ((v[0] * v[0] + v[1] * v[1]) + (v[2] * v[2] + v[3] * v[3])) + ((v[4] * v[4] + v[5] * v[5]) + (v[6] * v[6] + v[7] * v[7]));
                q += __shfl_xor(q, 1); q += __shfl_xor(q, 2); q += __shfl_xor(q, 4); q += __shfl_xor(q, 8);
                const float r = rsqrtf(q * (1.0f / HD) + EPS);
#pragma unroll
                for (int j = 0; j < 8; ++j) v[j] = v[j] * r * (which ? gk[j] : gq[j]);
#pragma unroll
                for (int j = 0; j < 8; ++j) { const float pt = __shfl_xor(v[j], 2); if (c16 < 2) v[j] = v[j] * cs[j] - pt * sn[j]; else if (c16 < 4) v[j] = v[j] * cs[j] + pt * sn[j]; }
                u32x4 w; w.x = pk2(v[0], v[1]); w.y = pk2(v[2], v[3]); w.z = pk2(v[4], v[5]); w.w = pk2(v[6], v[7]);
                *(u32x4*)p = w;
                if (which) { ks[0] += bf2f(w.x & 0xffffu); ks[1] += __builtin_bit_cast(float, w.x & 0xffff0000u); ks[2] += bf2f(w.y & 0xffffu); ks[3] += __builtin_bit_cast(float, w.y & 0xffff0000u);
                             ks[4] += bf2f(w.z & 0xffffu); ks[5] += __builtin_bit_cast(float, w.z & 0xffff0000u); ks[6] += bf2f(w.w & 0xffffu); ks[7] += __builtin_bit_cast(float, w.w & 0xffff0000u); } } }
#pragma unroll
        for (int j = 0; j < 8; ++j) { ks[j] += __shfl_xor(ks[j], 16); ks[j] += __shfl_xor(ks[j], 32); }
        if (sub == 0) {
#pragma unroll
            for (int j = 0; j < 8; ++j) red[wave * 128 + 8 * c16 + j] = ks[j]; }
        __syncthreads();
        if (tid < 128) { float a = 0.f;
#pragma unroll
            for (int w = 0; w < NWAVES; ++w) a += red[w * 128 + tid];
            kmean[((size_t)(b * NH + h) * NBLK + n) * HD + tid] = a * (1.0f / MB); }
        __syncthreads();
    }
}

__device__ __forceinline__ void phase_select(const Ctx& C, bool probe) {
    const int bid = C.bid, G = C.G; unsigned char* ws = C.ws();
    const bf16_t* qkv = (const bf16_t*)(ws + WS_ARENA + AR_QKV); const float* kmean = (const float*)(ws + WS_KMEAN);
    unsigned* bcnt = (unsigned*)ws + (probe ? 5120 : CW_BKT); int* blist = (int*)(ws + (probe ? WS_ARENA + ((size_t)100 << 20) : WS_BLIST));
    const int tid = opaque_tid(C.wid), lane = tid & 63;
    for (int wt = bid * NWAVES + C.wid; wt < (T / 64) * NH; wt += G * NWAVES) {
        const int h = wt & 7, tg = wt >> 3, t = tg * 64 + lane, b = (tg * 64) / SEQ, sq = t % SEQ, qb = ((tg * 64) % SEQ) / MB;
        if (qb == 0) continue;
        const bf16_t* qp = qkv + (size_t)t * NQKV + h * HD; const float* km = kmean + (size_t)(b * NH + h) * NBLK * HD;
        float acc[NBLK];
#pragma unroll
        for (int n = 0; n < NBLK; ++n) acc[n] = 0.f;
#pragma unroll 4
        for (int ch = 0; ch < 16; ++ch) { const u32x4 raw = *(const u32x4*)(qp + 8 * ch);
            const float q0 = bf2f(raw.x & 0xffffu), q1 = __builtin_bit_cast(float, raw.x & 0xffff0000u), q2 = bf2f(raw.y & 0xffffu), q3 = __builtin_bit_cast(float, raw.y & 0xffff0000u),
                        q4 = bf2f(raw.z & 0xffffu), q5 = __builtin_bit_cast(float, raw.z & 0xffff0000u), q6 = bf2f(raw.w & 0xffffu), q7 = __builtin_bit_cast(float, raw.w & 0xffff0000u);
#pragma unroll
            for (int n = 0; n < NBLK; ++n) { const float* kp = km + n * HD + 8 * ch;
                acc[n] += ((q0 * kp[0] + q1 * kp[1]) + (q2 * kp[2] + q3 * kp[3])) + ((q4 * kp[4] + q5 * kp[5]) + (q6 * kp[6] + q7 * kp[7])); } }
        const int nsel = qb < 3 ? qb : 3; int sel0 = -1, sel1 = -1, sel2 = -1;
#pragma unroll
        for (int j = 0; j < 3; ++j) { float bv = -INFINITY; int bi = 0;
#pragma unroll
            for (int n = 0; n < NBLK - 1; ++n) { const float v = (n < qb) ? acc[n] : -INFINITY; if (v > bv) { bv = v; bi = n; } }
#pragma unroll
            for (int n = 0; n < NBLK - 1; ++n) if (n == bi) acc[n] = -INFINITY;
            if (j < nsel) { if (j == 0) sel0 = bi; if (j == 1) sel1 = bi; if (j == 2) sel2 = bi; } }
        const unsigned long long lt = (1ull << lane) - 1ull; int mytot = 0;
        for (int n = 0; n < qb; ++n) { const int tot = __popcll(__ballot(sel0 == n)) + __popcll(__ballot(sel1 == n)) + __popcll(__ballot(sel2 == n)); if (lane == n) mytot = tot; }
        unsigned mybase = 0; if (lane < qb && mytot > 0) mybase = atomicAdd(bcnt + (b * NH + h) * NBLK + lane, (unsigned)mytot);
        for (int n = 0; n < qb; ++n) { const unsigned long long m0 = __ballot(sel0 == n), m1 = __ballot(sel1 == n), m2 = __ballot(sel2 == n); const int c0 = __popcll(m0), c1 = __popcll(m1);
            const unsigned base = (unsigned)__shfl((int)mybase, n); int j = -1, rank = 0;
            if (sel0 == n) { j = 0; rank = __popcll(m0 & lt); } else if (sel1 == n) { j = 1; rank = c0 + __popcll(m1 & lt); } else if (sel2 == n) { j = 2; rank = c0 + c1 + __popcll(m2 & lt); }
            if (j >= 0) blist[(size_t)((b * NH + h) * NBLK + n) * BKT_CAP + base + rank] = (sq << 2) | j; }
    }
}

constexpr int AT_KS = 0, AT_KROW = 272, AT_VT = 256 * AT_KROW, AT_VROW = 520, AT_CUM = AT_VT + 128 * AT_VROW;
constexpr int AT_OT = AT_CUM + 3072, AT_OTW = 32 * 80;
static_assert(AT_CUM + 540 * 4 <= AT_OT && AT_OT + 8 * AT_OTW <= LDS_TB, "attention LDS map");
constexpr int CW_AQ = 600;
__device__ __forceinline__ void phase_attn(const Ctx& C, bool probe, unsigned pflags) {
    LAS unsigned char* lds = C.lds; unsigned char* ws = C.ws();
    const bf16_t* qkv = (const bf16_t*)(ws + WS_ARENA + AR_QKV); const unsigned* bcnt = (const unsigned*)ws + (probe ? 5120 : CW_BKT); const int* blist = (const int*)(ws + (probe ? WS_ARENA + ((size_t)100 << 20) : WS_BLIST));
    bf16_t* opart = (bf16_t*)(ws + WS_ARENA + AR_OPART); float* lpart = (float*)(ws + WS_LPART);
    const int tid = opaque_tid(C.wid), lane = tid & 63, wave = C.wid, r31 = lane & 31, hh = lane >> 5;
    LAS int* cum = (LAS int*)(lds + AT_CUM); LAS int* misc = cum + 520;
    { const int n = tid >> 5, bh = tid & 31; const int c = (int)bcnt[bh * NBLK + n]; int v = (c + 511) >> 9; v = v < 1 ? 1 : v;
#pragma unroll
      for (int o = 1; o < 64; o <<= 1) { const int u = __shfl_up(v, o); if (lane >= o) v += u; }
      if (lane == 63) misc[wave] = v;
      __syncthreads();
      int base = 0;
#pragma unroll
      for (int w = 0; w < NWAVES; ++w) base += (w < wave) ? misc[w] : 0;
      cum[tid + 1] = v + base; if (tid == 0) cum[0] = 0;
      __syncthreads(); }
    const int nitems = cum[512];
    const float cexp = 0.12751743f;
    LAS unsigned char* otile = lds + AT_OT + wave * AT_OTW;
    if (tid == 0) misc[8] = (int)atomicAdd((unsigned*)C.ws() + CW_AQ + (probe ? 1 : 0), 1u);
    __syncthreads();
    int item = misc[8];
    int n = 0, h = 0, b = 0, bk = 0, chunk = 0, cnt = 0, nown = 0, nrg = 0; int ent[3]; bool val[3];
#define AT_DECODE(it_) do { int lo = 0, hi = 512; while (hi - lo > 1) { const int mid = (lo + hi) >> 1; if (cum[mid] <= (it_)) lo = mid; else hi = mid; } \
        chunk = (it_) - cum[lo]; n = lo >> 5; { const int bh = lo & 31; h = bh & 7; b = bh >> 3; bk = bh * NBLK + n; } cnt = (int)bcnt[bk]; \
        { const int rem = cnt - chunk * 512; const int nsrg = ((rem < 512 ? rem : 512) + 31) >> 5; nown = (chunk == 0) ? 8 : 0; nrg = nown + (nsrg > 0 ? nsrg : 0); } } while (0)
#define AT_ENTS() do { _Pragma("unroll") for (int it = 0; it < 3; ++it) { const int rg = wave + 8 * it; val[it] = false; ent[it] = 0; \
        if (rg < nrg) { if (rg < nown) { ent[it] = ((n * MB + (7 - rg) * 32 + r31) << 2) | 3; val[it] = true; } \
                        else { const int ei = chunk * 512 + (rg - nown) * 32 + r31; val[it] = ei < cnt; ent[it] = val[it] ? blist[(size_t)bk * BKT_CAP + ei] : 0; } } } } while (0)
    if (item < nitems) { AT_DECODE(item); AT_ENTS(); }
    while (item < nitems) {
        __syncthreads();
        const int tid = opaque_tid(C.wid), lane = tid & 63, r31 = lane & 31, hh = lane >> 5;
        if (tid == 0) misc[8] = (int)atomicAdd((unsigned*)C.ws() + CW_AQ + (probe ? 1 : 0), 1u);
        const int cn = n, ch = h, cb = b, cnown = nown, cnrg = nrg; int cent[3]; bool cval[3];
#pragma unroll
        for (int it = 0; it < 3; ++it) { cent[it] = ent[it]; cval[it] = val[it]; }
        bf16x8 qn[8];
        { const bf16_t* qp = qkv + (size_t)(cb * SEQ + (cent[0] >> 2)) * NQKV + ch * HD + 8 * hh;
#pragma unroll
          for (int s8 = 0; s8 < 8; ++s8) qn[s8] = *(const bf16x8*)(qp + 16 * s8); }
        {
          const int tl = tid;
          const bf16_t* kb = qkv + (size_t)(cb * SEQ + cn * MB) * NQKV + D + ch * HD;
#pragma unroll
          for (int i = 0; i < 8; ++i) { const int c = tl + 512 * i, row = c >> 4, c16 = c & 15; const u32x4 v = *(const u32x4*)(kb + (size_t)row * NQKV + c16 * 8); *(LAS u32x4*)(lds + AT_KS + row * AT_KROW + c16 * 16) = v; }
          const bf16_t* vb = kb + D;
#pragma unroll
          for (int i = 0; i < 4; ++i) { const int v = tl + 512 * i, kq = v >> 5, dq = v & 31; const bf16_t* src = vb + (size_t)(4 * kq) * NQKV + 4 * dq;
              const u32x2 r0 = *(const u32x2*)src, r1 = *(const u32x2*)(src + NQKV), r2 = *(const u32x2*)(src + 2 * NQKV), r3 = *(const u32x2*)(src + 3 * NQKV);
              LAS unsigned char* dst = lds + AT_VT + (4 * dq) * AT_VROW + kq * 8;
              u32x2 w;
              w.x = (r0.x & 0xffffu) | (r1.x << 16); w.y = (r2.x & 0xffffu) | (r3.x << 16); *(LAS u32x2*)(dst) = w;
              w.x = (r0.x >> 16) | (r1.x & 0xffff0000u); w.y = (r2.x >> 16) | (r3.x & 0xffff0000u); *(LAS u32x2*)(dst + AT_VROW) = w;
              w.x = (r0.y & 0xffffu) | (r1.y << 16); w.y = (r2.y & 0xffffu) | (r3.y << 16); *(LAS u32x2*)(dst + 2 * AT_VROW) = w;
              w.x = (r0.y >> 16) | (r1.y & 0xffff0000u); w.y = (r2.y >> 16) | (r3.y & 0xffff0000u); *(LAS u32x2*)(dst + 3 * AT_VROW) = w; } }
        __syncthreads();
        const int nextitem = misc[8];
        if (nextitem < nitems) { AT_DECODE(nextitem); AT_ENTS(); }
#pragma unroll
        for (int it = 0; it < 3; ++it) { const int rg = wave + 8 * it;
            if (rg < cnrg) {
            const bool own = rg < cnown; const int og = 7 - rg;
            const int sq = cent[it] >> 2, slot = cent[it] & 3, tq = cb * SEQ + sq;
            bf16x8 qf[8];
#pragma unroll
            for (int s8 = 0; s8 < 8; ++s8) qf[s8] = qn[s8];
            if (it < 2 && rg + 8 < cnrg) { const bf16_t* qp = qkv + (size_t)(cb * SEQ + (cent[it < 2 ? it + 1 : 2] >> 2)) * NQKV + ch * HD + 8 * hh;
#pragma unroll
                for (int s8 = 0; s8 < 8; ++s8) qn[s8] = *(const bf16x8*)(qp + 16 * s8); }
            f32x16 oacc[4];
#pragma unroll
            for (int dt = 0; dt < 4; ++dt)
#pragma unroll
                for (int i = 0; i < 16; ++i) oacc[dt][i] = 0.f;
            float lsum = 0.f;
            const int nkt = own ? (og + 1) : 8;
            const LAS unsigned char* kbase = lds + AT_KS + r31 * AT_KROW + 16 * hh;
            const LAS unsigned char* vbase = lds + AT_VT + r31 * AT_VROW + 8 * hh;
            for (int kt = 0; kt < nkt; ++kt) {
                f32x16 sacc;
#pragma unroll
                for (int i = 0; i < 16; ++i) sacc[i] = 0.f;
#pragma unroll
                for (int s8 = 0; s8 < 8; ++s8) { const bf16x8 kf = *(const LAS bf16x8*)(kbase + kt * 32 * AT_KROW + 32 * s8); sacc = __builtin_amdgcn_mfma_f32_32x32x16_bf16(kf, qf[s8], sacc, 0, 0, 0); }
                const bool diag = own && (kt == og);
                float p[16];
#pragma unroll
                for (int i = 0; i < 16; ++i) { const int krow = (i & 3) + 8 * (i >> 2) + 4 * hh; float e = __builtin_amdgcn_exp2f(sacc[i] * cexp); if (diag && krow > r31) e = 0.f; p[i] = e; lsum += e; }
                bf16x8 pb[2];
#pragma unroll
                for (int s2 = 0; s2 < 2; ++s2) { u32x4 w; w.x = cvt_pk_bf16(p[8 * s2 + 0], p[8 * s2 + 1]); w.y = cvt_pk_bf16(p[8 * s2 + 2], p[8 * s2 + 3]); w.z = cvt_pk_bf16(p[8 * s2 + 4], p[8 * s2 + 5]); w.w = cvt_pk_bf16(p[8 * s2 + 6], p[8 * s2 + 7]);
                    pb[s2] = __builtin_bit_cast(bf16x8, w); }
#pragma unroll
                for (int dt = 0; dt < 4; ++dt)
#pragma unroll
                    for (int s2 = 0; s2 < 2; ++s2) { const LAS unsigned char* vp = vbase + dt * 32 * AT_VROW + (kt * 32 + 16 * s2) * 2;
                        const u32x2 v0 = *(const LAS u32x2*)vp, v1 = *(const LAS u32x2*)(vp + 16); u32x4 w; w.x = v0.x; w.y = v0.y; w.z = v1.x; w.w = v1.y;
                        oacc[dt] = __builtin_amdgcn_mfma_f32_32x32x16_bf16(__builtin_bit_cast(bf16x8, w), pb[s2], oacc[dt], 0, 0, 0); }
            }
            { const auto sw = __builtin_amdgcn_permlane32_swap(__builtin_bit_cast(unsigned, lsum), __builtin_bit_cast(unsigned, lsum), false, false);
              lsum = __builtin_bit_cast(float, sw[0]) + __builtin_bit_cast(float, sw[1]); }
            const int pidx = cval[it] ? (int)(((unsigned)tq * NH + ch) * 4 + slot) : -1;
            if (hh == 0 && pidx >= 0) lpart[pidx] = lsum;
            const int l2 = lane, r2 = r31, h2 = hh;
#pragma unroll
            for (int dt = 0; dt < 4; ++dt) {
#pragma unroll
                for (int g4 = 0; g4 < 4; ++g4) { u32x2 w; w.x = cvt_pk_bf16(oacc[dt][4 * g4 + 0], oacc[dt][4 * g4 + 1]); w.y = cvt_pk_bf16(oacc[dt][4 * g4 + 2], oacc[dt][4 * g4 + 3]); *(LAS u32x2*)(otile + r2 * 80 + (8 * g4 + 4 * h2) * 2) = w; }
                asm volatile("s_waitcnt lgkmcnt(0)" ::: "memory");
#pragma unroll
                for (int hf = 0; hf < 2; ++hf) { const int row = (l2 >> 2) + 16 * hf, c4 = l2 & 3; const u32x4 v = *(const LAS u32x4*)(otile + row * 80 + c4 * 16); const int pr = __shfl(pidx, row);
                    if (pr >= 0 && !(pflags & 4u)) *(u32x4*)(opart + (size_t)pr * HD + 32 * dt + 8 * c4) = v; }
                asm volatile("s_waitcnt lgkmcnt(0)" ::: "memory"); }
            } }
        item = nextitem;
    }
#undef AT_DECODE
#undef AT_ENTS
}

__device__ __forceinline__ void phase_combine(const Ctx& C) {
    const int bid = C.bid, G = C.G; unsigned char* ws = C.ws();
    bf16_t* qkv = (bf16_t*)(ws + WS_ARENA + AR_QKV); const bf16_t* opart = (const bf16_t*)(ws + WS_ARENA + AR_OPART); const float* lpart = (const float*)(ws + WS_LPART);
    const int tid = opaque_tid(C.wid), lane = tid & 63, sub = lane >> 4, c16 = lane & 15;
#pragma unroll 4
    for (int p0 = (bid * NWAVES + C.wid) * 4; p0 < T * NH; p0 += G * NWAVES * 4) {
        const int pr = p0 + sub, h = pr & 7, t = pr >> 3, qb = (t % SEQ) / MB, nsel = qb < 3 ? qb : 3;
        float acc[8]; float l = 0.f;
#pragma unroll
        for (int i = 0; i < 8; ++i) acc[i] = 0.f;
#pragma unroll
        for (int j = 0; j < 4; ++j) { if (j < nsel || j == 3) { const size_t pidx = (size_t)pr * 4 + j; const u32x4 v = *(const u32x4*)(opart + pidx * HD + c16 * 8); l += lpart[pidx];
            acc[0] += bf2f(v.x & 0xffffu); acc[1] += __builtin_bit_cast(float, v.x & 0xffff0000u); acc[2] += bf2f(v.y & 0xffffu); acc[3] += __builtin_bit_cast(float, v.y & 0xffff0000u);
            acc[4] += bf2f(v.z & 0xffffu); acc[5] += __builtin_bit_cast(float, v.z & 0xffff0000u); acc[6] += bf2f(v.w & 0xffffu); acc[7] += __builtin_bit_cast(float, v.w & 0xffff0000u); } }
        const float inv = 1.0f / l;
        u32x4 w; w.x = pk2(acc[0] * inv, acc[1] * inv); w.y = pk2(acc[2] * inv, acc[3] * inv); w.z = pk2(acc[4] * inv, acc[5] * inv); w.w = pk2(acc[6] * inv, acc[7] * inv);
        *(u32x4*)(qkv + (size_t)t * NQKV + h * HD + c16 * 8) = w;
    }
}

__device__ __forceinline__ void phase_router(const Ctx& C, bool probe) {
    const int bid = C.bid, G = C.G; unsigned char* ws = C.ws(); const float* ffn_g = C.in(I_OFFNN); const float* w_r = C.in(I_OWR);
    const bf16_t* h3 = (const bf16_t*)(ws + WS_ARENA + AR_H3B); const float* ss3 = (const float*)(ws + WS_SS3); int* cnt = (int*)(ws + WS_CTL) + (probe ? 6144 : 0); int* tslot = (int*)(ws + (probe ? WS_ARENA + ((size_t)103 << 20) : WS_TSLOT)); int* tokof = (int*)(ws + (probe ? WS_ARENA + ((size_t)100 << 20) : WS_TOKOF)); float* gateof = (float*)(ws + (probe ? WS_ARENA + ((size_t)101 << 20) : WS_GATEOF)); f32x4* minfo = (f32x4*)(ws + (probe ? WS_ARENA + ((size_t)102 << 20) : WS_MINFO));
    const int tid = opaque_tid(C.wid), lane = tid & 63, w = C.wid;
    LAS int* lcnt = (LAS int*)C.lds; LAS int* lbase = lcnt + 8; LAS int* te = lcnt + 16; LAS int* trank = te + 128; LAS float* tp = (LAS float*)(trank + 128); LAS float* trs = tp + 128;
    float wg[16][NE];
#pragma unroll
    for (int i = 0; i < 16; ++i) { const int c = lane * 16 + i; const float g = ffn_g[c]; const f32x4 a = *(const f32x4*)(w_r + c * NE), b2 = *(const f32x4*)(w_r + c * NE + 4);
        wg[i][0] = a[0] * g; wg[i][1] = a[1] * g; wg[i][2] = a[2] * g; wg[i][3] = a[3] * g; wg[i][4] = b2[0] * g; wg[i][5] = b2[1] * g; wg[i][6] = b2[2] * g; wg[i][7] = b2[3] * g; }
    for (int grp = bid; grp < T / 64; grp += G) {
        if (tid < 8) lcnt[tid] = 0;
        __syncthreads();
        for (int i4 = 0; i4 < 8; i4 += 4) { u32x4 ra[4], rb[4];
#pragma unroll
          for (int u = 0; u < 4; ++u) { const u32x4* hp = (const u32x4*)(h3 + (size_t)(grp * 64 + w * 8 + i4 + u) * D + lane * 16); ra[u] = hp[0]; rb[u] = hp[1]; }
#pragma unroll
          for (int u = 0; u < 4; ++u) { const int i8 = i4 + u; const int tl = w * 8 + i8, t = grp * 64 + tl; const u32x4 r0 = ra[u], r1 = rb[u];
            const float xv[16] = {bf2f(r0.x & 0xffffu), __builtin_bit_cast(float, r0.x & 0xffff0000u), bf2f(r0.y & 0xffffu), __builtin_bit_cast(float, r0.y & 0xffff0000u), bf2f(r0.z & 0xffffu), __builtin_bit_cast(float, r0.z & 0xffff0000u), bf2f(r0.w & 0xffffu), __builtin_bit_cast(float, r0.w & 0xffff0000u),
                                  bf2f(r1.x & 0xffffu), __builtin_bit_cast(float, r1.x & 0xffff0000u), bf2f(r1.y & 0xffffu), __builtin_bit_cast(float, r1.y & 0xffff0000u), bf2f(r1.z & 0xffffu), __builtin_bit_cast(float, r1.z & 0xffff0000u), bf2f(r1.w & 0xffffu), __builtin_bit_cast(float, r1.w & 0xffff0000u)};
            float lg[NE];
#pragma unroll
            for (int e = 0; e < NE; ++e) lg[e] = 0.f;
#pragma unroll
            for (int i = 0; i < 16; ++i)
#pragma unroll
                for (int e = 0; e < NE; ++e) lg[e] += xv[i] * wg[i][e];
            const float r = row_rscale(ss3, t);
#pragma unroll
            for (int e = 0; e < NE; ++e) lg[e] = wave_sum(lg[e]) * r;
            if (lane == 0) { int e1 = 0; float v1 = lg[0];
#pragma unroll
                for (int e = 1; e < NE; ++e) if (lg[e] > v1) { v1 = lg[e]; e1 = e; }
                int e2 = -1; float v2 = -INFINITY;
#pragma unroll
                for (int e = 0; e < NE; ++e) if (e != e1 && lg[e] > v2) { v2 = lg[e]; e2 = e; }
                if (e2 < 0) { e2 = (e1 == 0) ? 1 : 0; v2 = v1; }
                const float p1 = 1.0f / (1.0f + __expf(v2 - v1)), p2 = 1.0f - p1;
                te[2 * tl] = e1; te[2 * tl + 1] = e2; tp[2 * tl] = p1; tp[2 * tl + 1] = p2; trs[tl] = r;
                trank[2 * tl] = __hip_atomic_fetch_add(lcnt + e1, 1, __ATOMIC_RELAXED, __HIP_MEMORY_SCOPE_WORKGROUP); trank[2 * tl + 1] = __hip_atomic_fetch_add(lcnt + e2, 1, __ATOMIC_RELAXED, __HIP_MEMORY_SCOPE_WORKGROUP); } } }
        __syncthreads();
        if (tid < 8) lbase[tid] = atomicAdd(cnt + tid, lcnt[tid]);
        __syncthreads();
        if (tid < 128) { const int e = te[tid], pos = lbase[e] + trank[tid]; tokof[e * T + pos] = grp * 64 + (tid >> 1); gateof[e * T + pos] = tp[tid]; tslot[grp * 128 + tid] = e * T + pos;
            f32x4 rec; rec[0] = trs[tid >> 1]; rec[1] = __builtin_bit_cast(float, grp * 64 + (tid >> 1)); rec[2] = tp[tid]; rec[3] = 0.f; minfo[(size_t)e * T + pos] = rec; }
        __syncthreads();
    }
}

struct McTok { u32x4 h0, h1, a0, a1, b0, b1; const bf16_t* sa; const bf16_t* sb; int na, nb; };
__device__ __forceinline__ void mc_acc(f32x4 (&a)[4], const u32x4& v0, const u32x4& v1) {
    a[0][0] += bf2f(v0.x & 0xffffu); a[0][1] += __builtin_bit_cast(float, v0.x & 0xffff0000u); a[0][2] += bf2f(v0.y & 0xffffu); a[0][3] += __builtin_bit_cast(float, v0.y & 0xffff0000u);
    a[1][0] += bf2f(v0.z & 0xffffu); a[1][1] += __builtin_bit_cast(float, v0.z & 0xffff0000u); a[1][2] += bf2f(v0.w & 0xffffu); a[1][3] += __builtin_bit_cast(float, v0.w & 0xffff0000u);
    a[2][0] += bf2f(v1.x & 0xffffu); a[2][1] += __builtin_bit_cast(float, v1.x & 0xffff0000u); a[2][2] += bf2f(v1.y & 0xffffu); a[2][3] += __builtin_bit_cast(float, v1.y & 0xffff0000u);
    a[3][0] += bf2f(v1.z & 0xffffu); a[3][1] += __builtin_bit_cast(float, v1.z & 0xffff0000u); a[3][2] += bf2f(v1.w & 0xffffu); a[3][3] += __builtin_bit_cast(float, v1.w & 0xffff0000u);
}
__device__ __forceinline__ void phase_moecombine(const Ctx& C, const LAS int* tb, int p) {
    const int bid = C.bid, G = C.G; unsigned char* ws = C.ws(); float* out = C.out();
    const int* tslot = (const int*)(ws + WS_TSLOT); const bf16_t* y2 = (const bf16_t*)(ws + WS_ARENA + AR_Y2); const bf16_t* ypart = (const bf16_t*)(ws + WS_ARENA + AR_YPART); const bf16_t* h3 = (const bf16_t*)(ws + WS_ARENA + AR_H3B);
    const int lane = opaque_tid(C.wid) & 63, pn = lane >> 4, cl = (lane & 15) * 16; const int nwg = tb[8], base = (nwg / G) * G;
    const int t0 = bid * NWAVES + C.wid, stride = G * NWAVES;
    for (int tc = t0; tc < T; tc += 32 * stride) {
        const int nt = (T - tc + stride - 1) / stride < 32 ? (T - tc + stride - 1) / stride : 32;
        int code = 0; if ((lane >> 1) < nt) code = tslot[(tc + (lane >> 1) * stride) * 2 + (lane & 1)];
        auto issue = [&](int k) -> McTok { McTok m; const int t = tc + k * stride;
            { const u32x4* hp = (const u32x4*)(h3 + (size_t)t * D + lane * 16); m.h0 = hp[0]; m.h1 = hp[1]; }
            { const int c = __shfl(code, 2 * k), e = c / T, pos = c % T; const int wg = tb[e] + (pos >> 8) * 4 + pn;
              if (wg < base) { m.sa = y2 + (size_t)(tb[16 + e] + pos) * D + pn * 256 + cl; m.na = 1; } else { m.sa = ypart + ((size_t)(wg - base) * p * 256 + (pos & 255)) * 256 + cl; m.na = p; }
              m.a0 = *(const u32x4*)m.sa; m.a1 = *(const u32x4*)(m.sa + 8); }
            { const int c = __shfl(code, 2 * k + 1), e = c / T, pos = c % T; const int wg = tb[e] + (pos >> 8) * 4 + pn;
              if (wg < base) { m.sb = y2 + (size_t)(tb[16 + e] + pos) * D + pn * 256 + cl; m.nb = 1; } else { m.sb = ypart + ((size_t)(wg - base) * p * 256 + (pos & 255)) * 256 + cl; m.nb = p; }
              m.b0 = *(const u32x4*)m.sb; m.b1 = *(const u32x4*)(m.sb + 8); }
            return m; };
        McTok cur = issue(0);
        for (int k = 0; k < nt; ++k) {
            McTok nxt = cur; if (k + 1 < nt) nxt = issue(k + 1);
            f32x4 a[4];
#pragma unroll
            for (int i = 0; i < 4; ++i) { a[i][0] = 0.f; a[i][1] = 0.f; a[i][2] = 0.f; a[i][3] = 0.f; }
            mc_acc(a, cur.h0, cur.h1); mc_acc(a, cur.a0, cur.a1);
            for (int q = 1; q < cur.na; ++q) { const u32x4 v0 = *(const u32x4*)(cur.sa + (size_t)q * 65536), v1 = *(const u32x4*)(cur.sa + (size_t)q * 65536 + 8); mc_acc(a, v0, v1); }
            mc_acc(a, cur.b0, cur.b1);
            for (int q = 1; q < cur.nb; ++q) { const u32x4 v0 = *(const u32x4*)(cur.sb + (size_t)q * 65536), v1 = *(const u32x4*)(cur.sb + (size_t)q * 65536 + 8); mc_acc(a, v0, v1); }
            { f32x4* hp = (f32x4*)(out + (size_t)(tc + k * stride) * D + lane * 16); hp[0] = a[0]; hp[1] = a[1]; hp[2] = a[2]; hp[3] = a[3]; }
            cur = nxt;
        }
    }
}

__device__ __forceinline__ void moe_tables(LAS int* tb, const int* cnt, int nN, int wid) {
    if (opaque_tid(wid) == 0) { int cu = 0, off = 0; for (int e = 0; e < NE; ++e) { const int c = cnt[e]; tb[e] = cu; tb[16 + e] = off; tb[32 + e] = c; cu += ((c + 255) / 256) * nN; off += c; } tb[8] = cu; tb[24] = off; }
    __syncthreads();
}
template <class Epi, class Sched>
__device__ __forceinline__ void gemm_run(const Ctx& C, const bf16_t* A, int lda, const bf16_t* Bt, int K, const void* tblbase, const Sched& S, const Epi& E) { pg8::gemm_fast<Epi, Sched, true, false>(C.lds, A, lda * 2, Bt, K * 2, tblbase, S, E, C.wid, C.noepi, 0, 0); }
template <class Epi, class Sched>
__device__ __forceinline__ void gemm_run8(const Ctx& C, const void* A, int lda, const void* Bt, int K, const void* tblbase, const Sched& S, const Epi& E, int ea, int eb) { pg8::gemm_fast<Epi, Sched, true, true>(C.lds, A, lda, Bt, K, tblbase, S, E, C.wid, C.noepi, ea * 0x01010101, eb * 0x01010101); }

__global__ void __launch_bounds__(NTHREADS) fwd_megakernel(Params P) {
    extern __shared__ __attribute__((aligned(16))) unsigned char lds_raw[];
    Ctx C; C.lds = (LAS unsigned char*)lds_raw; C.wid = __builtin_amdgcn_readfirstlane(threadIdx.x >> 6); C.bid = blockIdx.x; C.G = gridDim.x;
    if (threadIdx.x < 25) { const unsigned long long v = (threadIdx.x < 23) ? (unsigned long long)P.in[threadIdx.x] : (threadIdx.x == 23 ? (unsigned long long)P.out : (unsigned long long)P.ws);
        ((LAS unsigned long long*)(C.lds + LDS_PTR))[threadIdx.x] = v; }
    if (threadIdx.x < 2) ((LAS unsigned*)(C.lds + LDS_BST))[threadIdx.x] = 0u;
    if (threadIdx.x == 2) { ((LAS unsigned*)(C.lds + LDS_BST))[4] = P.mask; ((LAS unsigned*)(C.lds + LDS_BST))[5] = (unsigned)P.probe; }
    if (threadIdx.x == 0) (void)xb_add((unsigned*)P.ws + CW_BAR + XB_XCNT(xb_xcc_id()), 1u);
    __syncthreads();
    if (P.ws == nullptr) cg::this_grid().sync();
    LAS int* tb = (LAS int*)(C.lds + LDS_TB);
#define WSP(T_, off) ((T_*)(C.ws() + (off)))
#define ARP(off) ((bf16_t*)(C.ws() + WS_ARENA + (off)))

    const unsigned mask = __builtin_amdgcn_readfirstlane(((const volatile LAS unsigned*)(C.lds + LDS_BST))[4]); const unsigned probev = __builtin_amdgcn_readfirstlane(((const volatile LAS unsigned*)(C.lds + LDS_BST))[5]); const bool probe = probev != 0u; C.noepi = (probev & 2u) != 0u;
#define PH(k) (mask & (1u << (k)))
    float* d_f32 = (float*)(C.ws() + WS_ARENA); bf16_t* d_b16 = ARP((size_t)64 << 20); float* d_ss = (float*)(C.ws() + WS_ARENA + ((size_t)96 << 20));

    if (PH(0)) { phase_prep(C); grid_barrier(C); }
    if (PH(1)) { pg8::DenseOrder S; S.init(T, NPROJ, D, C.G, C.bid); pg8::EpiScaleBf16 E{ARP(AR_PROJ), NPROJ, WSP(float, WS_SS0)}; gemm_run(C, ARP(AR_XB), D, WSP(bf16_t, WS_WIN), D, WSP(float, WS_SS0), S, E); cvt_queue(C, 3, CV_NMOE + CV_IIN, CV_NMOE + CV_IIN + CV_IOUT + 2 * CV_IG); grid_barrier(C); }
    if (PH(2)) { phase_mixer(C); grid_barrier(C); }
    if (PH(3)) { pg8::DenseOrder S; S.init(T, D, D, C.G, C.bid); pg8::EpiResid<false, false> E{C.in(I_X), probe ? d_b16 : ARP(AR_H1B), nullptr, probe ? d_ss : WSP(float, WS_SS1), C.lds, C.wid}; gemm_run(C, ARP(AR_Y), D, WSP(bf16_t, WS_WOUT), D, WSP(float, WS_SS0), S, E); grid_barrier(C); }
    if (PH(4)) { pg8::DenseOrder S; S.init(T, NGU, D, C.G, C.bid); pg8::EpiSwiglu E{ARP(AR_ACT), FF, WSP(float, WS_SS1), nullptr, tb, false}; gemm_run(C, ARP(AR_H1B), D, WSP(bf16_t, WS_WGU), D, WSP(float, WS_SS1), S, E); cvt_queue(C, 4, CV_NMOE + CV_IIN + CV_IOUT + 2 * CV_IG, CV_NMOE + CV_NDENSE); grid_barrier(C); }
    if (PH(5)) { pg8::DenseOrder S; S.init(T, D, FF, C.G, C.bid); pg8::EpiResid<true, false> E{ARP(AR_H1B), probe ? d_b16 : ARP(AR_H2B), nullptr, probe ? d_ss : WSP(float, WS_SS2), C.lds, C.wid}; gemm_run(C, ARP(AR_ACT), FF, WSP(bf16_t, WS_WDN), FF, WSP(float, WS_SS0), S, E); grid_barrier(C); }
    if (PH(6)) { pg8::DenseOrder S; S.init(T, NQKV, D, C.G, C.bid); pg8::EpiQKV E{ARP(AR_QKV), C.in(I_OQN), C.in(I_OKN), WSP(float, WS_ROPE), WSP(float, WS_KMEAN), C.lds, C.wid}; gemm_run(C, ARP(AR_H2B), D, WSP(bf16_t, WS_WQKV), D, WSP(float, WS_SS2), S, E); grid_barrier(C); }
    if (PH(7)) { phase_qkprep(C); grid_barrier(C); }
    if (PH(8)) { phase_select(C, probe); grid_barrier(C); }
    if (PH(9)) { phase_attn(C, probe, probev); cvt_queue(C, 1, 0, 2 * NE * CV_IMG); grid_barrier(C); }
    if (PH(10)) { phase_combine(C); grid_barrier(C); }
    if (PH(11)) { pg8::DenseOrder S; S.init(T, D, D, C.G, C.bid); pg8::EpiResid<true, true> E{ARP(AR_H2B), probe ? d_b16 : ARP(AR_H3B), probe ? (unsigned char*)d_f32 : WSP(unsigned char, WS_H38), probe ? d_ss : WSP(float, WS_SS3), C.lds, C.wid}; gemm_run(C, ARP(AR_QKV), NQKV, WSP(bf16_t, WS_WO), D, WSP(float, WS_SS0), S, E); grid_barrier(C); }
    if (PH(12)) { phase_router(C, probe); grid_barrier(C); }
    if (PH(13)) { moe_tables(tb, WSP(int, WS_CTL), NGUE / 256, C.wid); pg8::MoeOrder S{tb, WSP(int, WS_TOKOF), NGUE / 256, C.G, C.bid, true, (size_t)NGUE * D / 2, D / 128, false};
        pg8::EpiSwiglu E{ARP(AR_MACT), FE, WSP(float, WS_SS3), WSP(int, WS_TOKOF), tb, true}; gemm_run8(C, WSP(unsigned char, WS_H38), D, WSP(unsigned char, WS_MGU), D, WSP(float, WS_MINFO), S, E, 127, 121); cvt_queue(C, 2, 2 * NE * CV_IMG, CV_NMOE); grid_barrier(C); }
    if (PH(14)) { moe_tables(tb, WSP(int, WS_CTL), D / 256, C.wid); pg8::MoeOrder S{tb, WSP(int, WS_TOKOF), D / 256, C.G, C.bid, false, (size_t)D * FE / 2, FE / 128, true};
        pg8::EpiMoeDown E{ARP(AR_Y2), ARP(AR_YPART), WSP(float, WS_GATEOF), tb, C.wid}; gemm_run8(C, ARP(AR_MACT), FE, WSP(unsigned char, WS_MDN), FE, WSP(float, WS_MINFO), S, E, 125, 121); grid_barrier(C); }
    if (PH(15) && !probe) { moe_tables(tb, WSP(int, WS_CTL), D / 256, C.wid); pg8::MoeOrder S{tb, WSP(int, WS_TOKOF), D / 256, C.G, C.bid, false, (size_t)D * FE / 2, FE / 128, true}; phase_moecombine(C, tb, S.pieces(tb[8])); }
}

extern "C" void kernel_launch(void* const* d_in, const int* in_sizes, int n_in, void* d_out, int out_size, void* d_ws, size_t ws_size, hipStream_t stream) {
    if (n_in != 23 || out_size != T * D || ws_size < WS_END) { fprintf(stderr, "kernel_launch: bad shapes n_in %d out %d ws %zu (need %zu)\n", n_in, out_size, ws_size, (size_t)WS_END); return; }
    static int grid_blocks = 0;
    if (!grid_blocks) {
        int dev = 0, cus = 0, per_cu = 0;
        (void)hipGetDevice(&dev); (void)hipDeviceGetAttribute(&cus, hipDeviceAttributeMultiprocessorCount, dev);
        (void)hipFuncSetAttribute((const void*)fwd_megakernel, hipFuncAttributeMaxDynamicSharedMemorySize, LDS_BYTES);
        (void)hipOccupancyMaxActiveBlocksPerMultiprocessor(&per_cu, (const void*)fwd_megakernel, NTHREADS, LDS_BYTES);
        if (per_cu < 1) { fprintf(stderr, "kernel_launch: occupancy query says %d blocks per CU\n", per_cu); per_cu = 1; }
        grid_blocks = cus * 1;
    }
    if (hipMemsetAsync((char*)d_ws + WS_CTL, 0, WS_CTLBYTES, stream) != hipSuccess) { fprintf(stderr, "kernel_launch: memset failed\n"); return; }
    Params p{};
    for (int i = 0; i < 23; ++i) p.in[i] = (const float*)d_in[i];
    p.out = (float*)d_out; p.ws = (unsigned char*)d_ws;
    p.mask = 0xffffu & ~(1u << 7); p.probe = 0;
    void* args[] = {&p};
    hipError_t e = hipLaunchCooperativeKernel((const void*)fwd_megakernel, dim3(grid_blocks), dim3(NTHREADS), args, LDS_BYTES, stream);
    if (e != hipSuccess) fprintf(stderr, "cooperative launch failed: %s (grid %d)\n", hipGetErrorString(e), grid_blocks);
#ifndef PROBE_MODE
#define PROBE_MODE 1
#endif
#ifdef PROBE_MASK
    (void)hipMemsetAsync((char*)d_ws + WS_CTL + 4096, 0, WS_CTLBYTES - 4096, stream);
    Params p2 = p; p2.mask = PROBE_MASK; p2.probe = PROBE_MODE; void* args2[] = {&p2};
    (void)hipLaunchCooperativeKernel((const void*)fwd_megakernel, dim3(grid_blocks), dim3(NTHREADS), args2, LDS_BYTES, stream);
#endif
}
```

```cpp
#include <hip/hip_runtime.h>
#include <hip/hip_cooperative_groups.h>
#include <cstdio>
#include <cstdint>

#define LAS __attribute__((address_space(3)))
typedef unsigned short bf16_t;
typedef short bf16x8 __attribute__((ext_vector_type(8)));
typedef float f32x4 __attribute__((ext_vector_type(4)));
typedef float f32x2 __attribute__((ext_vector_type(2)));
typedef float f32x16 __attribute__((ext_vector_type(16)));
typedef unsigned u32x4 __attribute__((ext_vector_type(4)));
typedef unsigned u32x2 __attribute__((ext_vector_type(2)));
typedef int v8i __attribute__((ext_vector_type(8)));

constexpr int T = 16384, D = 1024, SEQ = 4096, NBATCH = 4;
constexpr int CONV = 512, GM = 512, NPROJ = 2560;
constexpr int FF = 2816, NGU = 2 * FF;
constexpr int NH = 8, HD = 128, NQKV = 3072;
constexpr int NE = 8, FE = 3584, NGUE = 2 * FE;
constexpr int MB = 256, NBLK = SEQ / MB;
constexpr float EPS = 1e-6f;

constexpr size_t al256(size_t x) { return (x + 255) & ~(size_t)255; }
constexpr size_t WS_CTL = 0;
constexpr int NSS = 4;
constexpr size_t WS_CTLBYTES = 32768;
constexpr int CW_BKT = 64;
constexpr int CW_BAR = 1024;
constexpr size_t WS_SS0 = WS_CTLBYTES;
constexpr size_t WS_SS1 = WS_SS0 + (size_t)T * NSS * 4;
constexpr size_t WS_SS2 = WS_SS1 + (size_t)T * NSS * 4;
constexpr size_t WS_SS3 = WS_SS2 + (size_t)T * NSS * 4;
constexpr size_t WS_ROPE = WS_SS3 + (size_t)T * NSS * 4;
constexpr size_t WS_KMEAN = WS_ROPE + (size_t)SEQ * 16 * 2 * 4;
constexpr size_t KM_HALF = (size_t)NBATCH * NH * NBLK * HD;
constexpr size_t WS_TOKOF = WS_KMEAN + 2 * KM_HALF * 4;
constexpr size_t WS_WSPB = WS_TOKOF;
constexpr size_t WS_GATEOF = WS_TOKOF + (size_t)NE * T * 4;
constexpr size_t WS_TSLOT = al256(WS_GATEOF + (size_t)NE * T * 4);
constexpr size_t WS_MINFO = al256(WS_TSLOT + (size_t)T * 2 * 4);
constexpr size_t WS_WRF = al256(WS_MINFO + (size_t)NE * T * 16);
constexpr size_t WS_W = al256(WS_WRF + (size_t)32 * 2 * 64 * 16);
constexpr size_t WS_WIN = WS_W;
constexpr size_t WS_WOUT = WS_WIN + (size_t)NPROJ * D * 2;
constexpr size_t WS_WGU = WS_WOUT + (size_t)D * D * 2;
constexpr size_t WS_WDN = WS_WGU + (size_t)NGU * D * 2;
constexpr size_t WS_WQKV = WS_WDN + (size_t)D * FF * 2;
constexpr size_t WS_WO = WS_WQKV + (size_t)NQKV * D * 2;
constexpr size_t WS_MGU = WS_WO + (size_t)D * D * 2;
constexpr size_t WS_MDN = WS_MGU + (size_t)NE * NGUE * D;
constexpr size_t WS_ARENA = WS_MDN + (size_t)NE * D * FE;
constexpr size_t SZ_TD2 = (size_t)T * D * 2;
constexpr size_t AR_XB = 0, AR_PROJ = SZ_TD2, AR_Y = 0, AR_H1B = SZ_TD2, AR_ACT = 2 * SZ_TD2, AR_H2B = 0, AR_QKV = SZ_TD2,
                 AR_O = SZ_TD2 + (size_t)T * NQKV * 2, AR_H3B = 0, AR_MACT = (size_t)68 << 20, AR_H18 = (size_t)112 << 20;
constexpr int BKT_CAP = 3840;
constexpr size_t WS_BLIST = WS_WIN;
constexpr size_t WS_LPART = WS_BLIST + (size_t)512 * BKT_CAP * 4;
constexpr size_t WS_H38 = WS_WIN;
constexpr size_t AR_OPART = AR_O;
static_assert(WS_LPART + (size_t)T * NH * 4 * 4 <= WS_WQKV && WS_H38 + (size_t)T * D <= WS_WQKV, "attention lists / h3 fp8 fit the layer-0 weight copies");
static_assert(AR_OPART + (size_t)T * NH * 4 * HD * 2 <= SZ_TD2 + (size_t)(2 * T + 256) * FE * 2, "attention partials fit the arena");
constexpr size_t AR_YPART = SZ_TD2;
constexpr size_t AR_Y2 = (size_t)186 << 20;
static_assert(AR_YPART + (size_t)256 * 256 * 256 * 2 <= AR_MACT && AR_MACT + (size_t)(2 * T + 256) * FE <= AR_Y2 && AR_Y2 + (size_t)2 * T * D * 2 <= SZ_TD2 + (size_t)(2 * T + 256) * FE * 2, "MoE down arena");
constexpr size_t WS_END = WS_ARENA + SZ_TD2 + (size_t)(2 * T + 256) * FE * 2;
static_assert(AR_ACT + (size_t)T * FF * 2 <= SZ_TD2 + (size_t)2 * T * FE * 2, "arena");
static_assert(WS_END <= 486079488ull, "workspace budget");

__device__ __forceinline__ unsigned f2bf(float f) { unsigned u = __builtin_bit_cast(unsigned, f); return (u + 0x7fffu + ((u >> 16) & 1u)) >> 16; }
__device__ __forceinline__ float bf2f(unsigned b) { return __builtin_bit_cast(float, b << 16); }
__device__ __forceinline__ unsigned pk2(float lo, float hi) { return f2bf(lo) | (f2bf(hi) << 16); }
__device__ __forceinline__ unsigned cvt_pk_bf16(float lo, float hi) { unsigned r; asm volatile("v_cvt_pk_bf16_f32 %0, %1, %2" : "=v"(r) : "v"(lo), "v"(hi)); return r; }
__device__ __forceinline__ int opaque_tid(int wid) { int l; asm volatile("v_mbcnt_lo_u32_b32 %0, -1, 0\n\tv_mbcnt_hi_u32_b32 %0, -1, %0" : "=v"(l)); return wid * 64 + l; }
template <int CTRL> __device__ __forceinline__ float dpp_mov(float v) { return __builtin_bit_cast(float, __builtin_amdgcn_update_dpp(0, __builtin_bit_cast(int, v), CTRL, 0xf, 0xf, true)); }
__device__ __forceinline__ float wave_sum(float v) {
    v += dpp_mov<0xB1>(v); v += dpp_mov<0x4E>(v); v += dpp_mov<0x141>(v); v += dpp_mov<0x140>(v);
    const int b = __builtin_bit_cast(int, v);
    const float r0 = __builtin_bit_cast(float, __builtin_amdgcn_readlane(b, 0)), r1 = __builtin_bit_cast(float, __builtin_amdgcn_readlane(b, 16)),
                r2 = __builtin_bit_cast(float, __builtin_amdgcn_readlane(b, 32)), r3 = __builtin_bit_cast(float, __builtin_amdgcn_readlane(b, 48));
    return (r0 + r1) + (r2 + r3);
}
__device__ __forceinline__ float xsum32(float v) { float a = v, b = v; asm volatile("s_nop 1\n\tv_permlane32_swap_b32 %0, %1\n\ts_nop 1" : "+v"(a), "+v"(b)); return a + b; }
__device__ __forceinline__ void swap16u(unsigned& a, unsigned& b) { asm volatile("s_nop 1\n\tv_permlane16_swap_b32 %0, %1\n\ts_nop 1" : "+v"(a), "+v"(b)); }
__device__ __forceinline__ float rscale_of(const f32x4 p) { return rsqrtf(((p[0] + p[1]) + (p[2] + p[3])) * (1.0f / D) + EPS); }
__device__ __forceinline__ float row_rscale(const float* ssp, int row) { return rscale_of(*(const f32x4*)(ssp + (size_t)row * NSS)); }
__device__ __forceinline__ unsigned pk_fp8x4(float a, float b, float c, float d) {
    a = fminf(fmaxf(a, -448.f), 448.f); b = fminf(fmaxf(b, -448.f), 448.f); c = fminf(fmaxf(c, -448.f), 448.f); d = fminf(fmaxf(d, -448.f), 448.f);
    int p = __builtin_amdgcn_cvt_pk_fp8_f32(a, b, 0, false); p = __builtin_amdgcn_cvt_pk_fp8_f32(c, d, p, true); return (unsigned)p; }
__device__ __forceinline__ float silu_f(float g) { return g * __builtin_amdgcn_rcpf(1.0f + __builtin_amdgcn_exp2f(g * -1.4426950408889634f)); }

namespace pg8 {
constexpr int BM = 256, BK = 64, HALF = 128, HTB = HALF * BK * 2, STAGE_BYTES = 8 * HTB, NXCD = 8, WGM = 4;
constexpr int RI_OFF = STAGE_BYTES, RI_BYTES = 4 * 4096;
constexpr int EPI_OFF = RI_OFF + RI_BYTES, EPI_TILE = 8 * 144;
__host__ __device__ __forceinline__ int lds_byte(int r, int c) { const int st = (r >> 4) * 2 + (c >> 5), rr = r & 15, cc = c & 31, ob = rr * 64 + cc * 2; return st * 1024 + (ob ^ (((ob >> 9) & 1) << 5)); }
__host__ __device__ __forceinline__ void stage_rc(int b, int& R, int& C) { const int st = b / 1024, sb = b % 1024, swz = sb ^ (((sb >> 9) & 1) << 5); R = (st >> 1) * 16 + swz / 64; C = (st & 1) * 32 + (swz % 64) / 2; }
__host__ __device__ __forceinline__ int perm32(int rho) { const int n = rho >> 4, i = rho & 15; return 8 * (i >> 2) + 4 * n + (i & 3); }

struct Unit { int row0, pn, e, nvalid, kt0, nkt, piece; };

struct DenseOrder {
    int nM, nN, nwg, G, c, nkt;
    __device__ void init(int M, int N, int K, int G_, int c_) { nM = M / BM; nN = N / BM; nwg = nM * nN; G = G_; c = c_; nkt = K / BK; }
    __device__ __forceinline__ bool next(int i, Unit& u) const {
        const long L = (long)i * G + c; if (L >= nwg) return false;
        int wgid = (int)L; { const int q = nwg / NXCD, r = nwg % NXCD, xcd = wgid % NXCD, off = wgid / NXCD; wgid = (xcd < r ? xcd * (q + 1) : r * (q + 1) + (xcd - r) * q) + off; }
        const int nig = WGM * nN, gid = wgid / nig, fm = gid * WGM, gsz = (nM - fm) < WGM ? (nM - fm) : WGM;
        u.row0 = (fm + ((wgid % nig) % gsz)) * BM; u.pn = (wgid % nig) / gsz; u.e = 0; u.nvalid = BM; u.kt0 = 0; u.nkt = nkt; u.piece = -1; return true;
    }
    __device__ __forceinline__ int src_row(const Unit& u, int r) const { return u.row0 + r; }
    __device__ __forceinline__ unsigned tbl_off(const Unit& u) const { return (unsigned)u.row0 * 16u; }
    __device__ __forceinline__ size_t b_off(const Unit&) const { return 0; }
};
struct MoeOrder {
    __device__ __forceinline__ int tbv(int i) const { return __builtin_amdgcn_readfirstlane(tb[i]); }
    const LAS int* tb; const int* tokof; int nN, G, c; bool gather; size_t bstride; int nkt; bool splitk;
    __device__ __forceinline__ void tile(int L, Unit& u) const {
        const int nwg = tbv(8);
        int wgid = L; { const int q = nwg / NXCD, r = nwg % NXCD, xcd = wgid % NXCD, off = wgid / NXCD; wgid = (xcd < r ? xcd * (q + 1) : r * (q + 1) + (xcd - r) * q) + off; }
        int e = 0;
#pragma unroll
        for (int j = 1; j < 8; ++j) e += (wgid >= tbv(j)) ? 1 : 0;
        const int w = wgid - tbv(e), cnt = tbv(32 + e), nM = (cnt + BM - 1) / BM;
        const int nig = WGM * nN, gid = w / nig, fm = gid * WGM, gsz = (nM - fm) < WGM ? (nM - fm) : WGM;
        const int pm = fm + ((w % nig) % gsz); u.pn = (w % nig) / gsz; u.e = e; u.row0 = pm * BM; u.nvalid = (cnt - pm * BM) < BM ? (cnt - pm * BM) : BM;
    }
    __device__ __forceinline__ void tile_nat(int wg, Unit& u) const {
        int e = 0;
#pragma unroll
        for (int j = 1; j < 8; ++j) e += (wg >= tbv(j)) ? 1 : 0;
        const int w = wg - tbv(e), cnt = tbv(32 + e), pm = w / nN; u.pn = w % nN; u.e = e; u.row0 = pm * BM; u.nvalid = (cnt - pm * BM) < BM ? (cnt - pm * BM) : BM;
    }
    __device__ __forceinline__ int pieces(int nwg) const { const int base = (nwg / G) * G, R = nwg - base, ntrip = nkt / 2; int p = 1; if (R * 2 <= G && ntrip % 2 == 0) p = 2; if (R * 7 <= G && ntrip % 7 == 0) p = 7; return p; }
    __device__ __forceinline__ bool next(int i, Unit& u) const {
        const long L = (long)i * G + c; const int nwg = tbv(8);
        if (!splitk) { if (L >= nwg) return false; tile((int)L, u); u.kt0 = 0; u.nkt = nkt; u.piece = -1; return true; }
        const int base = (nwg / G) * G, R = nwg - base;
        if (L < base) { const int wg = ((int)L % NXCD) * (base / NXCD) + (int)L / NXCD; tile_nat(wg, u); u.kt0 = 0; u.nkt = nkt; u.piece = -1; return true; }
        if (R == 0) return false;
        const int p = pieces(nwg), j = (int)(L - base); if (j >= R * p) return false;
        tile_nat(base + j / p, u); const int per = nkt / p; u.kt0 = (j % p) * per; u.nkt = per; u.piece = j; return true;
    }
    __device__ __forceinline__ int src_row(const Unit& u, int r) const {
        if (gather) return (r < u.nvalid) ? tokof[u.e * T + u.row0 + r] : 0;
        return tbv(16 + u.e) + u.row0 + r;
    }
    __device__ __forceinline__ unsigned tbl_off(const Unit& u) const { return (unsigned)(u.e * T + u.row0) * 16u; }
    __device__ __forceinline__ size_t b_off(const Unit& u) const { return (size_t)u.e * bstride; }
};

struct EpiScaleBf16 {
    static constexpr bool PERM = true;
    bf16_t* O; int ldc; const float* ss;
    __device__ __forceinline__ void operator()(const f32x4 (&acc)[2][2][4][2], const Unit& u, int wr, int wc, int fr, int fq, const LAS f32x4* tbl) const {
        const int col0 = u.pn * BM + wc * 32 + 8 * fq; float rs[2][4]; const LAS f32x4* tb0 = tbl + (wr * 64 + fr); asm volatile("" : "+v"(tb0));
#pragma unroll
        for (int ai = 0; ai < 2; ++ai)
#pragma unroll
            for (int m = 0; m < 4; ++m) rs[ai][m] = rscale_of(tb0[ai * HALF + m * 16]);
#pragma unroll
        for (int ai = 0; ai < 2; ++ai)
#pragma unroll
            for (int m = 0; m < 4; ++m) { const int row = u.row0 + ai * HALF + wr * 64 + m * 16 + fr; const float r = rs[ai][m];
                bf16_t* rowp = O + (size_t)row * ldc + col0;
#pragma unroll
                for (int bj = 0; bj < 2; ++bj) { const f32x4 v0 = acc[ai][bj][m][0] * r, v1 = acc[ai][bj][m][1] * r;
                    u32x4 w; w.x = cvt_pk_bf16(v0[0], v0[1]); w.y = cvt_pk_bf16(v0[2], v0[3]); w.z = cvt_pk_bf16(v1[0], v1[1]); w.w = cvt_pk_bf16(v1[2], v1[3]);
                    *(u32x4*)(rowp + bj * HALF) = w; } }
    }
};
struct EpiQKV {
    static constexpr bool PERM = true;
    bf16_t* O; const float* qg; const float* kg; const float* rope; float* kmean; LAS unsigned char* lds; int wid;
    __device__ __forceinline__ void operator()(const f32x4 (&acc)[2][2][4][2], const Unit& u, int wr, int wc, int, int, const LAS f32x4* tbl) const {
        const int lane = opaque_tid(wid) & 63, fr = lane & 15, fq = lane >> 4;
        const int col0 = u.pn * BM + wc * 32 + 8 * fq; const LAS f32x4* tb0 = tbl + (wr * 64 + fr);
        float rr[2][4];
#pragma unroll
        for (int ai = 0; ai < 2; ++ai)
#pragma unroll
            for (int m = 0; m < 4; ++m) rr[ai][m] = rscale_of(tb0[ai * HALF + m * 16]);
        if (u.pn >= 8) {
#pragma unroll
            for (int ai = 0; ai < 2; ++ai)
#pragma unroll
                for (int m = 0; m < 4; ++m) { const int row = u.row0 + ai * HALF + wr * 64 + m * 16 + fr; bf16_t* rowp = O + (size_t)row * NQKV + col0; const float r = rr[ai][m];
#pragma unroll
                    for (int bj = 0; bj < 2; ++bj) { const f32x4 v0 = acc[ai][bj][m][0] * r, v1 = acc[ai][bj][m][1] * r;
                        u32x4 w; w.x = cvt_pk_bf16(v0[0], v0[1]); w.y = cvt_pk_bf16(v0[2], v0[3]); w.z = cvt_pk_bf16(v1[0], v1[1]); w.w = cvt_pk_bf16(v1[2], v1[3]);
                        *(u32x4*)(rowp + bj * HALF) = w; } }
            return; }
        LAS float* sc = (LAS float*)(lds + EPI_OFF);
#pragma unroll
        for (int ai = 0; ai < 2; ++ai)
#pragma unroll
            for (int m = 0; m < 4; ++m) { const int tr = ai * HALF + wr * 64 + m * 16 + fr; const float r = rr[ai][m];
#pragma unroll
                for (int bj = 0; bj < 2; ++bj) { const f32x4 v0 = acc[ai][bj][m][0] * r, v1 = acc[ai][bj][m][1] * r;
                    float q = ((v0[0] * v0[0] + v0[1] * v0[1]) + (v0[2] * v0[2] + v0[3] * v0[3])) + ((v1[0] * v1[0] + v1[1] * v1[1]) + (v1[2] * v1[2] + v1[3] * v1[3]));
                    q += __shfl_xor(q, 16); q += __shfl_xor(q, 32);
                    if (fq == 0) sc[(tr * 2 + bj) * 4 + wc] = q; } }
        asm volatile("s_waitcnt lgkmcnt(0)" ::: "memory"); __builtin_amdgcn_s_barrier(); asm volatile("" ::: "memory");
        const bool isk = u.pn >= 4; const float* gp = (isk ? kg : qg) + wc * 32 + 8 * fq; const f32x4 g0 = *(const f32x4*)gp, g1 = *(const f32x4*)(gp + 4);
        const int b = u.row0 / SEQ, nblk = (u.row0 % SEQ) / MB, h0 = (u.pn & 3) * 2;
        float cs[2][2][4];
#pragma unroll
        for (int bj = 0; bj < 2; ++bj)
#pragma unroll
            for (int n = 0; n < 2; ++n)
#pragma unroll
                for (int j = 0; j < 4; ++j) cs[bj][n][j] = 0.f;
#pragma unroll
        for (int ai = 0; ai < 2; ++ai)
#pragma unroll
            for (int m = 0; m < 4; ++m) { const int tr = ai * HALF + wr * 64 + m * 16 + fr, row = u.row0 + tr; const float r = rr[ai][m]; bf16_t* rowp = O + (size_t)row * NQKV + col0;
                f32x4 rc0 = (f32x4){1.f, 0.f, 1.f, 0.f}, rc1 = rc0, rc2 = rc0, rc3 = rc0;
                if (wc == 0) { const f32x4* rp = (const f32x4*)(rope + ((size_t)(row % SEQ) * 16 + 8 * (fq & 1)) * 2); rc0 = rp[0]; rc1 = rp[1]; rc2 = rp[2]; rc3 = rp[3]; }
#pragma unroll
                for (int bj = 0; bj < 2; ++bj) { const f32x4 p4 = *(const LAS f32x4*)(sc + (tr * 2 + bj) * 4); const float rn = rsqrtf(((p4[0] + p4[1]) + (p4[2] + p4[3])) * (1.0f / HD) + EPS) * r;
                    f32x4 v0 = acc[ai][bj][m][0] * rn * g0, v1 = acc[ai][bj][m][1] * rn * g1;
                    if (wc == 0) {
                        const float c[8] = {rc0[0], rc0[2], rc1[0], rc1[2], rc2[0], rc2[2], rc3[0], rc3[2]}, sn[8] = {rc0[1], rc0[3], rc1[1], rc1[3], rc2[1], rc2[3], rc3[1], rc3[3]};
#pragma unroll
                        for (int j = 0; j < 4; ++j) { const float p0 = __shfl_xor(v0[j], 32), p1 = __shfl_xor(v1[j], 32);
                            v0[j] = (fq < 2) ? v0[j] * c[j] - p0 * sn[j] : v0[j] * c[j] + p0 * sn[j]; v1[j] = (fq < 2) ? v1[j] * c[4 + j] - p1 * sn[4 + j] : v1[j] * c[4 + j] + p1 * sn[4 + j]; } }
                    u32x4 w; w.x = cvt_pk_bf16(v0[0], v0[1]); w.y = cvt_pk_bf16(v0[2], v0[3]); w.z = cvt_pk_bf16(v1[0], v1[1]); w.w = cvt_pk_bf16(v1[2], v1[3]);
                    *(u32x4*)(rowp + bj * HALF) = w;
                    if (isk) { cs[bj][0][0] += bf2f(w.x & 0xffffu); cs[bj][0][1] += __builtin_bit_cast(float, w.x & 0xffff0000u); cs[bj][0][2] += bf2f(w.y & 0xffffu); cs[bj][0][3] += __builtin_bit_cast(float, w.y & 0xffff0000u);
                               cs[bj][1][0] += bf2f(w.z & 0xffffu); cs[bj][1][1] += __builtin_bit_cast(float, w.z & 0xffff0000u); cs[bj][1][2] += bf2f(w.w & 0xffffu); cs[bj][1][3] += __builtin_bit_cast(float, w.w & 0xffff0000u); } } }
        if (isk) {
#pragma unroll
            for (int bj = 0; bj < 2; ++bj)
#pragma unroll
                for (int n = 0; n < 2; ++n)
#pragma unroll
                    for (int j = 0; j < 4; ++j) { float v = cs[bj][n][j]; v += __shfl_xor(v, 1); v += __shfl_xor(v, 2); v += __shfl_xor(v, 4); v += __shfl_xor(v, 8);
                        if (fr == 0) kmean[(size_t)wr * KM_HALF + ((size_t)(b * NH + h0 + bj) * NBLK + nblk) * HD + wc * 32 + 8 * fq + 4 * n + j] = v * (1.0f / MB); } }
    }
};
struct EpiSwiglu {
    static constexpr bool PERM = true;
    bf16_t* O; int ldc; const float* ss; const int* tokof; const LAS int* tb; bool moe, f8d;
    __device__ __forceinline__ void operator()(const f32x4 (&acc)[2][2][4][2], const Unit& u, int wr, int wc, int fr, int fq, const LAS f32x4* tbl) const {
        const int col0 = u.pn * HALF + wc * 32 + 8 * fq; float rs[2][4]; int orow[2][2]; int trb = wr * 64 + fr; asm volatile("" : "+v"(trb));
        const bool oddg = (fq & 1) != 0; const int cb = col0 - (oddg ? 8 : 0);
#pragma unroll
        for (int ai = 0; ai < 2; ++ai) {
#pragma unroll
            for (int m = 0; m < 4; ++m) { const int tr = ai * HALF + m * 16 + trb; rs[ai][m] = moe ? tbl[tr][0] : rscale_of(tbl[tr]); }
#pragma unroll
            for (int p = 0; p < 2; ++p) { const int tr = ai * HALF + (2 * p + (oddg ? 1 : 0)) * 16 + trb;
                if (moe) { const bool ok = tr < u.nvalid; orow[ai][p] = ok ? tb[16 + u.e] + u.row0 + tr : -1; } else orow[ai][p] = u.row0 + tr; } }
#pragma unroll
        for (int ai = 0; ai < 2; ++ai)
#pragma unroll
            for (int mp = 0; mp < 4; mp += 2) { unsigned wx[2], wy[2];
#pragma unroll
                for (int mm = 0; mm < 2; ++mm) { const int m = mp + mm; const float r = rs[ai][m];
                    const float rl = r * -1.4426950408889634f, r2 = r * r * 4.0f;
                    f32x4 a[2];
#pragma unroll
                    for (int n = 0; n < 2; ++n) { const f32x4 ga = acc[ai][0][m][n], ua = acc[ai][1][m][n];
#pragma unroll
                        for (int j = 0; j < 4; ++j) { const float sg = __builtin_amdgcn_rcpf(1.0f + __builtin_amdgcn_exp2f(ga[j] * rl)); a[n][j] = (ga[j] * ua[j]) * (sg * r2); } }
                    wx[mm] = pk_fp8x4(a[0][0], a[0][1], a[0][2], a[0][3]); wy[mm] = pk_fp8x4(a[1][0], a[1][1], a[1][2], a[1][3]); }
                swap16u(wx[0], wx[1]); swap16u(wy[0], wy[1]);
                const int ro = orow[ai][mp >> 1];
                if (ro >= 0) { u32x4 w; w.x = wx[0]; w.y = wy[0]; w.z = wx[1]; w.w = wy[1]; *(u32x4*)((unsigned char*)O + (size_t)ro * ldc + cb) = w; } }
    }
};
template <bool BASE16, bool F8COPY> struct EpiResid {
    static constexpr bool PERM = false;
    const void* base; bf16_t* hb; unsigned char* h8; float* ssout; LAS unsigned char* lds; int wid;
    __device__ __forceinline__ void operator()(const f32x4 (&acc)[2][2][4][2], const Unit& u, int wr, int wc, int fr, int fq, const LAS f32x4*) const {
        const int fq2 = (opaque_tid(wid) & 63) >> 4;
        const int colb = u.pn * BM + wc * 32, colw = (fq2 & 1) ? (12 + 4 * fq2) : (4 * fq2); LAS float* sc = (LAS float*)(lds + EPI_OFF);
        u32x4 LB[BASE16 ? 2 : 1][BASE16 ? 4 : 1][2];
        if (BASE16) {
#pragma unroll
            for (int ai = 0; ai < 2; ++ai)
#pragma unroll
                for (int m = 0; m < 4; ++m)
#pragma unroll
                    for (int bj = 0; bj < 2; ++bj) LB[BASE16 ? ai : 0][BASE16 ? m : 0][bj] = *(const u32x4*)((const bf16_t*)base + (size_t)(u.row0 + ai * HALF + wr * 64 + m * 16 + fr) * D + colb + bj * HALF + colw);
            asm volatile("" ::: "memory"); }
#pragma unroll
        for (int ai = 0; ai < 2; ++ai)
#pragma unroll
            for (int m = 0; m < 4; ++m) { const int tr = ai * HALF + wr * 64 + m * 16 + fr, row = u.row0 + tr; const size_t rb = (size_t)row * D + colb; float q = 0.f;
#pragma unroll
                for (int bj = 0; bj < 2; ++bj) { f32x4 bv0, bv1;
                    if (BASE16) { const u32x4 L = LB[BASE16 ? ai : 0][BASE16 ? m : 0][bj]; unsigned x0 = L.x, x1 = L.y, y0 = L.z, y1 = L.w; swap16u(x0, y0); swap16u(x1, y1);
                        bv0[0] = bf2f(x0 & 0xffffu); bv0[1] = __builtin_bit_cast(float, x0 & 0xffff0000u); bv0[2] = bf2f(x1 & 0xffffu); bv0[3] = __builtin_bit_cast(float, x1 & 0xffff0000u);
                        bv1[0] = bf2f(y0 & 0xffffu); bv1[1] = __builtin_bit_cast(float, y0 & 0xffff0000u); bv1[2] = bf2f(y1 & 0xffffu); bv1[3] = __builtin_bit_cast(float, y1 & 0xffff0000u); }
                    else { bv0 = *(const f32x4*)((const float*)base + rb + bj * HALF + 4 * fq); bv1 = *(const f32x4*)((const float*)base + rb + bj * HALF + 16 + 4 * fq); }
                    const f32x4 h0 = bv0 + acc[ai][bj][m][0], h1 = bv1 + acc[ai][bj][m][1];
                    q += ((h0[0] * h0[0] + h0[1] * h0[1]) + (h0[2] * h0[2] + h0[3] * h0[3])) + ((h1[0] * h1[0] + h1[1] * h1[1]) + (h1[2] * h1[2] + h1[3] * h1[3]));
                    unsigned a0 = cvt_pk_bf16(h0[0], h0[1]), a1 = cvt_pk_bf16(h0[2], h0[3]), b0 = cvt_pk_bf16(h1[0], h1[1]), b1 = cvt_pk_bf16(h1[2], h1[3]);
                    swap16u(a0, b0); swap16u(a1, b1);
                    { u32x4 w; w.x = a0; w.y = a1; w.z = b0; w.w = b1; *(u32x4*)(hb + rb + bj * HALF + colw) = w; }
                    if (F8COPY) { unsigned f0 = pk_fp8x4(h0[0], h0[1], h0[2], h0[3]), f1 = pk_fp8x4(h1[0], h1[1], h1[2], h1[3]); swap16u(f0, f1); u32x2 w8; w8.x = f0; w8.y = f1; *(u32x2*)(h8 + rb + bj * HALF + colw) = w8; } }
                q += __shfl_xor(q, 16); q += __shfl_xor(q, 32);
                if (fq == 0) sc[tr * 4 + wc] = q;
                asm volatile("" ::: "memory"); }
        asm volatile("s_waitcnt lgkmcnt(0)" ::: "memory"); __builtin_amdgcn_s_barrier(); asm volatile("" ::: "memory");
        { const int t2 = opaque_tid(wid); if (t2 < 256) { const f32x4 p = *(const LAS f32x4*)(sc + t2 * 4); ssout[(size_t)(u.row0 + t2) * NSS + u.pn] = (p[0] + p[1]) + (p[2] + p[3]); } }
        asm volatile("s_waitcnt lgkmcnt(0)" ::: "memory"); __builtin_amdgcn_s_barrier(); asm volatile("" ::: "memory");
    }
};
struct EpiMoeDown {
    static constexpr bool PERM = true;
    bf16_t* y2; bf16_t* ypart; const float* gateof; const LAS int* tb; int wid;
    __device__ __forceinline__ void operator()(const f32x4 (&acc)[2][2][4][2], const Unit& u, int wr, int wc, int, int, const LAS f32x4* tbl) const {
        const int lane = opaque_tid(wid) & 63, fr = lane & 15, fq = lane >> 4;
        const int cloc = wc * 32 + 8 * fq, trb = wr * 64 + fr;
        bf16_t* ob = (u.piece >= 0) ? ypart + (size_t)u.piece * (BM * BM) + cloc : y2 + (size_t)(tb[16 + u.e] + u.row0) * D + u.pn * BM + cloc; const int ld = (u.piece >= 0) ? BM : D;
#pragma unroll
        for (int ai = 0; ai < 2; ++ai)
#pragma unroll
            for (int m = 0; m < 4; ++m) { const int tr = ai * HALF + m * 16 + trb; const bool ok = tr < u.nvalid; const float gt = ok ? tbl[tr][2] : 0.f;
#pragma unroll
                for (int bj = 0; bj < 2; ++bj) { const f32x4 v0 = acc[ai][bj][m][0] * gt, v1 = acc[ai][bj][m][1] * gt;
                    u32x4 w; w.x = cvt_pk_bf16(v0[0], v0[1]); w.y = cvt_pk_bf16(v0[2], v0[3]); w.z = cvt_pk_bf16(v1[0], v1[1]); w.w = cvt_pk_bf16(v1[2], v1[3]);
                    if (ok) *(u32x4*)(ob + (size_t)tr * ld + bj * HALF) = w; } }
    }
};

template <class Epi, class Sched, bool ALIGN_EPI, bool F8>
__device__ __forceinline__ void gemm_fast(LAS unsigned char* lds, const void* A, int ldab, const void* Bt, int Kb, const void* tblbase, const Sched& S, const Epi& E, int wid, bool noepi, int sclA, int sclB) {
    const int lane = opaque_tid(wid) & 63, wr = wid >> 2, wc = wid & 3, fr = lane & 15, fq = lane >> 4;
    unsigned voffB[2];
#pragma unroll
    for (int i = 0; i < 2; ++i) { int R, C; stage_rc(opaque_tid(wid) * 16 + i * 8192, R, C); const int Rb = Epi::PERM ? ((R & ~31) + perm32(R & 31)) : R; voffB[i] = (unsigned)Rb * (unsigned)Kb + (unsigned)C * 2u; }
    const unsigned kstep = (unsigned)(BK * 2), hstep = (unsigned)HALF * (unsigned)Kb, tstep = 2u * hstep;
    const unsigned ldsw = (unsigned)wid * 1024u;
    const int fcol = fq * 8; constexpr int KOFF = 1024;
    const int aoff = lds_byte(wr * 64 + fr, fcol), boff = lds_byte(wc * 32 + fr, fcol);
    const __amdgpu_buffer_rsrc_t rA = __builtin_amdgcn_make_buffer_rsrc((void*)A, 0, 0x7fffffff, 0x00020000), rB = __builtin_amdgcn_make_buffer_rsrc((void*)Bt, 0, 0x7fffffff, 0x00020000), rT = __builtin_amdgcn_make_buffer_rsrc((void*)tblbase, 0, 0x7fffffff, 0x00020000);
#define PG8_SA(b, h) (((b) * 2 + (h)) * HTB)
#define PG8_SB(b, h) ((4 + (b) * 2 + (h)) * HTB)
#define PG8_STAGE(bufoff, rsrc, soff, voff) do { _Pragma("unroll") for (int _i = 0; _i < 2; ++_i) \
        __builtin_amdgcn_raw_ptr_buffer_load_lds(rsrc, (LAS void*)(lds + (bufoff) + ldsw + _i * 8192), 16, (voff)[_i], (soff), 0, 0); } while (0)
#define PG8_LDA(dst, b, h) do { _Pragma("unroll") for (int m = 0; m < 4; ++m) _Pragma("unroll") for (int k = 0; k < 2; ++k) dst[m][k] = *(const LAS bf16x8*)(lds + PG8_SA(b, h) + aoff + m * 2048 + k * KOFF); } while (0)
#define PG8_LDB(dst, b, h) do { _Pragma("unroll") for (int n = 0; n < 2; ++n) _Pragma("unroll") for (int k = 0; k < 2; ++k) dst[n][k] = *(const LAS bf16x8*)(lds + PG8_SB(b, h) + boff + n * 2048 + k * KOFF); } while (0)
#define PG8_V8(f) __builtin_shufflevector(__builtin_bit_cast(u32x4, (f)[0]), __builtin_bit_cast(u32x4, (f)[1]), 0, 1, 2, 3, 4, 5, 6, 7)
#define PG8_MMA(ai, bj, At, Bt_) do { __builtin_amdgcn_s_setprio(1); _Pragma("unroll") for (int m = 0; m < 4; ++m) _Pragma("unroll") for (int n = 0; n < 2; ++n) { \
        if constexpr (F8) acc[ai][bj][m][n] = __builtin_amdgcn_mfma_scale_f32_16x16x128_f8f6f4(__builtin_bit_cast(v8i, PG8_V8(Bt_[n])), __builtin_bit_cast(v8i, PG8_V8(At[m])), acc[ai][bj][m][n], 0, 0, 0, sclB, 0, sclA); \
        else { _Pragma("unroll") for (int k = 0; k < 2; ++k) acc[ai][bj][m][n] = __builtin_amdgcn_mfma_f32_16x16x32_bf16(Bt_[n][k], At[m][k], acc[ai][bj][m][n], 0, 0, 0); } } __builtin_amdgcn_s_setprio(0); } while (0)
#define PG8_WAIT_V(n) asm volatile("s_waitcnt vmcnt(" #n ")" ::: "memory")
#define PG8_WAIT_L(n) asm volatile("s_waitcnt lgkmcnt(" #n ")" ::: "memory")
#define PG8_BAR __builtin_amdgcn_s_barrier()
#define PG8_SCHED __builtin_amdgcn_sched_barrier(0)
#define PG8_TBL(u, bf) __builtin_amdgcn_raw_ptr_buffer_load_lds(rT, (LAS void*)(lds + RI_OFF + ((bf) * 2 + wr) * 4096 + wc * 1024), 16, (unsigned)lane * 16u, S.tbl_off(u) + (unsigned)wc * 1024u, 0, 0)
#define PG8_AOFFS(u, ao) do { _Pragma("unroll") for (int _i = 0; _i < 2; ++_i) { int _R, _C; stage_rc(opaque_tid(wid) * 16 + _i * 8192, _R, _C); _Pragma("unroll") for (int _h = 0; _h < 2; ++_h) \
        ao[_h][_i] = (unsigned)S.src_row(u, _h * HALF + _R) * (unsigned)ldab + (unsigned)_C * 2u; } } while (0)
    Unit cur, nxt; int ui = 0;
    if (!S.next(0, cur)) return;
    f32x4 acc[2][2][4][2];
#pragma unroll
    for (int a = 0; a < 2; ++a)
#pragma unroll
        for (int b = 0; b < 2; ++b)
#pragma unroll
            for (int m = 0; m < 4; ++m)
#pragma unroll
                for (int n = 0; n < 2; ++n) acc[a][b][m][n] = (f32x4){0.f, 0.f, 0.f, 0.f};
    bf16x8 At[4][2], B0[2][2], B1[2][2];
    unsigned aoc[2][2], aon[2][2];
    PG8_AOFFS(cur, aoc);
    unsigned sA = (unsigned)cur.kt0 * kstep;
    unsigned sB = (unsigned)(S.b_off(cur) * 2) + (unsigned)cur.pn * tstep + (unsigned)cur.kt0 * kstep;
    PG8_TBL(cur, 0);
    PG8_STAGE(PG8_SB(0, 0), rB, sB, voffB); PG8_STAGE(PG8_SB(0, 1), rB, sB + hstep, voffB); PG8_STAGE(PG8_SA(0, 0), rA, sA, aoc[0]); PG8_STAGE(PG8_SA(0, 1), rA, sA, aoc[1]);
    if (wr == 1) PG8_BAR;
    PG8_WAIT_V(2); PG8_BAR;
    PG8_STAGE(PG8_SB(1, 0), rB, sB + kstep, voffB); PG8_STAGE(PG8_SA(1, 0), rA, sA + kstep, aoc[0]); PG8_STAGE(PG8_SB(1, 1), rB, sB + hstep + kstep, voffB);
    PG8_WAIT_V(6); PG8_BAR;
    for (;;) {
        const bool has_next = S.next(ui + 1, nxt);
        if (has_next) { PG8_AOFFS(nxt, aon); } else {
#pragma unroll
            for (int h = 0; h < 2; ++h)
#pragma unroll
                for (int i = 0; i < 2; ++i) aon[h][i] = aoc[h][i]; }
        const unsigned nsB = has_next ? (unsigned)(S.b_off(nxt) * 2) + (unsigned)nxt.pn * tstep + (unsigned)nxt.kt0 * kstep : sB;
        const unsigned nsA = has_next ? (unsigned)nxt.kt0 * kstep : sA;
        const int nt = cur.nkt; int tsel = has_next ? 0 : -2; asm volatile("" : "+s"(tsel));
        for (int t = 0; t < nt; t += 2) {
            const bool last = (t == nt - 2);
            const unsigned a1 = sA + (unsigned)(t + 1) * kstep;
            const unsigned a2 = last ? nsA : sA + (unsigned)(t + 2) * kstep, b2 = last ? nsB : sB + (unsigned)(t + 2) * kstep;
            const unsigned a3 = a2 + kstep, b3 = b2 + kstep;
            PG8_LDB(B0, 0, 0); PG8_LDB(B1, 0, 1); PG8_SCHED; PG8_LDA(At, 0, 0); PG8_STAGE(PG8_SA(1, 1), rA, a1, aoc[1]);
            if (last) {
#pragma unroll
                for (int h = 0; h < 2; ++h)
#pragma unroll
                    for (int i = 0; i < 2; ++i) aoc[h][i] = aon[h][i]; }
            PG8_WAIT_V(8); PG8_WAIT_L(0); PG8_BAR; PG8_MMA(0, 0, At, B0); PG8_MMA(0, 1, At, B1); PG8_BAR; PG8_SCHED;
            PG8_LDA(At, 0, 1); if (t == tsel) PG8_TBL(nxt, (ui + 1) & 1);
            PG8_STAGE(PG8_SB(0, 0), rB, b2, voffB); PG8_STAGE(PG8_SB(0, 1), rB, b2 + hstep, voffB); PG8_STAGE(PG8_SA(0, 0), rA, a2, aoc[0]);
            PG8_WAIT_V(8); PG8_WAIT_L(0); PG8_BAR; PG8_MMA(1, 0, At, B0); PG8_MMA(1, 1, At, B1); PG8_BAR; PG8_SCHED;
            PG8_LDB(B0, 1, 0); PG8_LDB(B1, 1, 1); PG8_SCHED; PG8_LDA(At, 1, 0); PG8_STAGE(PG8_SA(0, 1), rA, a2, aoc[1]);
            PG8_WAIT_V(8); PG8_WAIT_L(0); PG8_BAR; PG8_MMA(0, 0, At, B0); PG8_MMA(0, 1, At, B1); PG8_BAR; PG8_SCHED;
            PG8_LDA(At, 1, 1); PG8_STAGE(PG8_SB(1, 0), rB, b3, voffB); PG8_STAGE(PG8_SB(1, 1), rB, b3 + hstep, voffB); PG8_STAGE(PG8_SA(1, 0), rA, a3, aoc[0]);
            PG8_WAIT_V(8); PG8_WAIT_L(0); PG8_BAR; PG8_MMA(1, 0, At, B0); PG8_MMA(1, 1, At, B1); PG8_BAR; PG8_SCHED;
        }
        if constexpr (ALIGN_EPI) { if (wr == 0) PG8_BAR; }
        if (!noepi) E(acc, cur, wr, wc, fr, fq, (const LAS f32x4*)(lds + RI_OFF + ((ui & 1) * 2 + wr) * 4096));
        if (!has_next) break;
#pragma unroll
        for (int a = 0; a < 2; ++a)
#pragma unroll
            for (int b = 0; b < 2; ++b)
#pragma unroll
                for (int m = 0; m < 4; ++m)
#pragma unroll
                    for (int n = 0; n < 2; ++n) acc[a][b][m][n] = (f32x4){0.f, 0.f, 0.f, 0.f};
        cur = nxt; sB = nsB; sA = nsA; ++ui;
        if constexpr (ALIGN_EPI) { if (wr == 1) PG8_BAR; }
    }
    PG8_WAIT_V(0);
    if constexpr (!ALIGN_EPI) { if (wr == 0) PG8_BAR; }
    PG8_BAR;
#undef PG8_SA
#undef PG8_SB
#undef PG8_STAGE
#undef PG8_LDA
#undef PG8_LDB
#undef PG8_MMA
#undef PG8_V8
#undef PG8_WAIT_V
#undef PG8_WAIT_L
#undef PG8_BAR
#undef PG8_SCHED
#undef PG8_AOFFS
#undef PG8_TBL
}
}

namespace cg = cooperative_groups;
constexpr int NTHREADS = 512, NWAVES = 8;
constexpr int LDS_BYTES = 163840;
constexpr int LDS_TB = LDS_BYTES - 1024;
constexpr int LDS_PTR = LDS_TB + 256;
constexpr int LDS_BST = LDS_PTR + 256;

struct Params {
    const float* in[23];
    float* out; unsigned char* ws;
    unsigned mask; int probe;
};
enum { I_X = 0, I_EMIXN, I_EWIN, I_ECONVW, I_ELNG, I_ELNB, I_EWSP, I_EBSP, I_EWOUT, I_EFFNN, I_EWGATE, I_EWUP, I_EWDOWN, I_OMIXN, I_OWQKV, I_OQN, I_OKN, I_OWO, I_OFFNN, I_OWR, I_OWGATE, I_OWUP, I_OWDOWN, I_OUT, I_WS };
struct Ctx { LAS unsigned char* lds; int wid, bid, G; bool noepi;
    template <class Tp> __device__ __forceinline__ Tp* ptr(int i) const { const unsigned long long v = ((const volatile LAS unsigned long long*)(lds + LDS_PTR))[i];
        const unsigned lo = __builtin_amdgcn_readfirstlane((unsigned)v), hi = __builtin_amdgcn_readfirstlane((unsigned)(v >> 32)); typedef Tp __attribute__((address_space(1)))* GP; return (Tp*)(GP)(((unsigned long long)hi << 32) | lo); }
    __device__ __forceinline__ const float* in(int i) const { return ptr<const float>(i); }
    __device__ __forceinline__ unsigned char* ws() const { return ptr<unsigned char>(I_WS); }
    __device__ __forceinline__ float* out() const { return ptr<float>(I_OUT); }
};

#define XB_TMO      128
#define XB_XCNT(j)  (256  + 64 * (j))
#define XB_XSUB(j)  (1280 + 64 * (j))
#define XB_XGEN(j)  (2304 + 64 * (j))
#define XB_TOP      3328
#define XB_TOPGEN   3392
#define XCD_BAR_WORDS 3456
#define XB_SPIN_CAP (1u << 20)
__device__ __forceinline__ unsigned xb_ld(unsigned* p)              { return __hip_atomic_load(p, __ATOMIC_RELAXED, __HIP_MEMORY_SCOPE_AGENT); }
__device__ __forceinline__ unsigned xb_add(unsigned* p, unsigned v) { return __hip_atomic_fetch_add(p, v, __ATOMIC_RELAXED, __HIP_MEMORY_SCOPE_AGENT); }
__device__ __forceinline__ unsigned xb_xcc_id() { return (unsigned)__builtin_amdgcn_s_getreg((3 << 11) | 20) & 0xFu; }
#define XB_SPIN(cond, bar) do { unsigned _sp = 0; while (cond) { __builtin_amdgcn_s_sleep(1); \
    if ((++_sp & 255u) == 0u) { if (xb_ld(&(bar)[XB_TMO])) break; if (_sp > XB_SPIN_CAP) { atomicAdd(&(bar)[XB_TMO], 1u); break; } } } } while (0)
#define XB_XFLG(j)  (XB_XSUB(j) + 32)
__device__ __forceinline__ void xcd_barrier_complete(unsigned* bar, unsigned x, unsigned G, unsigned& nloc, unsigned& nx, unsigned& mask) {
    unsigned sum, cnt, mine, sp = 0u;
    for (;;) {
        sum = 0u; cnt = 0u; mine = 0u; mask = 0u;
#pragma unroll
        for (unsigned j = 0; j < 16; ++j) { const unsigned c = xb_ld(&bar[XB_XCNT(j)]); sum += c; cnt += (c > 0u) ? 1u : 0u; mask |= (c > 0u) ? (1u << j) : 0u; mine = (j == x) ? c : mine; }
        if (sum == G) break;
        __builtin_amdgcn_s_sleep(1);
        if ((++sp & 255u) == 0u) { if (xb_ld(&bar[XB_TMO])) break; if (sp > XB_SPIN_CAP) { atomicAdd(&bar[XB_TMO], 1u); break; } }
    }
    nloc = mine > 0u ? mine : 1u; nx = cnt > 0u ? cnt : 1u;
}
__device__ __forceinline__ void grid_barrier(const Ctx& C) {
    asm volatile("s_waitcnt vmcnt(0)" ::: "memory");
    __syncthreads();
    if (opaque_tid(C.wid) == 0) {
        unsigned* bar = (unsigned*)C.ws() + CW_BAR; volatile LAS unsigned* st = (volatile LAS unsigned*)(C.lds + LDS_BST); const unsigned x = xb_xcc_id();
        __builtin_amdgcn_s_waitcnt(0);
        unsigned nloc = st[0], nx = st[1], mask = st[2];
        if (nloc == 0u) { xcd_barrier_complete(bar, x, (unsigned)C.G, nloc, nx, mask); st[0] = nloc; st[1] = nx; st[2] = mask; }
        const unsigned old = xb_add(&bar[XB_XSUB(x)], 1u);
        const unsigned gen = old / nloc;
        if (old + 1u == (gen + 1u) * nloc) {
            __builtin_amdgcn_fence(__ATOMIC_RELEASE, "agent");
            asm volatile("s_waitcnt vmcnt(0)" ::: "memory");
            __hip_atomic_store(&bar[XB_XFLG(x)], gen + 1u, __ATOMIC_RELAXED, __HIP_MEMORY_SCOPE_AGENT);
            { unsigned sp2 = 0u;
              for (;;) { unsigned mn = 0xffffffffu;
#pragma unroll
                  for (unsigned j = 0; j < 16; ++j) { const unsigned f = xb_ld(&bar[XB_XFLG(j)]); if (mask & (1u << j)) mn = f < mn ? f : mn; }
                  if (mn >= gen + 1u) break;
                  __builtin_amdgcn_s_sleep(1);
                  if ((++sp2 & 255u) == 0u) { if (xb_ld(&bar[XB_TMO])) break; if (sp2 > XB_SPIN_CAP) { atomicAdd(&bar[XB_TMO], 1u); break; } } } }
            __builtin_amdgcn_fence(__ATOMIC_ACQUIRE, "agent");
            xb_add(&bar[XB_XGEN(x)], 1u);
            asm volatile("s_waitcnt vmcnt(0)" ::: "memory");
        } else {
            XB_SPIN(xb_ld(&bar[XB_XGEN(x)]) == gen, bar);
            __builtin_amdgcn_fence(__ATOMIC_ACQUIRE, "agent");
            asm volatile("s_waitcnt vmcnt(0)" ::: "memory");
        }
    }
    __syncthreads();
}

__device__ __forceinline__ void p0_transpose_item(const float* W, int K, int N, bf16_t* WT, const float* fold, int inter, int which, LAS float* scr, int item, int lane) {
    const int nblk = N / 32, kb = item / nblk, nb = item % nblk, k0 = 64 * kb, n0 = 32 * nb;
    const int kr = lane >> 3, c4 = lane & 7; f32x4 v[8]; float f[8];
#pragma unroll
    for (int i = 0; i < 8; ++i) v[i] = *(const f32x4*)(W + (size_t)(k0 + 8 * i + kr) * N + n0 + 4 * c4);
#pragma unroll
    for (int i = 0; i < 8; ++i) f[i] = fold ? fold[k0 + 8 * i + kr] : 1.0f;
#pragma unroll
    for (int i = 0; i < 8; ++i) { LAS float* d = scr + (8 * i + kr) * 33 + 4 * c4; d[0] = v[i][0] * f[i]; d[1] = v[i][1] * f[i]; d[2] = v[i][2] * f[i]; d[3] = v[i][3] * f[i]; }
    asm volatile("s_waitcnt lgkmcnt(0)" ::: "memory");
    const int c = lane & 7;
#pragma unroll
    for (int j = 0; j < 4; ++j) { const int nl = (lane >> 3) + 8 * j, n = n0 + nl; const LAS float* sp = scr + (8 * c) * 33 + nl;
        u32x4 o; o.x = pk2(sp[0 * 33], sp[1 * 33]); o.y = pk2(sp[2 * 33], sp[3 * 33]); o.z = pk2(sp[4 * 33], sp[5 * 33]); o.w = pk2(sp[6 * 33], sp[7 * 33]);
        const int dr = inter ? (n / 128) * 256 + which * 128 + (n % 128) : n;
        *(u32x4*)(WT + (size_t)dr * K + k0 + 8 * c) = o; }
    asm volatile("s_waitcnt lgkmcnt(0)" ::: "memory");
}
__device__ __forceinline__ void p0_transpose_item8(const float* W, int K, int N, unsigned char* WT, const float* fold, int inter, int which, LAS float* scr, int item, int lane) {
    const int nblk = N / 32, kb = item / nblk, nb = item % nblk, k0 = 64 * kb, n0 = 32 * nb;
    const int kr = lane >> 3, c4 = lane & 7; f32x4 v[8]; float f[8];
#pragma unroll
    for (int i = 0; i < 8; ++i) v[i] = *(const f32x4*)(W + (size_t)(k0 + 8 * i + kr) * N + n0 + 4 * c4);
#pragma unroll
    for (int i = 0; i < 8; ++i) f[i] = (fold ? fold[k0 + 8 * i + kr] : 1.0f) * 64.0f;
#pragma unroll
    for (int i = 0; i < 8; ++i) { LAS float* d = scr + (8 * i + kr) * 33 + 4 * c4; d[0] = v[i][0] * f[i]; d[1] = v[i][1] * f[i]; d[2] = v[i][2] * f[i]; d[3] = v[i][3] * f[i]; }
    asm volatile("s_waitcnt lgkmcnt(0)" ::: "memory");
    const int c = lane & 7;
#pragma unroll
    for (int j = 0; j < 4; ++j) { const int nl = (lane >> 3) + 8 * j, n = n0 + nl; const LAS float* sp = scr + (8 * c) * 33 + nl;
        u32x2 o; o.x = pk_fp8x4(sp[0 * 33], sp[1 * 33], sp[2 * 33], sp[3 * 33]); o.y = pk_fp8x4(sp[4 * 33], sp[5 * 33], sp[6 * 33], sp[7 * 33]);
        const int dr = inter ? (n / 128) * 256 + which * 128 + (n % 128) : n;
        *(u32x2*)(WT + (size_t)dr * K + k0 + 8 * c) = o; }
    asm volatile("s_waitcnt lgkmcnt(0)" ::: "memory");
}
constexpr int CW_CVT = 896;
constexpr int CV_IMG = (D / 64) * (FE / 32), CV_IMD = (FE / 64) * (D / 32), CV_NMOE = NE * (2 * CV_IMG + CV_IMD), CV_BATCH = 2 * NWAVES;
constexpr int CV_IIN = (D / 64) * (NPROJ / 32), CV_IOUT = (D / 64) * (D / 32), CV_IG = (D / 64) * (FF / 32), CV_IDN = (FF / 64) * (D / 32), CV_IQKV = (D / 64) * (NQKV / 32);
constexpr int CV_NDENSE = CV_IIN + CV_IOUT + 2 * CV_IG + CV_IDN + CV_IQKV + CV_IOUT;
constexpr int CV_SCR = 2 * 64 * 33 * 4, CV_BC = NWAVES * CV_SCR;
static_assert(CV_BC + 64 <= LDS_TB, "cvt LDS map");
struct CvItem { const float* W; unsigned char* WT; const float* fold; int K, N, inter, which, k0, n0, f8; };
__device__ __forceinline__ CvItem cv_decode(const Ctx& C, int r) {
    CvItem it; unsigned char* ws = C.ws(); int item; it.inter = 0; it.which = 0; it.fold = nullptr; it.f8 = 0;
    if (r < 2 * NE * CV_IMG) { const int which = r >= NE * CV_IMG ? 1 : 0, rr = r - which * NE * CV_IMG, e = rr / CV_IMG; item = rr % CV_IMG;
        it.W = C.in(which ? I_OWUP : I_OWGATE) + (size_t)e * D * FE; it.K = D; it.N = FE; it.WT = ws + WS_MGU + (size_t)e * NGUE * D; it.fold = C.in(I_OFFNN); it.inter = 1; it.which = which; it.f8 = 1; }
    else if (r < CV_NMOE) { const int rr = r - 2 * NE * CV_IMG, e = rr / CV_IMD; item = rr % CV_IMD;
        it.W = C.in(I_OWDOWN) + (size_t)e * FE * D; it.K = FE; it.N = D; it.WT = ws + WS_MDN + (size_t)e * D * FE; it.f8 = 1; }
    else { int q = r - CV_NMOE;
        if (q < CV_IIN) { it.W = C.in(I_EWIN); it.K = D; it.N = NPROJ; it.WT = ws + WS_WIN; it.fold = C.in(I_EMIXN); }
        else if ((q -= CV_IIN) < CV_IOUT) { it.W = C.in(I_EWOUT); it.K = D; it.N = D; it.WT = ws + WS_WOUT; }
        else if ((q -= CV_IOUT) < 2 * CV_IG) { const int which = q >= CV_IG ? 1 : 0; q -= which * CV_IG; it.W = C.in(which ? I_EWUP : I_EWGATE); it.K = D; it.N = FF; it.WT = ws + WS_WGU; it.fold = C.in(I_EFFNN); it.inter = 1; it.which = which; it.f8 = 1; }
        else if ((q -= 2 * CV_IG) < CV_IDN) { it.W = C.in(I_EWDOWN); it.K = FF; it.N = D; it.WT = ws + WS_WDN; it.f8 = 1; }
        else if ((q -= CV_IDN) < CV_IQKV) { it.W = C.in(I_OWQKV); it.K = D; it.N = NQKV; it.WT = ws + WS_WQKV; it.fold = C.in(I_OMIXN); }
        else { q -= CV_IQKV; it.W = C.in(I_OWO); it.K = D; it.N = D; it.WT = ws + WS_WO; }
        item = q; }
    const int nblk = it.N / 32; it.k0 = 64 * (item / nblk); it.n0 = 32 * (item % nblk);
    return it;
}
__device__ __forceinline__ void cv_load(const CvItem& it, int lane, f32x4 (&v)[8], float (&f)[8]) {
    const int kr = lane >> 3, c4 = lane & 7;
#pragma unroll
    for (int i = 0; i < 8; ++i) v[i] = __builtin_nontemporal_load((const f32x4*)(it.W + (size_t)(it.k0 + 8 * i + kr) * it.N + it.n0 + 4 * c4));
    const float sc = it.f8 ? 64.0f : 1.0f;
#pragma unroll
    for (int i = 0; i < 8; ++i) f[i] = (it.fold ? it.fold[it.k0 + 8 * i + kr] : 1.0f) * sc;
}
__device__ __forceinline__ void cv_finish(const CvItem& it, int lane, const f32x4 (&v)[8], const float (&f)[8], LAS float* scr) {
    const int kr = lane >> 3, c4 = lane & 7;
#pragma unroll
    for (int i = 0; i < 8; ++i) { LAS float* d = scr + (8 * i + kr) * 33 + 4 * c4; d[0] = v[i][0] * f[i]; d[1] = v[i][1] * f[i]; d[2] = v[i][2] * f[i]; d[3] = v[i][3] * f[i]; }
    asm volatile("s_waitcnt lgkmcnt(0)" ::: "memory");
    const int c = lane & 7;
#pragma unroll
    for (int j = 0; j < 4; ++j) { const int nl = (lane >> 3) + 8 * j, n = it.n0 + nl; const LAS float* sp = scr + (8 * c) * 33 + nl;
        const int dr = it.inter ? (n / 128) * 256 + it.which * 128 + (n % 128) : n;
        if (it.f8) { u32x2 o; o.x = pk_fp8x4(sp[0 * 33], sp[1 * 33], sp[2 * 33], sp[3 * 33]); o.y = pk_fp8x4(sp[4 * 33], sp[5 * 33], sp[6 * 33], sp[7 * 33]);
            *(u32x2*)(it.WT + (size_t)dr * it.K + it.k0 + 8 * c) = o; }
        else { u32x4 o; o.x = pk2(sp[0 * 33], sp[1 * 33]); o.y = pk2(sp[2 * 33], sp[3 * 33]); o.z = pk2(sp[4 * 33], sp[5 * 33]); o.w = pk2(sp[6 * 33], sp[7 * 33]);
            *(u32x4*)((bf16_t*)it.WT + (size_t)dr * it.K + it.k0 + 8 * c) = o; } }
}
__device__ __forceinline__ void cvt_queue(const Ctx& C, int q, int first, int last) {
    unsigned* ctr = (unsigned*)C.ws() + CW_CVT + 16 * q;
    const int tid = opaque_tid(C.wid), lane = tid & 63, wave = C.wid;
    LAS float* scr = (LAS float*)(C.lds + wave * CV_SCR); volatile LAS unsigned* bc = (volatile LAS unsigned*)(C.lds + CV_BC);
    __syncthreads();
    if (tid == 0) bc[0] = xb_add(ctr, (unsigned)CV_BATCH);
    __syncthreads();
    int base = first + (int)bc[0], par = 0;
    while (base < last) {
        unsigned nxt = 0u;
        if (tid == 0) nxt = xb_add(ctr, (unsigned)CV_BATCH);
        const int r0 = base + wave, r1 = r0 + NWAVES;
        if (r0 < last) { const CvItem a = cv_decode(C, r0); f32x4 va[8]; float fa[8]; cv_load(a, lane, va, fa);
            if (r1 < last) { const CvItem b = cv_decode(C, r1); f32x4 vb[8]; float fb[8]; cv_load(b, lane, vb, fb); cv_finish(a, lane, va, fa, scr); cv_finish(b, lane, vb, fb, scr + 64 * 33); }
            else cv_finish(a, lane, va, fa, scr); }
        par ^= 1;
        if (tid == 0) bc[par] = nxt;
        __syncthreads();
        base = first + (int)bc[par];
    }
}
__device__ __forceinline__ void phase_prep(const Ctx& C) {
    const int bid = C.bid, G = C.G; unsigned char* ws = C.ws(); const int tid = opaque_tid(C.wid), lane = tid & 63, wave = C.wid;
    const int gw = bid * NWAVES + wave, NGW = G * NWAVES;
    cvt_queue(C, 0, CV_NMOE, CV_NMOE + CV_IIN);
    bf16_t* xb = (bf16_t*)(ws + WS_ARENA + AR_XB); float* ss0 = (float*)(ws + WS_SS0); const float* xin = C.in(I_X);
    for (int row0 = gw; row0 < T; row0 += 4 * NGW) {
        f32x4 v[4][4];
#pragma unroll
        for (int r = 0; r < 4; ++r) { const int row = row0 + r * NGW; const f32x4* xr = (const f32x4*)(xin + (size_t)(row < T ? row : row0) * D) + lane;
#pragma unroll
            for (int j = 0; j < 4; ++j) v[r][j] = __builtin_nontemporal_load(xr + 64 * j); }
#pragma unroll
        for (int r = 0; r < 4; ++r) { const int row = row0 + r * NGW; if (row < T) { float sq = 0.f; u32x2* o = (u32x2*)(xb + (size_t)row * D) + lane;
#pragma unroll
            for (int j = 0; j < 4; ++j) { const f32x4 x4 = v[r][j]; sq += (x4[0] * x4[0] + x4[1] * x4[1]) + (x4[2] * x4[2] + x4[3] * x4[3]); u32x2 w; w.x = pk2(x4[0], x4[1]); w.y = pk2(x4[2], x4[3]); o[64 * j] = w; }
            sq = wave_sum(sq);
            if (lane < NSS) ss0[(size_t)row * NSS + lane] = (lane == 0) ? sq : 0.f; } }
    }
    { const float* w_r = C.in(I_OWR); const float* fg = C.in(I_OFFNN); u32x4* wrf = (u32x4*)(ws + WS_WRF);
      for (int i = bid * NTHREADS + tid; i < 32 * 64; i += G * NTHREADS) { const int ks = i >> 6, l = i & 63, e = l & 15, kq = l >> 4; unsigned hi[8], lo[8];
#pragma unroll
          for (int j = 0; j < 8; ++j) { const int c = 32 * ks + 8 * kq + j; const float x = (e < NE) ? w_r[c * NE + e] * fg[c] : 0.f; hi[j] = f2bf(x); lo[j] = f2bf(x - bf2f(hi[j])); }
          u32x4 wh, wl; wh.x = hi[0] | (hi[1] << 16); wh.y = hi[2] | (hi[3] << 16); wh.z = hi[4] | (hi[5] << 16); wh.w = hi[6] | (hi[7] << 16);
          wl.x = lo[0] | (lo[1] << 16); wl.y = lo[2] | (lo[3] << 16); wl.z = lo[4] | (lo[5] << 16); wl.w = lo[6] | (lo[7] << 16);
          wrf[(ks * 2 + 0) * 64 + l] = wh; wrf[(ks * 2 + 1) * 64 + l] = wl; } }
    { const float* w_sp = C.in(I_EWSP); bf16_t* wspb = (bf16_t*)(ws + WS_WSPB);
      for (int i = bid * NTHREADS + tid; i < 8 * 128 * 16; i += G * NTHREADS) { const int row = i >> 4, k0 = 8 * (i & 15), trow = row & 127; const f32x4 a0 = *(const f32x4*)(w_sp + (size_t)row * 128 + k0), a1 = *(const f32x4*)(w_sp + (size_t)row * 128 + k0 + 4);
          float av[8] = {a0[0], a0[1], a0[2], a0[3], a1[0], a1[1], a1[2], a1[3]};
#pragma unroll
          for (int j = 0; j < 8; ++j) if (k0 + j > trow) av[j] = 0.f;
          u32x4 w; w.x = pk2(av[0], av[1]); w.y = pk2(av[2], av[3]); w.z = pk2(av[4], av[5]); w.w = pk2(av[6], av[7]); *(u32x4*)(wspb + (size_t)row * 128 + k0) = w; } }
    float* tab = (float*)(ws + WS_ROPE);
    for (int i = bid * NTHREADS + tid; i < SEQ * 16; i += G * NTHREADS) { const int sp = i / 16, f = i % 16; const double inv = pow(500000.0, -(double)f / 16.0); const double ang = (double)sp * inv;
        tab[2 * i] = (float)cos(ang); tab[2 * i + 1] = (float)sin(ang); }
}

constexpr int MX_VROW = 520, MX_MU = 256 * MX_VROW;
__device__ __forceinline__ void phase_mixer(const Ctx& C) {
    LAS unsigned char* lds = C.lds; const int bid = C.bid, G = C.G; unsigned char* ws = C.ws();
    const float* conv_w = C.in(I_ECONVW); const float* ln_g = C.in(I_ELNG); const float* ln_b = C.in(I_ELNB); const float* w_sp = C.in(I_EWSP); const float* b_sp = C.in(I_EBSP);
    const bf16_t* proj = (const bf16_t*)(ws + WS_ARENA + AR_PROJ); bf16_t* y = (bf16_t*)(ws + WS_ARENA + AR_Y);
    LAS float* mu = (LAS float*)(lds + MX_MU); LAS float* rstd = mu + 128;
    const int tid = opaque_tid(C.wid), lane = tid & 63, wave = C.wid, r31 = lane & 31, hh = lane >> 5;
    for (int unit = bid; unit < (T / 128) * 2; unit += G) {
        const int c = unit >> 1, hf = unit & 1, t0 = c * 128;
        { u32x4 vv[16];
#pragma unroll
          for (int i = 0; i < 16; ++i) vv[i] = *(const u32x4*)(proj + (size_t)(t0 + wave * 16 + i) * NPROJ + 3 * CONV + GM + lane * 8);
#pragma unroll
          for (int i = 0; i < 16; ++i) { const int sl = wave * 16 + i; const u32x4 v = vv[i];
            const float x0 = bf2f(v.x & 0xffffu), x1 = __builtin_bit_cast(float, v.x & 0xffff0000u), x2 = bf2f(v.y & 0xffffu), x3 = __builtin_bit_cast(float, v.y & 0xffff0000u),
                        x4 = bf2f(v.z & 0xffffu), x5 = __builtin_bit_cast(float, v.z & 0xffff0000u), x6 = bf2f(v.w & 0xffffu), x7 = __builtin_bit_cast(float, v.w & 0xffff0000u);
            float sm = ((x0 + x1) + (x2 + x3)) + ((x4 + x5) + (x6 + x7)), sq = ((x0 * x0 + x1 * x1) + (x2 * x2 + x3 * x3)) + ((x4 * x4 + x5 * x5) + (x6 * x6 + x7 * x7));
            sm = wave_sum(sm); sq = wave_sum(sq); const float m = sm * (1.0f / GM), var = sq * (1.0f / GM) - m * m;
            if (lane == 0) { mu[sl] = m; rstd[sl] = rsqrtf(fmaxf(var, 0.f) + EPS); } } }
        { const int co = tid & 31, sg = tid >> 5, ch = 256 * hf + 8 * co; float w0[8], w1[8], w2[8];
#pragma unroll
          for (int j = 0; j < 8; ++j) { w0[j] = conv_w[ch + j]; w1[j] = conv_w[CONV + ch + j]; w2[j] = conv_w[2 * CONV + ch + j]; }
          float zm2[8], zm1[8];
#pragma unroll
          for (int j = 0; j < 8; ++j) { zm2[j] = 0.f; zm1[j] = 0.f; }
          u32x4 AH[10], AC[10], AB[8];
#pragma unroll
          for (int i = -2; i < 8; ++i) { const int t = t0 + 8 * sg + i; const bool inseq = (i >= 0) || ((t0 + 8 * sg) % SEQ != 0); const bf16_t* pr = proj + (size_t)(inseq ? t : t0) * NPROJ + ch;
              AH[i + 2] = *(const u32x4*)pr; AC[i + 2] = *(const u32x4*)(pr + CONV); if (i >= 0) AB[i] = *(const u32x4*)(pr + 2 * CONV); }
#pragma unroll
          for (int i = -2; i < 8; ++i) { const int t = t0 + 8 * sg + i; const bool inseq = (i >= 0) || ((t0 + 8 * sg) % SEQ != 0);
              const u32x4 ah = AH[i + 2], ac = AC[i + 2];
              float z[8];
              z[0] = bf2f(ah.x & 0xffffu) * bf2f(ac.x & 0xffffu); z[1] = __builtin_bit_cast(float, ah.x & 0xffff0000u) * __builtin_bit_cast(float, ac.x & 0xffff0000u);
              z[2] = bf2f(ah.y & 0xffffu) * bf2f(ac.y & 0xffffu); z[3] = __builtin_bit_cast(float, ah.y & 0xffff0000u) * __builtin_bit_cast(float, ac.y & 0xffff0000u);
              z[4] = bf2f(ah.z & 0xffffu) * bf2f(ac.z & 0xffffu); z[5] = __builtin_bit_cast(float, ah.z & 0xffff0000u) * __builtin_bit_cast(float, ac.z & 0xffff0000u);
              z[6] = bf2f(ah.w & 0xffffu) * bf2f(ac.w & 0xffffu); z[7] = __builtin_bit_cast(float, ah.w & 0xffff0000u) * __builtin_bit_cast(float, ac.w & 0xffff0000u);
              if (!inseq) {
#pragma unroll
                  for (int j = 0; j < 8; ++j) z[j] = 0.f; }
              if (i >= 0) { const u32x4 ab = AB[i >= 0 ? i : 0]; float o[8];
#pragma unroll
                  for (int j = 0; j < 8; ++j) o[j] = w0[j] * zm2[j] + w1[j] * zm1[j] + w2[j] * z[j];
                  u32x4 w; w.x = pk2(bf2f(ab.x & 0xffffu) * o[0], __builtin_bit_cast(float, ab.x & 0xffff0000u) * o[1]); w.y = pk2(bf2f(ab.y & 0xffffu) * o[2], __builtin_bit_cast(float, ab.y & 0xffff0000u) * o[3]);
                  w.z = pk2(bf2f(ab.z & 0xffffu) * o[4], __builtin_bit_cast(float, ab.z & 0xffff0000u) * o[5]); w.w = pk2(bf2f(ab.w & 0xffffu) * o[6], __builtin_bit_cast(float, ab.w & 0xffff0000u) * o[7]);
                  *(u32x4*)(y + (size_t)t * D + ch) = w; }
#pragma unroll
              for (int j = 0; j < 8; ++j) { zm2[j] = zm1[j]; zm1[j] = z[j]; } } }
        __syncthreads();
        { u32x2 RV[4][4]; f32x4 GG[4], BB[4];
#pragma unroll
          for (int i = 0; i < 4; ++i) { const int v = tid + 512 * i, sq4 = v >> 6, cq = v & 63, chg = 256 * hf + 4 * cq; const bf16_t* src = proj + (size_t)(t0 + 4 * sq4) * NPROJ + 3 * CONV + GM + chg;
              GG[i] = *(const f32x4*)(ln_g + chg); BB[i] = *(const f32x4*)(ln_b + chg);
#pragma unroll
              for (int r = 0; r < 4; ++r) RV[i][r] = *(const u32x2*)(src + (size_t)r * NPROJ); }
#pragma unroll
          for (int i = 0; i < 4; ++i) { const int v = tid + 512 * i, sq4 = v >> 6, cq = v & 63, chl = 4 * cq; const f32x4 gg = GG[i], bb = BB[i];
            unsigned e[4][4];
#pragma unroll
            for (int r = 0; r < 4; ++r) { const u32x2 rv = RV[i][r]; const float m = mu[4 * sq4 + r], rs = rstd[4 * sq4 + r];
                e[r][0] = f2bf((bf2f(rv.x & 0xffffu) - m) * rs * gg[0] + bb[0]); e[r][1] = f2bf((__builtin_bit_cast(float, rv.x & 0xffff0000u) - m) * rs * gg[1] + bb[1]);
                e[r][2] = f2bf((bf2f(rv.y & 0xffffu) - m) * rs * gg[2] + bb[2]); e[r][3] = f2bf((__builtin_bit_cast(float, rv.y & 0xffff0000u) - m) * rs * gg[3] + bb[3]); }
            LAS unsigned char* dst = lds + chl * MX_VROW + sq4 * 8;
#pragma unroll
            for (int d = 0; d < 4; ++d) { u32x2 w; w.x = e[0][d] | (e[1][d] << 16); w.y = e[2][d] | (e[3][d] << 16); *(LAS u32x2*)(dst + d * MX_VROW) = w; } } }
        __syncthreads();
        { const int gl = wave >> 1, dt = wave & 1, g = 4 * hf + gl, chl = 64 * gl + 32 * dt + r31;
          bf16x8 bfr[8];
#pragma unroll
          for (int ks = 0; ks < 8; ++ks) { const LAS unsigned char* vp = lds + chl * MX_VROW + (16 * ks + 8 * hh) * 2; const u32x2 v0 = *(const LAS u32x2*)vp, v1 = *(const LAS u32x2*)(vp + 8);
              u32x4 w; w.x = v0.x; w.y = v0.y; w.z = v1.x; w.w = v1.y; bfr[ks] = __builtin_bit_cast(bf16x8, w); }
          const bf16_t* wspb = (const bf16_t*)(ws + WS_WSPB);
          bf16x8 WA[4][8]; u32x2 GU[4][4]; float bias[4];
#pragma unroll
          for (int tt = 0; tt < 4; ++tt) { const int trow = 32 * tt + r31; const bf16_t* wrow = wspb + ((size_t)g * 128 + trow) * 128 + 8 * hh;
#pragma unroll
              for (int ks = 0; ks < 8; ++ks) if (ks < 2 * tt + 2) WA[tt][ks] = *(const bf16x8*)(wrow + 16 * ks);
              const bf16_t* gp = proj + (size_t)(t0 + trow) * NPROJ + 3 * CONV + 256 * hf + 64 * gl + 32 * dt + 4 * hh;
#pragma unroll
              for (int g4 = 0; g4 < 4; ++g4) GU[tt][g4] = *(const u32x2*)(gp + 8 * g4);
              bias[tt] = b_sp[g * 128 + trow]; }
#pragma unroll
          for (int tt = 0; tt < 4; ++tt) { f32x16 acc;
#pragma unroll
              for (int i = 0; i < 16; ++i) acc[i] = 0.f;
#pragma unroll
              for (int ks = 0; ks < 8; ++ks) if (ks < 2 * tt + 2) acc = __builtin_amdgcn_mfma_f32_32x32x16_bf16(bfr[ks], WA[tt][ks], acc, 0, 0, 0);
              const int trow = 32 * tt + r31, chg0 = 256 * hf + 64 * gl + 32 * dt + 4 * hh, t = t0 + trow;
              bf16_t* yp = y + (size_t)t * D + CONV + chg0; const float bs = bias[tt];
#pragma unroll
              for (int g4 = 0; g4 < 4; ++g4) { const u32x2 gu = GU[tt][g4]; u32x2 o;
                  o.x = pk2(bf2f(gu.x & 0xffffu) * (acc[4 * g4 + 0] + bs), __builtin_bit_cast(float, gu.x & 0xffff0000u) * (acc[4 * g4 + 1] + bs));
                  o.y = pk2(bf2f(gu.y & 0xffffu) * (acc[4 * g4 + 2] + bs), __builtin_bit_cast(float, gu.y & 0xffff0000u) * (acc[4 * g4 + 3] + bs)); *(u32x2*)(yp + 8 * g4) = o; } } }
        __syncthreads();
    }
}

__device__ __forceinline__ void phase_qkprep(const Ctx& C) {
    LAS unsigned char* lds = C.lds; const int bid = C.bid, G = C.G; unsigned char* ws = C.ws(); const float* qn = C.in(I_OQN); const float* kn = C.in(I_OKN);
    bf16_t* qkv = (bf16_t*)(ws + WS_ARENA + AR_QKV); const float* rope = (const float*)(ws + WS_ROPE); float* kmean = (float*)(ws + WS_KMEAN);
    LAS float* red = (LAS float*)lds;
    const int tid = opaque_tid(C.wid), lane = tid & 63, wave = C.wid, c16 = lane & 15, sub = lane >> 4;
    float gq[8], gk[8];
#pragma unroll
    for (int j = 0; j < 8; ++j) { gq[j] = qn[8 * c16 + j]; gk[j] = kn[8 * c16 + j]; }
    for (int item = bid; item < NBATCH * NBLK * NH; item += G) {
        const int h = item % NH, n = (item / NH) % NBLK, b = item / (NH * NBLK); float ks[8];
#pragma unroll
        for (int j = 0; j < 8; ++j) ks[j] = 0.f;
#pragma unroll 4
        for (int it = 0; it < 8; ++it) { const int sq = n * MB + wave * 32 + it * 4 + sub, t = b * SEQ + sq;
            float cs[8], sn[8];
            { const f32x4* rp = (const f32x4*)(rope + (sq * 16 + 8 * (c16 & 1)) * 2); f32x4 r0 = (f32x4){1.f, 0.f, 1.f, 0.f}, r1 = r0, r2 = r0, r3 = r0; if (c16 < 4) { r0 = rp[0]; r1 = rp[1]; r2 = rp[2]; r3 = rp[3]; }
              cs[0] = r0[0]; sn[0] = r0[1]; cs[1] = r0[2]; sn[1] = r0[3]; cs[2] = r1[0]; sn[2] = r1[1]; cs[3] = r1[2]; sn[3] = r1[3];
              cs[4] = r2[0]; sn[4] = r2[1]; cs[5] = r2[2]; sn[5] = r2[3]; cs[6] = r3[0]; sn[6] = r3[1]; cs[7] = r3[2]; sn[7] = r3[3]; }
#pragma unroll
            for (int which = 0; which < 2; ++which) { bf16_t* p = qkv + (size_t)t * NQKV + which * D + h * HD + 8 * c16; const u32x4 raw = *(const u32x4*)p;
                float v[8] = {bf2f(raw.x & 0xffffu), __builtin_bit_cast(float, raw.x & 0xffff0000u), bf2f(raw.y & 0xffffu), __builtin_bit_cast(float, raw.y & 0xffff0000u),
                              bf2f(raw.z & 0xffffu), __builtin_bit_cast(float, raw.z & 0xffff0000u), bf2f(raw.w & 0xffffu), __builtin_bit_cast(float, raw.w & 0xffff0000u)};
                float q = ((v[0] * v[0] + v[1] * v[1]) + (v[2] * v[2] + v[3] * v[3])) + ((v[4] * v[4] + v[5] * v[5]) + (v[6] * v[6] + v[7] * v[7]));
                q += __shfl_xor(q, 1); q += __shfl_xor(q, 2); q += __shfl_xor(q, 4); q += __shfl_xor(q, 8);
                const float r = rsqrtf(q * (1.0f / HD) + EPS);
#pragma unroll
                for (int j = 0; j < 8; ++j) v[j] = v[j] * r * (which ? gk[j] : gq[j]);
#pragma unroll
                for (int j = 0; j < 8; ++j) { const float pt = __shfl_xor(v[j], 2); if (c16 < 2) v[j] = v[j] * cs[j] - pt * sn[j]; else if (c16 < 4) v[j] = v[j] * cs[j] + pt * sn[j]; }
                u32x4 w; w.x = pk2(v[0], v[1]); w.y = pk2(v[2], v[3]); w.z = pk2(v[4], v[5]); w.w = pk2(v[6], v[7]);
                *(u32x4*)p = w;
                if (which) { ks[0] += bf2f(w.x & 0xffffu); ks[1] += __builtin_bit_cast(float, w.x & 0xffff0000u); ks[2] += bf2f(w.y & 0xffffu); ks[3] += __builtin_bit_cast(float, w.y & 0xffff0000u);
                             ks[4] += bf2f(w.z & 0xffffu); ks[5] += __builtin_bit_cast(float, w.z & 0xffff0000u); ks[6] += bf2f(w.w & 0xffffu); ks[7] += __builtin_bit_cast(float, w.w & 0xffff0000u); } } }
#pragma unroll
        for (int j = 0; j < 8; ++j) { ks[j] += __shfl_xor(ks[j], 16); ks[j] += __shfl_xor(ks[j], 32); }
        if (sub == 0) {
#pragma unroll
            for (int j = 0; j < 8; ++j) red[wave * 128 + 8 * c16 + j] = ks[j]; }
        __syncthreads();
        if (tid < 128) { float a = 0.f;
#pragma unroll
            for (int w = 0; w < NWAVES; ++w) a += red[w * 128 + tid];
            kmean[((size_t)(b * NH + h) * NBLK + n) * HD + tid] = a * (1.0f / MB); }
        __syncthreads();
    }
}

__device__ __forceinline__ void phase_select(const Ctx& C, bool probe) {
    const int bid = C.bid, G = C.G; unsigned char* ws = C.ws();
    const bf16_t* qkv = (const bf16_t*)(ws + WS_ARENA + AR_QKV); const float* kmean = (const float*)(ws + WS_KMEAN);
    unsigned* bcnt = (unsigned*)ws + (probe ? 5120 : CW_BKT); int* blist = (int*)(ws + (probe ? WS_ARENA + ((size_t)100 << 20) : WS_BLIST));
    const int tid = opaque_tid(C.wid), lane = tid & 63; LAS float* kml = (LAS float*)(C.lds + C.wid * 8192);
    for (int wt = bid * NWAVES + C.wid; wt < (T / 64) * NH; wt += G * NWAVES) {
        const int h = wt & 7, tg = wt >> 3, t = tg * 64 + lane, b = (tg * 64) / SEQ, sq = t % SEQ, qb = ((tg * 64) % SEQ) / MB;
        if (qb == 0) continue;
        const bf16_t* qp = qkv + (size_t)t * NQKV + h * HD; const float* km = kmean + (size_t)(b * NH + h) * NBLK * HD;
        { const int m16 = lane & 15, kq = lane >> 4;
          f32x4 ka[4][2]; bf16x8 qf[4][4];
#pragma unroll
          for (int ks = 0; ks < 4; ++ks) { const float* kp = km + m16 * HD + 32 * ks + 8 * kq; ka[ks][0] = *(const f32x4*)kp + *(const f32x4*)(kp + KM_HALF); ka[ks][1] = *(const f32x4*)(kp + 4) + *(const f32x4*)(kp + KM_HALF + 4); }
#pragma unroll
          for (int tt = 0; tt < 4; ++tt) { const bf16_t* qrow = qkv + (size_t)(tg * 64 + tt * 16 + m16) * NQKV + h * HD + 8 * kq;
#pragma unroll
              for (int ks = 0; ks < 4; ++ks) qf[tt][ks] = *(const bf16x8*)(qrow + 32 * ks); }
          f32x4 sc4[4];
#pragma unroll
          for (int tt = 0; tt < 4; ++tt) sc4[tt] = (f32x4){0.f, 0.f, 0.f, 0.f};
#pragma unroll
          for (int ks = 0; ks < 4; ++ks) { float x[8] = {ka[ks][0][0], ka[ks][0][1], ka[ks][0][2], ka[ks][0][3], ka[ks][1][0], ka[ks][1][1], ka[ks][1][2], ka[ks][1][3]}; unsigned hi[8], lo[8];
#pragma unroll
              for (int j = 0; j < 8; ++j) { hi[j] = f2bf(x[j]); lo[j] = f2bf(x[j] - bf2f(hi[j])); }
              u32x4 wh, wl; wh.x = hi[0] | (hi[1] << 16); wh.y = hi[2] | (hi[3] << 16); wh.z = hi[4] | (hi[5] << 16); wh.w = hi[6] | (hi[7] << 16);
              wl.x = lo[0] | (lo[1] << 16); wl.y = lo[2] | (lo[3] << 16); wl.z = lo[4] | (lo[5] << 16); wl.w = lo[6] | (lo[7] << 16);
#pragma unroll
              for (int tt = 0; tt < 4; ++tt) { sc4[tt] = __builtin_amdgcn_mfma_f32_16x16x32_bf16(__builtin_bit_cast(bf16x8, wh), qf[tt][ks], sc4[tt], 0, 0, 0);
                                               sc4[tt] = __builtin_amdgcn_mfma_f32_16x16x32_bf16(__builtin_bit_cast(bf16x8, wl), qf[tt][ks], sc4[tt], 0, 0, 0); } }
#pragma unroll
          for (int tt = 0; tt < 4; ++tt) *(LAS f32x4*)(kml + (tt * 16 + m16) * 16 + 4 * kq) = sc4[tt];
          asm volatile("s_waitcnt lgkmcnt(0)" ::: "memory"); }
        float acc[NBLK];
        { const f32x4 a0 = *(const LAS f32x4*)(kml + lane * 16), a1 = *(const LAS f32x4*)(kml + lane * 16 + 4), a2 = *(const LAS f32x4*)(kml + lane * 16 + 8), a3 = *(const LAS f32x4*)(kml + lane * 16 + 12);
          acc[0] = a0[0]; acc[1] = a0[1]; acc[2] = a0[2]; acc[3] = a0[3]; acc[4] = a1[0]; acc[5] = a1[1]; acc[6] = a1[2]; acc[7] = a1[3];
          acc[8] = a2[0]; acc[9] = a2[1]; acc[10] = a2[2]; acc[11] = a2[3]; acc[12] = a3[0]; acc[13] = a3[1]; acc[14] = a3[2]; acc[15] = a3[3]; }
        asm volatile("s_waitcnt lgkmcnt(0)" ::: "memory");
        const int nsel = qb < 3 ? qb : 3; int sel0 = -1, sel1 = -1, sel2 = -1;
#pragma unroll
        for (int j = 0; j < 3; ++j) { float bv = -INFINITY; int bi = 0;
#pragma unroll
            for (int n = 0; n < NBLK - 1; ++n) { const float v = (n < qb) ? acc[n] : -INFINITY; if (v > bv) { bv = v; bi = n; } }
#pragma unroll
            for (int n = 0; n < NBLK - 1; ++n) if (n == bi) acc[n] = -INFINITY;
            if (j < nsel) { if (j == 0) sel0 = bi; if (j == 1) sel1 = bi; if (j == 2) sel2 = bi; } }
        const unsigned long long lt = (1ull << lane) - 1ull; int mytot = 0;
        for (int n = 0; n < qb; ++n) { const int tot = __popcll(__ballot(sel0 == n)) + __popcll(__ballot(sel1 == n)) + __popcll(__ballot(sel2 == n)); if (lane == n) mytot = tot; }
        unsigned mybase = 0; if (lane < qb && mytot > 0) mybase = atomicAdd(bcnt + (b * NH + h) * NBLK + lane, (unsigned)mytot);
        for (int n = 0; n < qb; ++n) { const unsigned long long m0 = __ballot(sel0 == n), m1 = __ballot(sel1 == n), m2 = __ballot(sel2 == n); const int c0 = __popcll(m0), c1 = __popcll(m1);
            const unsigned base = (unsigned)__shfl((int)mybase, n); int j = -1, rank = 0;
            if (sel0 == n) { j = 0; rank = __popcll(m0 & lt); } else if (sel1 == n) { j = 1; rank = c0 + __popcll(m1 & lt); } else if (sel2 == n) { j = 2; rank = c0 + c1 + __popcll(m2 & lt); }
            if (j >= 0) blist[(size_t)((b * NH + h) * NBLK + n) * BKT_CAP + base + rank] = (sq << 2) | j; }
    }
}

constexpr int AT_KS = 0, AT_KROW = 272, AT_VT = 256 * AT_KROW, AT_VROW = 520, AT_CUM = AT_VT + 128 * AT_VROW;
constexpr int AT_OT = AT_CUM + 3072, AT_OTW = 32 * 80;
static_assert(AT_CUM + 540 * 4 <= AT_OT && AT_OT + 8 * AT_OTW <= LDS_TB, "attention LDS map");
constexpr int CW_AQ = 600;
__device__ __forceinline__ void phase_attn(const Ctx& C, bool probe, unsigned pflags) {
    LAS unsigned char* lds = C.lds; unsigned char* ws = C.ws();
    const bf16_t* qkv = (const bf16_t*)(ws + WS_ARENA + AR_QKV); const unsigned* bcnt = (const unsigned*)ws + (probe ? 5120 : CW_BKT); const int* blist = (const int*)(ws + (probe ? WS_ARENA + ((size_t)100 << 20) : WS_BLIST));
    bf16_t* opart = (bf16_t*)(ws + WS_ARENA + AR_OPART); float* lpart = (float*)(ws + WS_LPART);
    const int tid = opaque_tid(C.wid), lane = tid & 63, wave = C.wid, r31 = lane & 31, hh = lane >> 5;
    LAS int* cum = (LAS int*)(lds + AT_CUM); LAS int* misc = cum + 520;
    { const int n = tid >> 5, bh = tid & 31; const int c = (int)bcnt[bh * NBLK + n]; int v = (c + 511) >> 9; v = v < 1 ? 1 : v;
#pragma unroll
      for (int o = 1; o < 64; o <<= 1) { const int u = __shfl_up(v, o); if (lane >= o) v += u; }
      if (lane == 63) misc[wave] = v;
      __syncthreads();
      int base = 0;
#pragma unroll
      for (int w = 0; w < NWAVES; ++w) base += (w < wave) ? misc[w] : 0;
      cum[tid + 1] = v + base; if (tid == 0) cum[0] = 0;
      __syncthreads(); }
    const int nitems = cum[512];
    const float cexp = 0.12751743f;
    LAS unsigned char* otile = lds + AT_OT + wave * AT_OTW;
    if (tid == 0) misc[8] = (int)atomicAdd((unsigned*)C.ws() + CW_AQ + (probe ? 1 : 0), 1u);
    __syncthreads();
    int item = misc[8];
    int n = 0, h = 0, b = 0, bk = 0, chunk = 0, cnt = 0, nown = 0, nrg = 0; int ent[3]; bool val[3];
#define AT_DECODE(it_) do { int lo = 0, hi = 512; while (hi - lo > 1) { const int mid = (lo + hi) >> 1; if (cum[mid] <= (it_)) lo = mid; else hi = mid; } \
        chunk = (it_) - cum[lo]; n = lo >> 5; { const int bh = lo & 31; h = bh & 7; b = bh >> 3; bk = bh * NBLK + n; } cnt = (int)bcnt[bk]; \
        { const int rem = cnt - chunk * 512; const int nsrg = ((rem < 512 ? rem : 512) + 31) >> 5; nown = (chunk == 0) ? 8 : 0; nrg = nown + (nsrg > 0 ? nsrg : 0); } } while (0)
#define AT_ENTS() do { _Pragma("unroll") for (int it = 0; it < 3; ++it) { const int rg = wave + 8 * it; val[it] = false; ent[it] = 0; \
        if (rg < nrg) { if (rg < nown) { ent[it] = ((n * MB + (7 - rg) * 32 + r31) << 2) | 3; val[it] = true; } \
                        else { const int ei = chunk * 512 + (rg - nown) * 32 + r31; val[it] = ei < cnt; ent[it] = val[it] ? blist[(size_t)bk * BKT_CAP + ei] : 0; } } } } while (0)
    if (item < nitems) { AT_DECODE(item); AT_ENTS(); }
    while (item < nitems) {
        __syncthreads();
        const int tid = opaque_tid(C.wid), lane = tid & 63, r31 = lane & 31, hh = lane >> 5;
        if (tid == 0) misc[8] = (int)atomicAdd((unsigned*)C.ws() + CW_AQ + (probe ? 1 : 0), 1u);
        const int cn = n, ch = h, cb = b, cnown = nown, cnrg = nrg; int cent[3]; bool cval[3];
#pragma unroll
        for (int it = 0; it < 3; ++it) { cent[it] = ent[it]; cval[it] = val[it]; }
        bf16x8 qn[8];
        { const bf16_t* qp = qkv + (size_t)(cb * SEQ + (cent[0] >> 2)) * NQKV + ch * HD + 8 * hh;
#pragma unroll
          for (int s8 = 0; s8 < 8; ++s8) qn[s8] = *(const bf16x8*)(qp + 16 * s8); }
        {
          const int tl = tid;
          const bf16_t* kb = qkv + (size_t)(cb * SEQ + cn * MB) * NQKV + D + ch * HD;
#pragma unroll
          for (int i = 0; i < 8; ++i) { const int c = tl + 512 * i, row = c >> 4, c16 = c & 15; const u32x4 v = *(const u32x4*)(kb + (size_t)row * NQKV + c16 * 8); *(LAS u32x4*)(lds + AT_KS + row * AT_KROW + c16 * 16) = v; }
          const bf16_t* vb = kb + D;
#pragma unroll
          for (int i = 0; i < 4; ++i) { const int v = tl + 512 * i, kq = v >> 5, dq = v & 31; const bf16_t* src = vb + (size_t)(4 * kq) * NQKV + 4 * dq;
              const u32x2 r0 = *(const u32x2*)src, r1 = *(const u32x2*)(src + NQKV), r2 = *(const u32x2*)(src + 2 * NQKV), r3 = *(const u32x2*)(src + 3 * NQKV);
              LAS unsigned char* dst = lds + AT_VT + (4 * dq) * AT_VROW + kq * 8;
              u32x2 w;
              w.x = (r0.x & 0xffffu) | (r1.x << 16); w.y = (r2.x & 0xffffu) | (r3.x << 16); *(LAS u32x2*)(dst) = w;
              w.x = (r0.x >> 16) | (r1.x & 0xffff0000u); w.y = (r2.x >> 16) | (r3.x & 0xffff0000u); *(LAS u32x2*)(dst + AT_VROW) = w;
              w.x = (r0.y & 0xffffu) | (r1.y << 16); w.y = (r2.y & 0xffffu) | (r3.y << 16); *(LAS u32x2*)(dst + 2 * AT_VROW) = w;
              w.x = (r0.y >> 16) | (r1.y & 0xffff0000u); w.y = (r2.y >> 16) | (r3.y & 0xffff0000u); *(LAS u32x2*)(dst + 3 * AT_VROW) = w; } }
        __syncthreads();
        const int nextitem = misc[8];
        if (nextitem < nitems) { AT_DECODE(nextitem); AT_ENTS(); }
#pragma unroll
        for (int it = 0; it < 3; ++it) { const int rg = wave + 8 * it;
            if (rg < cnrg) {
            const bool own = rg < cnown; const int og = 7 - rg;
            const int sq = cent[it] >> 2, slot = cent[it] & 3, tq = cb * SEQ + sq;
            bf16x8 qf[8];
#pragma unroll
            for (int s8 = 0; s8 < 8; ++s8) qf[s8] = qn[s8];
            if (it < 2 && rg + 8 < cnrg) { const bf16_t* qp = qkv + (size_t)(cb * SEQ + (cent[it < 2 ? it + 1 : 2] >> 2)) * NQKV + ch * HD + 8 * hh;
#pragma unroll
                for (int s8 = 0; s8 < 8; ++s8) qn[s8] = *(const bf16x8*)(qp + 16 * s8); }
            f32x16 oacc[4];
#pragma unroll
            for (int dt = 0; dt < 4; ++dt)
#pragma unroll
                for (int i = 0; i < 16; ++i) oacc[dt][i] = 0.f;
            float lsum = 0.f;
            const int nkt = own ? (og + 1) : 8;
            const LAS unsigned char* kbase = lds + AT_KS + r31 * AT_KROW + 16 * hh;
            const LAS unsigned char* vbase = lds + AT_VT + r31 * AT_VROW + 8 * hh;
            for (int kt = 0; kt < nkt; ++kt) {
                f32x16 sacc;
#pragma unroll
                for (int i = 0; i < 16; ++i) sacc[i] = 0.f;
#pragma unroll
                for (int s8 = 0; s8 < 8; ++s8) { const bf16x8 kf = *(const LAS bf16x8*)(kbase + kt * 32 * AT_KROW + 32 * s8); sacc = __builtin_amdgcn_mfma_f32_32x32x16_bf16(kf, qf[s8], sacc, 0, 0, 0); }
                const bool diag = own && (kt == og);
                float p[16];
#pragma unroll
                for (int i = 0; i < 16; ++i) { const int krow = (i & 3) + 8 * (i >> 2) + 4 * hh; float e = __builtin_amdgcn_exp2f(sacc[i] * cexp); if (diag && krow > r31) e = 0.f; p[i] = e; lsum += e; }
                bf16x8 pb[2];
#pragma unroll
                for (int s2 = 0; s2 < 2; ++s2) { u32x4 w; w.x = cvt_pk_bf16(p[8 * s2 + 0], p[8 * s2 + 1]); w.y = cvt_pk_bf16(p[8 * s2 + 2], p[8 * s2 + 3]); w.z = cvt_pk_bf16(p[8 * s2 + 4], p[8 * s2 + 5]); w.w = cvt_pk_bf16(p[8 * s2 + 6], p[8 * s2 + 7]);
                    pb[s2] = __builtin_bit_cast(bf16x8, w); }
#pragma unroll
                for (int dt = 0; dt < 4; ++dt)
#pragma unroll
                    for (int s2 = 0; s2 < 2; ++s2) { const LAS unsigned char* vp = vbase + dt * 32 * AT_VROW + (kt * 32 + 16 * s2) * 2;
                        const u32x2 v0 = *(const LAS u32x2*)vp, v1 = *(const LAS u32x2*)(vp + 16); u32x4 w; w.x = v0.x; w.y = v0.y; w.z = v1.x; w.w = v1.y;
                        oacc[dt] = __builtin_amdgcn_mfma_f32_32x32x16_bf16(__builtin_bit_cast(bf16x8, w), pb[s2], oacc[dt], 0, 0, 0); }
            }
            lsum = xsum32(lsum);
            const int pidx = cval[it] ? (int)(((unsigned)tq * NH + ch) * 4 + slot) : -1;
            if (hh == 0 && pidx >= 0) lpart[pidx] = lsum;
            const int l2 = lane, r2 = r31, h2 = hh;
#pragma unroll
            for (int dt = 0; dt < 4; ++dt) {
#pragma unroll
                for (int g4 = 0; g4 < 4; ++g4) { u32x2 w; w.x = cvt_pk_bf16(oacc[dt][4 * g4 + 0], oacc[dt][4 * g4 + 1]); w.y = cvt_pk_bf16(oacc[dt][4 * g4 + 2], oacc[dt][4 * g4 + 3]); *(LAS u32x2*)(otile + r2 * 80 + (8 * g4 + 4 * h2) * 2) = w; }
                asm volatile("s_waitcnt lgkmcnt(0)" ::: "memory");
#pragma unroll
                for (int hf = 0; hf < 2; ++hf) { const int row = (l2 >> 2) + 16 * hf, c4 = l2 & 3; const u32x4 v = *(const LAS u32x4*)(otile + row * 80 + c4 * 16); const int pr = __shfl(pidx, row);
                    if (pr >= 0 && !(pflags & 4u)) *(u32x4*)(opart + (size_t)pr * HD + 32 * dt + 8 * c4) = v; }
                asm volatile("s_waitcnt lgkmcnt(0)" ::: "memory"); }
            } }
        item = nextitem;
    }
#undef AT_DECODE
#undef AT_ENTS
}

__device__ __forceinline__ void phase_combine(const Ctx& C) {
    const int bid = C.bid, G = C.G; unsigned char* ws = C.ws();
    bf16_t* qkv = (bf16_t*)(ws + WS_ARENA + AR_QKV); const bf16_t* opart = (const bf16_t*)(ws + WS_ARENA + AR_OPART); const float* lpart = (const float*)(ws + WS_LPART);
    const int tid = opaque_tid(C.wid), lane = tid & 63, sub = lane >> 4, c16 = lane & 15;
    const int pstep = G * NWAVES * 4;
    for (int p0 = (bid * NWAVES + C.wid) * 4; p0 < T * NH; p0 += 2 * pstep) {
        u32x4 pv[2][4]; float lj[2][4];
#pragma unroll
        for (int u = 0; u < 2; ++u) { const int pr = (p0 + u * pstep < T * NH ? p0 + u * pstep : p0) + sub, t = pr >> 3, qb = (t % SEQ) / MB, nsel = qb < 3 ? qb : 3;
#pragma unroll
            for (int j = 0; j < 4; ++j) { const bool use = (j < nsel) || (j == 3); const size_t pidx = (size_t)pr * 4 + (use ? j : 3); pv[u][j] = *(const u32x4*)(opart + pidx * HD + c16 * 8); lj[u][j] = lpart[pidx]; } }
#pragma unroll
        for (int u = 0; u < 2; ++u) if (p0 + u * pstep < T * NH) { const int pr = p0 + u * pstep + sub, h = pr & 7, t = pr >> 3, qb = (t % SEQ) / MB, nsel = qb < 3 ? qb : 3;
            float acc[8]; float l = 0.f;
#pragma unroll
            for (int i = 0; i < 8; ++i) acc[i] = 0.f;
#pragma unroll
            for (int j = 0; j < 4; ++j) { const float m = ((j < nsel) || (j == 3)) ? 1.0f : 0.0f; const u32x4 v = pv[u][j]; l += lj[u][j] * m;
                acc[0] += bf2f(v.x & 0xffffu) * m; acc[1] += __builtin_bit_cast(float, v.x & 0xffff0000u) * m; acc[2] += bf2f(v.y & 0xffffu) * m; acc[3] += __builtin_bit_cast(float, v.y & 0xffff0000u) * m;
                acc[4] += bf2f(v.z & 0xffffu) * m; acc[5] += __builtin_bit_cast(float, v.z & 0xffff0000u) * m; acc[6] += bf2f(v.w & 0xffffu) * m; acc[7] += __builtin_bit_cast(float, v.w & 0xffff0000u) * m; }
            const float inv = 1.0f / l;
            u32x4 w; w.x = pk2(acc[0] * inv, acc[1] * inv); w.y = pk2(acc[2] * inv, acc[3] * inv); w.z = pk2(acc[4] * inv, acc[5] * inv); w.w = pk2(acc[6] * inv, acc[7] * inv);
            *(u32x4*)(qkv + (size_t)t * NQKV + h * HD + c16 * 8) = w; }
    }
}

__device__ __forceinline__ void phase_router(const Ctx& C, bool probe) {
    const int bid = C.bid, G = C.G; unsigned char* ws = C.ws(); const float* ffn_g = C.in(I_OFFNN); const float* w_r = C.in(I_OWR);
    const bf16_t* h3 = (const bf16_t*)(ws + WS_ARENA + AR_H3B); const float* ss3 = (const float*)(ws + WS_SS3); int* cnt = (int*)(ws + WS_CTL) + (probe ? 6144 : 0); int* tslot = (int*)(ws + (probe ? WS_ARENA + ((size_t)103 << 20) : WS_TSLOT)); int* tokof = (int*)(ws + (probe ? WS_ARENA + ((size_t)100 << 20) : WS_TOKOF)); float* gateof = (float*)(ws + (probe ? WS_ARENA + ((size_t)101 << 20) : WS_GATEOF)); f32x4* minfo = (f32x4*)(ws + (probe ? WS_ARENA + ((size_t)102 << 20) : WS_MINFO));
    const int tid = opaque_tid(C.wid), lane = tid & 63, w = C.wid;
    LAS int* lcnt = (LAS int*)C.lds; LAS int* lbase = lcnt + 8; LAS int* te = lcnt + 16; LAS int* trank = te + 128; LAS float* tp = (LAS float*)(trank + 128); LAS float* trs = tp + 128;
    LAS float* part = (LAS float*)(C.lds + 2048);
    const u32x4* wrf = (const u32x4*)(ws + WS_WRF);
    for (int grp = bid; grp < T / 64; grp += G) {
        if (tid < 8) lcnt[tid] = 0;
        { const int tile = w >> 1, kh = w & 1, m16 = lane & 15, kq = lane >> 4; const bf16_t* hrow = h3 + (size_t)(grp * 64 + tile * 16 + m16) * D + kh * 512 + 8 * kq;
          f32x4 acc = (f32x4){0.f, 0.f, 0.f, 0.f};
#pragma unroll
          for (int k8 = 0; k8 < 16; k8 += 8) { bf16x8 hb[8]; u32x4 ah[8], al[8];
#pragma unroll
              for (int ks = 0; ks < 8; ++ks) { hb[ks] = *(const bf16x8*)(hrow + 32 * (k8 + ks)); ah[ks] = wrf[((kh * 16 + k8 + ks) * 2 + 0) * 64 + lane]; al[ks] = wrf[((kh * 16 + k8 + ks) * 2 + 1) * 64 + lane]; }
#pragma unroll
              for (int ks = 0; ks < 8; ++ks) { acc = __builtin_amdgcn_mfma_f32_16x16x32_bf16(__builtin_bit_cast(bf16x8, ah[ks]), hb[ks], acc, 0, 0, 0); acc = __builtin_amdgcn_mfma_f32_16x16x32_bf16(__builtin_bit_cast(bf16x8, al[ks]), hb[ks], acc, 0, 0, 0); } }
          if (kq < 2) *(LAS f32x4*)(part + ((kh * 64 + tile * 16 + m16) * 8 + 4 * kq)) = acc; }
        __syncthreads();
        if (tid < 64) { const int tl = tid, t = grp * 64 + tl; const f32x4 a0 = *(const LAS f32x4*)(part + tl * 8), a1 = *(const LAS f32x4*)(part + tl * 8 + 4), b0 = *(const LAS f32x4*)(part + (64 + tl) * 8), b1 = *(const LAS f32x4*)(part + (64 + tl) * 8 + 4);
            const float r = row_rscale(ss3, t);
            float lg[NE] = {(a0[0] + b0[0]) * r, (a0[1] + b0[1]) * r, (a0[2] + b0[2]) * r, (a0[3] + b0[3]) * r, (a1[0] + b1[0]) * r, (a1[1] + b1[1]) * r, (a1[2] + b1[2]) * r, (a1[3] + b1[3]) * r};
            int e1 = 0; float v1 = lg[0];
#pragma unroll
            for (int e = 1; e < NE; ++e) if (lg[e] > v1) { v1 = lg[e]; e1 = e; }
            int e2 = -1; float v2 = -INFINITY;
#pragma unroll
            for (int e = 0; e < NE; ++e) if (e != e1 && lg[e] > v2) { v2 = lg[e]; e2 = e; }
            if (e2 < 0) { e2 = (e1 == 0) ? 1 : 0; v2 = v1; }
            const float p1 = 1.0f / (1.0f + __expf(v2 - v1)), p2 = 1.0f - p1;
            te[2 * tl] = e1; te[2 * tl + 1] = e2; tp[2 * tl] = p1; tp[2 * tl + 1] = p2; trs[tl] = r;
            trank[2 * tl] = __hip_atomic_fetch_add(lcnt + e1, 1, __ATOMIC_RELAXED, __HIP_MEMORY_SCOPE_WORKGROUP); trank[2 * tl + 1] = __hip_atomic_fetch_add(lcnt + e2, 1, __ATOMIC_RELAXED, __HIP_MEMORY_SCOPE_WORKGROUP); }
        __syncthreads();
        if (tid < 8) lbase[tid] = atomicAdd(cnt + tid, lcnt[tid]);
        __syncthreads();
        if (tid < 128) { const int e = te[tid], pos = lbase[e] + trank[tid]; tokof[e * T + pos] = grp * 64 + (tid >> 1); gateof[e * T + pos] = tp[tid]; tslot[grp * 128 + tid] = e * T + pos;
            f32x4 rec; rec[0] = trs[tid >> 1]; rec[1] = __builtin_bit_cast(float, grp * 64 + (tid >> 1)); rec[2] = tp[tid]; rec[3] = 0.f; minfo[(size_t)e * T + pos] = rec; }
        __syncthreads();
    }
}

struct McTok { u32x4 h0, h1, a0, a1, b0, b1; const bf16_t* sa; const bf16_t* sb; int na, nb; };
__device__ __forceinline__ void mc_acc(f32x4 (&a)[4], const u32x4& v0, const u32x4& v1) {
    a[0][0] += bf2f(v0.x & 0xffffu); a[0][1] += __builtin_bit_cast(float, v0.x & 0xffff0000u); a[0][2] += bf2f(v0.y & 0xffffu); a[0][3] += __builtin_bit_cast(float, v0.y & 0xffff0000u);
    a[1][0] += bf2f(v0.z & 0xffffu); a[1][1] += __builtin_bit_cast(float, v0.z & 0xffff0000u); a[1][2] += bf2f(v0.w & 0xffffu); a[1][3] += __builtin_bit_cast(float, v0.w & 0xffff0000u);
    a[2][0] += bf2f(v1.x & 0xffffu); a[2][1] += __builtin_bit_cast(float, v1.x & 0xffff0000u); a[2][2] += bf2f(v1.y & 0xffffu); a[2][3] += __builtin_bit_cast(float, v1.y & 0xffff0000u);
    a[3][0] += bf2f(v1.z & 0xffffu); a[3][1] += __builtin_bit_cast(float, v1.z & 0xffff0000u); a[3][2] += bf2f(v1.w & 0xffffu); a[3][3] += __builtin_bit_cast(float, v1.w & 0xffff0000u);
}
__device__ __forceinline__ void phase_moecombine(const Ctx& C, const LAS int* tb, int p) {
    const int bid = C.bid, G = C.G; unsigned char* ws = C.ws(); float* out = C.out();
    const int* tslot = (const int*)(ws + WS_TSLOT); const bf16_t* y2 = (const bf16_t*)(ws + WS_ARENA + AR_Y2); const bf16_t* ypart = (const bf16_t*)(ws + WS_ARENA + AR_YPART); const bf16_t* h3 = (const bf16_t*)(ws + WS_ARENA + AR_H3B);
    const int lane = opaque_tid(C.wid) & 63, pn = lane >> 4, cl = (lane & 15) * 16; const int nwg = tb[8], base = (nwg / G) * G;
    const int t0 = bid * NWAVES + C.wid, stride = G * NWAVES;
    for (int tc = t0; tc < T; tc += 32 * stride) {
        const int nt = (T - tc + stride - 1) / stride < 32 ? (T - tc + stride - 1) / stride : 32;
        int code = 0; if ((lane >> 1) < nt) code = tslot[(tc + (lane >> 1) * stride) * 2 + (lane & 1)];
        auto issue = [&](int k) -> McTok { McTok m; const int t = tc + k * stride;
            { const u32x4* hp = (const u32x4*)(h3 + (size_t)t * D + lane * 16); m.h0 = hp[0]; m.h1 = hp[1]; }
            { const int c = __shfl(code, 2 * k), e = c / T, pos = c % T; const int wg = tb[e] + (pos >> 8) * 4 + pn;
              if (wg < base) { m.sa = y2 + (size_t)(tb[16 + e] + pos) * D + pn * 256 + cl; m.na = 1; } else { m.sa = ypart + ((size_t)(wg - base) * p * 256 + (pos & 255)) * 256 + cl; m.na = p; }
              m.a0 = *(const u32x4*)m.sa; m.a1 = *(const u32x4*)(m.sa + 8); }
            { const int c = __shfl(code, 2 * k + 1), e = c / T, pos = c % T; const int wg = tb[e] + (pos >> 8) * 4 + pn;
              if (wg < base) { m.sb = y2 + (size_t)(tb[16 + e] + pos) * D + pn * 256 + cl; m.nb = 1; } else { m.sb = ypart + ((size_t)(wg - base) * p * 256 + (pos & 255)) * 256 + cl; m.nb = p; }
              m.b0 = *(const u32x4*)m.sb; m.b1 = *(const u32x4*)(m.sb + 8); }
            return m; };
        McTok cur = issue(0);
        for (int k = 0; k < nt; ++k) {
            McTok nxt = cur; if (k + 1 < nt) nxt = issue(k + 1);
            f32x4 a[4];
#pragma unroll
            for (int i = 0; i < 4; ++i) { a[i][0] = 0.f; a[i][1] = 0.f; a[i][2] = 0.f; a[i][3] = 0.f; }
            mc_acc(a, cur.h0, cur.h1); mc_acc(a, cur.a0, cur.a1);
            for (int q = 1; q < cur.na; ++q) { const u32x4 v0 = *(const u32x4*)(cur.sa + (size_t)q * 65536), v1 = *(const u32x4*)(cur.sa + (size_t)q * 65536 + 8); mc_acc(a, v0, v1); }
            mc_acc(a, cur.b0, cur.b1);
            for (int q = 1; q < cur.nb; ++q) { const u32x4 v0 = *(const u32x4*)(cur.sb + (size_t)q * 65536), v1 = *(const u32x4*)(cur.sb + (size_t)q * 65536 + 8); mc_acc(a, v0, v1); }
            { f32x4* hp = (f32x4*)(out + (size_t)(tc + k * stride) * D + lane * 16); hp[0] = a[0]; hp[1] = a[1]; hp[2] = a[2]; hp[3] = a[3]; }
            cur = nxt;
        }
    }
}

__device__ __forceinline__ void moe_tables(LAS int* tb, const int* cnt, int nN, int wid) {
    if (opaque_tid(wid) == 0) { int cu = 0, off = 0; for (int e = 0; e < NE; ++e) { const int c = cnt[e]; tb[e] = cu; tb[16 + e] = off; tb[32 + e] = c; cu += ((c + 255) / 256) * nN; off += c; } tb[8] = cu; tb[24] = off; }
    __syncthreads();
}
template <class Epi, class Sched>
__device__ __forceinline__ void gemm_run(const Ctx& C, const bf16_t* A, int lda, const bf16_t* Bt, int K, const void* tblbase, const Sched& S, const Epi& E) { pg8::gemm_fast<Epi, Sched, true, false>(C.lds, A, lda * 2, Bt, K * 2, tblbase, S, E, C.wid, C.noepi, 0, 0); }
template <class Epi, class Sched>
__device__ __forceinline__ void gemm_run8(const Ctx& C, const void* A, int lda, const void* Bt, int K, const void* tblbase, const Sched& S, const Epi& E, int ea, int eb) { pg8::gemm_fast<Epi, Sched, true, true>(C.lds, A, lda, Bt, K, tblbase, S, E, C.wid, C.noepi, ea * 0x01010101, eb * 0x01010101); }

__global__ void __launch_bounds__(NTHREADS) fwd_megakernel(Params P) {
    extern __shared__ __attribute__((aligned(16))) unsigned char lds_raw[];
    Ctx C; C.lds = (LAS unsigned char*)lds_raw; C.wid = __builtin_amdgcn_readfirstlane(threadIdx.x >> 6); C.bid = blockIdx.x; C.G = gridDim.x;
    if (threadIdx.x < 25) { const unsigned long long v = (threadIdx.x < 23) ? (unsigned long long)P.in[threadIdx.x] : (threadIdx.x == 23 ? (unsigned long long)P.out : (unsigned long long)P.ws);
        ((LAS unsigned long long*)(C.lds + LDS_PTR))[threadIdx.x] = v; }
    if (threadIdx.x < 2) ((LAS unsigned*)(C.lds + LDS_BST))[threadIdx.x] = 0u;
    if (threadIdx.x == 2) { ((LAS unsigned*)(C.lds + LDS_BST))[4] = P.mask; ((LAS unsigned*)(C.lds + LDS_BST))[5] = (unsigned)P.probe; }
    if (threadIdx.x == 0) (void)xb_add((unsigned*)P.ws + CW_BAR + XB_XCNT(xb_xcc_id()), 1u);
    __syncthreads();
    if (P.ws == nullptr) cg::this_grid().sync();
    LAS int* tb = (LAS int*)(C.lds + LDS_TB);
#define WSP(T_, off) ((T_*)(C.ws() + (off)))
#define ARP(off) ((bf16_t*)(C.ws() + WS_ARENA + (off)))

    const unsigned mask = __builtin_amdgcn_readfirstlane(((const volatile LAS unsigned*)(C.lds + LDS_BST))[4]); const unsigned probev = __builtin_amdgcn_readfirstlane(((const volatile LAS unsigned*)(C.lds + LDS_BST))[5]); const bool probe = probev != 0u; C.noepi = (probev & 2u) != 0u;
#define PH(k) (mask & (1u << (k)))
#ifndef CVT_FIRST
#define CVT_FIRST 96
#endif
    float* d_f32 = (float*)(C.ws() + WS_ARENA); bf16_t* d_b16 = ARP((size_t)64 << 20); float* d_ss = (float*)(C.ws() + WS_ARENA + ((size_t)96 << 20));

    if (PH(0)) { phase_prep(C); grid_barrier(C); }
    if (PH(1)) { pg8::DenseOrder S; S.init(T, NPROJ, D, C.G, C.bid); pg8::EpiScaleBf16 E{ARP(AR_PROJ), NPROJ, WSP(float, WS_SS0)}; gemm_run(C, ARP(AR_XB), D, WSP(bf16_t, WS_WIN), D, WSP(float, WS_SS0), S, E); cvt_queue(C, 3, CV_NMOE + CV_IIN, CV_NMOE + CV_IIN + CV_IOUT + 2 * CV_IG); grid_barrier(C); }
    if (PH(2)) { phase_mixer(C); grid_barrier(C); }
    if (PH(3)) { pg8::DenseOrder S; S.init(T, D, D, C.G, C.bid); pg8::EpiResid<false, true> E{C.in(I_X), probe ? d_b16 : ARP(AR_H1B), (unsigned char*)ARP(AR_H18), probe ? d_ss : WSP(float, WS_SS1), C.lds, C.wid}; gemm_run(C, ARP(AR_Y), D, WSP(bf16_t, WS_WOUT), D, WSP(float, WS_SS0), S, E); grid_barrier(C); }
    if (PH(4)) { pg8::DenseOrder S; S.init(T, NGU, D / 2, C.G, C.bid); pg8::EpiSwiglu E{ARP(AR_ACT), FF, WSP(float, WS_SS1), nullptr, tb, false, true}; gemm_run8(C, ARP(AR_H18), D, WSP(unsigned char, WS_WGU), D, WSP(float, WS_SS1), S, E, 127, 121); cvt_queue(C, 4, CV_NMOE + CV_IIN + CV_IOUT + 2 * CV_IG, CV_NMOE + CV_NDENSE); grid_barrier(C); }
    if (PH(5)) { pg8::DenseOrder S; S.init(T, D, FF / 2, C.G, C.bid);
        pg8::EpiResid<true, false> E{ARP(AR_H1B), probe ? d_b16 : ARP(AR_H2B), nullptr, probe ? d_ss : WSP(float, WS_SS2), C.lds, C.wid}; gemm_run8(C, ARP(AR_ACT), FF, WSP(unsigned char, WS_WDN), FF, WSP(float, WS_SS0), S, E, 125, 121); grid_barrier(C); }
    if (PH(6)) { pg8::DenseOrder S; S.init(T, NQKV, D, C.G, C.bid); pg8::EpiQKV E{ARP(AR_QKV), C.in(I_OQN), C.in(I_OKN), WSP(float, WS_ROPE), WSP(float, WS_KMEAN), C.lds, C.wid}; gemm_run(C, ARP(AR_H2B), D, WSP(bf16_t, WS_WQKV), D, WSP(float, WS_SS2), S, E); grid_barrier(C); }
    if (PH(7)) { phase_qkprep(C); grid_barrier(C); }
    if (PH(8)) { phase_select(C, probe); grid_barrier(C); }
    if (PH(9)) { if (C.bid < CVT_FIRST) { cvt_queue(C, 1, 0, 2 * NE * CV_IMG); phase_attn(C, probe, probev); } else { phase_attn(C, probe, probev); cvt_queue(C, 1, 0, 2 * NE * CV_IMG); } grid_barrier(C); }
    if (PH(10)) { phase_combine(C); grid_barrier(C); }
    if (PH(11)) { pg8::DenseOrder S; S.init(T, D, D, C.G, C.bid); pg8::EpiResid<true, true> E{ARP(AR_H2B), probe ? d_b16 : ARP(AR_H3B), probe ? (unsigned char*)d_f32 : WSP(unsigned char, WS_H38), probe ? d_ss : WSP(float, WS_SS3), C.lds, C.wid}; gemm_run(C, ARP(AR_QKV), NQKV, WSP(bf16_t, WS_WO), D, WSP(float, WS_SS0), S, E); grid_barrier(C); }
    if (PH(12)) { phase_router(C, probe); grid_barrier(C); }
    if (PH(13)) { moe_tables(tb, WSP(int, WS_CTL), NGUE / 256, C.wid); pg8::MoeOrder S{tb, WSP(int, WS_TOKOF), NGUE / 256, C.G, C.bid, true, (size_t)NGUE * D / 2, D / 128, false};
        pg8::EpiSwiglu E{ARP(AR_MACT), FE, WSP(float, WS_SS3), WSP(int, WS_TOKOF), tb, true, false}; gemm_run8(C, WSP(unsigned char, WS_H38), D, WSP(unsigned char, WS_MGU), D, WSP(float, WS_MINFO), S, E, 127, 121); cvt_queue(C, 2, 2 * NE * CV_IMG, CV_NMOE); grid_barrier(C); }
    if (PH(14)) { moe_tables(tb, WSP(int, WS_CTL), D / 256, C.wid); pg8::MoeOrder S{tb, WSP(int, WS_TOKOF), D / 256, C.G, C.bid, false, (size_t)D * FE / 2, FE / 128, true};
        pg8::EpiMoeDown E{ARP(AR_Y2), ARP(AR_YPART), WSP(float, WS_GATEOF), tb, C.wid}; gemm_run8(C, ARP(AR_MACT), FE, WSP(unsigned char, WS_MDN), FE, WSP(float, WS_MINFO), S, E, 125, 121); grid_barrier(C); }
    if (PH(15) && !probe) { moe_tables(tb, WSP(int, WS_CTL), D / 256, C.wid); pg8::MoeOrder S{tb, WSP(int, WS_TOKOF), D / 256, C.G, C.bid, false, (size_t)D * FE / 2, FE / 128, true}; phase_moecombine(C, tb, S.pieces(tb[8])); }
}

extern "C" void kernel_launch(void* const* d_in, const int* in_sizes, int n_in, void* d_out, int out_size, void* d_ws, size_t ws_size, hipStream_t stream) {
    if (n_in != 23 || out_size != T * D || ws_size < WS_END) { fprintf(stderr, "kernel_launch: bad shapes n_in %d out %d ws %zu (need %zu)\n", n_in, out_size, ws_size, (size_t)WS_END); return; }
    static int grid_blocks = 0;
    if (!grid_blocks) {
        int dev = 0, cus = 0, per_cu = 0;
        (void)hipGetDevice(&dev); (void)hipDeviceGetAttribute(&cus, hipDeviceAttributeMultiprocessorCount, dev);
        (void)hipFuncSetAttribute((const void*)fwd_megakernel, hipFuncAttributeMaxDynamicSharedMemorySize, LDS_BYTES);
        (void)hipOccupancyMaxActiveBlocksPerMultiprocessor(&per_cu, (const void*)fwd_megakernel, NTHREADS, LDS_BYTES);
        if (per_cu < 1) { fprintf(stderr, "kernel_launch: occupancy query says %d blocks per CU\n", per_cu); per_cu = 1; }
        grid_blocks = cus * 1;
    }
    if (hipMemsetAsync((char*)d_ws + WS_CTL, 0, WS_CTLBYTES, stream) != hipSuccess) { fprintf(stderr, "kernel_launch: memset failed\n"); return; }
    Params p{};
    for (int i = 0; i < 23; ++i) p.in[i] = (const float*)d_in[i];
    p.out = (float*)d_out; p.ws = (unsigned char*)d_ws;
    p.mask = 0xffffu & ~(1u << 7); p.probe = 0;
    void* args[] = {&p};
    hipError_t e = hipLaunchCooperativeKernel((const void*)fwd_megakernel, dim3(grid_blocks), dim3(NTHREADS), args, LDS_BYTES, stream);
    if (e != hipSuccess) fprintf(stderr, "cooperative launch failed: %s (grid %d)\n", hipGetErrorString(e), grid_blocks);
#ifndef PROBE_MODE
#define PROBE_MODE 1
#endif
#ifdef PROBE_MASK
    (void)hipMemsetAsync((char*)d_ws + WS_CTL + 4096, 0, WS_CTLBYTES - 4096, stream);
    Params p2 = p; p2.mask = PROBE_MASK; p2.probe = PROBE_MODE; void* args2[] = {&p2};
    (void)hipLaunchCooperativeKernel((const void*)fwd_megakernel, dim3(grid_blocks), dim3(NTHREADS), args2, LDS_BYTES, stream);
#endif
}
```
